# Optimizing an MI355X kernel written in HIP

```python
import math
import jax, jax.numpy as jnp
from jax import lax
import numpy as np

D_MODEL = 2048
BATCH = 4
SEQ = 2048
DEPTH = 1
DEC_BATCH = 128
DEC_SEQ = 8
PAST_LEN = 16384
PAGE_SIZE = 128

MIX_WIDTH = D_MODEL
M_WIDTH = MIX_WIDTH // 2
M_HEADS = 4
M_DH = M_WIDTH // M_HEADS
G_WIDTH = MIX_WIDTH // 2
G_HEADS = 4
G_DK = G_WIDTH // 2 // G_HEADS
G_DV = G_WIDTH // G_HEADS
G_LOWRANK = 16
GLA_NORMALIZER = 16.0
D_FF = 11 * D_MODEL // 4
CONV_W = 3
CHUNK = 128
EPS = 1e-6
NEG_BIG = -1e30

kernel_name = "hybrid_mlstm_gla_convffn_step"


def _in_sizes():
    return (M_WIDTH, M_WIDTH, M_WIDTH, M_WIDTH,
            M_HEADS, M_HEADS,
            G_HEADS * G_DK, G_HEADS * G_DK,
            G_WIDTH, G_WIDTH,
            G_LOWRANK,
            D_MODEL, D_MODEL)


def _f32(a):
    return a.astype(jnp.float32)


def _rmsnorm(x, w):
    xf = _f32(x)
    return xf * lax.rsqrt(jnp.mean(xf * xf, axis=-1, keepdims=True) + EPS) * _f32(w)


def _to_chunks(a, n_chunks, length):
    return jnp.moveaxis(a.reshape((a.shape[0], n_chunks, length) + a.shape[2:]), 1, 0)


def _from_chunks(a):
    a = jnp.moveaxis(a, 0, 1)
    return a.reshape((a.shape[0], a.shape[1] * a.shape[2]) + a.shape[3:])


def _mlstm(q, k, v, i_raw, log_f, C0, n0, m0):
    T = q.shape[1]
    L = math.gcd(T, CHUNK)
    nc = T // L
    causal = jnp.tril(jnp.ones((L, L), dtype=bool))

    def step(carry, xs):
        C, n, m = carry
        qc, kc, vc, ic, fc = xs
        b = jnp.swapaxes(jnp.cumsum(fc, axis=1), 1, 2)
        it = jnp.swapaxes(ic, 1, 2)
        log_d = b[..., :, None] - b[..., None, :] + it[..., None, :]
        log_d = jnp.where(causal, log_d, NEG_BIG)
        inter = b + m[..., None]
        m_t = jnp.maximum(inter, jnp.max(log_d, axis=-1))
        d = jnp.exp(log_d - m_t[..., None])
        s = jnp.einsum('blhd,bshd->bhls', qc, kc) * d
        w_inter = jnp.exp(inter - m_t)
        num = (jnp.einsum('bhls,bshe->blhe', s, vc)
               + jnp.swapaxes(w_inter, 1, 2)[..., None] * jnp.einsum('blhd,bhde->blhe', qc, C))
        den = jnp.sum(s, axis=-1) + w_inter * jnp.einsum('blhd,bhd->bhl', qc, n)
        floor = jnp.maximum(jnp.abs(den), jnp.exp(-m_t))
        h = num / jnp.swapaxes(floor, 1, 2)[..., None]
        m_end = m_t[..., -1]
        w_end = jnp.exp(b[..., -1:] - b + it - m_end[..., None])
        decay = jnp.exp(b[..., -1] + m - m_end)
        C_new = decay[..., None, None] * C + jnp.einsum('bhl,blhd,blhe->bhde', w_end, kc, vc)
        n_new = decay[..., None] * n + jnp.einsum('bhl,blhd->bhd', w_end, kc)
        return (C_new, n_new, m_end), h

    xs = tuple(_to_chunks(a, nc, L) for a in (q, k, v, i_raw, log_f))
    (C, n, m), hs = lax.scan(step, (C0, n0, m0), xs)
    return _from_chunks(hs), C, n, m


def _gla(q, k, v, log_a, S0):
    T = q.shape[1]
    L = math.gcd(T, CHUNK)
    nc = T // L
    causal = jnp.tril(jnp.ones((L, L), dtype=bool))[None, :, :, None, None]

    def step(S, xs):
        qc, kc, vc, ac = xs
        b = jnp.cumsum(ac, axis=1)
        diff = b[:, :, None] - b[:, None, :]
        decay = jnp.where(causal, jnp.exp(jnp.minimum(diff, 0.0)), 0.0)
        a_mat = jnp.einsum('bthd,bshd,btshd->bhts', qc, kc, decay)
        o = (jnp.einsum('bhts,bshe->bthe', a_mat, vc)
             + jnp.einsum('bthd,bhde->bthe', qc * jnp.exp(b), S))
        b_end = b[:, -1]
        S_new = (jnp.exp(b_end)[..., None] * S
                 + jnp.einsum('bshd,bshe->bhde', kc * jnp.exp(b_end[:, None] - b), vc))
        return S_new, o

    xs = tuple(_to_chunks(a, nc, L) for a in (q, k, v, log_a))
    S, os_ = lax.scan(step, S0, xs)
    return _from_chunks(os_), S


def _head_norm(h, w):
    hn = h * lax.rsqrt(jnp.mean(h * h, axis=-1, keepdims=True) + EPS)
    return hn.reshape(h.shape[0], h.shape[1], -1) * _f32(w)


def _layer(x, C0, n0, m0, S0, conv0,
           w_in, mlstm_i_bias, mlstm_f_bias, gla_alpha_up, gla_alpha_bias,
           mlstm_head_norm_w, gla_head_norm_w, w_branch_a, w_branch_b, w_out,
           norm_mix_w, norm_ffn_w, ffn_w_up, ffn_w_gate, ffn_conv_w, ffn_conv_b, ffn_w_down):
    B, T, _ = x.shape
    x = _f32(x)
    h = _rmsnorm(x, norm_mix_w)
    proj = h @ _f32(w_in)
    split_at = np.cumsum(_in_sizes())[:-1].tolist()
    mq, mk, mv, mo, mi, mf, gq, gk, gv, gr, gal, gate_a, gate_b = jnp.split(proj, split_at, axis=-1)

    q_m = mq.reshape(B, T, M_HEADS, M_DH)
    k_m = mk.reshape(B, T, M_HEADS, M_DH) * (M_DH ** -0.5)
    v_m = mv.reshape(B, T, M_HEADS, M_DH)
    i_raw = mi + _f32(mlstm_i_bias)
    log_f = jax.nn.log_sigmoid(mf + _f32(mlstm_f_bias))
    h_m, C1, n1, m1 = _mlstm(q_m, k_m, v_m, i_raw, log_f, _f32(C0), _f32(n0), _f32(m0))
    y_m = _head_norm(h_m, mlstm_head_norm_w) * jax.nn.sigmoid(mo)

    q_g = gq.reshape(B, T, G_HEADS, G_DK) * (G_DK ** -0.5)
    k_g = gk.reshape(B, T, G_HEADS, G_DK)
    v_g = gv.reshape(B, T, G_HEADS, G_DV)
    log_a = jax.nn.log_sigmoid(gal @ _f32(gla_alpha_up) + _f32(gla_alpha_bias)) / GLA_NORMALIZER
    log_a = log_a.reshape(B, T, G_HEADS, G_DK)
    o_g, S1 = _gla(q_g, k_g, v_g, log_a, _f32(S0))
    y_g = _head_norm(o_g, gla_head_norm_w) * jax.nn.silu(gr)

    merged = (jax.nn.sigmoid(gate_a) * (y_m @ _f32(w_branch_a))
              + jax.nn.sigmoid(gate_b) * (y_g @ _f32(w_branch_b)))
    x = x + merged @ _f32(w_out)

    h2 = _rmsnorm(x, norm_ffn_w)
    u = h2 @ _f32(ffn_w_up)
    g = h2 @ _f32(ffn_w_gate)
    u_pad = jnp.concatenate([_f32(conv0), u], axis=1)
    cw = _f32(ffn_conv_w)
    uc = _f32(ffn_conv_b) + sum(cw[j] * u_pad[:, j:j + T] for j in range(CONV_W))
    x = x + (jax.nn.gelu(uc) * g) @ _f32(ffn_w_down)
    conv1 = u_pad[:, T:]
    return x, C1, n1, m1, S1, conv1


def setup_inputs(seed: int = 0) -> dict:
    key = jax.random.key(seed)
    ks = jax.random.split(key, 32)
    n_in = sum(_in_sizes())
    nrm = jax.random.normal
    f32 = jnp.float32
    return {
        "x_prompt": nrm(ks[0], (BATCH, SEQ, D_MODEL), f32),
        "x_sample": nrm(ks[1], (DEC_BATCH, DEC_SEQ, D_MODEL), f32),
        "state_mlstm_C": 0.05 * nrm(ks[2], (DEPTH, DEC_BATCH, M_HEADS, M_DH, M_DH), f32),
        "state_mlstm_n": 0.05 * nrm(ks[3], (DEPTH, DEC_BATCH, M_HEADS, M_DH), f32),
        "state_mlstm_m": nrm(ks[4], (DEPTH, DEC_BATCH, M_HEADS), f32),
        "state_gla_S": 0.05 * nrm(ks[5], (DEPTH, DEC_BATCH, G_HEADS, G_DK, G_DV), f32),
        "state_ffn_conv": nrm(ks[6], (DEPTH, DEC_BATCH, CONV_W - 1, D_FF), f32),
        "w_in": nrm(ks[7], (DEPTH, D_MODEL, n_in), f32) * D_MODEL ** -0.5,
        "mlstm_i_bias": 0.1 * nrm(ks[8], (DEPTH, M_HEADS), f32),
        "mlstm_f_bias": 3.0 + 0.5 * nrm(ks[9], (DEPTH, M_HEADS), f32),
        "gla_alpha_up": nrm(ks[10], (DEPTH, G_LOWRANK, G_HEADS * G_DK), f32) * G_LOWRANK ** -0.5,
        "gla_alpha_bias": 0.01 * nrm(ks[11], (DEPTH, G_HEADS * G_DK), f32),
        "mlstm_head_norm_w": 1.0 + 0.05 * nrm(ks[12], (DEPTH, M_WIDTH), f32),
        "gla_head_norm_w": 1.0 + 0.05 * nrm(ks[13], (DEPTH, G_WIDTH), f32),
        "w_branch_a": nrm(ks[14], (DEPTH, M_WIDTH, D_MODEL), f32) * M_WIDTH ** -0.5,
        "w_branch_b": nrm(ks[15], (DEPTH, G_WIDTH, D_MODEL), f32) * G_WIDTH ** -0.5,
        "w_out": nrm(ks[16], (DEPTH, D_MODEL, D_MODEL), f32) * D_MODEL ** -0.5,
        "norm_mix_w": 1.0 + 0.05 * nrm(ks[17], (DEPTH, D_MODEL), f32),
        "norm_ffn_w": 1.0 + 0.05 * nrm(ks[18], (DEPTH, D_MODEL), f32),
        "ffn_w_up": nrm(ks[19], (DEPTH, D_MODEL, D_FF), f32) * D_MODEL ** -0.5,
        "ffn_w_gate": nrm(ks[20], (DEPTH, D_MODEL, D_FF), f32) * D_MODEL ** -0.5,
        "ffn_conv_w": nrm(ks[21], (DEPTH, CONV_W, D_FF), f32) * CONV_W ** -0.5,
        "ffn_conv_b": 0.01 * nrm(ks[22], (DEPTH, D_FF), f32),
        "ffn_w_down": nrm(ks[23], (DEPTH, D_FF, D_MODEL), f32) * D_FF ** -0.5,
        "final_norm_w": 1.0 + 0.05 * nrm(ks[24], (D_MODEL,), f32),
    }


def reference(x_prompt, x_sample, state_mlstm_C, state_mlstm_n, state_mlstm_m, state_gla_S,
              state_ffn_conv, w_in, mlstm_i_bias, mlstm_f_bias, gla_alpha_up, gla_alpha_bias,
              mlstm_head_norm_w, gla_head_norm_w, w_branch_a, w_branch_b, w_out,
              norm_mix_w, norm_ffn_w, ffn_w_up, ffn_w_gate, ffn_conv_w, ffn_conv_b, ffn_w_down,
              final_norm_w):
    bp = x_prompt.shape[0]
    f32 = jnp.float32
    xp, xs = x_prompt, x_sample
    pC, pn, pm, pS, pconv = [], [], [], [], []
    sC, sn, sm, sS, sconv = [], [], [], [], []
    for l in range(DEPTH):
        params = (w_in[l], mlstm_i_bias[l], mlstm_f_bias[l], gla_alpha_up[l], gla_alpha_bias[l],
                  mlstm_head_norm_w[l], gla_head_norm_w[l], w_branch_a[l], w_branch_b[l], w_out[l],
                  norm_mix_w[l], norm_ffn_w[l], ffn_w_up[l], ffn_w_gate[l], ffn_conv_w[l],
                  ffn_conv_b[l], ffn_w_down[l])
        xp, C1, n1, m1, S1, cv1 = _layer(
            xp, jnp.zeros((bp, M_HEADS, M_DH, M_DH), f32), jnp.zeros((bp, M_HEADS, M_DH), f32),
            jnp.zeros((bp, M_HEADS), f32), jnp.zeros((bp, G_HEADS, G_DK, G_DV), f32),
            jnp.zeros((bp, CONV_W - 1, D_FF), f32), *params)
        pC.append(C1); pn.append(n1); pm.append(m1); pS.append(S1); pconv.append(cv1)
        xs, C2, n2, m2, S2, cv2 = _layer(
            xs, state_mlstm_C[l], state_mlstm_n[l], state_mlstm_m[l], state_gla_S[l],
            state_ffn_conv[l], *params)
        sC.append(C2); sn.append(n2); sm.append(m2); sS.append(S2); sconv.append(cv2)
    y_prompt = _rmsnorm(xp, final_norm_w).astype(x_prompt.dtype)
    y_sample = _rmsnorm(xs, final_norm_w).astype(x_sample.dtype)
    return (y_prompt, y_sample,
            jnp.stack(pC), jnp.stack(pn), jnp.stack(pm), jnp.stack(pS), jnp.stack(pconv),
            jnp.stack(sC), jnp.stack(sn), jnp.stack(sm), jnp.stack(sS), jnp.stack(sconv))
```

```cpp
#include <hip/hip_runtime.h>
#include <hip/hip_cooperative_groups.h>
#include <cstdio>
#include <cstdint>
namespace cg = cooperative_groups;

#ifndef MK_N_LAUNCHES
#define MK_N_LAUNCHES 1
#endif

namespace pg8 {
#define PG8_LAS __attribute__((address_space(3)))
typedef unsigned short bf16_t;
typedef short bf16x8 __attribute__((ext_vector_type(8)));
typedef float f32x4 __attribute__((ext_vector_type(4)));
typedef unsigned u32x4 __attribute__((ext_vector_type(4)));
constexpr int BM = 256, BK = 64, HALF = 128, HTB = HALF * BK * 2  , STAGE_BYTES = 8 * HTB, NXCD = 8, WGM = 8;

__host__ __device__ __forceinline__ int lds_byte(int r, int c) { const int st = (r >> 4) * 2 + (c >> 5), rr = r & 15, cc = c & 31, ob = rr * 64 + cc * 2; return st * 1024 + (ob ^ (((ob >> 9) & 1) << 5)); }
__host__ __device__ __forceinline__ void stage_rc(int b, int& R, int& C) { const int st = b / 1024, sb = b % 1024, swz = sb ^ (((sb >> 9) & 1) << 5); R = (st >> 1) * 16 + swz / 64; C = (st & 1) * 32 + (swz % 64) / 2; }
__host__ __device__ __forceinline__ int perm32(int rho) { const int n = rho >> 4, i = rho & 15; return 8 * (i >> 2) + 4 * n + (i & 3); }

struct Unit { int pm, pn, seg; };
struct Gemm { const bf16_t* A; const bf16_t* Bt; const bf16_t* A2; const bf16_t* Bt2; int M, N, K; };

struct StaticOrder {
    int nM, nN, nwg, G, c;
    __host__ __device__ void init(int M, int N, int G_, int c_) { nM = M / BM; nN = N / BM; nwg = nM * nN; G = G_; c = c_; }
    __host__ __device__ bool next(int i, Unit& u) const {
        const long L = (long)i * G + c; if (L >= nwg) return false;
        int wgid = (int)L; { const int q = nwg / NXCD, r = nwg % NXCD, xcd = wgid % NXCD, off = wgid / NXCD; wgid = (xcd < r ? xcd * (q + 1) : r * (q + 1) + (xcd - r) * q) + off; }
        const int nig = WGM * nN, gid = wgid / nig, fm = gid * WGM, gsz = (nM - fm) < WGM ? (nM - fm) : WGM;
        u.pm = fm + ((wgid % nig) % gsz); u.pn = (wgid % nig) / gsz; u.seg = 0; return true;
    }
};
struct TwoSegOrder {
    StaticOrder S;
    __host__ __device__ bool next(int i, Unit& u) const { if (!S.next(i >> 1, u)) return false; u.seg = i & 1; return true; }
};

__device__ __forceinline__ unsigned cvt_pk_bf16(float lo, float hi) { unsigned r; asm volatile("v_cvt_pk_bf16_f32 %0, %1, %2" : "=v"(r) : "v"(lo), "v"(hi)); return r; }

template <class Epi, class Sched, bool ALIGN_EPI = false, bool SP2 = false>
__device__ __forceinline__ void gemm_phase(PG8_LAS unsigned char* lds, const Gemm g, const Sched& S, const Epi& E) {
    const int tid = threadIdx.x, wid = __builtin_amdgcn_readfirstlane(tid >> 6), lane = tid & 63, wr = wid >> 2, wc = wid & 3, fr = lane & 15, fq = lane >> 4;
    const int K = g.K, nt = K / BK;
    unsigned voffA[2], voffB[2];
#pragma unroll
    for (int i = 0; i < 2; ++i) { int R, C; stage_rc(tid * 16 + i * 8192, R, C); const int Rb = Epi::PERM ? ((R & ~31) + perm32(R & 31)) : R;
        voffA[i] = (unsigned)(R * K + C) * 2u; voffB[i] = (unsigned)(Rb * K + C) * 2u; }
    const size_t kstep = (size_t)(BK * 2);
    const size_t hstep = (size_t)HALF * K * 2;
    const size_t tstep = 2 * hstep;
    const unsigned ldsw = (unsigned)wid * 1024u;
    const int aoff = lds_byte(wr * 64 + fr, fq * 8), boff = lds_byte(wc * 32 + fr, fq * 8);
#define PG8_SA(b, h) (((b) * 2 + (h)) * HTB)
#define PG8_SB(b, h) ((4 + (b) * 2 + (h)) * HTB)
#define PG8_STAGE(bufoff, gbase, voff) do { _Pragma("unroll") for (int _i = 0; _i < 2; ++_i) \
        __builtin_amdgcn_global_load_lds((const unsigned*)((const char*)(gbase) + (voff)[_i]), (PG8_LAS unsigned*)(lds + (bufoff) + ldsw + _i * 8192), 16, 0, 0); } while (0)
#define PG8_LDA(dst, b, h) do { _Pragma("unroll") for (int m = 0; m < 4; ++m) _Pragma("unroll") for (int k = 0; k < 2; ++k) dst[m][k] = *(const PG8_LAS bf16x8*)(lds + PG8_SA(b, h) + aoff + m * 2048 + k * 1024); } while (0)
#define PG8_LDB(dst, b, h) do { _Pragma("unroll") for (int n = 0; n < 2; ++n) _Pragma("unroll") for (int k = 0; k < 2; ++k) dst[n][k] = *(const PG8_LAS bf16x8*)(lds + PG8_SB(b, h) + boff + n * 2048 + k * 1024); } while (0)
#define PG8_MMA(ai, bj, At, Bt) do { __builtin_amdgcn_s_setprio(1); _Pragma("unroll") for (int m = 0; m < 4; ++m) _Pragma("unroll") for (int n = 0; n < 2; ++n) _Pragma("unroll") for (int k = 0; k < 2; ++k) \
        acc[ai][bj][m][n] = __builtin_amdgcn_mfma_f32_16x16x32_bf16(Bt[n][k], At[m][k], acc[ai][bj][m][n], 0, 0, 0); __builtin_amdgcn_s_setprio(0); } while (0)
#define PG8_WAIT_V(n) asm volatile("s_waitcnt vmcnt(" #n ")" ::: "memory")
#define PG8_WAIT_L(n) asm volatile("s_waitcnt lgkmcnt(" #n ")" ::: "memory")
#define PG8_BAR __builtin_amdgcn_s_barrier()
#define PG8_SCHED __builtin_amdgcn_sched_barrier(0)
    Unit cur, nxt; int ui = 0;
    if (!S.next(0, cur)) return;
    f32x4 acc[2][2][4][2];
#pragma unroll
    for (int a = 0; a < 2; ++a)
#pragma unroll
        for (int b = 0; b < 2; ++b)
#pragma unroll
            for (int m = 0; m < 4; ++m)
#pragma unroll
                for (int n = 0; n < 2; ++n) acc[a][b][m][n] = (f32x4){0.f, 0.f, 0.f, 0.f};
    bf16x8 At[4][2], B0[2][2], B1[2][2];
    const char* cA = (const char*)(cur.seg ? g.A2 : g.A) + (size_t)cur.pm * tstep; const char* cB = (const char*)(cur.seg ? g.Bt2 : g.Bt) + (size_t)cur.pn * tstep;
    if constexpr (SP2) {
        PG8_STAGE(PG8_SB(0, 0), cB, voffB); PG8_STAGE(PG8_SB(0, 1), cB + hstep, voffB); PG8_STAGE(PG8_SA(0, 0), cA, voffA); PG8_STAGE(PG8_SA(0, 1), cA + hstep, voffA);
        if (wr == 1) PG8_BAR;
        PG8_WAIT_V(2); PG8_BAR;
        PG8_STAGE(PG8_SB(1, 0), cB + kstep, voffB); PG8_STAGE(PG8_SA(1, 0), cA + kstep, voffA); PG8_STAGE(PG8_SB(1, 1), cB + hstep + kstep, voffB);
        PG8_WAIT_V(6); PG8_BAR;
    } else {
        PG8_STAGE(PG8_SB(0, 0), cB, voffB); PG8_STAGE(PG8_SA(0, 0), cA, voffA); PG8_STAGE(PG8_SB(0, 1), cB + hstep, voffB); PG8_STAGE(PG8_SA(0, 1), cA + hstep, voffA);
        if (wr == 1) PG8_BAR;
        PG8_WAIT_V(4); PG8_BAR;
        PG8_STAGE(PG8_SB(1, 0), cB + kstep, voffB); PG8_STAGE(PG8_SA(1, 0), cA + kstep, voffA); PG8_STAGE(PG8_SB(1, 1), cB + hstep + kstep, voffB);
        PG8_WAIT_V(6); PG8_BAR;
    }
    for (;;) {
        const bool has_next = S.next(ui + 1, nxt);
        const char* nA = has_next ? (const char*)(nxt.seg ? g.A2 : g.A) + (size_t)nxt.pm * tstep : cA; const char* nB = has_next ? (const char*)(nxt.seg ? g.Bt2 : g.Bt) + (size_t)nxt.pn * tstep : cB;
        for (int t = 0; t < nt; t += 2) {
            const bool last = (t == nt - 2);
            const char* a1 = cA + (size_t)(t + 1) * kstep;
            const char* a2 = last ? nA : cA + (size_t)(t + 2) * kstep; const char* b2 = last ? nB : cB + (size_t)(t + 2) * kstep;
            const char* a3 = a2 + kstep; const char* b3 = b2 + kstep;
            if constexpr (SP2) {
            PG8_LDB(B0, 0, 0); PG8_LDB(B1, 0, 1); PG8_SCHED; PG8_LDA(At, 0, 0); PG8_STAGE(PG8_SA(1, 1), a1 + hstep, voffA);
            PG8_WAIT_V(8); PG8_WAIT_L(0); PG8_BAR; PG8_MMA(0, 0, At, B0); PG8_MMA(0, 1, At, B1); PG8_BAR; PG8_SCHED;
            PG8_LDA(At, 0, 1); PG8_STAGE(PG8_SB(0, 0), b2, voffB); PG8_STAGE(PG8_SB(0, 1), b2 + hstep, voffB); PG8_STAGE(PG8_SA(0, 0), a2, voffA);
            PG8_WAIT_V(8); PG8_WAIT_L(0); PG8_BAR; PG8_MMA(1, 0, At, B0); PG8_MMA(1, 1, At, B1); PG8_BAR; PG8_SCHED;
            PG8_LDB(B0, 1, 0); PG8_LDB(B1, 1, 1); PG8_SCHED; PG8_LDA(At, 1, 0); PG8_STAGE(PG8_SA(0, 1), a2 + hstep, voffA);
            PG8_WAIT_V(8); PG8_WAIT_L(0); PG8_BAR; PG8_MMA(0, 0, At, B0); PG8_MMA(0, 1, At, B1); PG8_BAR; PG8_SCHED;
            PG8_LDA(At, 1, 1); PG8_STAGE(PG8_SB(1, 0), b3, voffB); PG8_STAGE(PG8_SB(1, 1), b3 + hstep, voffB); PG8_STAGE(PG8_SA(1, 0), a3, voffA);
            PG8_WAIT_V(8); PG8_WAIT_L(0); PG8_BAR; PG8_MMA(1, 0, At, B0); PG8_MMA(1, 1, At, B1); PG8_BAR; PG8_SCHED;
            } else {
            PG8_LDB(B0, 0, 0); PG8_SCHED; PG8_LDA(At, 0, 0); PG8_STAGE(PG8_SA(1, 1), a1 + hstep, voffA);
            PG8_WAIT_L(8); PG8_BAR; PG8_WAIT_L(0); PG8_MMA(0, 0, At, B0); PG8_BAR; PG8_SCHED;
            PG8_LDB(B1, 0, 1); PG8_STAGE(PG8_SB(0, 0), b2, voffB);
            PG8_BAR; PG8_WAIT_L(0); PG8_MMA(0, 1, At, B1); PG8_BAR;
            PG8_LDA(At, 0, 1); PG8_STAGE(PG8_SA(0, 0), a2, voffA);
            PG8_BAR; PG8_WAIT_L(0); PG8_MMA(1, 0, At, B0); PG8_BAR; PG8_SCHED;
            PG8_STAGE(PG8_SB(0, 1), b2 + hstep, voffB);
            PG8_WAIT_V(6); PG8_BAR; PG8_MMA(1, 1, At, B1); PG8_BAR;
            PG8_LDB(B0, 1, 0); PG8_SCHED; PG8_LDA(At, 1, 0); PG8_STAGE(PG8_SA(0, 1), a2 + hstep, voffA);
            PG8_WAIT_L(8); PG8_BAR; PG8_WAIT_L(0); PG8_MMA(0, 0, At, B0); PG8_BAR; PG8_SCHED;
            PG8_LDB(B1, 1, 1); PG8_STAGE(PG8_SB(1, 0), b3, voffB);
            PG8_BAR; PG8_WAIT_L(0); PG8_MMA(0, 1, At, B1); PG8_BAR;
            PG8_LDA(At, 1, 1); PG8_STAGE(PG8_SA(1, 0), a3, voffA);
            PG8_BAR; PG8_WAIT_L(0); PG8_MMA(1, 0, At, B0); PG8_BAR; PG8_SCHED;
            PG8_STAGE(PG8_SB(1, 1), b3 + hstep, voffB);
            PG8_WAIT_V(6); PG8_BAR; PG8_MMA(1, 1, At, B1); PG8_BAR;
            }
        }
        if constexpr (ALIGN_EPI) { if (wr == 0) PG8_BAR; }
        E(acc, cur, wr, wc, fr, fq);
        if (!has_next) break;
        if (nxt.seg == 0)
#pragma unroll
        for (int a = 0; a < 2; ++a)
#pragma unroll
            for (int b = 0; b < 2; ++b)
#pragma unroll
                for (int m = 0; m < 4; ++m)
#pragma unroll
                    for (int n = 0; n < 2; ++n) acc[a][b][m][n] = (f32x4){0.f, 0.f, 0.f, 0.f};
        cur = nxt; cA = nA; cB = nB; ++ui;
        if constexpr (ALIGN_EPI) { if (wr == 1) PG8_BAR; }
    }
    PG8_WAIT_V(0);
    if constexpr (!ALIGN_EPI) { if (wr == 0) PG8_BAR; }
    PG8_BAR;
#undef PG8_SA
#undef PG8_SB
#undef PG8_STAGE
#undef PG8_LDA
#undef PG8_LDB
#undef PG8_MMA
#undef PG8_WAIT_V
#undef PG8_WAIT_L
#undef PG8_BAR
#undef PG8_SCHED
}
}

#define LAS __attribute__((address_space(3)))
typedef unsigned short bf16;
typedef short bf16x8 __attribute__((ext_vector_type(8)));
typedef float f32x4 __attribute__((ext_vector_type(4)));
typedef unsigned u32x4 __attribute__((ext_vector_type(4)));
typedef unsigned u32x2 __attribute__((ext_vector_type(2)));
using pg8::cvt_pk_bf16;

constexpr int NWAVES = 8, NTHR = 512;
constexpr int DM = 2048, MP = 8192, MS = 1024, MT = 9216, TP = 2048, TS = 8;
constexpr int NIN = 11288, NPROJ = 11264, NPROJ_PAD = 11520, DFF = 5632;
constexpr int C_MQ = 0, C_MK = 1024, C_MV = 2048, C_MO = 3072, C_GQ = 4096, C_GK = 4608, C_GV = 5120, C_GR = 6144, C_GA = 7168, C_GB = 9216;
constexpr float EPS = 1e-6f;
constexpr int NCH = 16;
constexpr int LDS_BYTES = 147456;

constexpr size_t O_YP = 0, O_YS = 16777216, O_PC = 18874368, O_PN = 19922944, O_PM = 19927040, O_PS = 19927056, O_PCONV = 20451344,
                 O_SC = 20496400, O_SN = 54050832, O_SM = 54181904, O_SS = 54182416, O_SCONV = 70959632;

constexpr size_t MiB = 1u << 20;
constexpr size_t WS_GATES = 64 * 1024;
constexpr size_t WS_PART = WS_GATES + (size_t)MT * 32 * 4;
constexpr size_t WS_DN = WS_PART + (size_t)MT * 32 * 4;
constexpr size_t WS_NPREV = WS_DN + 256 * 256 * 4;
constexpr size_t WS_CHS = WS_NPREV + 256 * 256 * 2;
constexpr size_t WS_BEND = WS_CHS + 256 * 2 * 4;
static_assert(WS_BEND + 256 * 128 * 4 <= 4 * MiB, "small region");
constexpr size_t WS_WIN = 4 * MiB;
constexpr size_t WS_WA = WS_WIN + (size_t)NPROJ_PAD * DM * 2;
constexpr size_t WS_WB = WS_WA + (size_t)2048 * 1024 * 2;
constexpr size_t WS_WO = WS_WB + (size_t)2048 * 1024 * 2;
constexpr size_t WS_WUG = WS_WO + (size_t)2048 * 2048 * 2;
constexpr size_t WS_WD = WS_WUG + (size_t)2 * DFF * DM * 2;
constexpr size_t WS_R1 = WS_WD + (size_t)DM * DFF * 2;
static_assert(WS_R1 == 131 * MiB, "map");
constexpr size_t WS_XN = WS_R1;
constexpr size_t WS_X1W = WS_R1 + 36 * MiB;
constexpr size_t WS_X1 = WS_R1 + 72 * MiB;
constexpr size_t WS_DC = WS_R1;
constexpr size_t WS_DS = WS_R1 + 64 * MiB;
constexpr size_t WS_CT = WS_R1 + 96 * MiB;
constexpr size_t WS_ST = WS_R1 + 128 * MiB;
constexpr size_t WS_YM = WS_R1 + 144 * MiB;
constexpr size_t WS_YG = WS_YM + 18 * MiB;
constexpr size_t WS_PROJ = WS_YG + 18 * MiB;
constexpr size_t WS_U = WS_PROJ, WS_G = WS_PROJ + 99 * MiB;
constexpr size_t WS_END = WS_PROJ + 198 * MiB;
static_assert(WS_END == 509 * MiB, "map");

struct Args {
    const float* in[25]; float* out; unsigned char* ws; int ph_lo, ph_hi;
};
enum { I_XP = 0, I_XS, I_C, I_N, I_M, I_S, I_CONV, I_WIN, I_BI, I_BF, I_AUP, I_AB, I_MHW, I_GHW, I_WA, I_WB, I_WO, I_NMIX, I_NFFN, I_WUP, I_WGATE, I_CW, I_CB, I_WDOWN, I_FNW };

__device__ __forceinline__ float bf2f(unsigned short b) { return __builtin_bit_cast(float, (unsigned)b << 16); }
__device__ __forceinline__ float bflo(unsigned w) { return __builtin_bit_cast(float, w << 16); }
__device__ __forceinline__ float bfhi(unsigned w) { return __builtin_bit_cast(float, w & 0xffff0000u); }
__device__ __forceinline__ unsigned short f2bf(float f) { return (unsigned short)(cvt_pk_bf16(f, 0.f) & 0xffffu); }
__device__ __forceinline__ float logsig(float z) { return fminf(z, 0.f) - log1pf(__expf(-fabsf(z))); }
__device__ __forceinline__ float sigm(float z) { return 1.f / (1.f + __expf(-z)); }
__device__ __forceinline__ float wave_sum(float v) {
#pragma unroll
    for (int o = 1; o < 64; o <<= 1) v += __shfl_xor(v, o);
    return v;
}
__device__ __forceinline__ float wave_max(float v) {
#pragma unroll
    for (int o = 1; o < 64; o <<= 1) v = fmaxf(v, __shfl_xor(v, o));
    return v;
}
__device__ __forceinline__ float sum4(f32x4 v) { return (v.x + v.y) + (v.z + v.w); }
__device__ __forceinline__ float dot4(f32x4 a, f32x4 b) { return (a.x * b.x + a.y * b.y) + (a.z * b.z + a.w * b.w); }
__device__ __forceinline__ float gelu_tanh(float v) { const float u = 0.7978845608028654f * (v + 0.044715f * v * v * v); return v * sigm(2.f * u); }

typedef f32x4 AccT[2][2][4][2];
struct EpiProj {
    static constexpr bool PERM = true;
    bf16* P; float* gates;
    __device__ __forceinline__ void operator()(AccT& acc, const pg8::Unit& u, int wr, int wc, int fr, int fq) const {
        const int row0 = u.pm * 256 + wr * 64 + fr;
        if (u.pn < 44) {
            const int col0 = u.pn * 256 + wc * 32 + 8 * fq;
#pragma unroll
            for (int ai = 0; ai < 2; ++ai)
#pragma unroll
                for (int m = 0; m < 4; ++m) { bf16* rowp = P + (size_t)(row0 + ai * 128 + m * 16) * NPROJ + col0;
#pragma unroll
                    for (int bj = 0; bj < 2; ++bj) { const f32x4 v0 = acc[ai][bj][m][0], v1 = acc[ai][bj][m][1]; u32x4 w;
                        w.x = cvt_pk_bf16(v0[0], v0[1]); w.y = cvt_pk_bf16(v0[2], v0[3]); w.z = cvt_pk_bf16(v1[0], v1[1]); w.w = cvt_pk_bf16(v1[2], v1[3]);
                        *(u32x4*)(rowp + bj * 128) = w; } }
        } else if (wc == 0) {
#pragma unroll
            for (int ai = 0; ai < 2; ++ai)
#pragma unroll
                for (int m = 0; m < 4; ++m) { float* rowp = gates + (size_t)(row0 + ai * 128 + m * 16) * 32 + 8 * fq;
                    *(f32x4*)rowp = acc[ai][0][m][0]; *(f32x4*)(rowp + 4) = acc[ai][0][m][1]; }
        }
    }
};
struct EpiBranch {
    static constexpr bool PERM = true;
    const bf16* P; bf16* O;
    __device__ __forceinline__ void operator()(AccT& acc, const pg8::Unit& u, int wr, int wc, int fr, int fq) const {
        const int row0 = u.pm * 256 + wr * 64 + fr, col0 = u.pn * 256 + wc * 32 + 8 * fq;
#pragma unroll
        for (int ai = 0; ai < 2; ++ai)
#pragma unroll
            for (int m = 0; m < 4; ++m) { const int row = row0 + ai * 128 + m * 16;
#pragma unroll
                for (int bj = 0; bj < 2; ++bj) { const int col = col0 + bj * 128;
                    const u32x4 ga = *(const u32x4*)(P + (size_t)row * NPROJ + C_GA + col), gb = *(const u32x4*)(P + (size_t)row * NPROJ + C_GB + col);
                    float fa[8] = {bflo(ga.x), bfhi(ga.x), bflo(ga.y), bfhi(ga.y), bflo(ga.z), bfhi(ga.z), bflo(ga.w), bfhi(ga.w)};
                    float fb[8] = {bflo(gb.x), bfhi(gb.x), bflo(gb.y), bfhi(gb.y), bflo(gb.z), bfhi(gb.z), bflo(gb.w), bfhi(gb.w)};
                    if (u.seg == 0) {
#pragma unroll
                        for (int i = 0; i < 8; ++i) { const float r = (1.f + __expf(-fb[i])) / (1.f + __expf(-fa[i])); acc[ai][bj][m][i >> 2][i & 3] *= r; }
                    } else {
                        float o[8];
#pragma unroll
                        for (int i = 0; i < 8; ++i) o[i] = acc[ai][bj][m][i >> 2][i & 3] * sigm(fb[i]);
                        u32x4 w; w.x = cvt_pk_bf16(o[0], o[1]); w.y = cvt_pk_bf16(o[2], o[3]); w.z = cvt_pk_bf16(o[4], o[5]); w.w = cvt_pk_bf16(o[6], o[7]);
                        *(u32x4*)(O + (size_t)row * DM + col) = w;
                    } } }
    }
};
struct EpiOut {
    static constexpr bool PERM = true;
    const float* xp; const float* xs; float* X1; bf16* X1W; const float* nw; float* part;
    __device__ __forceinline__ void operator()(AccT& acc, const pg8::Unit& u, int wr, int wc, int fr, int fq) const {
        const int row0 = u.pm * 256 + wr * 64 + fr, col0 = u.pn * 256 + wc * 32 + 8 * fq;
#pragma unroll
        for (int ai = 0; ai < 2; ++ai)
#pragma unroll
            for (int m = 0; m < 4; ++m) { const int row = row0 + ai * 128 + m * 16;
                const float* xrow = row < MP ? xp + (size_t)row * DM : xs + (size_t)(row - MP) * DM;
                float ss = 0.f;
#pragma unroll
                for (int bj = 0; bj < 2; ++bj) { const int col = col0 + bj * 128;
                    const f32x4 v0 = acc[ai][bj][m][0] + *(const f32x4*)(xrow + col), v1 = acc[ai][bj][m][1] + *(const f32x4*)(xrow + col + 4);
                    *(f32x4*)(X1 + (size_t)row * DM + col) = v0; *(f32x4*)(X1 + (size_t)row * DM + col + 4) = v1;
                    ss += dot4(v0, v0) + dot4(v1, v1);
                    const f32x4 w0 = *(const f32x4*)(nw + col), w1 = *(const f32x4*)(nw + col + 4);
                    u32x4 w; w.x = cvt_pk_bf16(v0[0] * w0[0], v0[1] * w0[1]); w.y = cvt_pk_bf16(v0[2] * w0[2], v0[3] * w0[3]);
                    w.z = cvt_pk_bf16(v1[0] * w1[0], v1[1] * w1[1]); w.w = cvt_pk_bf16(v1[2] * w1[2], v1[3] * w1[3]);
                    *(u32x4*)(X1W + (size_t)row * DM + col) = w; }
                ss += __shfl_xor(ss, 16); ss += __shfl_xor(ss, 32);
                if (fq == 0) part[(size_t)row * 32 + u.pn * 4 + wc] = ss; }
    }
};
__device__ __forceinline__ float row_rstd(const float* part, int row, int fq) {
    const f32x4 a = *(const f32x4*)(part + (size_t)row * 32 + fq * 8), b = *(const f32x4*)(part + (size_t)row * 32 + fq * 8 + 4);
    float s = sum4(a) + sum4(b); s += __shfl_xor(s, 16); s += __shfl_xor(s, 32);
    return rsqrtf(s * (1.f / DM) + EPS);
}
struct EpiUG {
    static constexpr bool PERM = true;
    const float* part; bf16* U; bf16* G; float* out;
    __device__ __forceinline__ void operator()(AccT& acc, const pg8::Unit& u, int wr, int wc, int fr, int fq) const {
        const int row0 = u.pm * 256 + wr * 64 + fr, col = u.pn * 128 + wc * 32 + 8 * fq;
#pragma unroll
        for (int ai = 0; ai < 2; ++ai)
#pragma unroll
            for (int m = 0; m < 4; ++m) { const int row = row0 + ai * 128 + m * 16;
                const float r = row_rstd(part, row, fq);
                const f32x4 u0 = acc[ai][0][m][0] * r, u1 = acc[ai][0][m][1] * r, g0 = acc[ai][1][m][0] * r, g1 = acc[ai][1][m][1] * r;
                u32x4 w; w.x = cvt_pk_bf16(u0[0], u0[1]); w.y = cvt_pk_bf16(u0[2], u0[3]); w.z = cvt_pk_bf16(u1[0], u1[1]); w.w = cvt_pk_bf16(u1[2], u1[3]);
                *(u32x4*)(U + (size_t)row * DFF + col) = w;
                w.x = cvt_pk_bf16(g0[0], g0[1]); w.y = cvt_pk_bf16(g0[2], g0[3]); w.z = cvt_pk_bf16(g1[0], g1[1]); w.w = cvt_pk_bf16(g1[2], g1[3]);
                *(u32x4*)(G + (size_t)row * DFF + col) = w;
                float* cs = nullptr;
                if (row < MP) { const int t = row & (TP - 1); if (t >= TP - 2) cs = out + O_PCONV + ((size_t)(row >> 11) * 2 + (t - (TP - 2))) * DFF + col; }
                else { const int rr = row - MP, t = rr & 7; if (t >= 6) cs = out + O_SCONV + ((size_t)(rr >> 3) * 2 + (t - 6)) * DFF + col; }
                if (cs) { *(f32x4*)cs = u0; *(f32x4*)(cs + 4) = u1; } }
    }
};
struct EpiDown {
    static constexpr bool PERM = true;
    const float* X1; float* out; float* part;
    __device__ __forceinline__ void operator()(AccT& acc, const pg8::Unit& u, int wr, int wc, int fr, int fq) const {
        const int row0 = u.pm * 256 + wr * 64 + fr, col0 = u.pn * 256 + wc * 32 + 8 * fq;
#pragma unroll
        for (int ai = 0; ai < 2; ++ai)
#pragma unroll
            for (int m = 0; m < 4; ++m) { const int row = row0 + ai * 128 + m * 16; float ss = 0.f;
#pragma unroll
                for (int bj = 0; bj < 2; ++bj) { const int col = col0 + bj * 128;
                    const f32x4 v0 = acc[ai][bj][m][0] + *(const f32x4*)(X1 + (size_t)row * DM + col), v1 = acc[ai][bj][m][1] + *(const f32x4*)(X1 + (size_t)row * DM + col + 4);
                    *(f32x4*)(out + (size_t)row * DM + col) = v0; *(f32x4*)(out + (size_t)row * DM + col + 4) = v1;
                    ss += dot4(v0, v0) + dot4(v1, v1); }
                ss += __shfl_xor(ss, 16); ss += __shfl_xor(ss, 32);
                if (fq == 0) part[(size_t)row * 32 + u.pn * 4 + wc] = ss; }
    }
};

template <class ColPtr>
__device__ __forceinline__ void transpose_item(const ColPtr& cp, int K, int srcN, bf16* WT, LAS float* scr, int kb, int nb, int lane) {
    const int k0 = 64 * kb, n0 = 32 * nb;
    const float* src = cp(n0 + (lane & 31));
#pragma unroll 8
    for (int i = 0; i < 32; ++i) { const int kk = 2 * i + (lane >> 5); scr[kk * 33 + (lane & 31)] = src ? src[(size_t)(k0 + kk) * srcN] : 0.f; }
    asm volatile("s_waitcnt lgkmcnt(0)" ::: "memory");
    const int c = lane & 7;
#pragma unroll
    for (int j = 0; j < 4; ++j) { const int n = (lane >> 3) + 8 * j; const LAS float* s = scr + (8 * c) * 33 + n;
        u32x4 o; o.x = cvt_pk_bf16(s[0 * 33], s[1 * 33]); o.y = cvt_pk_bf16(s[2 * 33], s[3 * 33]); o.z = cvt_pk_bf16(s[4 * 33], s[5 * 33]); o.w = cvt_pk_bf16(s[6 * 33], s[7 * 33]);
        *(u32x4*)(WT + (size_t)(n0 + n) * K + k0 + 8 * c) = o; }
    asm volatile("s_waitcnt lgkmcnt(0)" ::: "memory");
}
struct ColWin { const float* W; __device__ __forceinline__ const float* operator()(int n) const {
    int c; if (n < 4096) c = n; else if (n < 7168) c = n + 8; else if (n < 11264) c = n + 24; else if (n < 11272) c = 4096 + (n - 11264); else if (n < 11288) c = 7176 + (n - 11272); else return nullptr;
    return W + c; } };
struct ColPlain { const float* W; __device__ __forceinline__ const float* operator()(int n) const { return W + n; } };
struct ColUG { const float* Wu; const float* Wg; __device__ __forceinline__ const float* operator()(int n) const { const int pn = n >> 8, w = n & 255; return w < 128 ? Wu + pn * 128 + w : Wg + pn * 128 + (w - 128); } };

__device__ __forceinline__ void p0_prologue(const Args& a, LAS unsigned char* lds, int vcu, int G) {
    const int tid = threadIdx.x, lane = tid & 63, wave = __builtin_amdgcn_readfirstlane(tid >> 6);
    LAS float* scr = (LAS float*)(lds + wave * 16384);
    const int gw = vcu * NWAVES + wave, NGW = G * NWAVES;
    unsigned char* ws = a.ws;
    constexpr int I_WIN_ = 32 * (NPROJ_PAD / 32), I_A = 16 * 64, I_O = 32 * 64, I_UG = 32 * (2 * DFF / 32), I_D = (DFF / 64) * 64;
    constexpr int NITEMS = I_WIN_ + 2 * I_A + I_O + I_UG + I_D;
    for (int it = gw; it < NITEMS; it += NGW) {
        int r = it;
        if (r < I_WIN_) { ColWin cp{a.in[I_WIN]}; const int nblk = NPROJ_PAD / 32; transpose_item(cp, DM, NIN, (bf16*)(ws + WS_WIN), scr, r / nblk, r % nblk, lane); continue; } r -= I_WIN_;
        if (r < I_A) { ColPlain cp{a.in[I_WA]}; transpose_item(cp, 1024, DM, (bf16*)(ws + WS_WA), scr, r / 64, r % 64, lane); continue; } r -= I_A;
        if (r < I_A) { ColPlain cp{a.in[I_WB]}; transpose_item(cp, 1024, DM, (bf16*)(ws + WS_WB), scr, r / 64, r % 64, lane); continue; } r -= I_A;
        if (r < I_O) { ColPlain cp{a.in[I_WO]}; transpose_item(cp, DM, DM, (bf16*)(ws + WS_WO), scr, r / 64, r % 64, lane); continue; } r -= I_O;
        if (r < I_UG) { ColUG cp{a.in[I_WUP], a.in[I_WGATE]}; const int nblk = 2 * DFF / 32; transpose_item(cp, DM, DFF, (bf16*)(ws + WS_WUG), scr, r / nblk, r % nblk, lane); continue; } r -= I_UG;
        { ColPlain cp{a.in[I_WDOWN]}; transpose_item(cp, DFF, DM, (bf16*)(ws + WS_WD), scr, r / 64, r % 64, lane); }
    }
    const float* nw = a.in[I_NMIX]; bf16* XN = (bf16*)(ws + WS_XN);
    for (int m = gw; m < MT; m += NGW) {
        const float* xrow = m < MP ? a.in[I_XP] + (size_t)m * DM : a.in[I_XS] + (size_t)(m - MP) * DM;
        f32x4 v[8]; float s = 0.f;
#pragma unroll
        for (int j = 0; j < 8; ++j) { v[j] = *(const f32x4*)(xrow + 4 * lane + 256 * j); s += dot4(v[j], v[j]); }
        const float r = rsqrtf(wave_sum(s) * (1.f / DM) + EPS);
#pragma unroll
        for (int j = 0; j < 8; ++j) { const f32x4 w = *(const f32x4*)(nw + 4 * lane + 256 * j); u32x2 o; o.x = cvt_pk_bf16(v[j][0] * r * w[0], v[j][1] * r * w[1]); o.y = cvt_pk_bf16(v[j][2] * r * w[2], v[j][3] * r * w[3]);
            *(u32x2*)(XN + (size_t)m * DM + 4 * lane + 256 * j) = o; }
    }
}

__device__ __forceinline__ void stage_vt(LAS bf16* Vt, const bf16* P, int row0, int colbase, int tid) {
#pragma unroll
    for (int i = 0; i < 8; ++i) { const int idx = tid + NTHR * i, s = idx >> 5, ep = idx & 31;
        const u32x4 w = *(const u32x4*)(P + (size_t)(row0 + s) * NPROJ + colbase + 8 * ep);
        LAS bf16* d = Vt + (8 * ep) * 136 + s;
        d[0 * 136] = (bf16)(w.x & 0xffff); d[1 * 136] = (bf16)(w.x >> 16); d[2 * 136] = (bf16)(w.y & 0xffff); d[3 * 136] = (bf16)(w.y >> 16);
        d[4 * 136] = (bf16)(w.z & 0xffff); d[5 * 136] = (bf16)(w.z >> 16); d[6 * 136] = (bf16)(w.w & 0xffff); d[7 * 136] = (bf16)(w.w >> 16); }
}
__device__ __forceinline__ void gla_logdecay(const Args& a, const float* gates, int row0, int h, LAS float* galS, LAS float* segS, int tid, float (&la)[32], float& off, float& tot) {
    const int d = tid & 127, seg = tid >> 7;
    { const int t = tid >> 2, q = tid & 3; *(LAS f32x4*)(galS + t * 16 + q * 4) = *(const f32x4*)(gates + (size_t)(row0 + t) * 32 + 8 + q * 4); }
    float up[16];
#pragma unroll
    for (int j = 0; j < 16; ++j) up[j] = a.in[I_AUP][j * 512 + h * 128 + d];
    const float ab = a.in[I_AB][h * 128 + d];
    __syncthreads();
    float ssum = 0.f;
#pragma unroll
    for (int i = 0; i < 32; ++i) { const int t = seg * 32 + i; float z = ab;
#pragma unroll
        for (int q = 0; q < 4; ++q) { const f32x4 g = *(const LAS f32x4*)(galS + t * 16 + q * 4); z += g[0] * up[4 * q] + g[1] * up[4 * q + 1] + g[2] * up[4 * q + 2] + g[3] * up[4 * q + 3]; }
        la[i] = logsig(z) * (1.f / 16.f); ssum += la[i]; }
    segS[seg * 128 + d] = ssum;
    __syncthreads();
    off = 0.f; tot = 0.f;
#pragma unroll
    for (int s = 0; s < 4; ++s) { const float v = segS[s * 128 + d]; tot += v; off += (s < seg) ? v : 0.f; }
}

template <bool ML>
__device__ __forceinline__ void chunk_state(const Args& a, LAS unsigned char* lds, int bh, int c) {
    constexpr int DK = ML ? 256 : 128, NDT = DK / 16;
    int tid_ = threadIdx.x; asm volatile("" : "+v"(tid_));
    const int tid = tid_, lane = tid & 63, wave = __builtin_amdgcn_readfirstlane(tid >> 6), fr = lane & 15, fq = lane >> 4;
    const int b = bh >> 2, h = bh & 3, row0 = b * TP + c * 128, item = bh * NCH + c;
    unsigned char* ws = a.ws;
    const bf16* P = (const bf16*)(ws + WS_PROJ); const float* gates = (const float*)(ws + WS_GATES);
    LAS bf16* Kt = (LAS bf16*)lds; LAS bf16* Vt = (LAS bf16*)(lds + 69632); LAS float* sc = (LAS float*)(lds + 139264);
    __syncthreads();
    if (ML) {
        if (tid < 128) { const float mi = gates[(size_t)(row0 + tid) * 32 + h], mf = gates[(size_t)(row0 + tid) * 32 + 4 + h];
            sc[tid] = logsig(mf + a.in[I_BF][h]); sc[128 + tid] = mi + a.in[I_BI][h]; }
        __syncthreads();
        if (tid < 128) { float bs = 0.f; for (int s = 0; s <= tid; ++s) bs += sc[s]; sc[256 + tid] = sc[128 + tid] - bs; if (tid == 127) sc[384] = bs; }
        __syncthreads();
        if (tid < 64) { const float mx = wave_max(fmaxf(sc[256 + tid], sc[320 + tid])); if (tid == 0) sc[385] = mx; }
        __syncthreads();
        const float Ah = sc[385];
        if (tid < 128) sc[tid] = __expf(sc[256 + tid] - Ah);
        if (tid == 0) { float* chs = (float*)(ws + WS_CHS); chs[item * 2] = Ah; chs[item * 2 + 1] = sc[384]; }
        __syncthreads();
#pragma unroll
        for (int i = 0; i < 8; ++i) { const int idx = tid + NTHR * i, s = idx >> 5, dp = idx & 31; const float w = sc[s] * (1.f / 16.f);
            const u32x4 v = *(const u32x4*)(P + (size_t)(row0 + s) * NPROJ + C_MK + h * 256 + 8 * dp);
            LAS bf16* d = Kt + (8 * dp) * 136 + s;
            d[0 * 136] = f2bf(bflo(v.x) * w); d[1 * 136] = f2bf(bfhi(v.x) * w); d[2 * 136] = f2bf(bflo(v.y) * w); d[3 * 136] = f2bf(bfhi(v.y) * w);
            d[4 * 136] = f2bf(bflo(v.z) * w); d[5 * 136] = f2bf(bfhi(v.z) * w); d[6 * 136] = f2bf(bflo(v.w) * w); d[7 * 136] = f2bf(bfhi(v.w) * w); }
    } else {
        float la[32], off, tot;
        LAS float* galS = (LAS float*)(lds + 34816); gla_logdecay(a, gates, row0, h, galS, galS + 2048, tid, la, off, tot);
        const int d = tid & 127, seg = tid >> 7;
        if (seg == 0) ((float*)(ws + WS_BEND))[item * 128 + d] = tot;
        float bcur = off;
#pragma unroll
        for (int i = 0; i < 32; ++i) { const int t = seg * 32 + i; bcur += la[i];
            const float kv = bf2f(P[(size_t)(row0 + t) * NPROJ + C_GK + h * 128 + d]);
            Kt[d * 136 + t] = f2bf(kv * __expf(tot - bcur)); }
    }
    stage_vt(Vt, P, row0, (ML ? C_MV : C_GV) + h * 256, tid);
    __syncthreads();
    f32x4 acc[2][NDT];
#pragma unroll
    for (int e = 0; e < 2; ++e)
#pragma unroll
        for (int d = 0; d < NDT; ++d) acc[e][d] = (f32x4){0.f, 0.f, 0.f, 0.f};
#pragma unroll
    for (int ks = 0; ks < 4; ++ks) {
        bf16x8 vb[2];
#pragma unroll
        for (int e = 0; e < 2; ++e) vb[e] = *(const LAS bf16x8*)(Vt + (wave * 32 + e * 16 + fr) * 136 + ks * 32 + fq * 8);
#pragma unroll
        for (int d = 0; d < NDT; ++d) { const bf16x8 ka = *(const LAS bf16x8*)(Kt + (d * 16 + fr) * 136 + ks * 32 + fq * 8);
#pragma unroll
            for (int e = 0; e < 2; ++e) acc[e][d] = __builtin_amdgcn_mfma_f32_16x16x32_bf16(ka, vb[e], acc[e][d], 0, 0, 0); }
    }
    float* dst = (float*)(ws + (ML ? WS_DC : WS_DS)) + (size_t)item * 256 * DK;
#pragma unroll
    for (int e = 0; e < 2; ++e)
#pragma unroll
        for (int d = 0; d < NDT; ++d) *(f32x4*)(dst + (size_t)(wave * 32 + e * 16 + fr) * DK + d * 16 + 4 * fq) = acc[e][d];
    if (ML && tid < 256) { float s = 0.f;
#pragma unroll 8
        for (int i = 0; i < 128; ++i) s += bf2f(Kt[tid * 136 + i]);
        ((float*)(ws + WS_DN))[item * 256 + tid] = s; }
}

__device__ __forceinline__ void scan_mlstm(const Args& a, int j) {
    const int tid = threadIdx.x, bh = j >> 5, eb = j & 31;
    unsigned char* ws = a.ws;
    const float* chs = (const float*)(ws + WS_CHS);
    const int e = eb * 8 + (tid >> 6), d4 = (tid & 63) * 4;
    const float* dC = (const float*)(ws + WS_DC) + (size_t)bh * NCH * 65536 + (size_t)e * 256 + d4;
    bf16* CT = (bf16*)(ws + WS_CT) + (size_t)bh * NCH * 65536 + (size_t)e * 256 + d4;
    f32x4 Cv = {0.f, 0.f, 0.f, 0.f}; float Fs = 0.f, Mp = 0.f;
    const bool do_n = (eb == 0 && tid < 256);
    float nv = 0.f;
    f32x4 dv[NCH];
#pragma unroll
    for (int c = 0; c < NCH; ++c) dv[c] = *(const f32x4*)(dC + (size_t)c * 65536);
#pragma unroll
    for (int c = 0; c < NCH; ++c) {
        u32x2 o; o.x = cvt_pk_bf16(Cv[0], Cv[1]); o.y = cvt_pk_bf16(Cv[2], Cv[3]); *(u32x2*)(CT + (size_t)c * 65536) = o;
        if (do_n) ((bf16*)(ws + WS_NPREV))[(bh * NCH + c) * 256 + tid] = f2bf(nv);
        const float Ah = chs[(bh * NCH + c) * 2], bt = chs[(bh * NCH + c) * 2 + 1];
        const float Ac = Ah - Fs, Mn = fmaxf(Mp, Ac), f1 = __expf(Mp - Mn), f2 = __expf(Ac - Mn);
        Cv = Cv * f1 + dv[c] * f2;
        if (do_n) nv = nv * f1 + ((const float*)(ws + WS_DN))[(bh * NCH + c) * 256 + tid] * f2;
        Mp = Mn; Fs += bt;
    }
    float* oC = a.out + O_PC + (size_t)bh * 65536;
#pragma unroll
    for (int i = 0; i < 4; ++i) oC[(size_t)(d4 + i) * 256 + e] = Cv[i];
    if (do_n) a.out[O_PN + bh * 256 + tid] = nv;
    if (eb == 0 && tid == 0) a.out[O_PM + bh] = Fs + Mp;
}
__device__ __forceinline__ void scan_gla(const Args& a, int j) {
    const int tid = threadIdx.x, bh = j >> 4, eb = j & 15;
    unsigned char* ws = a.ws;
    const float* bend = (const float*)(ws + WS_BEND);
    const int ee = eb * 16 + (tid >> 5), d4 = (tid & 31) * 4;
    const float* dS = (const float*)(ws + WS_DS) + (size_t)bh * NCH * 32768 + (size_t)ee * 128 + d4;
    bf16* ST = (bf16*)(ws + WS_ST) + (size_t)bh * NCH * 32768 + (size_t)ee * 128 + d4;
    f32x4 Sv = {0.f, 0.f, 0.f, 0.f};
    f32x4 dv[NCH];
#pragma unroll
    for (int c = 0; c < NCH; ++c) dv[c] = *(const f32x4*)(dS + (size_t)c * 32768);
#pragma unroll
    for (int c = 0; c < NCH; ++c) {
        u32x2 o; o.x = cvt_pk_bf16(Sv[0], Sv[1]); o.y = cvt_pk_bf16(Sv[2], Sv[3]); *(u32x2*)(ST + (size_t)c * 32768) = o;
        const f32x4 be = *(const f32x4*)(bend + (bh * NCH + c) * 128 + d4);
        Sv[0] = Sv[0] * __expf(be[0]) + dv[c][0]; Sv[1] = Sv[1] * __expf(be[1]) + dv[c][1]; Sv[2] = Sv[2] * __expf(be[2]) + dv[c][2]; Sv[3] = Sv[3] * __expf(be[3]) + dv[c][3];
    }
    float* oS = a.out + O_PS + (size_t)bh * 32768;
#pragma unroll
    for (int i = 0; i < 4; ++i) oS[(size_t)(d4 + i) * 256 + ee] = Sv[i];
}

template <bool ML>
__device__ __forceinline__ void chunk_out(const Args& a, LAS unsigned char* lds, int bh, int c) {
    constexpr int DK = ML ? 256 : 128, QS = DK + 8, NKK = DK / 32;
    int tid_ = threadIdx.x; asm volatile("" : "+v"(tid_));
    const int tid = tid_, lane = tid & 63, wave = __builtin_amdgcn_readfirstlane(tid >> 6), fr = lane & 15, fq = lane >> 4;
    const int b = bh >> 2, h = bh & 3, row0 = b * TP + c * 128, item = bh * NCH + c;
    unsigned char* ws = a.ws;
    const bf16* P = (const bf16*)(ws + WS_PROJ); const float* gates = (const float*)(ws + WS_GATES);
    LAS bf16* Qs = (LAS bf16*)lds; LAS bf16* Ks = Qs + 128 * QS;
    LAS float* sc = (LAS float*)(lds + 143616);
    __syncthreads();
    if (ML) {
        const float* chs = (const float*)(ws + WS_CHS);
        float Fs = 0.f, Mp = 0.f;
        for (int cc = 0; cc < c; ++cc) { const float Ah = chs[(bh * NCH + cc) * 2], bt = chs[(bh * NCH + cc) * 2 + 1]; Mp = fmaxf(Mp, Ah - Fs); Fs += bt; }
        if (tid < 128) { const float mi = gates[(size_t)(row0 + tid) * 32 + h], mf = gates[(size_t)(row0 + tid) * 32 + 4 + h];
            sc[512 + tid] = logsig(mf + a.in[I_BF][h]); sc[640 + tid] = mi + a.in[I_BI][h]; }
        __syncthreads();
        float bs = 0.f;
        if (tid < 128) { for (int s = 0; s <= tid; ++s) bs += sc[512 + s]; sc[tid] = sc[640 + tid] - bs - Fs; }
        __syncthreads();
        if (tid < 128) { float M = Mp; for (int s = 0; s <= tid; ++s) M = fmaxf(M, sc[s]); sc[128 + tid] = M; sc[256 + tid] = __expf(Mp - M); sc[384 + tid] = __expf(-(Fs + bs + M)); }
#pragma unroll
        for (int i = 0; i < 8; ++i) { const int idx = tid + NTHR * i, t = idx >> 5, p = idx & 31;
            *(LAS u32x4*)(Qs + t * QS + p * 8) = *(const u32x4*)(P + (size_t)(row0 + t) * NPROJ + C_MQ + h * 256 + p * 8);
            *(LAS u32x4*)(Ks + t * QS + p * 8) = *(const u32x4*)(P + (size_t)(row0 + t) * NPROJ + C_MK + h * 256 + p * 8); }
    } else {
        float la[32], off, tot;
        LAS float* galS = (LAS float*)(lds + 69632); LAS float* segS = galS + 128 * 16;
        gla_logdecay(a, gates, row0, h, galS, segS, tid, la, off, tot);
        const int d = tid & 127, seg = tid >> 7;
        float bcur = off;
#pragma unroll
        for (int i = 0; i < 32; ++i) { const int t = seg * 32 + i; bcur += la[i];
            const float qv = bf2f(P[(size_t)(row0 + t) * NPROJ + C_GQ + h * 128 + d]), kv = bf2f(P[(size_t)(row0 + t) * NPROJ + C_GK + h * 128 + d]);
            Qs[t * QS + d] = f2bf(qv * 0.08838834764831845f * __expf(bcur)); Ks[t * QS + d] = f2bf(kv * __expf(-bcur)); }
    }
    __syncthreads();
    bf16x8 qf[NKK];
#pragma unroll
    for (int kk = 0; kk < NKK; ++kk) qf[kk] = *(const LAS bf16x8*)(Qs + (wave * 16 + fr) * QS + kk * 32 + fq * 8);
    const int t = wave * 16 + fr;
    u32x2 pb[8]; float den = 0.f;
    {
        const float Mt = ML ? sc[128 + t] : 0.f;
#pragma unroll
        for (int st = 0; st < 8; ++st) { f32x4 s = {0.f, 0.f, 0.f, 0.f};
#pragma unroll
            for (int kk = 0; kk < NKK; ++kk) { const bf16x8 kf = *(const LAS bf16x8*)(Ks + (st * 16 + fr) * QS + kk * 32 + fq * 8); s = __builtin_amdgcn_mfma_f32_16x16x32_bf16(kf, qf[kk], s, 0, 0, 0); }
            float p[4];
#pragma unroll
            for (int r = 0; r < 4; ++r) { const int si = st * 16 + 4 * fq + r;
                if (ML) p[r] = (si <= t) ? s[r] * (1.f / 16.f) * __expf(sc[si] - Mt) : 0.f; else p[r] = (si <= t) ? s[r] : 0.f;
                den += p[r]; }
            pb[st].x = cvt_pk_bf16(p[0], p[1]); pb[st].y = cvt_pk_bf16(p[2], p[3]); }
    }
    __syncthreads();
    LAS bf16* Cl = (LAS bf16*)lds;
    if (ML) {
        const bf16* CT = (const bf16*)(ws + WS_CT) + (size_t)item * 65536;
#pragma unroll
        for (int i = 0; i < 16; ++i) { const int idx = tid + NTHR * i, e = idx >> 5, p = idx & 31; *(LAS u32x4*)(Cl + e * QS + p * 8) = *(const u32x4*)(CT + (size_t)e * 256 + p * 8); }
        { const int e = tid >> 5, p = tid & 31; u32x4 v = {0u, 0u, 0u, 0u};
          if (e == 0) v = *(const u32x4*)((const bf16*)(ws + WS_NPREV) + (size_t)item * 256 + p * 8);
          *(LAS u32x4*)(Cl + (256 + e) * QS + p * 8) = v; }
    } else {
        const bf16* ST = (const bf16*)(ws + WS_ST) + (size_t)item * 32768;
#pragma unroll
        for (int i = 0; i < 8; ++i) { const int idx = tid + NTHR * i, e = idx >> 4, p = idx & 15; *(LAS u32x4*)(Cl + e * QS + p * 8) = *(const u32x4*)(ST + (size_t)e * 128 + p * 8); }
    }
    __syncthreads();
    f32x4 acc[16];
#pragma unroll
    for (int et = 0; et < 16; ++et) { acc[et] = (f32x4){0.f, 0.f, 0.f, 0.f};
#pragma unroll
        for (int kk = 0; kk < NKK; ++kk) { const bf16x8 cf = *(const LAS bf16x8*)(Cl + (et * 16 + fr) * QS + kk * 32 + fq * 8); acc[et] = __builtin_amdgcn_mfma_f32_16x16x32_bf16(cf, qf[kk], acc[et], 0, 0, 0); } }
    float wint = 1.f, qn = 0.f;
    if (ML) {
        f32x4 dn = {0.f, 0.f, 0.f, 0.f};
#pragma unroll
        for (int kk = 0; kk < NKK; ++kk) { const bf16x8 nf = *(const LAS bf16x8*)(Cl + (256 + fr) * QS + kk * 32 + fq * 8); dn = __builtin_amdgcn_mfma_f32_16x16x32_bf16(nf, qf[kk], dn, 0, 0, 0); }
        qn = __shfl(dn[0], fr);
        wint = sc[256 + t];
#pragma unroll
        for (int et = 0; et < 16; ++et) acc[et] = acc[et] * wint;
    }
    __syncthreads();
    LAS bf16* Vt = (LAS bf16*)lds;
    stage_vt(Vt, P, row0, (ML ? C_MV : C_GV) + h * 256, tid);
    __syncthreads();
#pragma unroll
    for (int ks = 0; ks < 4; ++ks) {
        u32x4 pw; pw.x = pb[2 * ks].x; pw.y = pb[2 * ks].y; pw.z = pb[2 * ks + 1].x; pw.w = pb[2 * ks + 1].y;
        const bf16x8 pf = __builtin_bit_cast(bf16x8, pw);
#pragma unroll
        for (int et = 0; et < 16; ++et) { const LAS bf16* vp = Vt + (et * 16 + fr) * 136 + ks * 32 + 4 * fq;
            const u32x2 lo = *(const LAS u32x2*)vp, hi = *(const LAS u32x2*)(vp + 16);
            u32x4 vw; vw.x = lo.x; vw.y = lo.y; vw.z = hi.x; vw.w = hi.y;
            acc[et] = __builtin_amdgcn_mfma_f32_16x16x32_bf16(__builtin_bit_cast(bf16x8, vw), pf, acc[et], 0, 0, 0); }
    }
    float inv = 1.f;
    if (ML) { den += __shfl_xor(den, 16); den += __shfl_xor(den, 32); den += wint * qn; inv = 1.f / fmaxf(fabsf(den), sc[384 + t]); }
    float ss = 0.f;
#pragma unroll
    for (int et = 0; et < 16; ++et) { acc[et] = acc[et] * inv; ss += dot4(acc[et], acc[et]); }
    ss += __shfl_xor(ss, 16); ss += __shfl_xor(ss, 32);
    const float rn = rsqrtf(ss * (1.f / 256.f) + EPS);
    const float* hw = a.in[ML ? I_MHW : I_GHW] + h * 256;
    const bf16* gp = P + (size_t)(row0 + t) * NPROJ + (ML ? C_MO : C_GR) + h * 256;
    bf16* yp = (bf16*)(ws + (ML ? WS_YM : WS_YG)) + (size_t)(row0 + t) * 1024 + h * 256;
#pragma unroll
    for (int et = 0; et < 16; ++et) { const int e = et * 16 + 4 * fq;
        const u32x2 gw = *(const u32x2*)(gp + e); const f32x4 w = *(const f32x4*)(hw + e);
        const float g0 = bflo(gw.x), g1 = bfhi(gw.x), g2 = bflo(gw.y), g3 = bfhi(gw.y);
        float o0 = acc[et][0] * rn * w[0], o1 = acc[et][1] * rn * w[1], o2 = acc[et][2] * rn * w[2], o3 = acc[et][3] * rn * w[3];
        if (ML) { o0 *= sigm(g0); o1 *= sigm(g1); o2 *= sigm(g2); o3 *= sigm(g3); } else { o0 *= g0 * sigm(g0); o1 *= g1 * sigm(g1); o2 *= g2 * sigm(g2); o3 *= g3 * sigm(g3); }
        u32x2 o; o.x = cvt_pk_bf16(o0, o1); o.y = cvt_pk_bf16(o2, o3); *(u32x2*)(yp + e) = o; }
}

template <bool ML>
__device__ __forceinline__ void sample_item(const Args& a, LAS unsigned char* lds, int b, int h) {
    constexpr int DK = ML ? 256 : 128;
    int tid_ = threadIdx.x; asm volatile("" : "+v"(tid_));
    const int tid = tid_, lane = tid & 63, wave = __builtin_amdgcn_readfirstlane(tid >> 6);
    unsigned char* ws = a.ws;
    const bf16* P = (const bf16*)(ws + WS_PROJ); const float* gates = (const float*)(ws + WS_GATES);
    const int row0 = MP + b * 8, bh = b * 4 + h;
    LAS float* qT = (LAS float*)lds;
    LAS float* wkT = qT + 2048;
    LAS float* kT = wkT + 2048;
    LAS float* vS = kT + 2048;
    LAS float* red = vS + 2048;
    LAS float* sm = red + 16384;
    __syncthreads();
    float aS[8], Mt[8], bS[8]; float m0 = 0.f, dec = 1.f;
    if (ML) {
        m0 = a.in[I_M][bh]; float bs = 0.f, M = m0;
#pragma unroll
        for (int t = 0; t < 8; ++t) { const float mi = gates[(size_t)(row0 + t) * 32 + h], mf = gates[(size_t)(row0 + t) * 32 + 4 + h];
            bs += logsig(mf + a.in[I_BF][h]); bS[t] = bs; aS[t] = mi + a.in[I_BI][h] - bs; M = fmaxf(M, aS[t]); Mt[t] = M; }
        dec = __expf(m0 - Mt[7]);
        if (tid == 0) {
#pragma unroll
            for (int t = 0; t < 8; ++t) { sm[200 + t] = aS[t]; sm[208 + t] = Mt[t]; sm[216 + t] = bS[t]; } }
        if (tid < 256) { const int d = tid;
#pragma unroll
            for (int t = 0; t < 8; ++t) { const float qv = bf2f(P[(size_t)(row0 + t) * NPROJ + C_MQ + h * 256 + d]), kv = bf2f(P[(size_t)(row0 + t) * NPROJ + C_MK + h * 256 + d]) * (1.f / 16.f);
                qT[d * 8 + t] = qv; kT[d * 8 + t] = kv; wkT[d * 8 + t] = kv * __expf(aS[t] - Mt[7]); } }
    } else {
        if (tid < 128) { const int d = tid; float up[16];
#pragma unroll
            for (int j = 0; j < 16; ++j) up[j] = a.in[I_AUP][j * 512 + h * 128 + d];
            const float ab = a.in[I_AB][h * 128 + d];
            float bc[8]; float bs = 0.f;
#pragma unroll
            for (int t = 0; t < 8; ++t) { float z = ab;
#pragma unroll
                for (int j = 0; j < 16; ++j) z += gates[(size_t)(row0 + t) * 32 + 8 + j] * up[j];
                bs += logsig(z) * (1.f / 16.f); bc[t] = bs; }
            sm[72 + d] = __expf(bs);
#pragma unroll
            for (int t = 0; t < 8; ++t) { const float qv = bf2f(P[(size_t)(row0 + t) * NPROJ + C_GQ + h * 128 + d]), kv = bf2f(P[(size_t)(row0 + t) * NPROJ + C_GK + h * 128 + d]);
                qT[d * 8 + t] = qv * 0.08838834764831845f * __expf(bc[t]); kT[d * 8 + t] = kv * __expf(-bc[t]); wkT[d * 8 + t] = kv * __expf(bs - bc[t]); } }
    }
    { const int t = tid >> 6; const u32x2 w = *(const u32x2*)(P + (size_t)(row0 + t) * NPROJ + (ML ? C_MV : C_GV) + h * 256 + 4 * lane);
      *(LAS f32x4*)(vS + t * 256 + 4 * lane) = (f32x4){bflo(w.x), bfhi(w.x), bflo(w.y), bfhi(w.y)}; }
    __syncthreads();
    if (tid < 64) { const int t = tid >> 3, s = tid & 7; float sdot = 0.f;
        for (int d = 0; d < DK; ++d) sdot += qT[d * 8 + t] * kT[d * 8 + s];
        float p; if (ML) p = (s <= t) ? sdot * __expf(sm[200 + s] - sm[208 + t]) : 0.f; else p = (s <= t) ? sdot : 0.f;
        sm[tid] = p; }
    else if (ML && tid < 72) { const int t = tid - 64; float sdot = 0.f; const float* n0 = a.in[I_N] + (size_t)bh * 256;
        for (int d = 0; d < 256; ++d) sdot += qT[d * 8 + t] * n0[d];
        sm[64 + t] = sdot; }
    const float* C0 = a.in[ML ? I_C : I_S] + (size_t)bh * DK * 256;
    float* C1 = a.out + (ML ? O_SC : O_SS) + (size_t)bh * DK * 256;
    f32x4 v[8], acc[8];
#pragma unroll
    for (int s = 0; s < 8; ++s) { v[s] = *(const LAS f32x4*)(vS + s * 256 + 4 * lane); acc[s] = (f32x4){0.f, 0.f, 0.f, 0.f}; }
#pragma unroll 4
    for (int i = 0; i < DK / 8; ++i) { const int d = wave + 8 * i;
        const f32x4 cv = *(const f32x4*)(C0 + (size_t)d * 256 + 4 * lane);
        const f32x4 q0 = *(const LAS f32x4*)(qT + d * 8), q1 = *(const LAS f32x4*)(qT + d * 8 + 4), k0 = *(const LAS f32x4*)(wkT + d * 8), k1 = *(const LAS f32x4*)(wkT + d * 8 + 4);
        const float dd = ML ? dec : sm[72 + d];
        acc[0] += cv * q0[0]; acc[1] += cv * q0[1]; acc[2] += cv * q0[2]; acc[3] += cv * q0[3]; acc[4] += cv * q1[0]; acc[5] += cv * q1[1]; acc[6] += cv * q1[2]; acc[7] += cv * q1[3];
        f32x4 cn = cv * dd;
        cn += v[0] * k0[0]; cn += v[1] * k0[1]; cn += v[2] * k0[2]; cn += v[3] * k0[3]; cn += v[4] * k1[0]; cn += v[5] * k1[1]; cn += v[6] * k1[2]; cn += v[7] * k1[3];
        *(f32x4*)(C1 + (size_t)d * 256 + 4 * lane) = cn; }
#pragma unroll
    for (int s = 0; s < 8; ++s) *(LAS f32x4*)(red + (wave * 8 + s) * 256 + 4 * lane) = acc[s];
    __syncthreads();
    const int t = wave;
    f32x4 qc = {0.f, 0.f, 0.f, 0.f};
#pragma unroll
    for (int w = 0; w < 8; ++w) qc += *(const LAS f32x4*)(red + (w * 8 + t) * 256 + 4 * lane);
    float wint = 1.f, den = 0.f, Mtt = 0.f, btt = 0.f;
    if (ML) { Mtt = sm[208 + t]; btt = sm[216 + t]; wint = __expf(m0 - Mtt); }
    f32x4 num = qc * wint;
#pragma unroll
    for (int s = 0; s < 8; ++s) { const float p = sm[t * 8 + s]; num += v[s] * p; den += p; }
    if (ML) { den += wint * sm[64 + t]; const float fl = fmaxf(fabsf(den), __expf(-(btt + Mtt))); num = num * (1.f / fl); }
    const float rn = rsqrtf(wave_sum(dot4(num, num)) * (1.f / 256.f) + EPS);
    const f32x4 w = *(const f32x4*)(a.in[ML ? I_MHW : I_GHW] + h * 256 + 4 * lane);
    const u32x2 gw = *(const u32x2*)(P + (size_t)(row0 + t) * NPROJ + (ML ? C_MO : C_GR) + h * 256 + 4 * lane);
    const float g0 = bflo(gw.x), g1 = bfhi(gw.x), g2 = bflo(gw.y), g3 = bfhi(gw.y);
    float o0 = num[0] * rn * w[0], o1 = num[1] * rn * w[1], o2 = num[2] * rn * w[2], o3 = num[3] * rn * w[3];
    if (ML) { o0 *= sigm(g0); o1 *= sigm(g1); o2 *= sigm(g2); o3 *= sigm(g3); } else { o0 *= g0 * sigm(g0); o1 *= g1 * sigm(g1); o2 *= g2 * sigm(g2); o3 *= g3 * sigm(g3); }
    u32x2 o; o.x = cvt_pk_bf16(o0, o1); o.y = cvt_pk_bf16(o2, o3);
    *(u32x2*)((bf16*)(ws + (ML ? WS_YM : WS_YG)) + (size_t)(row0 + t) * 1024 + h * 256 + 4 * lane) = o;
    if (ML) {
        if (tid < 256) { float s = dec * a.in[I_N][(size_t)bh * 256 + tid];
#pragma unroll
            for (int q = 0; q < 8; ++q) s += wkT[tid * 8 + q];
            a.out[O_SN + (size_t)bh * 256 + tid] = s; }
        if (tid == 0) a.out[O_SM + bh] = bS[7] + Mt[7];
    }
}

__device__ __forceinline__ void act_phase(const Args& a, int vcu, int G) {
    unsigned char* ws = a.ws; const bf16* U = (const bf16*)(ws + WS_U); bf16* Gb = (bf16*)(ws + WS_G);
    const float* cw = a.in[I_CW]; const float* cb = a.in[I_CB]; const float* cst = a.in[I_CONV];
    const size_t total = (size_t)MT * (DFF / 8);
    for (size_t idx = (size_t)vcu * NTHR + threadIdx.x; idx < total; idx += (size_t)G * NTHR) {
        const int row = (int)(idx / (DFF / 8)), col = (int)(idx % (DFF / 8)) * 8;
        int t; const float* st = nullptr;
        if (row < MP) t = row & (TP - 1); else { const int rr = row - MP; t = rr & 7; st = cst + (size_t)(rr >> 3) * 2 * DFF + col; }
        float u0[8], u1[8], u2[8], g[8];
        { const u32x4 w = *(const u32x4*)(U + (size_t)row * DFF + col); u2[0] = bflo(w.x); u2[1] = bfhi(w.x); u2[2] = bflo(w.y); u2[3] = bfhi(w.y); u2[4] = bflo(w.z); u2[5] = bfhi(w.z); u2[6] = bflo(w.w); u2[7] = bfhi(w.w); }
        { const u32x4 w = *(const u32x4*)(Gb + (size_t)row * DFF + col); g[0] = bflo(w.x); g[1] = bfhi(w.x); g[2] = bflo(w.y); g[3] = bfhi(w.y); g[4] = bflo(w.z); g[5] = bfhi(w.z); g[6] = bflo(w.w); g[7] = bfhi(w.w); }
        if (t >= 1) { const u32x4 w = *(const u32x4*)(U + (size_t)(row - 1) * DFF + col); u1[0] = bflo(w.x); u1[1] = bfhi(w.x); u1[2] = bflo(w.y); u1[3] = bfhi(w.y); u1[4] = bflo(w.z); u1[5] = bfhi(w.z); u1[6] = bflo(w.w); u1[7] = bfhi(w.w); }
        else {
#pragma unroll
            for (int i = 0; i < 8; ++i) u1[i] = st ? st[DFF + i] : 0.f; }
        if (t >= 2) { const u32x4 w = *(const u32x4*)(U + (size_t)(row - 2) * DFF + col); u0[0] = bflo(w.x); u0[1] = bfhi(w.x); u0[2] = bflo(w.y); u0[3] = bfhi(w.y); u0[4] = bflo(w.z); u0[5] = bfhi(w.z); u0[6] = bflo(w.w); u0[7] = bfhi(w.w); }
        else {
#pragma unroll
            for (int i = 0; i < 8; ++i) u0[i] = st ? st[(size_t)t * DFF + i] : 0.f; }
        float o[8];
#pragma unroll
        for (int i = 0; i < 8; ++i) { const float uc = cb[col + i] + cw[col + i] * u0[i] + cw[DFF + col + i] * u1[i] + cw[2 * DFF + col + i] * u2[i]; o[i] = gelu_tanh(uc) * g[i]; }
        u32x4 w; w.x = cvt_pk_bf16(o[0], o[1]); w.y = cvt_pk_bf16(o[2], o[3]); w.z = cvt_pk_bf16(o[4], o[5]); w.w = cvt_pk_bf16(o[6], o[7]);
        *(u32x4*)(Gb + (size_t)row * DFF + col) = w;
    }
}
__device__ __forceinline__ void final_norm(const Args& a, int vcu, int G) {
    const int tid = threadIdx.x, lane = tid & 63, wave = tid >> 6;
    const float* part = (const float*)(a.ws + WS_PART); const float* fw = a.in[I_FNW];
    for (int m = vcu * NWAVES + wave; m < MT; m += G * NWAVES) {
        float s = (lane < 32) ? part[(size_t)m * 32 + lane] : 0.f; s = wave_sum(s);
        const float r = rsqrtf(s * (1.f / DM) + EPS);
        float* row = a.out + (size_t)m * DM;
#pragma unroll
        for (int j = 0; j < 8; ++j) { const f32x4 v = *(const f32x4*)(row + 4 * lane + 256 * j), w = *(const f32x4*)(fw + 4 * lane + 256 * j);
            *(f32x4*)(row + 4 * lane + 256 * j) = (f32x4){v[0] * r * w[0], v[1] * r * w[1], v[2] * r * w[2], v[3] * r * w[3]}; }
    }
}

constexpr int N_PHASES = 11;
__global__ void __launch_bounds__(NTHR) fwd_kernel(Args args) {
    extern __shared__ __attribute__((aligned(16))) unsigned char lds_raw[];
    LAS unsigned char* lds = (LAS unsigned char*)lds_raw;
    cg::grid_group grid = cg::this_grid();
    const int G = gridDim.x, bx = blockIdx.x;
    const int vcu = (G % 8 == 0) ? (bx % 8) * (G / 8) + bx / 8 : bx;
    const int lo = args.ph_lo, hi = args.ph_hi;
    unsigned char* ws = args.ws;
#ifndef BIS
#define BIS 15
#endif
#ifndef PHASE_MASK
#define PHASE_MASK 0x7ff
#endif
#define IN(k) (((PHASE_MASK >> (k)) & 1) && lo <= (k) && (k) < hi)
#define SEAM(k) do { if (IN(k) && IN((k) + 1)) grid.sync(); } while (0)
    if (IN(0)) { p0_prologue(args, lds, vcu, G); __syncthreads(); }
    SEAM(0);
    if (IN(1)) {
        pg8::Gemm g{(const bf16*)(ws + WS_XN), (const bf16*)(ws + WS_WIN), nullptr, nullptr, MT, NPROJ_PAD, DM}; pg8::StaticOrder S; S.init(MT, NPROJ_PAD, G, bx);
        EpiProj E{(bf16*)(ws + WS_PROJ), (float*)(ws + WS_GATES)};
        pg8::gemm_phase<EpiProj, pg8::StaticOrder, true, true>(lds, g, S, E);
    }
    SEAM(1);
    if (IN(2)) {
        for (int it = bx; it < 1536; it += G) {
            if (it < 512) { if (BIS & 1) sample_item<true>(args, lds, it >> 2, it & 3); }
            else if (it < 1024) { if (BIS & 2) sample_item<false>(args, lds, (it - 512) >> 2, (it - 512) & 3); }
            else if (it < 1280) { if (BIS & 4) chunk_state<true>(args, lds, (it - 1024) >> 4, (it - 1024) & 15); }
            else { if (BIS & 8) chunk_state<false>(args, lds, (it - 1280) >> 4, (it - 1280) & 15); }
        }
    }
    SEAM(2);
    if (IN(3)) { for (int it = bx; it < 768; it += G) { if (it < 512) scan_mlstm(args, it); else scan_gla(args, it - 512); } }
    SEAM(3);
    if (IN(4)) { for (int it = bx; it < 512; it += G) { if (it < 256) { if (BIS & 1) chunk_out<true>(args, lds, it >> 4, it & 15); } else { if (BIS & 2) chunk_out<false>(args, lds, (it - 256) >> 4, (it - 256) & 15); } } __syncthreads(); }
    SEAM(4);
    if (IN(5)) {
        pg8::Gemm g{(const bf16*)(ws + WS_YM), (const bf16*)(ws + WS_WA), (const bf16*)(ws + WS_YG), (const bf16*)(ws + WS_WB), MT, DM, 1024}; pg8::TwoSegOrder S; S.S.init(MT, DM, G, bx);
        EpiBranch E{(const bf16*)(ws + WS_PROJ), (bf16*)(ws + WS_XN)};
        pg8::gemm_phase<EpiBranch, pg8::TwoSegOrder, true, true>(lds, g, S, E);
    }
    SEAM(5);
    if (IN(6)) {
        pg8::Gemm g{(const bf16*)(ws + WS_XN), (const bf16*)(ws + WS_WO), nullptr, nullptr, MT, DM, DM}; pg8::StaticOrder S; S.init(MT, DM, G, bx);
        EpiOut E{args.in[I_XP], args.in[I_XS], (float*)(ws + WS_X1), (bf16*)(ws + WS_X1W), args.in[I_NFFN], (float*)(ws + WS_PART)};
        pg8::gemm_phase<EpiOut, pg8::StaticOrder, true, true>(lds, g, S, E);
    }
    SEAM(6);
    if (IN(7)) {
        pg8::Gemm g{(const bf16*)(ws + WS_X1W), (const bf16*)(ws + WS_WUG), nullptr, nullptr, MT, 2 * DFF, DM}; pg8::StaticOrder S; S.init(MT, 2 * DFF, G, bx);
        EpiUG E{(const float*)(ws + WS_PART), (bf16*)(ws + WS_U), (bf16*)(ws + WS_G), args.out};
        pg8::gemm_phase<EpiUG, pg8::StaticOrder, true, true>(lds, g, S, E);
    }
    SEAM(7);
    if (IN(8)) act_phase(args, vcu, G);
    SEAM(8);
    if (IN(9)) {
        pg8::Gemm g{(const bf16*)(ws + WS_G), (const bf16*)(ws + WS_WD), nullptr, nullptr, MT, DM, DFF}; pg8::StaticOrder S; S.init(MT, DM, G, bx);
        EpiDown E{(const float*)(ws + WS_X1), args.out, (float*)(ws + WS_PART)};
        pg8::gemm_phase<EpiDown, pg8::StaticOrder, true, true>(lds, g, S, E);
    }
    SEAM(9);
    if (IN(10)) final_norm(args, vcu, G);
#undef IN
#undef SEAM
}

extern "C" void kernel_launch(void* const* d_in, const int* in_sizes, int n_in, void* d_out, int out_size, void* d_ws, size_t ws_size, hipStream_t stream) {
    static int grid = 0;
    if (grid == 0) {
        if (n_in != 25 || ws_size < WS_END) { fprintf(stderr, "kernel_launch: unexpected n_in %d / ws_size %zu (need %zu)\n", n_in, ws_size, (size_t)WS_END); grid = -1; return; }
        int dev = 0, cus = 0, per_cu = 0;
        (void)hipGetDevice(&dev); (void)hipDeviceGetAttribute(&cus, hipDeviceAttributeMultiprocessorCount, dev);
        if (hipFuncSetAttribute((const void*)fwd_kernel, hipFuncAttributeMaxDynamicSharedMemorySize, LDS_BYTES) != hipSuccess) { fprintf(stderr, "kernel_launch: hipFuncSetAttribute failed\n"); grid = -1; return; }
        if (hipOccupancyMaxActiveBlocksPerMultiprocessor(&per_cu, (const void*)fwd_kernel, NTHR, LDS_BYTES) != hipSuccess || per_cu < 1) { fprintf(stderr, "kernel_launch: occupancy query says %d\n", per_cu); per_cu = 1; }
        (void)hipGetLastError();
        grid = cus * 1;
        if (grid <= 0) grid = 256;
    }
    if (grid < 0) return;
    Args a{};
    for (int i = 0; i < 25; ++i) a.in[i] = (const float*)d_in[i];
    a.out = (float*)d_out; a.ws = (unsigned char*)d_ws;
    if (MK_N_LAUNCHES == 1) {
        a.ph_lo = 0; a.ph_hi = N_PHASES;
        void* kargs[] = {&a};
        hipError_t e = hipLaunchCooperativeKernel((const void*)fwd_kernel, dim3(grid), dim3(NTHR), kargs, LDS_BYTES, stream);
        if (e != hipSuccess) fprintf(stderr, "kernel_launch: cooperative launch failed: %s (grid %d)\n", hipGetErrorString(e), grid);
    } else {
        for (int p = 0; p < N_PHASES; ++p) { a.ph_lo = p; a.ph_hi = p + 1; hipLaunchKernelGGL(fwd_kernel, dim3(grid), dim3(NTHR), LDS_BYTES, stream, a); }
    }
}
```

```cpp
#include <hip/hip_runtime.h>
#include <hip/hip_cooperative_groups.h>
#include <cstdio>
#include <cstdint>
namespace cg = cooperative_groups;

#ifndef MK_N_LAUNCHES
#define MK_N_LAUNCHES 1
#endif

namespace pg8 {
#define PG8_LAS __attribute__((address_space(3)))
typedef unsigned short bf16_t;
typedef short bf16x8 __attribute__((ext_vector_type(8)));
typedef float f32x4 __attribute__((ext_vector_type(4)));
typedef unsigned u32x4 __attribute__((ext_vector_type(4)));
constexpr int BM = 256, BK = 64, HALF = 128, HTB = HALF * BK * 2  , STAGE_BYTES = 8 * HTB, NXCD = 8, WGM = 8;

__host__ __device__ __forceinline__ int lds_byte(int r, int c) { const int st = (r >> 4) * 2 + (c >> 5), rr = r & 15, cc = c & 31, ob = rr * 64 + cc * 2; return st * 1024 + (ob ^ (((ob >> 9) & 1) << 5)); }
__host__ __device__ __forceinline__ void stage_rc(int b, int& R, int& C) { const int st = b / 1024, sb = b % 1024, swz = sb ^ (((sb >> 9) & 1) << 5); R = (st >> 1) * 16 + swz / 64; C = (st & 1) * 32 + (swz % 64) / 2; }
__host__ __device__ __forceinline__ int perm32(int rho) { const int n = rho >> 4, i = rho & 15; return 8 * (i >> 2) + 4 * n + (i & 3); }

struct Unit { int pm, pn, seg; };
struct Gemm { const bf16_t* A; const bf16_t* Bt; const bf16_t* A2; const bf16_t* Bt2; int M, N, K; };

struct StaticOrder {
    int nM, nN, nwg, G, c;
    __host__ __device__ void init(int M, int N, int G_, int c_) { nM = M / BM; nN = N / BM; nwg = nM * nN; G = G_; c = c_; }
    __host__ __device__ bool next(int i, Unit& u) const {
        const long L = (long)i * G + c; if (L >= nwg) return false;
        int wgid = (int)L; { const int q = nwg / NXCD, r = nwg % NXCD, xcd = wgid % NXCD, off = wgid / NXCD; wgid = (xcd < r ? xcd * (q + 1) : r * (q + 1) + (xcd - r) * q) + off; }
        const int nig = WGM * nN, gid = wgid / nig, fm = gid * WGM, gsz = (nM - fm) < WGM ? (nM - fm) : WGM;
        u.pm = fm + ((wgid % nig) % gsz); u.pn = (wgid % nig) / gsz; u.seg = 0; return true;
    }
};
struct TwoSegOrder {
    StaticOrder S;
    __host__ __device__ bool next(int i, Unit& u) const { if (!S.next(i >> 1, u)) return false; u.seg = i & 1; return true; }
};

__device__ __forceinline__ unsigned cvt_pk_bf16(float lo, float hi) { unsigned r; asm volatile("v_cvt_pk_bf16_f32 %0, %1, %2" : "=v"(r) : "v"(lo), "v"(hi)); return r; }

template <class Epi, class Sched, bool ALIGN_EPI = false, bool SP2 = false>
__device__ __forceinline__ void gemm_phase(PG8_LAS unsigned char* lds, const Gemm g, const Sched& S, const Epi& E) {
    const int tid = threadIdx.x, wid = __builtin_amdgcn_readfirstlane(tid >> 6), lane = tid & 63, wr = wid >> 2, wc = wid & 3, fr = lane & 15, fq = lane >> 4;
    const int K = g.K, nt = K / BK;
    unsigned voffA[2], voffB[2];
#pragma unroll
    for (int i = 0; i < 2; ++i) { int R, C; stage_rc(tid * 16 + i * 8192, R, C); const int Rb = Epi::PERM ? ((R & ~31) + perm32(R & 31)) : R;
        voffA[i] = (unsigned)(R * K + C) * 2u; voffB[i] = (unsigned)(Rb * K + C) * 2u; }
    const size_t kstep = (size_t)(BK * 2);
    const size_t hstep = (size_t)HALF * K * 2;
    const size_t tstep = 2 * hstep;
    const unsigned ldsw = (unsigned)wid * 1024u;
    const int aoff = lds_byte(wr * 64 + fr, fq * 8), boff = lds_byte(wc * 32 + fr, fq * 8);
#define PG8_SA(b, h) (((b) * 2 + (h)) * HTB)
#define PG8_SB(b, h) ((4 + (b) * 2 + (h)) * HTB)
#define PG8_STAGE(bufoff, gbase, voff) do { _Pragma("unroll") for (int _i = 0; _i < 2; ++_i) \
        __builtin_amdgcn_global_load_lds((const unsigned*)((const char*)(gbase) + (voff)[_i]), (PG8_LAS unsigned*)(lds + (bufoff) + ldsw + _i * 8192), 16, 0, 0); } while (0)
#define PG8_LDA(dst, b, h) do { _Pragma("unroll") for (int m = 0; m < 4; ++m) _Pragma("unroll") for (int k = 0; k < 2; ++k) dst[m][k] = *(const PG8_LAS bf16x8*)(lds + PG8_SA(b, h) + aoff + m * 2048 + k * 1024); } while (0)
#define PG8_LDB(dst, b, h) do { _Pragma("unroll") for (int n = 0; n < 2; ++n) _Pragma("unroll") for (int k = 0; k < 2; ++k) dst[n][k] = *(const PG8_LAS bf16x8*)(lds + PG8_SB(b, h) + boff + n * 2048 + k * 1024); } while (0)
#define PG8_MMA(ai, bj, At, Bt) do { __builtin_amdgcn_s_setprio(1); _Pragma("unroll") for (int m = 0; m < 4; ++m) _Pragma("unroll") for (int n = 0; n < 2; ++n) _Pragma("unroll") for (int k = 0; k < 2; ++k) \
        acc[ai][bj][m][n] = __builtin_amdgcn_mfma_f32_16x16x32_bf16(Bt[n][k], At[m][k], acc[ai][bj][m][n], 0, 0, 0); __builtin_amdgcn_s_setprio(0); } while (0)
#define PG8_WAIT_V(n) asm volatile("s_waitcnt vmcnt(" #n ")" ::: "memory")
#define PG8_WAIT_L(n) asm volatile("s_waitcnt lgkmcnt(" #n ")" ::: "memory")
#define PG8_BAR __builtin_amdgcn_s_barrier()
#define PG8_SCHED __builtin_amdgcn_sched_barrier(0)
    Unit cur, nxt; int ui = 0;
    if (!S.next(0, cur)) return;
    f32x4 acc[2][2][4][2];
#pragma unroll
    for (int a = 0; a < 2; ++a)
#pragma unroll
        for (int b = 0; b < 2; ++b)
#pragma unroll
            for (int m = 0; m < 4; ++m)
#pragma unroll
                for (int n = 0; n < 2; ++n) acc[a][b][m][n] = (f32x4){0.f, 0.f, 0.f, 0.f};
    bf16x8 At[4][2], B0[2][2], B1[2][2];
    const char* cA = (const char*)(cur.seg ? g.A2 : g.A) + (size_t)cur.pm * tstep; const char* cB = (const char*)(cur.seg ? g.Bt2 : g.Bt) + (size_t)cur.pn * tstep;
    if constexpr (SP2) {
        PG8_STAGE(PG8_SB(0, 0), cB, voffB); PG8_STAGE(PG8_SB(0, 1), cB + hstep, voffB); PG8_STAGE(PG8_SA(0, 0), cA, voffA); PG8_STAGE(PG8_SA(0, 1), cA + hstep, voffA);
        if (wr == 1) PG8_BAR;
        PG8_WAIT_V(2); PG8_BAR;
        PG8_STAGE(PG8_SB(1, 0), cB + kstep, voffB); PG8_STAGE(PG8_SA(1, 0), cA + kstep, voffA); PG8_STAGE(PG8_SB(1, 1), cB + hstep + kstep, voffB);
        PG8_WAIT_V(6); PG8_BAR;
    } else {
        PG8_STAGE(PG8_SB(0, 0), cB, voffB); PG8_STAGE(PG8_SA(0, 0), cA, voffA); PG8_STAGE(PG8_SB(0, 1), cB + hstep, voffB); PG8_STAGE(PG8_SA(0, 1), cA + hstep, voffA);
        if (wr == 1) PG8_BAR;
        PG8_WAIT_V(4); PG8_BAR;
        PG8_STAGE(PG8_SB(1, 0), cB + kstep, voffB); PG8_STAGE(PG8_SA(1, 0), cA + kstep, voffA); PG8_STAGE(PG8_SB(1, 1), cB + hstep + kstep, voffB);
        PG8_WAIT_V(6); PG8_BAR;
    }
    for (;;) {
        const bool has_next = S.next(ui + 1, nxt);
        const char* nA = has_next ? (const char*)(nxt.seg ? g.A2 : g.A) + (size_t)nxt.pm * tstep : cA; const char* nB = has_next ? (const char*)(nxt.seg ? g.Bt2 : g.Bt) + (size_t)nxt.pn * tstep : cB;
        for (int t = 0; t < nt; t += 2) {
            const bool last = (t == nt - 2);
            const char* a1 = cA + (size_t)(t + 1) * kstep;
            const char* a2 = last ? nA : cA + (size_t)(t + 2) * kstep; const char* b2 = last ? nB : cB + (size_t)(t + 2) * kstep;
            const char* a3 = a2 + kstep; const char* b3 = b2 + kstep;
            if constexpr (SP2) {
            PG8_LDB(B0, 0, 0); PG8_LDB(B1, 0, 1); PG8_SCHED; PG8_LDA(At, 0, 0); PG8_STAGE(PG8_SA(1, 1), a1 + hstep, voffA);
            PG8_WAIT_V(8); PG8_WAIT_L(0); PG8_BAR; PG8_MMA(0, 0, At, B0); PG8_MMA(0, 1, At, B1); PG8_BAR; PG8_SCHED;
            PG8_LDA(At, 0, 1); PG8_STAGE(PG8_SB(0, 0), b2, voffB); PG8_STAGE(PG8_SB(0, 1), b2 + hstep, voffB); PG8_STAGE(PG8_SA(0, 0), a2, voffA);
            PG8_WAIT_V(8); PG8_WAIT_L(0); PG8_BAR; PG8_MMA(1, 0, At, B0); PG8_MMA(1, 1, At, B1); PG8_BAR; PG8_SCHED;
            PG8_LDB(B0, 1, 0); PG8_LDB(B1, 1, 1); PG8_SCHED; PG8_LDA(At, 1, 0); PG8_STAGE(PG8_SA(0, 1), a2 + hstep, voffA);
            PG8_WAIT_V(8); PG8_WAIT_L(0); PG8_BAR; PG8_MMA(0, 0, At, B0); PG8_MMA(0, 1, At, B1); PG8_BAR; PG8_SCHED;
            PG8_LDA(At, 1, 1); PG8_STAGE(PG8_SB(1, 0), b3, voffB); PG8_STAGE(PG8_SB(1, 1), b3 + hstep, voffB); PG8_STAGE(PG8_SA(1, 0), a3, voffA);
            PG8_WAIT_V(8); PG8_WAIT_L(0); PG8_BAR; PG8_MMA(1, 0, At, B0); PG8_MMA(1, 1, At, B1); PG8_BAR; PG8_SCHED;
            } else {
            PG8_LDB(B0, 0, 0); PG8_SCHED; PG8_LDA(At, 0, 0); PG8_STAGE(PG8_SA(1, 1), a1 + hstep, voffA);
            PG8_WAIT_L(8); PG8_BAR; PG8_WAIT_L(0); PG8_MMA(0, 0, At, B0); PG8_BAR; PG8_SCHED;
            PG8_LDB(B1, 0, 1); PG8_STAGE(PG8_SB(0, 0), b2, voffB);
            PG8_BAR; PG8_WAIT_L(0); PG8_MMA(0, 1, At, B1); PG8_BAR;
            PG8_LDA(At, 0, 1); PG8_STAGE(PG8_SA(0, 0), a2, voffA);
            PG8_BAR; PG8_WAIT_L(0); PG8_MMA(1, 0, At, B0); PG8_BAR; PG8_SCHED;
            PG8_STAGE(PG8_SB(0, 1), b2 + hstep, voffB);
            PG8_WAIT_V(6); PG8_BAR; PG8_MMA(1, 1, At, B1); PG8_BAR;
            PG8_LDB(B0, 1, 0); PG8_SCHED; PG8_LDA(At, 1, 0); PG8_STAGE(PG8_SA(0, 1), a2 + hstep, voffA);
            PG8_WAIT_L(8); PG8_BAR; PG8_WAIT_L(0); PG8_MMA(0, 0, At, B0); PG8_BAR; PG8_SCHED;
            PG8_LDB(B1, 1, 1); PG8_STAGE(PG8_SB(1, 0), b3, voffB);
            PG8_BAR; PG8_WAIT_L(0); PG8_MMA(0, 1, At, B1); PG8_BAR;
            PG8_LDA(At, 1, 1); PG8_STAGE(PG8_SA(1, 0), a3, voffA);
            PG8_BAR; PG8_WAIT_L(0); PG8_MMA(1, 0, At, B0); PG8_BAR; PG8_SCHED;
            PG8_STAGE(PG8_SB(1, 1), b3 + hstep, voffB);
            PG8_WAIT_V(6); PG8_BAR; PG8_MMA(1, 1, At, B1); PG8_BAR;
            }
        }
        if constexpr (ALIGN_EPI) { if (wr == 0) PG8_BAR; }
        E(acc, cur, wr, wc, fr, fq);
        if (!has_next) break;
        if (nxt.seg == 0)
#pragma unroll
        for (int a = 0; a < 2; ++a)
#pragma unroll
            for (int b = 0; b < 2; ++b)
#pragma unroll
                for (int m = 0; m < 4; ++m)
#pragma unroll
                    for (int n = 0; n < 2; ++n) acc[a][b][m][n] = (f32x4){0.f, 0.f, 0.f, 0.f};
        cur = nxt; cA = nA; cB = nB; ++ui;
        if constexpr (ALIGN_EPI) { if (wr == 1) PG8_BAR; }
    }
    PG8_WAIT_V(0);
    if constexpr (!ALIGN_EPI) { if (wr == 0) PG8_BAR; }
    PG8_BAR;
#undef PG8_SA
#undef PG8_SB
#undef PG8_STAGE
#undef PG8_LDA
#undef PG8_LDB
#undef PG8_MMA
#undef PG8_WAIT_V
#undef PG8_WAIT_L
#undef PG8_BAR
#undef PG8_SCHED
}
}

#define LAS __attribute__((address_space(3)))
typedef unsigned short bf16;
typedef short bf16x8 __attribute__((ext_vector_type(8)));
typedef float f32x4 __attribute__((ext_vector_type(4)));
typedef unsigned u32x4 __attribute__((ext_vector_type(4)));
typedef unsigned u32x2 __attribute__((ext_vector_type(2)));
using pg8::cvt_pk_bf16;

constexpr int NWAVES = 8, NTHR = 512;
constexpr int DM = 2048, MP = 8192, MS = 1024, MT = 9216, TP = 2048, TS = 8;
constexpr int NIN = 11288, NPROJ = 11264, NPROJ_PAD = 11520, DFF = 5632;
constexpr int C_MQ = 0, C_MK = 1024, C_MV = 2048, C_MO = 3072, C_GQ = 4096, C_GK = 4608, C_GV = 5120, C_GR = 6144, C_GA = 7168, C_GB = 9216;
constexpr float EPS = 1e-6f;
constexpr int NCH = 16;
constexpr int LDS_BYTES = 147456;

constexpr size_t O_YP = 0, O_YS = 16777216, O_PC = 18874368, O_PN = 19922944, O_PM = 19927040, O_PS = 19927056, O_PCONV = 20451344,
                 O_SC = 20496400, O_SN = 54050832, O_SM = 54181904, O_SS = 54182416, O_SCONV = 70959632;

constexpr size_t MiB = 1u << 20;
constexpr size_t WS_GATES = 64 * 1024;
constexpr size_t WS_PART = WS_GATES + (size_t)MT * 32 * 4;
constexpr size_t WS_DN = WS_PART + (size_t)MT * 32 * 4;
constexpr size_t WS_NPREV = WS_DN + 256 * 256 * 4;
constexpr size_t WS_CHS = WS_NPREV + 256 * 256 * 2;
constexpr size_t WS_BEND = WS_CHS + 256 * 2 * 4;
static_assert(WS_BEND + 256 * 128 * 4 <= 4 * MiB, "small region");
constexpr size_t WS_WIN = 4 * MiB;
constexpr size_t WS_WA = WS_WIN + (size_t)NPROJ_PAD * DM * 2;
constexpr size_t WS_WB = WS_WA + (size_t)2048 * 1024 * 2;
constexpr size_t WS_WO = WS_WB + (size_t)2048 * 1024 * 2;
constexpr size_t WS_WUG = WS_WO + (size_t)2048 * 2048 * 2;
constexpr size_t WS_WD = WS_WUG + (size_t)2 * DFF * DM * 2;
constexpr size_t WS_R1 = WS_WD + (size_t)DM * DFF * 2;
static_assert(WS_R1 == 131 * MiB, "map");
constexpr size_t WS_XN = WS_R1;
constexpr size_t WS_X1W = WS_R1 + 36 * MiB;
constexpr size_t WS_X1 = WS_R1 + 72 * MiB;
constexpr size_t WS_DC = WS_R1;
constexpr size_t WS_DS = WS_R1 + 64 * MiB;
constexpr size_t WS_CT = WS_R1 + 96 * MiB;
constexpr size_t WS_ST = WS_R1 + 128 * MiB;
constexpr size_t WS_YM = WS_R1 + 144 * MiB;
constexpr size_t WS_YG = WS_YM + 18 * MiB;
constexpr size_t WS_PROJ = WS_YG + 18 * MiB;
constexpr size_t WS_U = WS_PROJ, WS_G = WS_PROJ + 99 * MiB;
constexpr size_t WS_END = WS_PROJ + 198 * MiB;
static_assert(WS_END == 509 * MiB, "map");

struct Args {
    const float* in[25]; float* out; unsigned char* ws; int ph_lo, ph_hi;
};
enum { I_XP = 0, I_XS, I_C, I_N, I_M, I_S, I_CONV, I_WIN, I_BI, I_BF, I_AUP, I_AB, I_MHW, I_GHW, I_WA, I_WB, I_WO, I_NMIX, I_NFFN, I_WUP, I_WGATE, I_CW, I_CB, I_WDOWN, I_FNW };

__device__ __forceinline__ float bf2f(unsigned short b) { return __builtin_bit_cast(float, (unsigned)b << 16); }
__device__ __forceinline__ float bflo(unsigned w) { return __builtin_bit_cast(float, w << 16); }
__device__ __forceinline__ float bfhi(unsigned w) { return __builtin_bit_cast(float, w & 0xffff0000u); }
__device__ __forceinline__ unsigned short f2bf(float f) { return (unsigned short)(cvt_pk_bf16(f, 0.f) & 0xffffu); }
__device__ __forceinline__ float logsig(float z) { return fminf(z, 0.f) - log1pf(__expf(-fabsf(z))); }
__device__ __forceinline__ float sigm(float z) { return 1.f / (1.f + __expf(-z)); }
__device__ __forceinline__ float wave_sum(float v) {
#pragma unroll
    for (int o = 1; o < 64; o <<= 1) v += __shfl_xor(v, o);
    return v;
}
__device__ __forceinline__ float wave_max(float v) {
#pragma unroll
    for (int o = 1; o < 64; o <<= 1) v = fmaxf(v, __shfl_xor(v, o));
    return v;
}
__device__ __forceinline__ float sum4(f32x4 v) { return (v.x + v.y) + (v.z + v.w); }
__device__ __forceinline__ float dot4(f32x4 a, f32x4 b) { return (a.x * b.x + a.y * b.y) + (a.z * b.z + a.w * b.w); }
__device__ __forceinline__ float gelu_tanh(float v) { const float u = 0.7978845608028654f * (v + 0.044715f * v * v * v); return v * sigm(2.f * u); }

typedef f32x4 AccT[2][2][4][2];
struct EpiProj {
    static constexpr bool PERM = true;
    bf16* P; float* gates;
    __device__ __forceinline__ void operator()(AccT& acc, const pg8::Unit& u, int wr, int wc, int fr, int fq) const {
        const int row0 = u.pm * 256 + wr * 64 + fr;
        if (u.pn < 44) {
            const int col0 = u.pn * 256 + wc * 32 + 8 * fq;
#pragma unroll
            for (int ai = 0; ai < 2; ++ai)
#pragma unroll
                for (int m = 0; m < 4; ++m) { bf16* rowp = P + (size_t)(row0 + ai * 128 + m * 16) * NPROJ + col0;
#pragma unroll
                    for (int bj = 0; bj < 2; ++bj) { const f32x4 v0 = acc[ai][bj][m][0], v1 = acc[ai][bj][m][1]; u32x4 w;
                        w.x = cvt_pk_bf16(v0[0], v0[1]); w.y = cvt_pk_bf16(v0[2], v0[3]); w.z = cvt_pk_bf16(v1[0], v1[1]); w.w = cvt_pk_bf16(v1[2], v1[3]);
                        *(u32x4*)(rowp + bj * 128) = w; } }
        } else if (wc == 0) {
#pragma unroll
            for (int ai = 0; ai < 2; ++ai)
#pragma unroll
                for (int m = 0; m < 4; ++m) { float* rowp = gates + (size_t)(row0 + ai * 128 + m * 16) * 32 + 8 * fq;
                    *(f32x4*)rowp = acc[ai][0][m][0]; *(f32x4*)(rowp + 4) = acc[ai][0][m][1]; }
        }
    }
};
struct EpiBranch {
    static constexpr bool PERM = true;
    const bf16* P; bf16* O;
    __device__ __forceinline__ void operator()(AccT& acc, const pg8::Unit& u, int wr, int wc, int fr, int fq) const {
        const int row0 = u.pm * 256 + wr * 64 + fr, col0 = u.pn * 256 + wc * 32 + 8 * fq;
#pragma unroll
        for (int ai = 0; ai < 2; ++ai)
#pragma unroll
            for (int m = 0; m < 4; ++m) { const int row = row0 + ai * 128 + m * 16;
#pragma unroll
                for (int bj = 0; bj < 2; ++bj) { const int col = col0 + bj * 128;
                    const u32x4 ga = *(const u32x4*)(P + (size_t)row * NPROJ + C_GA + col), gb = *(const u32x4*)(P + (size_t)row * NPROJ + C_GB + col);
                    float fa[8] = {bflo(ga.x), bfhi(ga.x), bflo(ga.y), bfhi(ga.y), bflo(ga.z), bfhi(ga.z), bflo(ga.w), bfhi(ga.w)};
                    float fb[8] = {bflo(gb.x), bfhi(gb.x), bflo(gb.y), bfhi(gb.y), bflo(gb.z), bfhi(gb.z), bflo(gb.w), bfhi(gb.w)};
                    if (u.seg == 0) {
#pragma unroll
                        for (int i = 0; i < 8; ++i) { const float r = (1.f + __expf(-fb[i])) / (1.f + __expf(-fa[i])); acc[ai][bj][m][i >> 2][i & 3] *= r; }
                    } else {
                        float o[8];
#pragma unroll
                        for (int i = 0; i < 8; ++i) o[i] = acc[ai][bj][m][i >> 2][i & 3] * sigm(fb[i]);
                        u32x4 w; w.x = cvt_pk_bf16(o[0], o[1]); w.y = cvt_pk_bf16(o[2], o[3]); w.z = cvt_pk_bf16(o[4], o[5]); w.w = cvt_pk_bf16(o[6], o[7]);
                        *(u32x4*)(O + (size_t)row * DM + col) = w;
                    } } }
    }
};
struct EpiOut {
    static constexpr bool PERM = true;
    const float* xp; const float* xs; float* X1; bf16* X1W; const float* nw; float* part;
    __device__ __forceinline__ void operator()(AccT& acc, const pg8::Unit& u, int wr, int wc, int fr, int fq) const {
        const int row0 = u.pm * 256 + wr * 64 + fr, col0 = u.pn * 256 + wc * 32 + 8 * fq;
#pragma unroll
        for (int ai = 0; ai < 2; ++ai)
#pragma unroll
            for (int m = 0; m < 4; ++m) { const int row = row0 + ai * 128 + m * 16;
                const float* xrow = row < MP ? xp + (size_t)row * DM : xs + (size_t)(row - MP) * DM;
                float ss = 0.f;
#pragma unroll
                for (int bj = 0; bj < 2; ++bj) { const int col = col0 + bj * 128;
                    const f32x4 v0 = acc[ai][bj][m][0] + *(const f32x4*)(xrow + col), v1 = acc[ai][bj][m][1] + *(const f32x4*)(xrow + col + 4);
                    *(f32x4*)(X1 + (size_t)row * DM + col) = v0; *(f32x4*)(X1 + (size_t)row * DM + col + 4) = v1;
                    ss += dot4(v0, v0) + dot4(v1, v1);
                    const f32x4 w0 = *(const f32x4*)(nw + col), w1 = *(const f32x4*)(nw + col + 4);
                    u32x4 w; w.x = cvt_pk_bf16(v0[0] * w0[0], v0[1] * w0[1]); w.y = cvt_pk_bf16(v0[2] * w0[2], v0[3] * w0[3]);
                    w.z = cvt_pk_bf16(v1[0] * w1[0], v1[1] * w1[1]); w.w = cvt_pk_bf16(v1[2] * w1[2], v1[3] * w1[3]);
                    *(u32x4*)(X1W + (size_t)row * DM + col) = w; }
                ss += __shfl_xor(ss, 16); ss += __shfl_xor(ss, 32);
                if (fq == 0) part[(size_t)row * 32 + u.pn * 4 + wc] = ss; }
    }
};
__device__ __forceinline__ float row_rstd(const float* part, int row, int fq) {
    const f32x4 a = *(const f32x4*)(part + (size_t)row * 32 + fq * 8), b = *(const f32x4*)(part + (size_t)row * 32 + fq * 8 + 4);
    float s = sum4(a) + sum4(b); s += __shfl_xor(s, 16); s += __shfl_xor(s, 32);
    return rsqrtf(s * (1.f / DM) + EPS);
}
struct EpiUG {
    static constexpr bool PERM = true;
    const float* part; bf16* U; bf16* G; float* out;
    __device__ __forceinline__ void operator()(AccT& acc, const pg8::Unit& u, int wr, int wc, int fr, int fq) const {
        const int row0 = u.pm * 256 + wr * 64 + fr, col = u.pn * 128 + wc * 32 + 8 * fq;
#pragma unroll
        for (int ai = 0; ai < 2; ++ai)
#pragma unroll
            for (int m = 0; m < 4; ++m) { const int row = row0 + ai * 128 + m * 16;
                const float r = row_rstd(part, row, fq);
                const f32x4 u0 = acc[ai][0][m][0] * r, u1 = acc[ai][0][m][1] * r, g0 = acc[ai][1][m][0] * r, g1 = acc[ai][1][m][1] * r;
                u32x4 w; w.x = cvt_pk_bf16(u0[0], u0[1]); w.y = cvt_pk_bf16(u0[2], u0[3]); w.z = cvt_pk_bf16(u1[0], u1[1]); w.w = cvt_pk_bf16(u1[2], u1[3]);
                *(u32x4*)(U + (size_t)row * DFF + col) = w;
                w.x = cvt_pk_bf16(g0[0], g0[1]); w.y = cvt_pk_bf16(g0[2], g0[3]); w.z = cvt_pk_bf16(g1[0], g1[1]); w.w = cvt_pk_bf16(g1[2], g1[3]);
                *(u32x4*)(G + (size_t)row * DFF + col) = w;
                float* cs = nullptr;
                if (row < MP) { const int t = row & (TP - 1); if (t >= TP - 2) cs = out + O_PCONV + ((size_t)(row >> 11) * 2 + (t - (TP - 2))) * DFF + col; }
                else { const int rr = row - MP, t = rr & 7; if (t >= 6) cs = out + O_SCONV + ((size_t)(rr >> 3) * 2 + (t - 6)) * DFF + col; }
                if (cs) { *(f32x4*)cs = u0; *(f32x4*)(cs + 4) = u1; } }
    }
};
struct EpiDown {
    static constexpr bool PERM = true;
    const float* X1; float* out; float* part;
    __device__ __forceinline__ void operator()(AccT& acc, const pg8::Unit& u, int wr, int wc, int fr, int fq) const {
        const int row0 = u.pm * 256 + wr * 64 + fr, col0 = u.pn * 256 + wc * 32 + 8 * fq;
#pragma unroll
        for (int ai = 0; ai < 2; ++ai)
#pragma unroll
            for (int m = 0; m < 4; ++m) { const int row = row0 + ai * 128 + m * 16; float ss = 0.f;
#pragma unroll
                for (int bj = 0; bj < 2; ++bj) { const int col = col0 + bj * 128;
                    const f32x4 v0 = acc[ai][bj][m][0] + *(const f32x4*)(X1 + (size_t)row * DM + col), v1 = acc[ai][bj][m][1] + *(const f32x4*)(X1 + (size_t)row * DM + col + 4);
                    *(f32x4*)(out + (size_t)row * DM + col) = v0; *(f32x4*)(out + (size_t)row * DM + col + 4) = v1;
                    ss += dot4(v0, v0) + dot4(v1, v1); }
                ss += __shfl_xor(ss, 16); ss += __shfl_xor(ss, 32);
                if (fq == 0) part[(size_t)row * 32 + u.pn * 4 + wc] = ss; }
    }
};

template <class ColPtr>
__device__ __forceinline__ void transpose_item(const ColPtr& cp, int K, int srcN, bf16* WT, LAS float* scr, int kb, int nb, int lane) {
    const int k0 = 64 * kb, n0 = 32 * nb;
    const float* src = cp(n0 + (lane & 31));
#pragma unroll 8
    for (int i = 0; i < 32; ++i) { const int kk = 2 * i + (lane >> 5); scr[kk * 33 + (lane & 31)] = src ? src[(size_t)(k0 + kk) * srcN] : 0.f; }
    asm volatile("s_waitcnt lgkmcnt(0)" ::: "memory");
    const int c = lane & 7;
#pragma unroll
    for (int j = 0; j < 4; ++j) { const int n = (lane >> 3) + 8 * j; const LAS float* s = scr + (8 * c) * 33 + n;
        u32x4 o; o.x = cvt_pk_bf16(s[0 * 33], s[1 * 33]); o.y = cvt_pk_bf16(s[2 * 33], s[3 * 33]); o.z = cvt_pk_bf16(s[4 * 33], s[5 * 33]); o.w = cvt_pk_bf16(s[6 * 33], s[7 * 33]);
        *(u32x4*)(WT + (size_t)(n0 + n) * K + k0 + 8 * c) = o; }
    asm volatile("s_waitcnt lgkmcnt(0)" ::: "memory");
}
struct ColWin { const float* W; __device__ __forceinline__ const float* operator()(int n) const {
    int c; if (n < 4096) c = n; else if (n < 7168) c = n + 8; else if (n < 11264) c = n + 24; else if (n < 11272) c = 4096 + (n - 11264); else if (n < 11288) c = 7176 + (n - 11272); else return nullptr;
    return W + c; } };
struct ColPlain { const float* W; __device__ __forceinline__ const float* operator()(int n) const { return W + n; } };
struct ColUG { const float* Wu; const float* Wg; __device__ __forceinline__ const float* operator()(int n) const { const int pn = n >> 8, w = n & 255; return w < 128 ? Wu + pn * 128 + w : Wg + pn * 128 + (w - 128); } };

__device__ __forceinline__ void p0_prologue(const Args& a, LAS unsigned char* lds, int vcu, int G) {
    const int tid = threadIdx.x, lane = tid & 63, wave = __builtin_amdgcn_readfirstlane(tid >> 6);
    LAS float* scr = (LAS float*)(lds + wave * 16384);
    const int gw = vcu * NWAVES + wave, NGW = G * NWAVES;
    unsigned char* ws = a.ws;
    constexpr int I_WIN_ = 32 * (NPROJ_PAD / 32), I_A = 16 * 64, I_O = 32 * 64, I_UG = 32 * (2 * DFF / 32), I_D = (DFF / 64) * 64;
    constexpr int NITEMS = I_WIN_ + 2 * I_A + I_O + I_UG + I_D;
    for (int it = gw; it < NITEMS; it += NGW) {
        int r = it;
        if (r < I_WIN_) { ColWin cp{a.in[I_WIN]}; const int nblk = NPROJ_PAD / 32; transpose_item(cp, DM, NIN, (bf16*)(ws + WS_WIN), scr, r / nblk, r % nblk, lane); continue; } r -= I_WIN_;
        if (r < I_A) { ColPlain cp{a.in[I_WA]}; transpose_item(cp, 1024, DM, (bf16*)(ws + WS_WA), scr, r / 64, r % 64, lane); continue; } r -= I_A;
        if (r < I_A) { ColPlain cp{a.in[I_WB]}; transpose_item(cp, 1024, DM, (bf16*)(ws + WS_WB), scr, r / 64, r % 64, lane); continue; } r -= I_A;
        if (r < I_O) { ColPlain cp{a.in[I_WO]}; transpose_item(cp, DM, DM, (bf16*)(ws + WS_WO), scr, r / 64, r % 64, lane); continue; } r -= I_O;
        if (r < I_UG) { ColUG cp{a.in[I_WUP], a.in[I_WGATE]}; const int nblk = 2 * DFF / 32; transpose_item(cp, DM, DFF, (bf16*)(ws + WS_WUG), scr, r / nblk, r % nblk, lane); continue; } r -= I_UG;
        { ColPlain cp{a.in[I_WDOWN]}; transpose_item(cp, DFF, DM, (bf16*)(ws + WS_WD), scr, r / 64, r % 64, lane); }
    }
    const float* nw = a.in[I_NMIX]; bf16* XN = (bf16*)(ws + WS_XN);
    for (int m = gw; m < MT; m += NGW) {
        const float* xrow = m < MP ? a.in[I_XP] + (size_t)m * DM : a.in[I_XS] + (size_t)(m - MP) * DM;
        f32x4 v[8]; float s = 0.f;
#pragma unroll
        for (int j = 0; j < 8; ++j) { v[j] = *(const f32x4*)(xrow + 4 * lane + 256 * j); s += dot4(v[j], v[j]); }
        const float r = rsqrtf(wave_sum(s) * (1.f / DM) + EPS);
#pragma unroll
        for (int j = 0; j < 8; ++j) { const f32x4 w = *(const f32x4*)(nw + 4 * lane + 256 * j); u32x2 o; o.x = cvt_pk_bf16(v[j][0] * r * w[0], v[j][1] * r * w[1]); o.y = cvt_pk_bf16(v[j][2] * r * w[2], v[j][3] * r * w[3]);
            *(u32x2*)(XN + (size_t)m * DM + 4 * lane + 256 * j) = o; }
    }
}

__device__ __forceinline__ void stage_vt(LAS bf16* Vt, const bf16* P, int row0, int colbase, int tid) {
#pragma unroll
    for (int i = 0; i < 8; ++i) { const int idx = tid + NTHR * i, s = idx >> 5, ep = idx & 31;
        const u32x4 w = *(const u32x4*)(P + (size_t)(row0 + s) * NPROJ + colbase + 8 * ep);
        LAS bf16* d = Vt + (8 * ep) * 136 + s;
        d[0 * 136] = (bf16)(w.x & 0xffff); d[1 * 136] = (bf16)(w.x >> 16); d[2 * 136] = (bf16)(w.y & 0xffff); d[3 * 136] = (bf16)(w.y >> 16);
        d[4 * 136] = (bf16)(w.z & 0xffff); d[5 * 136] = (bf16)(w.z >> 16); d[6 * 136] = (bf16)(w.w & 0xffff); d[7 * 136] = (bf16)(w.w >> 16); }
}
__device__ __forceinline__ void gla_logdecay(const Args& a, const float* gates, int row0, int h, LAS float* galS, LAS float* segS, int tid, float (&la)[32], float& off, float& tot) {
    const int d = tid & 127, seg = tid >> 7;
    { const int t = tid >> 2, q = tid & 3; *(LAS f32x4*)(galS + t * 16 + q * 4) = *(const f32x4*)(gates + (size_t)(row0 + t) * 32 + 8 + q * 4); }
    float up[16];
#pragma unroll
    for (int j = 0; j < 16; ++j) up[j] = a.in[I_AUP][j * 512 + h * 128 + d];
    const float ab = a.in[I_AB][h * 128 + d];
    __syncthreads();
    float ssum = 0.f;
#pragma unroll
    for (int i = 0; i < 32; ++i) { const int t = seg * 32 + i; float z = ab;
#pragma unroll
        for (int q = 0; q < 4; ++q) { const f32x4 g = *(const LAS f32x4*)(galS + t * 16 + q * 4); z += g[0] * up[4 * q] + g[1] * up[4 * q + 1] + g[2] * up[4 * q + 2] + g[3] * up[4 * q + 3]; }
        la[i] = logsig(z) * (1.f / 16.f); ssum += la[i]; }
    segS[seg * 128 + d] = ssum;
    __syncthreads();
    off = 0.f; tot = 0.f;
#pragma unroll
    for (int s = 0; s < 4; ++s) { const float v = segS[s * 128 + d]; tot += v; off += (s < seg) ? v : 0.f; }
}

template <bool ML>
__device__ __forceinline__ void chunk_state(const Args& a, LAS unsigned char* lds, int bh, int c) {
    constexpr int DK = ML ? 256 : 128, NDT = DK / 16;
    int tid_ = threadIdx.x; asm volatile("" : "+v"(tid_));
    const int tid = tid_, lane = tid & 63, wave = __builtin_amdgcn_readfirstlane(tid >> 6), fr = lane & 15, fq = lane >> 4;
    const int b = bh >> 2, h = bh & 3, row0 = b * TP + c * 128, item = bh * NCH + c;
    unsigned char* ws = a.ws;
    const bf16* P = (const bf16*)(ws + WS_PROJ); const float* gates = (const float*)(ws + WS_GATES);
    LAS bf16* Kt = (LAS bf16*)lds; LAS bf16* Vt = (LAS bf16*)(lds + 69632); LAS float* sc = (LAS float*)(lds + 139264);
    __syncthreads();
    if (ML) {
        if (tid < 128) { const float mi = gates[(size_t)(row0 + tid) * 32 + h], mf = gates[(size_t)(row0 + tid) * 32 + 4 + h];
            sc[tid] = logsig(mf + a.in[I_BF][h]); sc[128 + tid] = mi + a.in[I_BI][h]; }
        __syncthreads();
        if (tid < 128) { float bs = 0.f; for (int s = 0; s <= tid; ++s) bs += sc[s]; sc[256 + tid] = sc[128 + tid] - bs; if (tid == 127) sc[384] = bs; }
        __syncthreads();
        if (tid < 64) { const float mx = wave_max(fmaxf(sc[256 + tid], sc[320 + tid])); if (tid == 0) sc[385] = mx; }
        __syncthreads();
        const float Ah = sc[385];
        if (tid < 128) sc[tid] = __expf(sc[256 + tid] - Ah);
        if (tid == 0) { float* chs = (float*)(ws + WS_CHS); chs[item * 2] = Ah; chs[item * 2 + 1] = sc[384]; }
        __syncthreads();
#pragma unroll
        for (int i = 0; i < 8; ++i) { const int idx = tid + NTHR * i, s = idx >> 5, dp = idx & 31; const float w = sc[s] * (1.f / 16.f);
            const u32x4 v = *(const u32x4*)(P + (size_t)(row0 + s) * NPROJ + C_MK + h * 256 + 8 * dp);
            LAS bf16* d = Kt + (8 * dp) * 136 + s;
            d[0 * 136] = f2bf(bflo(v.x) * w); d[1 * 136] = f2bf(bfhi(v.x) * w); d[2 * 136] = f2bf(bflo(v.y) * w); d[3 * 136] = f2bf(bfhi(v.y) * w);
            d[4 * 136] = f2bf(bflo(v.z) * w); d[5 * 136] = f2bf(bfhi(v.z) * w); d[6 * 136] = f2bf(bflo(v.w) * w); d[7 * 136] = f2bf(bfhi(v.w) * w); }
    } else {
        float la[32], off, tot;
        LAS float* galS = (LAS float*)(lds + 34816); gla_logdecay(a, gates, row0, h, galS, galS + 2048, tid, la, off, tot);
        const int d = tid & 127, seg = tid >> 7;
        if (seg == 0) ((float*)(ws + WS_BEND))[item * 128 + d] = tot;
        float bcur = off;
#pragma unroll
        for (int i = 0; i < 32; ++i) { const int t = seg * 32 + i; bcur += la[i];
            const float kv = bf2f(P[(size_t)(row0 + t) * NPROJ + C_GK + h * 128 + d]);
            Kt[d * 136 + t] = f2bf(kv * __expf(tot - bcur)); }
    }
    stage_vt(Vt, P, row0, (ML ? C_MV : C_GV) + h * 256, tid);
    __syncthreads();
    f32x4 acc[2][NDT];
#pragma unroll
    for (int e = 0; e < 2; ++e)
#pragma unroll
        for (int d = 0; d < NDT; ++d) acc[e][d] = (f32x4){0.f, 0.f, 0.f, 0.f};
#pragma unroll
    for (int ks = 0; ks < 4; ++ks) {
        bf16x8 vb[2];
#pragma unroll
        for (int e = 0; e < 2; ++e) vb[e] = *(const LAS bf16x8*)(Vt + (wave * 32 + e * 16 + fr) * 136 + ks * 32 + fq * 8);
#pragma unroll
        for (int d = 0; d < NDT; ++d) { const bf16x8 ka = *(const LAS bf16x8*)(Kt + (d * 16 + fr) * 136 + ks * 32 + fq * 8);
#pragma unroll
            for (int e = 0; e < 2; ++e) acc[e][d] = __builtin_amdgcn_mfma_f32_16x16x32_bf16(ka, vb[e], acc[e][d], 0, 0, 0); }
    }
    float* dst = (float*)(ws + (ML ? WS_DC : WS_DS)) + (size_t)item * 256 * DK;
#pragma unroll
    for (int e = 0; e < 2; ++e)
#pragma unroll
        for (int d = 0; d < NDT; ++d) *(f32x4*)(dst + (size_t)(wave * 32 + e * 16 + fr) * DK + d * 16 + 4 * fq) = acc[e][d];
    if (ML && tid < 256) { float s = 0.f;
#pragma unroll 8
        for (int i = 0; i < 128; ++i) s += bf2f(Kt[tid * 136 + i]);
        ((float*)(ws + WS_DN))[item * 256 + tid] = s; }
}

__device__ __forceinline__ void scan_mlstm(const Args& a, int j) {
    const int tid = threadIdx.x, bh = j >> 5, eb = j & 31;
    unsigned char* ws = a.ws;
    const float* chs = (const float*)(ws + WS_CHS);
    const int e = eb * 8 + (tid >> 6), d4 = (tid & 63) * 4;
    const float* dC = (const float*)(ws + WS_DC) + (size_t)bh * NCH * 65536 + (size_t)e * 256 + d4;
    bf16* CT = (bf16*)(ws + WS_CT) + (size_t)bh * NCH * 65536 + (size_t)e * 256 + d4;
    f32x4 Cv = {0.f, 0.f, 0.f, 0.f}; float Fs = 0.f, Mp = 0.f;
    const bool do_n = (eb == 0 && tid < 256);
    float nv = 0.f;
    f32x4 dv[NCH];
#pragma unroll
    for (int c = 0; c < NCH; ++c) dv[c] = *(const f32x4*)(dC + (size_t)c * 65536);
#pragma unroll
    for (int c = 0; c < NCH; ++c) {
        u32x2 o; o.x = cvt_pk_bf16(Cv[0], Cv[1]); o.y = cvt_pk_bf16(Cv[2], Cv[3]); *(u32x2*)(CT + (size_t)c * 65536) = o;
        if (do_n) ((bf16*)(ws + WS_NPREV))[(bh * NCH + c) * 256 + tid] = f2bf(nv);
        const float Ah = chs[(bh * NCH + c) * 2], bt = chs[(bh * NCH + c) * 2 + 1];
        const float Ac = Ah - Fs, Mn = fmaxf(Mp, Ac), f1 = __expf(Mp - Mn), f2 = __expf(Ac - Mn);
        Cv = Cv * f1 + dv[c] * f2;
        if (do_n) nv = nv * f1 + ((const float*)(ws + WS_DN))[(bh * NCH + c) * 256 + tid] * f2;
        Mp = Mn; Fs += bt;
    }
    float* oC = a.out + O_PC + (size_t)bh * 65536;
#pragma unroll
    for (int i = 0; i < 4; ++i) oC[(size_t)(d4 + i) * 256 + e] = Cv[i];
    if (do_n) a.out[O_PN + bh * 256 + tid] = nv;
    if (eb == 0 && tid == 0) a.out[O_PM + bh] = Fs + Mp;
}
__device__ __forceinline__ void scan_gla(const Args& a, int j) {
    const int tid = threadIdx.x, bh = j >> 4, eb = j & 15;
    unsigned char* ws = a.ws;
    const float* bend = (const float*)(ws + WS_BEND);
    const int ee = eb * 16 + (tid >> 5), d4 = (tid & 31) * 4;
    const float* dS = (const float*)(ws + WS_DS) + (size_t)bh * NCH * 32768 + (size_t)ee * 128 + d4;
    bf16* ST = (bf16*)(ws + WS_ST) + (size_t)bh * NCH * 32768 + (size_t)ee * 128 + d4;
    f32x4 Sv = {0.f, 0.f, 0.f, 0.f};
    f32x4 dv[NCH];
#pragma unroll
    for (int c = 0; c < NCH; ++c) dv[c] = *(const f32x4*)(dS + (size_t)c * 32768);
#pragma unroll
    for (int c = 0; c < NCH; ++c) {
        u32x2 o; o.x = cvt_pk_bf16(Sv[0], Sv[1]); o.y = cvt_pk_bf16(Sv[2], Sv[3]); *(u32x2*)(ST + (size_t)c * 32768) = o;
        const f32x4 be = *(const f32x4*)(bend + (bh * NCH + c) * 128 + d4);
        Sv[0] = Sv[0] * __expf(be[0]) + dv[c][0]; Sv[1] = Sv[1] * __expf(be[1]) + dv[c][1]; Sv[2] = Sv[2] * __expf(be[2]) + dv[c][2]; Sv[3] = Sv[3] * __expf(be[3]) + dv[c][3];
    }
    float* oS = a.out + O_PS + (size_t)bh * 32768;
#pragma unroll
    for (int i = 0; i < 4; ++i) oS[(size_t)(d4 + i) * 256 + ee] = Sv[i];
}

template <bool ML>
__device__ __forceinline__ void chunk_out(const Args& a, LAS unsigned char* lds, int bh, int c) {
    constexpr int DK = ML ? 256 : 128, QS = DK + 8, NKK = DK / 32;
    int tid_ = threadIdx.x; asm volatile("" : "+v"(tid_));
    const int tid = tid_, lane = tid & 63, wave = __builtin_amdgcn_readfirstlane(tid >> 6), fr = lane & 15, fq = lane >> 4;
    const int b = bh >> 2, h = bh & 3, row0 = b * TP + c * 128, item = bh * NCH + c;
    unsigned char* ws = a.ws;
    const bf16* P = (const bf16*)(ws + WS_PROJ); const float* gates = (const float*)(ws + WS_GATES);
    LAS bf16* Qs = (LAS bf16*)lds; LAS bf16* Ks = Qs + 128 * QS;
    LAS float* sc = (LAS float*)(lds + 143616);
    __syncthreads();
    if (ML) {
        const float* chs = (const float*)(ws + WS_CHS);
        float Fs = 0.f, Mp = 0.f;
        for (int cc = 0; cc < c; ++cc) { const float Ah = chs[(bh * NCH + cc) * 2], bt = chs[(bh * NCH + cc) * 2 + 1]; Mp = fmaxf(Mp, Ah - Fs); Fs += bt; }
        if (tid < 128) { const float mi = gates[(size_t)(row0 + tid) * 32 + h], mf = gates[(size_t)(row0 + tid) * 32 + 4 + h];
            sc[512 + tid] = logsig(mf + a.in[I_BF][h]); sc[640 + tid] = mi + a.in[I_BI][h]; }
        __syncthreads();
        float bs = 0.f;
        if (tid < 128) { for (int s = 0; s <= tid; ++s) bs += sc[512 + s]; sc[tid] = sc[640 + tid] - bs - Fs; }
        __syncthreads();
        if (tid < 128) { float M = Mp; for (int s = 0; s <= tid; ++s) M = fmaxf(M, sc[s]); sc[128 + tid] = M; sc[256 + tid] = __expf(Mp - M); sc[384 + tid] = __expf(-(Fs + bs + M)); }
#pragma unroll
        for (int i = 0; i < 8; ++i) { const int idx = tid + NTHR * i, t = idx >> 5, p = idx & 31;
            *(LAS u32x4*)(Qs + t * QS + p * 8) = *(const u32x4*)(P + (size_t)(row0 + t) * NPROJ + C_MQ + h * 256 + p * 8);
            *(LAS u32x4*)(Ks + t * QS + p * 8) = *(const u32x4*)(P + (size_t)(row0 + t) * NPROJ + C_MK + h * 256 + p * 8); }
    } else {
        float la[32], off, tot;
        LAS float* galS = (LAS float*)(lds + 69632); LAS float* segS = galS + 128 * 16;
        gla_logdecay(a, gates, row0, h, galS, segS, tid, la, off, tot);
        const int d = tid & 127, seg = tid >> 7;
        float bcur = off;
#pragma unroll
        for (int i = 0; i < 32; ++i) { const int t = seg * 32 + i; bcur += la[i];
            const float qv = bf2f(P[(size_t)(row0 + t) * NPROJ + C_GQ + h * 128 + d]), kv = bf2f(P[(size_t)(row0 + t) * NPROJ + C_GK + h * 128 + d]);
            Qs[t * QS + d] = f2bf(qv * 0.08838834764831845f * __expf(bcur)); Ks[t * QS + d] = f2bf(kv * __expf(-bcur)); }
    }
    __syncthreads();
    bf16x8 qf[NKK];
#pragma unroll
    for (int kk = 0; kk < NKK; ++kk) qf[kk] = *(const LAS bf16x8*)(Qs + (wave * 16 + fr) * QS + kk * 32 + fq * 8);
    const int t = wave * 16 + fr;
    u32x2 pb[8]; float den = 0.f;
    {
        const float Mt = ML ? sc[128 + t] : 0.f;
#pragma unroll
        for (int st = 0; st < 8; ++st) { f32x4 s = {0.f, 0.f, 0.f, 0.f};
#pragma unroll
            for (int kk = 0; kk < NKK; ++kk) { const bf16x8 kf = *(const LAS bf16x8*)(Ks + (st * 16 + fr) * QS + kk * 32 + fq * 8); s = __builtin_amdgcn_mfma_f32_16x16x32_bf16(kf, qf[kk], s, 0, 0, 0); }
            float p[4];
#pragma unroll
            for (int r = 0; r < 4; ++r) { const int si = st * 16 + 4 * fq + r;
                if (ML) p[r] = (si <= t) ? s[r] * (1.f / 16.f) * __expf(sc[si] - Mt) : 0.f; else p[r] = (si <= t) ? s[r] : 0.f;
                den += p[r]; }
            pb[st].x = cvt_pk_bf16(p[0], p[1]); pb[st].y = cvt_pk_bf16(p[2], p[3]); }
    }
    __syncthreads();
    LAS bf16* Cl = (LAS bf16*)lds;
    if (ML) {
        const bf16* CT = (const bf16*)(ws + WS_CT) + (size_t)item * 65536;
#pragma unroll
        for (int i = 0; i < 16; ++i) { const int idx = tid + NTHR * i, e = idx >> 5, p = idx & 31; *(LAS u32x4*)(Cl + e * QS + p * 8) = *(const u32x4*)(CT + (size_t)e * 256 + p * 8); }
        { const int e = tid >> 5, p = tid & 31; u32x4 v = {0u, 0u, 0u, 0u};
          if (e == 0) v = *(const u32x4*)((const bf16*)(ws + WS_NPREV) + (size_t)item * 256 + p * 8);
          *(LAS u32x4*)(Cl + (256 + e) * QS + p * 8) = v; }
    } else {
        const bf16* ST = (const bf16*)(ws + WS_ST) + (size_t)item * 32768;
#pragma unroll
        for (int i = 0; i < 8; ++i) { const int idx = tid + NTHR * i, e = idx >> 4, p = idx & 15; *(LAS u32x4*)(Cl + e * QS + p * 8) = *(const u32x4*)(ST + (size_t)e * 128 + p * 8); }
    }
    __syncthreads();
    f32x4 acc[16];
#pragma unroll
    for (int et = 0; et < 16; ++et) { acc[et] = (f32x4){0.f, 0.f, 0.f, 0.f};
#pragma unroll
        for (int kk = 0; kk < NKK; ++kk) { const bf16x8 cf = *(const LAS bf16x8*)(Cl + (et * 16 + fr) * QS + kk * 32 + fq * 8); acc[et] = __builtin_amdgcn_mfma_f32_16x16x32_bf16(cf, qf[kk], acc[et], 0, 0, 0); } }
    float wint = 1.f, qn = 0.f;
    if (ML) {
        f32x4 dn = {0.f, 0.f, 0.f, 0.f};
#pragma unroll
        for (int kk = 0; kk < NKK; ++kk) { const bf16x8 nf = *(const LAS bf16x8*)(Cl + (256 + fr) * QS + kk * 32 + fq * 8); dn = __builtin_amdgcn_mfma_f32_16x16x32_bf16(nf, qf[kk], dn, 0, 0, 0); }
        qn = __shfl(dn[0], fr);
        wint = sc[256 + t];
#pragma unroll
        for (int et = 0; et < 16; ++et) acc[et] = acc[et] * wint;
    }
    __syncthreads();
    LAS bf16* Vt = (LAS bf16*)lds;
    stage_vt(Vt, P, row0, (ML ? C_MV : C_GV) + h * 256, tid);
    __syncthreads();
#pragma unroll
    for (int ks = 0; ks < 4; ++ks) {
        u32x4 pw; pw.x = pb[2 * ks].x; pw.y = pb[2 * ks].y; pw.z = pb[2 * ks + 1].x; pw.w = pb[2 * ks + 1].y;
        const bf16x8 pf = __builtin_bit_cast(bf16x8, pw);
#pragma unroll
        for (int et = 0; et < 16; ++et) { const LAS bf16* vp = Vt + (et * 16 + fr) * 136 + ks * 32 + 4 * fq;
            const u32x2 lo = *(const LAS u32x2*)vp, hi = *(const LAS u32x2*)(vp + 16);
            u32x4 vw; vw.x = lo.x; vw.y = lo.y; vw.z = hi.x; vw.w = hi.y;
            acc[et] = __builtin_amdgcn_mfma_f32_16x16x32_bf16(__builtin_bit_cast(bf16x8, vw), pf, acc[et], 0, 0, 0); }
    }
    float inv = 1.f;
    if (ML) { den += __shfl_xor(den, 16); den += __shfl_xor(den, 32); den += wint * qn; inv = 1.f / fmaxf(fabsf(den), sc[384 + t]); }
    float ss = 0.f;
#pragma unroll
    for (int et = 0; et < 16; ++et) { acc[et] = acc[et] * inv; ss += dot4(acc[et], acc[et]); }
    ss += __shfl_xor(ss, 16); ss += __shfl_xor(ss, 32);
    const float rn = rsqrtf(ss * (1.f / 256.f) + EPS);
    const float* hw = a.in[ML ? I_MHW : I_GHW] + h * 256;
    const bf16* gp = P + (size_t)(row0 + t) * NPROJ + (ML ? C_MO : C_GR) + h * 256;
    bf16* yp = (bf16*)(ws + (ML ? WS_YM : WS_YG)) + (size_t)(row0 + t) * 1024 + h * 256;
#pragma unroll
    for (int et = 0; et < 16; ++et) { const int e = et * 16 + 4 * fq;
        const u32x2 gw = *(const u32x2*)(gp + e); const f32x4 w = *(const f32x4*)(hw + e);
        const float g0 = bflo(gw.x), g1 = bfhi(gw.x), g2 = bflo(gw.y), g3 = bfhi(gw.y);
        float o0 = acc[et][0] * rn * w[0], o1 = acc[et][1] * rn * w[1], o2 = acc[et][2] * rn * w[2], o3 = acc[et][3] * rn * w[3];
        if (ML) { o0 *= sigm(g0); o1 *= sigm(g1); o2 *= sigm(g2); o3 *= sigm(g3); } else { o0 *= g0 * sigm(g0); o1 *= g1 * sigm(g1); o2 *= g2 * sigm(g2); o3 *= g3 * sigm(g3); }
        u32x2 o; o.x = cvt_pk_bf16(o0, o1); o.y = cvt_pk_bf16(o2, o3); *(u32x2*)(yp + e) = o; }
}

template <bool ML>
__device__ __forceinline__ void sample_item(const Args& a, LAS unsigned char* lds, int b, int h) {
    constexpr int DK = ML ? 256 : 128;
    int tid_ = threadIdx.x; asm volatile("" : "+v"(tid_));
    const int tid = tid_, lane = tid & 63, wave = __builtin_amdgcn_readfirstlane(tid >> 6);
    unsigned char* ws = a.ws;
    const bf16* P = (const bf16*)(ws + WS_PROJ); const float* gates = (const float*)(ws + WS_GATES);
    const int row0 = MP + b * 8, bh = b * 4 + h;
    LAS float* qT = (LAS float*)lds;
    LAS float* wkT = qT + 2048;
    LAS float* kT = wkT + 2048;
    LAS float* vS = kT + 2048;
    LAS float* red = vS + 2048;
    LAS float* sm = red + 16384;
    __syncthreads();
    float aS[8], Mt[8], bS[8]; float m0 = 0.f, dec = 1.f;
    if (ML) {
        m0 = a.in[I_M][bh]; float bs = 0.f, M = m0;
#pragma unroll
        for (int t = 0; t < 8; ++t) { const float mi = gates[(size_t)(row0 + t) * 32 + h], mf = gates[(size_t)(row0 + t) * 32 + 4 + h];
            bs += logsig(mf + a.in[I_BF][h]); bS[t] = bs; aS[t] = mi + a.in[I_BI][h] - bs; M = fmaxf(M, aS[t]); Mt[t] = M; }
        dec = __expf(m0 - Mt[7]);
        if (tid == 0) {
#pragma unroll
            for (int t = 0; t < 8; ++t) { sm[200 + t] = aS[t]; sm[208 + t] = Mt[t]; sm[216 + t] = bS[t]; } }
        if (tid < 256) { const int d = tid;
#pragma unroll
            for (int t = 0; t < 8; ++t) { const float qv = bf2f(P[(size_t)(row0 + t) * NPROJ + C_MQ + h * 256 + d]), kv = bf2f(P[(size_t)(row0 + t) * NPROJ + C_MK + h * 256 + d]) * (1.f / 16.f);
                qT[d * 8 + t] = qv; kT[d * 8 + t] = kv; wkT[d * 8 + t] = kv * __expf(aS[t] - Mt[7]); } }
    } else {
        if (tid < 128) { const int d = tid; float up[16];
#pragma unroll
            for (int j = 0; j < 16; ++j) up[j] = a.in[I_AUP][j * 512 + h * 128 + d];
            const float ab = a.in[I_AB][h * 128 + d];
            float bc[8]; float bs = 0.f;
#pragma unroll
            for (int t = 0; t < 8; ++t) { float z = ab;
#pragma unroll
                for (int j = 0; j < 16; ++j) z += gates[(size_t)(row0 + t) * 32 + 8 + j] * up[j];
                bs += logsig(z) * (1.f / 16.f); bc[t] = bs; }
            sm[72 + d] = __expf(bs);
#pragma unroll
            for (int t = 0; t < 8; ++t) { const float qv = bf2f(P[(size_t)(row0 + t) * NPROJ + C_GQ + h * 128 + d]), kv = bf2f(P[(size_t)(row0 + t) * NPROJ + C_GK + h * 128 + d]);
                qT[d * 8 + t] = qv * 0.08838834764831845f * __expf(bc[t]); kT[d * 8 + t] = kv * __expf(-bc[t]); wkT[d * 8 + t] = kv * __expf(bs - bc[t]); } }
    }
    { const int t = tid >> 6; const u32x2 w = *(const u32x2*)(P + (size_t)(row0 + t) * NPROJ + (ML ? C_MV : C_GV) + h * 256 + 4 * lane);
      *(LAS f32x4*)(vS + t * 256 + 4 * lane) = (f32x4){bflo(w.x), bfhi(w.x), bflo(w.y), bfhi(w.y)}; }
    __syncthreads();
    if (tid < 64) { const int t = tid >> 3, s = tid & 7; float sdot = 0.f;
        for (int d = 0; d < DK; ++d) sdot += qT[d * 8 + t] * kT[d * 8 + s];
        float p; if (ML) p = (s <= t) ? sdot * __expf(sm[200 + s] - sm[208 + t]) : 0.f; else p = (s <= t) ? sdot : 0.f;
        sm[tid] = p; }
    else if (ML && tid < 72) { const int t = tid - 64; float sdot = 0.f; const float* n0 = a.in[I_N] + (size_t)bh * 256;
        for (int d = 0; d < 256; ++d) sdot += qT[d * 8 + t] * n0[d];
        sm[64 + t] = sdot; }
    const float* C0 = a.in[ML ? I_C : I_S] + (size_t)bh * DK * 256;
    float* C1 = a.out + (ML ? O_SC : O_SS) + (size_t)bh * DK * 256;
    f32x4 v[8], acc[8];
#pragma unroll
    for (int s = 0; s < 8; ++s) { v[s] = *(const LAS f32x4*)(vS + s * 256 + 4 * lane); acc[s] = (f32x4){0.f, 0.f, 0.f, 0.f}; }
#pragma unroll 4
    for (int i = 0; i < DK / 8; ++i) { const int d = wave + 8 * i;
        const f32x4 cv = *(const f32x4*)(C0 + (size_t)d * 256 + 4 * lane);
        const f32x4 q0 = *(const LAS f32x4*)(qT + d * 8), q1 = *(const LAS f32x4*)(qT + d * 8 + 4), k0 = *(const LAS f32x4*)(wkT + d * 8), k1 = *(const LAS f32x4*)(wkT + d * 8 + 4);
        const float dd = ML ? dec : sm[72 + d];
        acc[0] += cv * q0[0]; acc[1] += cv * q0[1]; acc[2] += cv * q0[2]; acc[3] += cv * q0[3]; acc[4] += cv * q1[0]; acc[5] += cv * q1[1]; acc[6] += cv * q1[2]; acc[7] += cv * q1[3];
        f32x4 cn = cv * dd;
        cn += v[0] * k0[0]; cn += v[1] * k0[1]; cn += v[2] * k0[2]; cn += v[3] * k0[3]; cn += v[4] * k1[0]; cn += v[5] * k1[1]; cn += v[6] * k1[2]; cn += v[7] * k1[3];
        *(f32x4*)(C1 + (size_t)d * 256 + 4 * lane) = cn; }
#pragma unroll
    for (int s = 0; s < 8; ++s) *(LAS f32x4*)(red + (wave * 8 + s) * 256 + 4 * lane) = acc[s];
    __syncthreads();
    const int t = wave;
    f32x4 qc = {0.f, 0.f, 0.f, 0.f};
#pragma unroll
    for (int w = 0; w < 8; ++w) qc += *(const LAS f32x4*)(red + (w * 8 + t) * 256 + 4 * lane);
    float wint = 1.f, den = 0.f, Mtt = 0.f, btt = 0.f;
    if (ML) { Mtt = sm[208 + t]; btt = sm[216 + t]; wint = __expf(m0 - Mtt); }
    f32x4 num = qc * wint;
#pragma unroll
    for (int s = 0; s < 8; ++s) { const float p = sm[t * 8 + s]; num += v[s] * p; den += p; }
    if (ML) { den += wint * sm[64 + t]; const float fl = fmaxf(fabsf(den), __expf(-(btt + Mtt))); num = num * (1.f / fl); }
    const float rn = rsqrtf(wave_sum(dot4(num, num)) * (1.f / 256.f) + EPS);
    const f32x4 w = *(const f32x4*)(a.in[ML ? I_MHW : I_GHW] + h * 256 + 4 * lane);
    const u32x2 gw = *(const u32x2*)(P + (size_t)(row0 + t) * NPROJ + (ML ? C_MO : C_GR) + h * 256 + 4 * lane);
    const float g0 = bflo(gw.x), g1 = bfhi(gw.x), g2 = bflo(gw.y), g3 = bfhi(gw.y);
    float o0 = num[0] * rn * w[0], o1 = num[1] * rn * w[1], o2 = num[2] * rn * w[2], o3 = num[3] * rn * w[3];
    if (ML) { o0 *= sigm(g0); o1 *= sigm(g1); o2 *= sigm(g2); o3 *= sigm(g3); } else { o0 *= g0 * sigm(g0); o1 *= g1 * sigm(g1); o2 *= g2 * sigm(g2); o3 *= g3 * sigm(g3); }
    u32x2 o; o.x = cvt_pk_bf16(o0, o1); o.y = cvt_pk_bf16(o2, o3);
    *(u32x2*)((bf16*)(ws + (ML ? WS_YM : WS_YG)) + (size_t)(row0 + t) * 1024 + h * 256 + 4 * lane) = o;
    if (ML) {
        if (tid < 256) { float s = dec * a.in[I_N][(size_t)bh * 256 + tid];
#pragma unroll
            for (int q = 0; q < 8; ++q) s += wkT[tid * 8 + q];
            a.out[O_SN + (size_t)bh * 256 + tid] = s; }
        if (tid == 0) a.out[O_SM + bh] = bS[7] + Mt[7];
    }
}

__device__ __forceinline__ void act_phase(const Args& a, int vcu, int G) {
    unsigned char* ws = a.ws; const bf16* U = (const bf16*)(ws + WS_U); bf16* Gb = (bf16*)(ws + WS_G);
    const float* cw = a.in[I_CW]; const float* cb = a.in[I_CB]; const float* cst = a.in[I_CONV];
    const size_t total = (size_t)MT * (DFF / 8);
    for (size_t idx = (size_t)vcu * NTHR + threadIdx.x; idx < total; idx += (size_t)G * NTHR) {
        const int row = (int)(idx / (DFF / 8)), col = (int)(idx % (DFF / 8)) * 8;
        int t; const float* st = nullptr;
        if (row < MP) t = row & (TP - 1); else { const int rr = row - MP; t = rr & 7; st = cst + (size_t)(rr >> 3) * 2 * DFF + col; }
        float u0[8], u1[8], u2[8], g[8];
        { const u32x4 w = *(const u32x4*)(U + (size_t)row * DFF + col); u2[0] = bflo(w.x); u2[1] = bfhi(w.x); u2[2] = bflo(w.y); u2[3] = bfhi(w.y); u2[4] = bflo(w.z); u2[5] = bfhi(w.z); u2[6] = bflo(w.w); u2[7] = bfhi(w.w); }
        { const u32x4 w = *(const u32x4*)(Gb + (size_t)row * DFF + col); g[0] = bflo(w.x); g[1] = bfhi(w.x); g[2] = bflo(w.y); g[3] = bfhi(w.y); g[4] = bflo(w.z); g[5] = bfhi(w.z); g[6] = bflo(w.w); g[7] = bfhi(w.w); }
        if (t >= 1) { const u32x4 w = *(const u32x4*)(U + (size_t)(row - 1) * DFF + col); u1[0] = bflo(w.x); u1[1] = bfhi(w.x); u1[2] = bflo(w.y); u1[3] = bfhi(w.y); u1[4] = bflo(w.z); u1[5] = bfhi(w.z); u1[6] = bflo(w.w); u1[7] = bfhi(w.w); }
        else {
#pragma unroll
            for (int i = 0; i < 8; ++i) u1[i] = st ? st[DFF + i] : 0.f; }
        if (t >= 2) { const u32x4 w = *(const u32x4*)(U + (size_t)(row - 2) * DFF + col); u0[0] = bflo(w.x); u0[1] = bfhi(w.x); u0[2] = bflo(w.y); u0[3] = bfhi(w.y); u0[4] = bflo(w.z); u0[5] = bfhi(w.z); u0[6] = bflo(w.w); u0[7] = bfhi(w.w); }
        else {
#pragma unroll
            for (int i = 0; i < 8; ++i) u0[i] = st ? st[(size_t)t * DFF + i] : 0.f; }
        float o[8];
#pragma unroll
        for (int i = 0; i < 8; ++i) { const float uc = cb[col + i] + cw[col + i] * u0[i] + cw[DFF + col + i] * u1[i] + cw[2 * DFF + col + i] * u2[i]; o[i] = gelu_tanh(uc) * g[i]; }
        u32x4 w; w.x = cvt_pk_bf16(o[0], o[1]); w.y = cvt_pk_bf16(o[2], o[3]); w.z = cvt_pk_bf16(o[4], o[5]); w.w = cvt_pk_bf16(o[6], o[7]);
        *(u32x4*)(Gb + (size_t)row * DFF + col) = w;
    }
}
__device__ __forceinline__ void final_norm(const Args& a, int vcu, int G) {
    const int tid = threadIdx.x, lane = tid & 63, wave = tid >> 6;
    const float* part = (const float*)(a.ws + WS_PART); const float* fw = a.in[I_FNW];
    for (int m = vcu * NWAVES + wave; m < MT; m += G * NWAVES) {
        float s = (lane < 32) ? part[(size_t)m * 32 + lane] : 0.f; s = wave_sum(s);
        const float r = rsqrtf(s * (1.f / DM) + EPS);
        float* row = a.out + (size_t)m * DM;
#pragma unroll
        for (int j = 0; j < 8; ++j) { const f32x4 v = *(const f32x4*)(row + 4 * lane + 256 * j), w = *(const f32x4*)(fw + 4 * lane + 256 * j);
            *(f32x4*)(row + 4 * lane + 256 * j) = (f32x4){v[0] * r * w[0], v[1] * r * w[1], v[2] * r * w[2], v[3] * r * w[3]}; }
    }
}

#define XB_TMO      128
#define XB_XCNT(j)  (256  + 64 * (j))
#define XB_XSUB(j)  (1280 + 64 * (j))
#define XB_XGEN(j)  (2304 + 64 * (j))
#define XB_TOP      3328
#define XB_TOPGEN   3392
#define XCD_BAR_WORDS 3456
#define XB_SPIN_CAP (1u << 18)

__device__ __forceinline__ unsigned xb_ld(unsigned* p)              { return __hip_atomic_load(p, __ATOMIC_RELAXED, __HIP_MEMORY_SCOPE_AGENT); }
__device__ __forceinline__ unsigned xb_add(unsigned* p, unsigned v) { return __hip_atomic_fetch_add(p, v, __ATOMIC_RELAXED, __HIP_MEMORY_SCOPE_AGENT); }
__device__ __forceinline__ unsigned xb_xcc_id() { return (unsigned)__builtin_amdgcn_s_getreg((3 << 11) | 20) & 0xFu; }
#define XB_SPIN(cond, bar) do { unsigned _sp = 0; while (cond) { __builtin_amdgcn_s_sleep(1); \
    if ((++_sp & 255u) == 0u) { if (xb_ld(&(bar)[XB_TMO])) break; if (_sp > XB_SPIN_CAP) { atomicAdd(&(bar)[XB_TMO], 1u); break; } } } } while (0)

struct XcdBarrier {
    unsigned* bar; unsigned x;
    volatile LAS unsigned* st;
};

__device__ __forceinline__ XcdBarrier xcd_barrier_post(unsigned* bar, volatile LAS unsigned* st) {
    XcdBarrier b; b.bar = bar; b.x = xb_xcc_id(); b.st = st;
    if (threadIdx.x == 0) (void)xb_add(&bar[XB_XCNT(b.x)], 1u);
    return b;
}
__device__ __forceinline__ void xcd_barrier_complete(unsigned* bar, unsigned x, unsigned& nloc, unsigned& nx) {
    const unsigned G = gridDim.x * gridDim.y * gridDim.z;
    unsigned sum, cnt, mine, sp = 0u;
    for (;;) {
        sum = 0u; cnt = 0u; mine = 0u;
#pragma unroll
        for (unsigned j = 0; j < 16; ++j) { const unsigned c = xb_ld(&bar[XB_XCNT(j)]); sum += c; cnt += (c > 0u) ? 1u : 0u; mine = (j == x) ? c : mine; }
        if (sum == G) break;
        __builtin_amdgcn_s_sleep(1);
        if ((++sp & 255u) == 0u) { if (xb_ld(&bar[XB_TMO])) break; if (sp > XB_SPIN_CAP) { atomicAdd(&bar[XB_TMO], 1u); break; } }
    }
    nloc = mine > 0u ? mine : 1u; nx = cnt > 0u ? cnt : 1u;
}

__device__ __forceinline__ void xcd_barrier(const XcdBarrier& b) {
    asm volatile("s_waitcnt vmcnt(0)" ::: "memory");
    __syncthreads();
    if (threadIdx.x == 0) {
        unsigned* bar = b.bar;
        __builtin_amdgcn_s_waitcnt(0);
        unsigned nloc = b.st[0], nx = b.st[1];
        if (nloc == 0u) { xcd_barrier_complete(bar, b.x, nloc, nx); b.st[0] = nloc; b.st[1] = nx; }
        const unsigned old = xb_add(&bar[XB_XSUB(b.x)], 1u);
        const unsigned gen = old / nloc;
        if (old + 1u == (gen + 1u) * nloc) {
            __builtin_amdgcn_fence(__ATOMIC_RELEASE, "agent");
            asm volatile("s_waitcnt vmcnt(0)" ::: "memory");
            const unsigned og = xb_add(&bar[XB_TOP], 1u);
            const unsigned tg = og / nx;
            if (og + 1u == (tg + 1u) * nx) xb_add(&bar[XB_TOPGEN], 1u);
            else XB_SPIN(xb_ld(&bar[XB_TOPGEN]) == tg, bar);
            __builtin_amdgcn_fence(__ATOMIC_ACQUIRE, "agent");
            xb_add(&bar[XB_XGEN(b.x)], 1u);
            asm volatile("s_waitcnt vmcnt(0)" ::: "memory");
        } else {
            XB_SPIN(xb_ld(&bar[XB_XGEN(b.x)]) == gen, bar);
            __builtin_amdgcn_fence(__ATOMIC_ACQUIRE, "agent");
            asm volatile("s_waitcnt vmcnt(0)" ::: "memory");
        }
    }
    __syncthreads();
}

constexpr int N_PHASES = 11;
__global__ void __launch_bounds__(NTHR) fwd_kernel(Args args) {
    extern __shared__ __attribute__((aligned(16))) unsigned char lds_raw[];
    LAS unsigned char* lds = (LAS unsigned char*)lds_raw;
    cg::grid_group grid = cg::this_grid();
    volatile LAS unsigned* bst = (volatile LAS unsigned*)(lds + LDS_BYTES - 16);
    if (threadIdx.x < 4) bst[threadIdx.x] = 0u;
    __syncthreads();
    XcdBarrier xbar = xcd_barrier_post((unsigned*)args.ws, bst);
    const int G = gridDim.x, bx = blockIdx.x;
    const int vcu = (G % 8 == 0) ? (bx % 8) * (G / 8) + bx / 8 : bx;
    const int lo = args.ph_lo, hi = args.ph_hi;
    unsigned char* ws = args.ws;
#ifndef USE_CG_SYNC
#define USE_CG_SYNC 0
#endif
#ifndef DOUBLE_MASK
#define DOUBLE_MASK 0
#endif
#define REP(k) for (int rep_ = 0; rep_ < 1 + ((DOUBLE_MASK >> (k)) & 1); ++rep_)
#ifndef BIS
#define BIS 15
#endif
#ifndef PHASE_MASK
#define PHASE_MASK 0x7ff
#endif
#define IN(k) (((PHASE_MASK >> (k)) & 1) && lo <= (k) && (k) < hi)
#define SEAM(k) do { if (IN(k) && IN((k) + 1)) { if (USE_CG_SYNC || lo < 0) grid.sync(); else xcd_barrier(xbar); } } while (0)
    if (IN(0)) REP(0) { p0_prologue(args, lds, vcu, G); __syncthreads(); }
    SEAM(0);
    if (IN(1)) REP(1) {
        pg8::Gemm g{(const bf16*)(ws + WS_XN), (const bf16*)(ws + WS_WIN), nullptr, nullptr, MT, NPROJ_PAD, DM}; pg8::StaticOrder S; S.init(MT, NPROJ_PAD, G, bx);
        EpiProj E{(bf16*)(ws + WS_PROJ), (float*)(ws + WS_GATES)};
        pg8::gemm_phase<EpiProj, pg8::StaticOrder, true, true>(lds, g, S, E);
    }
    SEAM(1);
    if (IN(2)) REP(2) {
        for (int it = bx; it < 1536; it += G) {
            if (it < 512) { if (BIS & 1) sample_item<true>(args, lds, it >> 2, it & 3); }
            else if (it < 1024) { if (BIS & 2) sample_item<false>(args, lds, (it - 512) >> 2, (it - 512) & 3); }
            else if (it < 1280) { if (BIS & 4) chunk_state<true>(args, lds, (it - 1024) >> 4, (it - 1024) & 15); }
            else { if (BIS & 8) chunk_state<false>(args, lds, (it - 1280) >> 4, (it - 1280) & 15); }
        }
    }
    SEAM(2);
    if (IN(3)) REP(3) { for (int it = bx; it < 768; it += G) { if (it < 512) scan_mlstm(args, it); else scan_gla(args, it - 512); } }
    SEAM(3);
    if (IN(4)) REP(4) { for (int it = bx; it < 512; it += G) { if (it < 256) { if (BIS & 1) chunk_out<true>(args, lds, it >> 4, it & 15); } else { if (BIS & 2) chunk_out<false>(args, lds, (it - 256) >> 4, (it - 256) & 15); } } __syncthreads(); }
    SEAM(4);
    if (IN(5)) REP(5) {
        pg8::Gemm g{(const bf16*)(ws + WS_YM), (const bf16*)(ws + WS_WA), (const bf16*)(ws + WS_YG), (const bf16*)(ws + WS_WB), MT, DM, 1024}; pg8::TwoSegOrder S; S.S.init(MT, DM, G, bx);
        EpiBranch E{(const bf16*)(ws + WS_PROJ), (bf16*)(ws + WS_XN)};
        pg8::gemm_phase<EpiBranch, pg8::TwoSegOrder, true, true>(lds, g, S, E);
    }
    SEAM(5);
    if (IN(6)) REP(6) {
        pg8::Gemm g{(const bf16*)(ws + WS_XN), (const bf16*)(ws + WS_WO), nullptr, nullptr, MT, DM, DM}; pg8::StaticOrder S; S.init(MT, DM, G, bx);
        EpiOut E{args.in[I_XP], args.in[I_XS], (float*)(ws + WS_X1), (bf16*)(ws + WS_X1W), args.in[I_NFFN], (float*)(ws + WS_PART)};
        pg8::gemm_phase<EpiOut, pg8::StaticOrder, true, true>(lds, g, S, E);
    }
    SEAM(6);
    if (IN(7)) REP(7) {
        pg8::Gemm g{(const bf16*)(ws + WS_X1W), (const bf16*)(ws + WS_WUG), nullptr, nullptr, MT, 2 * DFF, DM}; pg8::StaticOrder S; S.init(MT, 2 * DFF, G, bx);
        EpiUG E{(const float*)(ws + WS_PART), (bf16*)(ws + WS_U), (bf16*)(ws + WS_G), args.out};
        pg8::gemm_phase<EpiUG, pg8::StaticOrder, true, true>(lds, g, S, E);
    }
    SEAM(7);
    if (IN(8)) REP(8) act_phase(args, vcu, G);
    SEAM(8);
    if (IN(9)) REP(9) {
        pg8::Gemm g{(const bf16*)(ws + WS_G), (const bf16*)(ws + WS_WD), nullptr, nullptr, MT, DM, DFF}; pg8::StaticOrder S; S.init(MT, DM, G, bx);
        EpiDown E{(const float*)(ws + WS_X1), args.out, (float*)(ws + WS_PART)};
        pg8::gemm_phase<EpiDown, pg8::StaticOrder, true, true>(lds, g, S, E);
    }
    SEAM(9);
    if (IN(10)) REP(10) final_norm(args, vcu, G);
#ifdef EXTRA_SYNCS
    for (int i_ = 0; i_ < EXTRA_SYNCS; ++i_) xcd_barrier(xbar);
#endif
#undef IN
#undef SEAM
}

extern "C" void kernel_launch(void* const* d_in, const int* in_sizes, int n_in, void* d_out, int out_size, void* d_ws, size_t ws_size, hipStream_t stream) {
    static int grid = 0;
    if (grid == 0) {
        if (n_in != 25 || ws_size < WS_END) { fprintf(stderr, "kernel_launch: unexpected n_in %d / ws_size %zu (need %zu)\n", n_in, ws_size, (size_t)WS_END); grid = -1; return; }
        int dev = 0, cus = 0, per_cu = 0;
        (void)hipGetDevice(&dev); (void)hipDeviceGetAttribute(&cus, hipDeviceAttributeMultiprocessorCount, dev);
        if (hipFuncSetAttribute((const void*)fwd_kernel, hipFuncAttributeMaxDynamicSharedMemorySize, LDS_BYTES) != hipSuccess) { fprintf(stderr, "kernel_launch: hipFuncSetAttribute failed\n"); grid = -1; return; }
        if (hipOccupancyMaxActiveBlocksPerMultiprocessor(&per_cu, (const void*)fwd_kernel, NTHR, LDS_BYTES) != hipSuccess || per_cu < 1) { fprintf(stderr, "kernel_launch: occupancy query says %d\n", per_cu); per_cu = 1; }
        (void)hipGetLastError();
        grid = cus * 1;
        if (grid <= 0) grid = 256;
    }
    if (grid < 0) return;
    if (hipMemsetAsync(d_ws, 0, 65536, stream) != hipSuccess) { fprintf(stderr, "kernel_launch: memset failed\n"); return; }
    Args a{};
    for (int i = 0; i < 25; ++i) a.in[i] = (const float*)d_in[i];
    a.out = (float*)d_out; a.ws = (unsigned char*)d_ws;
    if (MK_N_LAUNCHES == 1) {
        a.ph_lo = 0; a.ph_hi = N_PHASES;
        void* kargs[] = {&a};
        hipError_t e = hipLaunchCooperativeKernel((const void*)fwd_kernel, dim3(grid), dim3(NTHR), kargs, LDS_BYTES, stream);
        if (e != hipSuccess) fprintf(stderr, "kernel_launch: cooperative launch failed: %s (grid %d)\n", hipGetErrorString(e), grid);
    } else {
        for (int p = 0; p < N_PHASES; ++p) { a.ph_lo = p; a.ph_hi = p + 1; hipLaunchKernelGGL(fwd_kernel, dim3(grid), dim3(NTHR), LDS_BYTES, stream, a); }
    }
}
```

```cpp
#include <hip/hip_runtime.h>
#include <hip/hip_cooperative_groups.h>
#include <cstdio>
#include <cstdint>
namespace cg = cooperative_groups;

#ifndef MK_N_LAUNCHES
#define MK_N_LAUNCHES 1
#endif

namespace pg8 {
#define PG8_LAS __attribute__((address_space(3)))
typedef unsigned short bf16_t;
typedef short bf16x8 __attribute__((ext_vector_type(8)));
typedef float f32x4 __attribute__((ext_vector_type(4)));
typedef unsigned u32x4 __attribute__((ext_vector_type(4)));
constexpr int BM = 256, BK = 64, HALF = 128, HTB = HALF * BK * 2  , STAGE_BYTES = 8 * HTB, NXCD = 8, WGM = 8;

__host__ __device__ __forceinline__ int lds_byte(int r, int c) { const int st = (r >> 4) * 2 + (c >> 5), rr = r & 15, cc = c & 31, ob = rr * 64 + cc * 2; return st * 1024 + (ob ^ (((ob >> 9) & 1) << 5)); }
__host__ __device__ __forceinline__ void stage_rc(int b, int& R, int& C) { const int st = b / 1024, sb = b % 1024, swz = sb ^ (((sb >> 9) & 1) << 5); R = (st >> 1) * 16 + swz / 64; C = (st & 1) * 32 + (swz % 64) / 2; }
__host__ __device__ __forceinline__ int perm32(int rho) { const int n = rho >> 4, i = rho & 15; return 8 * (i >> 2) + 4 * n + (i & 3); }

struct Unit { int pm, pn, seg; };
struct Gemm { const bf16_t* A; const bf16_t* Bt; const bf16_t* A2; const bf16_t* Bt2; int M, N, K; };

struct StaticOrder {
    int nM, nN, nwg, G, c;
    __host__ __device__ void init(int M, int N, int G_, int c_) { nM = M / BM; nN = N / BM; nwg = nM * nN; G = G_; c = c_; }
    __host__ __device__ bool next(int i, Unit& u) const {
        const long L = (long)i * G + c; if (L >= nwg) return false;
        int wgid = (int)L; { const int q = nwg / NXCD, r = nwg % NXCD, xcd = wgid % NXCD, off = wgid / NXCD; wgid = (xcd < r ? xcd * (q + 1) : r * (q + 1) + (xcd - r) * q) + off; }
        const int nig = WGM * nN, gid = wgid / nig, fm = gid * WGM, gsz = (nM - fm) < WGM ? (nM - fm) : WGM;
        u.pm = fm + ((wgid % nig) % gsz); u.pn = (wgid % nig) / gsz; u.seg = 0; return true;
    }
};
struct TwoSegOrder {
    StaticOrder S;
    __host__ __device__ bool next(int i, Unit& u) const { if (!S.next(i >> 1, u)) return false; u.seg = i & 1; return true; }
};

__device__ __forceinline__ unsigned cvt_pk_bf16(float lo, float hi) { unsigned r; asm volatile("v_cvt_pk_bf16_f32 %0, %1, %2" : "=v"(r) : "v"(lo), "v"(hi)); return r; }

template <class Epi, class Sched, bool ALIGN_EPI = false, bool SP2 = false>
__device__ __forceinline__ void gemm_phase(PG8_LAS unsigned char* lds, const Gemm g, const Sched& S, const Epi& E) {
    int tid_ = threadIdx.x; asm volatile("" : "+v"(tid_));
    const int tid = tid_, wid = __builtin_amdgcn_readfirstlane(tid >> 6), lane = tid & 63, wr = wid >> 2, wc = wid & 3, fr = lane & 15, fq = lane >> 4;
    const int K = g.K, nt = K / BK;
    unsigned voffA[2], voffB[2];
#pragma unroll
    for (int i = 0; i < 2; ++i) { int R, C; stage_rc(tid * 16 + i * 8192, R, C); const int Rb = Epi::PERM ? ((R & ~31) + perm32(R & 31)) : R;
        voffA[i] = (unsigned)(R * K + C) * 2u; voffB[i] = (unsigned)(Rb * K + C) * 2u; }
    const size_t kstep = (size_t)(BK * 2);
    const size_t hstep = (size_t)HALF * K * 2;
    const size_t tstep = 2 * hstep;
    const unsigned ldsw = (unsigned)wid * 1024u;
    const int aoff = lds_byte(wr * 64 + fr, fq * 8), boff = lds_byte(wc * 32 + fr, fq * 8);
#define PG8_SA(b, h) (((b) * 2 + (h)) * HTB)
#define PG8_SB(b, h) ((4 + (b) * 2 + (h)) * HTB)
#define PG8_STAGE(bufoff, gbase, voff) do { _Pragma("unroll") for (int _i = 0; _i < 2; ++_i) \
        __builtin_amdgcn_global_load_lds((const unsigned*)((const char*)(gbase) + (voff)[_i]), (PG8_LAS unsigned*)(lds + (bufoff) + ldsw + _i * 8192), 16, 0, 0); } while (0)
#define PG8_LDA(dst, b, h) do { _Pragma("unroll") for (int m = 0; m < 4; ++m) _Pragma("unroll") for (int k = 0; k < 2; ++k) dst[m][k] = *(const PG8_LAS bf16x8*)(lds + PG8_SA(b, h) + aoff + m * 2048 + k * 1024); } while (0)
#define PG8_LDB(dst, b, h) do { _Pragma("unroll") for (int n = 0; n < 2; ++n) _Pragma("unroll") for (int k = 0; k < 2; ++k) dst[n][k] = *(const PG8_LAS bf16x8*)(lds + PG8_SB(b, h) + boff + n * 2048 + k * 1024); } while (0)
#define PG8_MMA(ai, bj, At, Bt) do { __builtin_amdgcn_s_setprio(1); _Pragma("unroll") for (int m = 0; m < 4; ++m) _Pragma("unroll") for (int n = 0; n < 2; ++n) _Pragma("unroll") for (int k = 0; k < 2; ++k) \
        acc[ai][bj][m][n] = __builtin_amdgcn_mfma_f32_16x16x32_bf16(Bt[n][k], At[m][k], acc[ai][bj][m][n], 0, 0, 0); __builtin_amdgcn_s_setprio(0); } while (0)
#define PG8_WAIT_V(n) asm volatile("s_waitcnt vmcnt(" #n ")" ::: "memory")
#define PG8_WAIT_L(n) asm volatile("s_waitcnt lgkmcnt(" #n ")" ::: "memory")
#define PG8_BAR __builtin_amdgcn_s_barrier()
#define PG8_SCHED __builtin_amdgcn_sched_barrier(0)
    Unit cur, nxt; int ui = 0;
    if (!S.next(0, cur)) return;
    f32x4 acc[2][2][4][2];
#pragma unroll
    for (int a = 0; a < 2; ++a)
#pragma unroll
        for (int b = 0; b < 2; ++b)
#pragma unroll
            for (int m = 0; m < 4; ++m)
#pragma unroll
                for (int n = 0; n < 2; ++n) acc[a][b][m][n] = (f32x4){0.f, 0.f, 0.f, 0.f};
    bf16x8 At[4][2], B0[2][2], B1[2][2];
    const char* cA = (const char*)(cur.seg ? g.A2 : g.A) + (size_t)cur.pm * tstep; const char* cB = (const char*)(cur.seg ? g.Bt2 : g.Bt) + (size_t)cur.pn * tstep;
    if constexpr (SP2) {
        PG8_STAGE(PG8_SB(0, 0), cB, voffB); PG8_STAGE(PG8_SB(0, 1), cB + hstep, voffB); PG8_STAGE(PG8_SA(0, 0), cA, voffA); PG8_STAGE(PG8_SA(0, 1), cA + hstep, voffA);
        if (wr == 1) PG8_BAR;
        PG8_WAIT_V(2); PG8_BAR;
        PG8_STAGE(PG8_SB(1, 0), cB + kstep, voffB); PG8_STAGE(PG8_SA(1, 0), cA + kstep, voffA); PG8_STAGE(PG8_SB(1, 1), cB + hstep + kstep, voffB);
        PG8_WAIT_V(6); PG8_BAR;
    } else {
        PG8_STAGE(PG8_SB(0, 0), cB, voffB); PG8_STAGE(PG8_SA(0, 0), cA, voffA); PG8_STAGE(PG8_SB(0, 1), cB + hstep, voffB); PG8_STAGE(PG8_SA(0, 1), cA + hstep, voffA);
        if (wr == 1) PG8_BAR;
        PG8_WAIT_V(4); PG8_BAR;
        PG8_STAGE(PG8_SB(1, 0), cB + kstep, voffB); PG8_STAGE(PG8_SA(1, 0), cA + kstep, voffA); PG8_STAGE(PG8_SB(1, 1), cB + hstep + kstep, voffB);
        PG8_WAIT_V(6); PG8_BAR;
    }
    for (;;) {
        const bool has_next = S.next(ui + 1, nxt);
        const char* nA = has_next ? (const char*)(nxt.seg ? g.A2 : g.A) + (size_t)nxt.pm * tstep : cA; const char* nB = has_next ? (const char*)(nxt.seg ? g.Bt2 : g.Bt) + (size_t)nxt.pn * tstep : cB;
        for (int t = 0; t < nt; t += 2) {
            const bool last = (t == nt - 2);
            const char* a1 = cA + (size_t)(t + 1) * kstep;
            const char* a2 = last ? nA : cA + (size_t)(t + 2) * kstep; const char* b2 = last ? nB : cB + (size_t)(t + 2) * kstep;
            const char* a3 = a2 + kstep; const char* b3 = b2 + kstep;
            if constexpr (SP2) {
            PG8_LDB(B0, 0, 0); PG8_LDB(B1, 0, 1); PG8_SCHED; PG8_LDA(At, 0, 0); PG8_STAGE(PG8_SA(1, 1), a1 + hstep, voffA);
            PG8_WAIT_V(8); PG8_WAIT_L(0); PG8_BAR; PG8_MMA(0, 0, At, B0); PG8_MMA(0, 1, At, B1); PG8_BAR; PG8_SCHED;
            PG8_LDA(At, 0, 1); PG8_STAGE(PG8_SB(0, 0), b2, voffB); PG8_STAGE(PG8_SB(0, 1), b2 + hstep, voffB); PG8_STAGE(PG8_SA(0, 0), a2, voffA);
            PG8_WAIT_V(8); PG8_WAIT_L(0); PG8_BAR; PG8_MMA(1, 0, At, B0); PG8_MMA(1, 1, At, B1); PG8_BAR; PG8_SCHED;
            PG8_LDB(B0, 1, 0); PG8_LDB(B1, 1, 1); PG8_SCHED; PG8_LDA(At, 1, 0); PG8_STAGE(PG8_SA(0, 1), a2 + hstep, voffA);
            PG8_WAIT_V(8); PG8_WAIT_L(0); PG8_BAR; PG8_MMA(0, 0, At, B0); PG8_MMA(0, 1, At, B1); PG8_BAR; PG8_SCHED;
            PG8_LDA(At, 1, 1); PG8_STAGE(PG8_SB(1, 0), b3, voffB); PG8_STAGE(PG8_SB(1, 1), b3 + hstep, voffB); PG8_STAGE(PG8_SA(1, 0), a3, voffA);
            PG8_WAIT_V(8); PG8_WAIT_L(0); PG8_BAR; PG8_MMA(1, 0, At, B0); PG8_MMA(1, 1, At, B1); PG8_BAR; PG8_SCHED;
            } else {
            PG8_LDB(B0, 0, 0); PG8_SCHED; PG8_LDA(At, 0, 0); PG8_STAGE(PG8_SA(1, 1), a1 + hstep, voffA);
            PG8_WAIT_L(8); PG8_BAR; PG8_WAIT_L(0); PG8_MMA(0, 0, At, B0); PG8_BAR; PG8_SCHED;
            PG8_LDB(B1, 0, 1); PG8_STAGE(PG8_SB(0, 0), b2, voffB);
            PG8_BAR; PG8_WAIT_L(0); PG8_MMA(0, 1, At, B1); PG8_BAR;
            PG8_LDA(At, 0, 1); PG8_STAGE(PG8_SA(0, 0), a2, voffA);
            PG8_BAR; PG8_WAIT_L(0); PG8_MMA(1, 0, At, B0); PG8_BAR; PG8_SCHED;
            PG8_STAGE(PG8_SB(0, 1), b2 + hstep, voffB);
            PG8_WAIT_V(6); PG8_BAR; PG8_MMA(1, 1, At, B1); PG8_BAR;
            PG8_LDB(B0, 1, 0); PG8_SCHED; PG8_LDA(At, 1, 0); PG8_STAGE(PG8_SA(0, 1), a2 + hstep, voffA);
            PG8_WAIT_L(8); PG8_BAR; PG8_WAIT_L(0); PG8_MMA(0, 0, At, B0); PG8_BAR; PG8_SCHED;
            PG8_LDB(B1, 1, 1); PG8_STAGE(PG8_SB(1, 0), b3, voffB);
            PG8_BAR; PG8_WAIT_L(0); PG8_MMA(0, 1, At, B1); PG8_BAR;
            PG8_LDA(At, 1, 1); PG8_STAGE(PG8_SA(1, 0), a3, voffA);
            PG8_BAR; PG8_WAIT_L(0); PG8_MMA(1, 0, At, B0); PG8_BAR; PG8_SCHED;
            PG8_STAGE(PG8_SB(1, 1), b3 + hstep, voffB);
            PG8_WAIT_V(6); PG8_BAR; PG8_MMA(1, 1, At, B1); PG8_BAR;
            }
        }
        if constexpr (ALIGN_EPI) { if (wr == 0) PG8_BAR; }
        E(acc, cur, wr, wc, fr, fq);
        if (!has_next) break;
        if (nxt.seg == 0)
#pragma unroll
        for (int a = 0; a < 2; ++a)
#pragma unroll
            for (int b = 0; b < 2; ++b)
#pragma unroll
                for (int m = 0; m < 4; ++m)
#pragma unroll
                    for (int n = 0; n < 2; ++n) acc[a][b][m][n] = (f32x4){0.f, 0.f, 0.f, 0.f};
        cur = nxt; cA = nA; cB = nB; ++ui;
        if constexpr (ALIGN_EPI) { if (wr == 1) PG8_BAR; }
    }
    PG8_WAIT_V(0);
    if constexpr (!ALIGN_EPI) { if (wr == 0) PG8_BAR; }
    PG8_BAR;
#undef PG8_SA
#undef PG8_SB
#undef PG8_STAGE
#undef PG8_LDA
#undef PG8_LDB
#undef PG8_MMA
#undef PG8_WAIT_V
#undef PG8_WAIT_L
#undef PG8_BAR
#undef PG8_SCHED
}
}

#define LAS __attribute__((address_space(3)))
typedef unsigned short bf16;
typedef short bf16x8 __attribute__((ext_vector_type(8)));
typedef float f32x4 __attribute__((ext_vector_type(4)));
typedef unsigned u32x4 __attribute__((ext_vector_type(4)));
typedef unsigned u32x2 __attribute__((ext_vector_type(2)));
using pg8::cvt_pk_bf16;

constexpr int NWAVES = 8, NTHR = 512;
constexpr int DM = 2048, MP = 8192, MS = 1024, MT = 9216, TP = 2048, TS = 8;
constexpr int NIN = 11288, NPROJ = 11264, NPROJ_PAD = 11520, DFF = 5632;
constexpr int C_MQ = 0, C_MK = 1024, C_MV = 2048, C_MO = 3072, C_GQ = 4096, C_GK = 4608, C_GV = 5120, C_GR = 6144, C_GA = 7168, C_GB = 9216;
constexpr float EPS = 1e-6f;
constexpr int NCH = 16;
constexpr int LDS_BYTES = 147456;

constexpr size_t O_YP = 0, O_YS = 16777216, O_PC = 18874368, O_PN = 19922944, O_PM = 19927040, O_PS = 19927056, O_PCONV = 20451344,
                 O_SC = 20496400, O_SN = 54050832, O_SM = 54181904, O_SS = 54182416, O_SCONV = 70959632;

constexpr size_t MiB = 1u << 20;
constexpr size_t WS_GATES = 64 * 1024;
constexpr size_t WS_PART = WS_GATES + (size_t)MT * 32 * 4;
constexpr size_t WS_DN = WS_PART + (size_t)MT * 32 * 4;
constexpr size_t WS_NPREV = WS_DN + 256 * 256 * 4;
constexpr size_t WS_CHS = WS_NPREV + 256 * 256 * 2;
constexpr size_t WS_BEND = WS_CHS + 256 * 2 * 4;
constexpr size_t WS_RSTD = WS_BEND + 256 * 128 * 4;
static_assert(WS_RSTD + MT * 4 <= 4 * MiB, "small region");
constexpr size_t WS_WIN = 4 * MiB;
constexpr size_t WS_WA = WS_WIN + (size_t)NPROJ_PAD * DM * 2;
constexpr size_t WS_WB = WS_WA + (size_t)2048 * 1024 * 2;
constexpr size_t WS_WO = WS_WB + (size_t)2048 * 1024 * 2;
constexpr size_t WS_WUG = WS_WO + (size_t)2048 * 2048 * 2;
constexpr size_t WS_WD = WS_WUG + (size_t)2 * DFF * DM * 2;
constexpr size_t WS_R1 = WS_WD + (size_t)DM * DFF * 2;
static_assert(WS_R1 == 131 * MiB, "map");
constexpr size_t WS_XN = WS_R1;
constexpr size_t WS_X1W = WS_R1 + 36 * MiB;
constexpr size_t WS_X1 = WS_R1 + 72 * MiB;
constexpr size_t WS_DC = WS_R1;
constexpr size_t WS_DS = WS_R1 + 64 * MiB;
constexpr size_t WS_CT = WS_R1 + 96 * MiB;
constexpr size_t WS_ST = WS_R1 + 128 * MiB;
constexpr size_t WS_YM = WS_R1 + 144 * MiB;
constexpr size_t WS_YG = WS_YM + 18 * MiB;
constexpr size_t WS_PROJ = WS_YG + 18 * MiB;
constexpr size_t WS_U = WS_PROJ, WS_G = WS_PROJ + 99 * MiB;
constexpr size_t WS_END = WS_PROJ + 198 * MiB;
static_assert(WS_END == 509 * MiB, "map");

struct Args {
    const float* in[25]; float* out; unsigned char* ws; int ph_lo, ph_hi;
};
enum { I_XP = 0, I_XS, I_C, I_N, I_M, I_S, I_CONV, I_WIN, I_BI, I_BF, I_AUP, I_AB, I_MHW, I_GHW, I_WA, I_WB, I_WO, I_NMIX, I_NFFN, I_WUP, I_WGATE, I_CW, I_CB, I_WDOWN, I_FNW };

__device__ __forceinline__ float bf2f(unsigned short b) { return __builtin_bit_cast(float, (unsigned)b << 16); }
__device__ __forceinline__ float bflo(unsigned w) { return __builtin_bit_cast(float, w << 16); }
__device__ __forceinline__ float bfhi(unsigned w) { return __builtin_bit_cast(float, w & 0xffff0000u); }
__device__ __forceinline__ unsigned short f2bf(float f) { return (unsigned short)(cvt_pk_bf16(f, 0.f) & 0xffffu); }
__device__ __forceinline__ float logsig(float z) { return fminf(z, 0.f) - log1pf(__expf(-fabsf(z))); }
__device__ __forceinline__ float sigm(float z) { return 1.f / (1.f + __expf(-z)); }
__device__ __forceinline__ float wave_sum(float v) {
#pragma unroll
    for (int o = 1; o < 64; o <<= 1) v += __shfl_xor(v, o);
    return v;
}
__device__ __forceinline__ float wave_max(float v) {
#pragma unroll
    for (int o = 1; o < 64; o <<= 1) v = fmaxf(v, __shfl_xor(v, o));
    return v;
}
__device__ __forceinline__ float sum4(f32x4 v) { return (v.x + v.y) + (v.z + v.w); }
__device__ __forceinline__ float dot4(f32x4 a, f32x4 b) { return (a.x * b.x + a.y * b.y) + (a.z * b.z + a.w * b.w); }
__device__ __forceinline__ float gelu_tanh(float v) { const float u = 0.7978845608028654f * (v + 0.044715f * v * v * v); return v * sigm(2.f * u); }

typedef f32x4 AccT[2][2][4][2];
struct EpiProj {
    static constexpr bool PERM = true;
    bf16* P; float* gates;
    __device__ __forceinline__ void operator()(AccT& acc, const pg8::Unit& u, int wr, int wc, int fr, int fq) const {
        const int row0 = u.pm * 256 + wr * 64 + fr;
        if (u.pn < 44) {
            const int col0 = u.pn * 256 + wc * 32 + 8 * fq;
#pragma unroll
            for (int ai = 0; ai < 2; ++ai)
#pragma unroll
                for (int m = 0; m < 4; ++m) { bf16* rowp = P + (size_t)(row0 + ai * 128 + m * 16) * NPROJ + col0;
#pragma unroll
                    for (int bj = 0; bj < 2; ++bj) { const f32x4 v0 = acc[ai][bj][m][0], v1 = acc[ai][bj][m][1]; u32x4 w;
                        w.x = cvt_pk_bf16(v0[0], v0[1]); w.y = cvt_pk_bf16(v0[2], v0[3]); w.z = cvt_pk_bf16(v1[0], v1[1]); w.w = cvt_pk_bf16(v1[2], v1[3]);
                        *(u32x4*)(rowp + bj * 128) = w; } }
        } else if (wc == 0) {
#pragma unroll
            for (int ai = 0; ai < 2; ++ai)
#pragma unroll
                for (int m = 0; m < 4; ++m) { float* rowp = gates + (size_t)(row0 + ai * 128 + m * 16) * 32 + 8 * fq;
                    *(f32x4*)rowp = acc[ai][0][m][0]; *(f32x4*)(rowp + 4) = acc[ai][0][m][1]; }
        }
    }
};
struct EpiBranch {
    static constexpr bool PERM = true;
    const bf16* P; bf16* O;
    __device__ __forceinline__ void operator()(AccT& acc, const pg8::Unit& u, int wr, int wc, int fr, int fq) const {
        const int row0 = u.pm * 256 + wr * 64 + fr, col0 = u.pn * 256 + wc * 32 + 8 * fq;
#pragma unroll
        for (int ai = 0; ai < 2; ++ai)
#pragma unroll
            for (int m = 0; m < 4; ++m) { const int row = row0 + ai * 128 + m * 16;
#pragma unroll
                for (int bj = 0; bj < 2; ++bj) { const int col = col0 + bj * 128;
                    const u32x4 ga = *(const u32x4*)(P + (size_t)row * NPROJ + C_GA + col), gb = *(const u32x4*)(P + (size_t)row * NPROJ + C_GB + col);
                    float fa[8] = {bflo(ga.x), bfhi(ga.x), bflo(ga.y), bfhi(ga.y), bflo(ga.z), bfhi(ga.z), bflo(ga.w), bfhi(ga.w)};
                    float fb[8] = {bflo(gb.x), bfhi(gb.x), bflo(gb.y), bfhi(gb.y), bflo(gb.z), bfhi(gb.z), bflo(gb.w), bfhi(gb.w)};
                    if (u.seg == 0) {
#pragma unroll
                        for (int i = 0; i < 8; ++i) { const float r = (1.f + __expf(-fb[i])) / (1.f + __expf(-fa[i])); acc[ai][bj][m][i >> 2][i & 3] *= r; }
                    } else {
                        float o[8];
#pragma unroll
                        for (int i = 0; i < 8; ++i) o[i] = acc[ai][bj][m][i >> 2][i & 3] * sigm(fb[i]);
                        u32x4 w; w.x = cvt_pk_bf16(o[0], o[1]); w.y = cvt_pk_bf16(o[2], o[3]); w.z = cvt_pk_bf16(o[4], o[5]); w.w = cvt_pk_bf16(o[6], o[7]);
                        *(u32x4*)(O + (size_t)row * DM + col) = w;
                    } } }
    }
};
struct EpiOut {
    static constexpr bool PERM = true;
    const float* xp; const float* xs; float* X1; bf16* X1W; const float* nw; float* part;
    __device__ __forceinline__ void operator()(AccT& acc, const pg8::Unit& u, int wr, int wc, int fr, int fq) const {
        const int row0 = u.pm * 256 + wr * 64 + fr, col0 = u.pn * 256 + wc * 32 + 8 * fq;
#pragma unroll
        for (int ai = 0; ai < 2; ++ai)
#pragma unroll
            for (int m = 0; m < 4; ++m) { const int row = row0 + ai * 128 + m * 16;
                const float* xrow = row < MP ? xp + (size_t)row * DM : xs + (size_t)(row - MP) * DM;
                float ss = 0.f;
#pragma unroll
                for (int bj = 0; bj < 2; ++bj) { const int col = col0 + bj * 128;
                    const f32x4 v0 = acc[ai][bj][m][0] + *(const f32x4*)(xrow + col), v1 = acc[ai][bj][m][1] + *(const f32x4*)(xrow + col + 4);
                    *(f32x4*)(X1 + (size_t)row * DM + col) = v0; *(f32x4*)(X1 + (size_t)row * DM + col + 4) = v1;
                    ss += dot4(v0, v0) + dot4(v1, v1);
                    const f32x4 w0 = *(const f32x4*)(nw + col), w1 = *(const f32x4*)(nw + col + 4);
                    u32x4 w; w.x = cvt_pk_bf16(v0[0] * w0[0], v0[1] * w0[1]); w.y = cvt_pk_bf16(v0[2] * w0[2], v0[3] * w0[3]);
                    w.z = cvt_pk_bf16(v1[0] * w1[0], v1[1] * w1[1]); w.w = cvt_pk_bf16(v1[2] * w1[2], v1[3] * w1[3]);
                    *(u32x4*)(X1W + (size_t)row * DM + col) = w; }
                ss += __shfl_xor(ss, 16); ss += __shfl_xor(ss, 32);
                if (fq == 0) part[(size_t)row * 32 + u.pn * 4 + wc] = ss; }
    }
};
struct EpiUG {
    static constexpr bool PERM = true;
    const float* rstd; bf16* U; bf16* G; float* out;
    __device__ __forceinline__ void operator()(AccT& acc, const pg8::Unit& u, int wr, int wc, int fr, int fq) const {
        const int row0 = u.pm * 256 + wr * 64 + fr, col = u.pn * 128 + wc * 32 + 8 * fq;
#pragma unroll
        for (int ai = 0; ai < 2; ++ai)
#pragma unroll
            for (int m = 0; m < 4; ++m) { const int row = row0 + ai * 128 + m * 16;
                const float r = rstd[row];
                const f32x4 u0 = acc[ai][0][m][0] * r, u1 = acc[ai][0][m][1] * r, g0 = acc[ai][1][m][0] * r, g1 = acc[ai][1][m][1] * r;
                u32x4 w; w.x = cvt_pk_bf16(u0[0], u0[1]); w.y = cvt_pk_bf16(u0[2], u0[3]); w.z = cvt_pk_bf16(u1[0], u1[1]); w.w = cvt_pk_bf16(u1[2], u1[3]);
                *(u32x4*)(U + (size_t)row * DFF + col) = w;
                w.x = cvt_pk_bf16(g0[0], g0[1]); w.y = cvt_pk_bf16(g0[2], g0[3]); w.z = cvt_pk_bf16(g1[0], g1[1]); w.w = cvt_pk_bf16(g1[2], g1[3]);
                *(u32x4*)(G + (size_t)row * DFF + col) = w;
                float* cs = nullptr;
                if (row < MP) { const int t = row & (TP - 1); if (t >= TP - 2) cs = out + O_PCONV + ((size_t)(row >> 11) * 2 + (t - (TP - 2))) * DFF + col; }
                else { const int rr = row - MP, t = rr & 7; if (t >= 6) cs = out + O_SCONV + ((size_t)(rr >> 3) * 2 + (t - 6)) * DFF + col; }
                if (cs) { *(f32x4*)cs = u0; *(f32x4*)(cs + 4) = u1; } }
    }
};
struct EpiDown {
    static constexpr bool PERM = true;
    const float* X1; float* out; float* part;
    __device__ __forceinline__ void operator()(AccT& acc, const pg8::Unit& u, int wr, int wc, int fr, int fq) const {
        const int row0 = u.pm * 256 + wr * 64 + fr, col0 = u.pn * 256 + wc * 32 + 8 * fq;
#pragma unroll
        for (int ai = 0; ai < 2; ++ai)
#pragma unroll
            for (int m = 0; m < 4; ++m) { const int row = row0 + ai * 128 + m * 16; float ss = 0.f;
#pragma unroll
                for (int bj = 0; bj < 2; ++bj) { const int col = col0 + bj * 128;
                    const f32x4 v0 = acc[ai][bj][m][0] + *(const f32x4*)(X1 + (size_t)row * DM + col), v1 = acc[ai][bj][m][1] + *(const f32x4*)(X1 + (size_t)row * DM + col + 4);
                    *(f32x4*)(out + (size_t)row * DM + col) = v0; *(f32x4*)(out + (size_t)row * DM + col + 4) = v1;
                    ss += dot4(v0, v0) + dot4(v1, v1); }
                ss += __shfl_xor(ss, 16); ss += __shfl_xor(ss, 32);
                if (fq == 0) part[(size_t)row * 32 + u.pn * 4 + wc] = ss; }
    }
};

template <class ColPtr>
__device__ __forceinline__ void transpose_item(const ColPtr& cp, int K, int srcN, bf16* WT, LAS float* scr, int kb, int nb, int lane) {
    const int k0 = 64 * kb, n0 = 64 * nb, kr = lane >> 4, n4 = (lane & 15) * 4;
    const float* src = cp(n0 + n4);
    f32x4 v[16];
#pragma unroll
    for (int i = 0; i < 16; ++i) v[i] = src ? *(const f32x4*)(src + (size_t)(k0 + 4 * i + kr) * srcN) : (f32x4){0.f, 0.f, 0.f, 0.f};
#pragma unroll
    for (int i = 0; i < 16; ++i) { LAS float* d = scr + (4 * i + kr) * 65 + n4; d[0] = v[i][0]; d[1] = v[i][1]; d[2] = v[i][2]; d[3] = v[i][3]; }
    asm volatile("s_waitcnt lgkmcnt(0)" ::: "memory");
    const int c = lane & 7;
#pragma unroll
    for (int j = 0; j < 8; ++j) { const int n = (lane >> 3) + 8 * j; const LAS float* s = scr + (8 * c) * 65 + n;
        u32x4 o; o.x = cvt_pk_bf16(s[0 * 65], s[1 * 65]); o.y = cvt_pk_bf16(s[2 * 65], s[3 * 65]); o.z = cvt_pk_bf16(s[4 * 65], s[5 * 65]); o.w = cvt_pk_bf16(s[6 * 65], s[7 * 65]);
        *(u32x4*)(WT + (size_t)(n0 + n) * K + k0 + 8 * c) = o; }
    asm volatile("s_waitcnt lgkmcnt(0)" ::: "memory");
}
struct ColWin { const float* W; __device__ __forceinline__ const float* operator()(int n) const {
    int c; if (n < 4096) c = n; else if (n < 7168) c = n + 8; else if (n < 11264) c = n + 24; else if (n < 11272) c = 4096 + (n - 11264); else if (n < 11288) c = 7176 + (n - 11272); else return nullptr;
    return W + c; } };
struct ColPlain { const float* W; __device__ __forceinline__ const float* operator()(int n) const { return W + n; } };
struct ColUG { const float* Wu; const float* Wg; __device__ __forceinline__ const float* operator()(int n) const { const int pn = n >> 8, w = n & 255; return w < 128 ? Wu + pn * 128 + w : Wg + pn * 128 + (w - 128); } };

__device__ __forceinline__ void p0_prologue(const Args& a, LAS unsigned char* lds, int vcu, int G) {
    int tid_ = threadIdx.x; asm volatile("" : "+v"(tid_));
    const int tid = tid_, lane = tid & 63, wave = __builtin_amdgcn_readfirstlane(tid >> 6);
    LAS float* scr = (LAS float*)(lds + wave * 16640);
    const int gw = vcu * NWAVES + wave, NGW = G * NWAVES;
    unsigned char* ws = a.ws;
    constexpr int I_WIN_ = 32 * (NPROJ_PAD / 64), I_A = 16 * 32, I_O = 32 * 32, I_UG = 32 * (2 * DFF / 64), I_D = (DFF / 64) * 32;
    constexpr int NITEMS = I_WIN_ + 2 * I_A + I_O + I_UG + I_D;
    for (int it = gw; it < NITEMS; it += NGW) {
        int r = it;
        if (r < I_WIN_) { ColWin cp{a.in[I_WIN]}; const int nblk = NPROJ_PAD / 64; transpose_item(cp, DM, NIN, (bf16*)(ws + WS_WIN), scr, r / nblk, r % nblk, lane); continue; } r -= I_WIN_;
        if (r < I_A) { ColPlain cp{a.in[I_WA]}; transpose_item(cp, 1024, DM, (bf16*)(ws + WS_WA), scr, r / 32, r % 32, lane); continue; } r -= I_A;
        if (r < I_A) { ColPlain cp{a.in[I_WB]}; transpose_item(cp, 1024, DM, (bf16*)(ws + WS_WB), scr, r / 32, r % 32, lane); continue; } r -= I_A;
        if (r < I_O) { ColPlain cp{a.in[I_WO]}; transpose_item(cp, DM, DM, (bf16*)(ws + WS_WO), scr, r / 32, r % 32, lane); continue; } r -= I_O;
        if (r < I_UG) { ColUG cp{a.in[I_WUP], a.in[I_WGATE]}; const int nblk = 2 * DFF / 64; transpose_item(cp, DM, DFF, (bf16*)(ws + WS_WUG), scr, r / nblk, r % nblk, lane); continue; } r -= I_UG;
        { ColPlain cp{a.in[I_WDOWN]}; transpose_item(cp, DFF, DM, (bf16*)(ws + WS_WD), scr, r / 32, r % 32, lane); }
    }
    const float* nw = a.in[I_NMIX]; bf16* XN = (bf16*)(ws + WS_XN);
    for (int m = gw; m < MT; m += NGW) {
        const float* xrow = m < MP ? a.in[I_XP] + (size_t)m * DM : a.in[I_XS] + (size_t)(m - MP) * DM;
        f32x4 v[8]; float s = 0.f;
#pragma unroll
        for (int j = 0; j < 8; ++j) { v[j] = *(const f32x4*)(xrow + 4 * lane + 256 * j); s += dot4(v[j], v[j]); }
        const float r = rsqrtf(wave_sum(s) * (1.f / DM) + EPS);
#pragma unroll
        for (int j = 0; j < 8; ++j) { const f32x4 w = *(const f32x4*)(nw + 4 * lane + 256 * j); u32x2 o; o.x = cvt_pk_bf16(v[j][0] * r * w[0], v[j][1] * r * w[1]); o.y = cvt_pk_bf16(v[j][2] * r * w[2], v[j][3] * r * w[3]);
            *(u32x2*)(XN + (size_t)m * DM + 4 * lane + 256 * j) = o; }
    }
}

__device__ __forceinline__ void stage_v(LAS bf16* Vs, const bf16* P, int row0, int colbase, int tid) {
#pragma unroll
    for (int i = 0; i < 8; ++i) { const int idx = tid + NTHR * i, s = idx >> 5, p = idx & 31;
        *(LAS u32x4*)(Vs + s * 272 + p * 8) = *(const u32x4*)(P + (size_t)(row0 + s) * NPROJ + colbase + 8 * p); }
}
typedef short v4i16_t __attribute__((ext_vector_type(4)));
__device__ __forceinline__ u32x2 tr64(const LAS bf16* p) { return __builtin_bit_cast(u32x2, __builtin_amdgcn_ds_read_tr16_b64_v4i16((LAS v4i16_t*)p)); }
__device__ __forceinline__ bf16x8 tr_frag(const LAS bf16* img, int RS, int c0, int ks, int lane) {
    const int g = lane >> 4, q = (lane & 15) >> 2, p = lane & 3;
    const LAS bf16* a = img + (32 * ks + 4 * g + q) * RS + c0 + 4 * p;
    const u32x2 lo = tr64(a), hi = tr64(a + 16 * RS);
    u32x4 w; w.x = lo.x; w.y = lo.y; w.z = hi.x; w.w = hi.y;
    return __builtin_bit_cast(bf16x8, w);
}
__device__ __forceinline__ float wave_iscan_add(float v, int lane) {
#pragma unroll
    for (int o = 1; o < 64; o <<= 1) { const float t = __shfl_up(v, o); if (lane >= o) v += t; }
    return v;
}
__device__ __forceinline__ float wave_iscan_max(float v, int lane) {
#pragma unroll
    for (int o = 1; o < 64; o <<= 1) { const float t = __shfl_up(v, o); if (lane >= o) v = fmaxf(v, t); }
    return v;
}

__device__ __forceinline__ void gla_logdecay(const Args& a, const float* gates, int row0, int h, LAS float* galS, LAS float* segS, int tid, float (&la)[32], float& off, float& tot) {
    const int d = tid & 127, seg = tid >> 7;
    { const int t = tid >> 2, q = tid & 3; *(LAS f32x4*)(galS + t * 16 + q * 4) = *(const f32x4*)(gates + (size_t)(row0 + t) * 32 + 8 + q * 4); }
    float up[16];
#pragma unroll
    for (int j = 0; j < 16; ++j) up[j] = a.in[I_AUP][j * 512 + h * 128 + d];
    const float ab = a.in[I_AB][h * 128 + d];
    __syncthreads();
    float ssum = 0.f;
#pragma unroll
    for (int i = 0; i < 32; ++i) { const int t = seg * 32 + i; float z = ab;
#pragma unroll
        for (int q = 0; q < 4; ++q) { const f32x4 g = *(const LAS f32x4*)(galS + t * 16 + q * 4); z += g[0] * up[4 * q] + g[1] * up[4 * q + 1] + g[2] * up[4 * q + 2] + g[3] * up[4 * q + 3]; }
        la[i] = logsig(z) * (1.f / 16.f); ssum += la[i]; }
    segS[seg * 128 + d] = ssum;
    __syncthreads();
    off = 0.f; tot = 0.f;
#pragma unroll
    for (int s = 0; s < 4; ++s) { const float v = segS[s * 128 + d]; tot += v; off += (s < seg) ? v : 0.f; }
}

template <bool ML>
__device__ __forceinline__ void chunk_state(const Args& a, LAS unsigned char* lds, int bh, int c) {
    constexpr int DK = ML ? 256 : 128, NDT = DK / 16, RSK = DK + 16;
    int tid_ = threadIdx.x; asm volatile("" : "+v"(tid_));
    const int tid = tid_, lane = tid & 63, wave = __builtin_amdgcn_readfirstlane(tid >> 6), fr = lane & 15, fq = lane >> 4;
    const int b = bh >> 2, h = bh & 3, row0 = b * TP + c * 128, item = bh * NCH + c;
    unsigned char* ws = a.ws;
    const bf16* P = (const bf16*)(ws + WS_PROJ); const float* gates = (const float*)(ws + WS_GATES);
    LAS bf16* Ks = (LAS bf16*)lds; LAS bf16* Vs = (LAS bf16*)(lds + 69632); LAS float* sc = (LAS float*)(lds + 139264);
    __syncthreads();
    stage_v(Vs, P, row0, (ML ? C_MV : C_GV) + h * 256, tid);
    if (ML) {
        if (wave == 0) {
            const int t0 = 2 * lane;
            const float lf0 = logsig(gates[(size_t)(row0 + t0) * 32 + 4 + h] + a.in[I_BF][h]), lf1 = logsig(gates[(size_t)(row0 + t0 + 1) * 32 + 4 + h] + a.in[I_BF][h]);
            const float i0 = gates[(size_t)(row0 + t0) * 32 + h] + a.in[I_BI][h], i1 = gates[(size_t)(row0 + t0 + 1) * 32 + h] + a.in[I_BI][h];
            const float pr = lf0 + lf1, S = wave_iscan_add(pr, lane), ex = S - pr;
            const float ah0 = i0 - (ex + lf0), ah1 = i1 - S;
            const float Ah = wave_max(fmaxf(ah0, ah1));
            sc[t0] = __expf(ah0 - Ah) * (1.f / 16.f); sc[t0 + 1] = __expf(ah1 - Ah) * (1.f / 16.f);
            if (lane == 63) { float* chs = (float*)(ws + WS_CHS); chs[item * 2] = Ah; chs[item * 2 + 1] = S; }
        }
        __syncthreads();
#pragma unroll
        for (int i = 0; i < 8; ++i) { const int idx = tid + NTHR * i, s = idx >> 5, dp = idx & 31; const float w = sc[s];
            const u32x4 v = *(const u32x4*)(P + (size_t)(row0 + s) * NPROJ + C_MK + h * 256 + 8 * dp);
            u32x4 o; o.x = cvt_pk_bf16(bflo(v.x) * w, bfhi(v.x) * w); o.y = cvt_pk_bf16(bflo(v.y) * w, bfhi(v.y) * w); o.z = cvt_pk_bf16(bflo(v.z) * w, bfhi(v.z) * w); o.w = cvt_pk_bf16(bflo(v.w) * w, bfhi(v.w) * w);
            *(LAS u32x4*)(Ks + s * RSK + 8 * dp) = o; }
    } else {
        float la[32], off, tot;
        LAS float* galS = (LAS float*)(lds + 36864); gla_logdecay(a, gates, row0, h, galS, galS + 2048, tid, la, off, tot);
        const int d = tid & 127, seg = tid >> 7;
        if (seg == 0) ((float*)(ws + WS_BEND))[item * 128 + d] = tot;
        float bcur = off;
#pragma unroll
        for (int i = 0; i < 32; ++i) { const int t = seg * 32 + i; bcur += la[i];
            const float kv = bf2f(P[(size_t)(row0 + t) * NPROJ + C_GK + h * 128 + d]);
            Ks[t * RSK + d] = f2bf(kv * __expf(tot - bcur)); }
    }
    __syncthreads();
    f32x4 acc[2][NDT];
#pragma unroll
    for (int e = 0; e < 2; ++e)
#pragma unroll
        for (int d = 0; d < NDT; ++d) acc[e][d] = (f32x4){0.f, 0.f, 0.f, 0.f};
#pragma unroll
    for (int ks = 0; ks < 4; ++ks) {
        bf16x8 vb[2];
#pragma unroll
        for (int e = 0; e < 2; ++e) vb[e] = tr_frag(Vs, 272, wave * 32 + e * 16, ks, lane);
#pragma unroll
        for (int d = 0; d < NDT; ++d) { const bf16x8 ka = tr_frag(Ks, RSK, d * 16, ks, lane);
#pragma unroll
            for (int e = 0; e < 2; ++e) acc[e][d] = __builtin_amdgcn_mfma_f32_16x16x32_bf16(ka, vb[e], acc[e][d], 0, 0, 0); }
    }
    float* dst = (float*)(ws + (ML ? WS_DC : WS_DS)) + (size_t)item * 256 * DK;
#pragma unroll
    for (int e = 0; e < 2; ++e)
#pragma unroll
        for (int d = 0; d < NDT; ++d) *(f32x4*)(dst + (size_t)(wave * 32 + e * 16 + fr) * DK + d * 16 + 4 * fq) = acc[e][d];
    if (ML && tid < 256) { float s = 0.f;
#pragma unroll 16
        for (int i = 0; i < 128; ++i) s += bf2f(Ks[i * RSK + tid]);
        ((float*)(ws + WS_DN))[item * 256 + tid] = s; }
}

__device__ __forceinline__ void scan_mlstm(const Args& a, int j) {
    int tid_ = threadIdx.x; asm volatile("" : "+v"(tid_));
    const int tid = tid_, bh = j >> 5, eb = j & 31;
    unsigned char* ws = a.ws;
    const float* chs = (const float*)(ws + WS_CHS);
    const int e = eb * 8 + (tid >> 6), d4 = (tid & 63) * 4;
    const float* dC = (const float*)(ws + WS_DC) + (size_t)bh * NCH * 65536 + (size_t)e * 256 + d4;
    bf16* CT = (bf16*)(ws + WS_CT) + (size_t)bh * NCH * 65536 + (size_t)e * 256 + d4;
    f32x4 Cv = {0.f, 0.f, 0.f, 0.f}; float Fs = 0.f, Mp = 0.f;
    const bool do_n = (eb == 0 && tid < 256);
    float nv = 0.f;
    f32x4 dv[NCH];
#pragma unroll
    for (int c = 0; c < NCH; ++c) dv[c] = *(const f32x4*)(dC + (size_t)c * 65536);
#pragma unroll
    for (int c = 0; c < NCH; ++c) {
        u32x2 o; o.x = cvt_pk_bf16(Cv[0], Cv[1]); o.y = cvt_pk_bf16(Cv[2], Cv[3]); *(u32x2*)(CT + (size_t)c * 65536) = o;
        if (do_n) ((bf16*)(ws + WS_NPREV))[(bh * NCH + c) * 256 + tid] = f2bf(nv);
        const float Ah = chs[(bh * NCH + c) * 2], bt = chs[(bh * NCH + c) * 2 + 1];
        const float Ac = Ah - Fs, Mn = fmaxf(Mp, Ac), f1 = __expf(Mp - Mn), f2 = __expf(Ac - Mn);
        Cv = Cv * f1 + dv[c] * f2;
        if (do_n) nv = nv * f1 + ((const float*)(ws + WS_DN))[(bh * NCH + c) * 256 + tid] * f2;
        Mp = Mn; Fs += bt;
    }
    float* oC = a.out + O_PC + (size_t)bh * 65536;
#pragma unroll
    for (int i = 0; i < 4; ++i) oC[(size_t)(d4 + i) * 256 + e] = Cv[i];
    if (do_n) a.out[O_PN + bh * 256 + tid] = nv;
    if (eb == 0 && tid == 0) a.out[O_PM + bh] = Fs + Mp;
}
__device__ __forceinline__ void scan_gla(const Args& a, int j) {
    int tid_ = threadIdx.x; asm volatile("" : "+v"(tid_));
    const int tid = tid_, bh = j >> 4, eb = j & 15;
    unsigned char* ws = a.ws;
    const float* bend = (const float*)(ws + WS_BEND);
    const int ee = eb * 16 + (tid >> 5), d4 = (tid & 31) * 4;
    const float* dS = (const float*)(ws + WS_DS) + (size_t)bh * NCH * 32768 + (size_t)ee * 128 + d4;
    bf16* ST = (bf16*)(ws + WS_ST) + (size_t)bh * NCH * 32768 + (size_t)ee * 128 + d4;
    f32x4 Sv = {0.f, 0.f, 0.f, 0.f};
    f32x4 dv[NCH];
#pragma unroll
    for (int c = 0; c < NCH; ++c) dv[c] = *(const f32x4*)(dS + (size_t)c * 32768);
#pragma unroll
    for (int c = 0; c < NCH; ++c) {
        u32x2 o; o.x = cvt_pk_bf16(Sv[0], Sv[1]); o.y = cvt_pk_bf16(Sv[2], Sv[3]); *(u32x2*)(ST + (size_t)c * 32768) = o;
        const f32x4 be = *(const f32x4*)(bend + (bh * NCH + c) * 128 + d4);
        Sv[0] = Sv[0] * __expf(be[0]) + dv[c][0]; Sv[1] = Sv[1] * __expf(be[1]) + dv[c][1]; Sv[2] = Sv[2] * __expf(be[2]) + dv[c][2]; Sv[3] = Sv[3] * __expf(be[3]) + dv[c][3];
    }
    float* oS = a.out + O_PS + (size_t)bh * 32768;
#pragma unroll
    for (int i = 0; i < 4; ++i) oS[(size_t)(d4 + i) * 256 + ee] = Sv[i];
}

template <bool ML>
__device__ __forceinline__ void chunk_out(const Args& a, LAS unsigned char* lds, int bh, int c) {
    constexpr int DK = ML ? 256 : 128, QS = DK + 8, NKK = DK / 32;
    int tid_ = threadIdx.x; asm volatile("" : "+v"(tid_));
    const int tid = tid_, lane = tid & 63, wave = __builtin_amdgcn_readfirstlane(tid >> 6), fr = lane & 15, fq = lane >> 4;
    const int b = bh >> 2, h = bh & 3, row0 = b * TP + c * 128, item = bh * NCH + c;
    unsigned char* ws = a.ws;
    const bf16* P = (const bf16*)(ws + WS_PROJ); const float* gates = (const float*)(ws + WS_GATES);
    LAS bf16* Qs = (LAS bf16*)lds; LAS bf16* Ks = Qs + 128 * QS;
    LAS float* sc = (LAS float*)(lds + 143616);
    __syncthreads();
    if (ML) {
        if (wave == 0) {
            const float* chs = (const float*)(ws + WS_CHS);
            const float Ahc = lane < NCH ? chs[(bh * NCH + lane) * 2] : 0.f, btc = lane < NCH ? chs[(bh * NCH + lane) * 2 + 1] : 0.f;
            const float fsx = wave_iscan_add(btc, lane) - btc;
            const float Mp = fmaxf(0.f, wave_max(lane < c ? Ahc - fsx : -3.0e38f)), Fs = wave_sum(lane < c ? btc : 0.f);
            const int t0 = 2 * lane;
            const float lf0 = logsig(gates[(size_t)(row0 + t0) * 32 + 4 + h] + a.in[I_BF][h]), lf1 = logsig(gates[(size_t)(row0 + t0 + 1) * 32 + 4 + h] + a.in[I_BF][h]);
            const float i0 = gates[(size_t)(row0 + t0) * 32 + h] + a.in[I_BI][h], i1 = gates[(size_t)(row0 + t0 + 1) * 32 + h] + a.in[I_BI][h];
            const float pr = lf0 + lf1, S = wave_iscan_add(pr, lane), b0 = S - lf1, b1 = S;
            const float a0 = i0 - b0 - Fs, a1 = i1 - b1 - Fs;
            const float cm = wave_iscan_max(fmaxf(a0, a1), lane); float exm = __shfl_up(cm, 1); if (lane == 0) exm = -3.0e38f;
            const float M0 = fmaxf(fmaxf(Mp, exm), a0), M1 = fmaxf(M0, a1);
            sc[t0] = a0; sc[t0 + 1] = a1; sc[128 + t0] = M0; sc[128 + t0 + 1] = M1; sc[256 + t0] = __expf(Mp - M0); sc[256 + t0 + 1] = __expf(Mp - M1);
            sc[384 + t0] = __expf(-(Fs + b0 + M0)); sc[384 + t0 + 1] = __expf(-(Fs + b1 + M1));
        }
#pragma unroll
        for (int i = 0; i < 8; ++i) { const int idx = tid + NTHR * i, t = idx >> 5, p = idx & 31;
            *(LAS u32x4*)(Qs + t * QS + p * 8) = *(const u32x4*)(P + (size_t)(row0 + t) * NPROJ + C_MQ + h * 256 + p * 8);
            *(LAS u32x4*)(Ks + t * QS + p * 8) = *(const u32x4*)(P + (size_t)(row0 + t) * NPROJ + C_MK + h * 256 + p * 8); }
    } else {
        float la[32], off, tot;
        LAS float* galS = (LAS float*)(lds + 69632); LAS float* segS = galS + 128 * 16;
        gla_logdecay(a, gates, row0, h, galS, segS, tid, la, off, tot);
        const int d = tid & 127, seg = tid >> 7;
        float bcur = off;
#pragma unroll
        for (int i = 0; i < 32; ++i) { const int t = seg * 32 + i; bcur += la[i];
            const float qv = bf2f(P[(size_t)(row0 + t) * NPROJ + C_GQ + h * 128 + d]), kv = bf2f(P[(size_t)(row0 + t) * NPROJ + C_GK + h * 128 + d]);
            Qs[t * QS + d] = f2bf(qv * 0.08838834764831845f * __expf(bcur)); Ks[t * QS + d] = f2bf(kv * __expf(-bcur)); }
    }
    __syncthreads();
    bf16x8 qf[NKK];
#pragma unroll
    for (int kk = 0; kk < NKK; ++kk) qf[kk] = *(const LAS bf16x8*)(Qs + (wave * 16 + fr) * QS + kk * 32 + fq * 8);
    const int t = wave * 16 + fr;
    u32x2 pb[8]; float den = 0.f;
    {
        const float Mt = ML ? sc[128 + t] : 0.f;
#pragma unroll
        for (int st = 0; st < 8; ++st) { f32x4 s = {0.f, 0.f, 0.f, 0.f};
#pragma unroll
            for (int kk = 0; kk < NKK; ++kk) { const bf16x8 kf = *(const LAS bf16x8*)(Ks + (st * 16 + fr) * QS + kk * 32 + fq * 8); s = __builtin_amdgcn_mfma_f32_16x16x32_bf16(kf, qf[kk], s, 0, 0, 0); }
            float p[4];
            f32x4 as4 = {0.f, 0.f, 0.f, 0.f}; if (ML) as4 = *(const LAS f32x4*)(sc + st * 16 + 4 * fq);
#pragma unroll
            for (int r = 0; r < 4; ++r) { const int si = st * 16 + 4 * fq + r;
                const float e = ML ? s[r] * (1.f / 16.f) * __expf(fminf(as4[r] - Mt, 0.f)) : s[r];
                p[r] = (si <= t) ? e : 0.f;
                den += p[r]; }
            pb[st].x = cvt_pk_bf16(p[0], p[1]); pb[st].y = cvt_pk_bf16(p[2], p[3]);
            __builtin_amdgcn_sched_barrier(0); }
    }
    __syncthreads();
    LAS bf16* Cl = (LAS bf16*)lds;
    if (ML) {
        const bf16* CT = (const bf16*)(ws + WS_CT) + (size_t)item * 65536;
#pragma unroll
        for (int i = 0; i < 16; ++i) { const int idx = tid + NTHR * i, e = idx >> 5, p = idx & 31; *(LAS u32x4*)(Cl + e * QS + p * 8) = *(const u32x4*)(CT + (size_t)e * 256 + p * 8); }
        { const int e = tid >> 5, p = tid & 31; u32x4 v = {0u, 0u, 0u, 0u};
          if (e == 0) v = *(const u32x4*)((const bf16*)(ws + WS_NPREV) + (size_t)item * 256 + p * 8);
          *(LAS u32x4*)(Cl + (256 + e) * QS + p * 8) = v; }
    } else {
        const bf16* ST = (const bf16*)(ws + WS_ST) + (size_t)item * 32768;
#pragma unroll
        for (int i = 0; i < 8; ++i) { const int idx = tid + NTHR * i, e = idx >> 4, p = idx & 15; *(LAS u32x4*)(Cl + e * QS + p * 8) = *(const u32x4*)(ST + (size_t)e * 128 + p * 8); }
    }
    __syncthreads();
    f32x4 acc[16];
#pragma unroll
    for (int et = 0; et < 16; ++et) { acc[et] = (f32x4){0.f, 0.f, 0.f, 0.f};
#pragma unroll
        for (int kk = 0; kk < NKK; ++kk) { const bf16x8 cf = *(const LAS bf16x8*)(Cl + (et * 16 + fr) * QS + kk * 32 + fq * 8); acc[et] = __builtin_amdgcn_mfma_f32_16x16x32_bf16(cf, qf[kk], acc[et], 0, 0, 0); }
        if ((et & 1) == 1) __builtin_amdgcn_sched_barrier(0); }
    float wint = 1.f, qn = 0.f;
    if (ML) {
        f32x4 dn = {0.f, 0.f, 0.f, 0.f};
#pragma unroll
        for (int kk = 0; kk < NKK; ++kk) { const bf16x8 nf = *(const LAS bf16x8*)(Cl + (256 + fr) * QS + kk * 32 + fq * 8); dn = __builtin_amdgcn_mfma_f32_16x16x32_bf16(nf, qf[kk], dn, 0, 0, 0); }
        qn = __shfl(dn[0], fr);
        wint = sc[256 + t];
#pragma unroll
        for (int et = 0; et < 16; ++et) acc[et] = acc[et] * wint;
    }
    __syncthreads();
    LAS bf16* Vs = (LAS bf16*)lds;
    stage_v(Vs, P, row0, (ML ? C_MV : C_GV) + h * 256, tid);
    __syncthreads();
#pragma unroll
    for (int ks = 0; ks < 4; ++ks) {
        u32x4 pw; pw.x = pb[2 * ks].x; pw.y = pb[2 * ks].y; pw.z = pb[2 * ks + 1].x; pw.w = pb[2 * ks + 1].y;
        const bf16x8 pf = __builtin_bit_cast(bf16x8, pw);
#pragma unroll
        for (int et = 0; et < 16; ++et) { acc[et] = __builtin_amdgcn_mfma_f32_16x16x32_bf16(tr_frag(Vs, 272, et * 16, ks, lane), pf, acc[et], 0, 0, 0); if ((et & 3) == 3) __builtin_amdgcn_sched_barrier(0); }
    }
    float inv = 1.f;
    if (ML) { den += __shfl_xor(den, 16); den += __shfl_xor(den, 32); den += wint * qn; inv = 1.f / fmaxf(fabsf(den), sc[384 + t]); }
    float ss = 0.f;
#pragma unroll
    for (int et = 0; et < 16; ++et) { acc[et] = acc[et] * inv; ss += dot4(acc[et], acc[et]); }
    ss += __shfl_xor(ss, 16); ss += __shfl_xor(ss, 32);
    const float rn = rsqrtf(ss * (1.f / 256.f) + EPS);
    const float* hw = a.in[ML ? I_MHW : I_GHW] + h * 256;
    const bf16* gp = P + (size_t)(row0 + t) * NPROJ + (ML ? C_MO : C_GR) + h * 256;
    bf16* yp = (bf16*)(ws + (ML ? WS_YM : WS_YG)) + (size_t)(row0 + t) * 1024 + h * 256;
#pragma unroll
    for (int et = 0; et < 16; ++et) { const int e = et * 16 + 4 * fq;
        const u32x2 gw = *(const u32x2*)(gp + e); const f32x4 w = *(const f32x4*)(hw + e);
        const float g0 = bflo(gw.x), g1 = bfhi(gw.x), g2 = bflo(gw.y), g3 = bfhi(gw.y);
        float o0 = acc[et][0] * rn * w[0], o1 = acc[et][1] * rn * w[1], o2 = acc[et][2] * rn * w[2], o3 = acc[et][3] * rn * w[3];
        if (ML) { o0 *= sigm(g0); o1 *= sigm(g1); o2 *= sigm(g2); o3 *= sigm(g3); } else { o0 *= g0 * sigm(g0); o1 *= g1 * sigm(g1); o2 *= g2 * sigm(g2); o3 *= g3 * sigm(g3); }
        u32x2 o; o.x = cvt_pk_bf16(o0, o1); o.y = cvt_pk_bf16(o2, o3); *(u32x2*)(yp + e) = o;
        if ((et & 3) == 3) __builtin_amdgcn_sched_barrier(0); }
}

template <bool ML>
__device__ __forceinline__ void sample_item(const Args& a, LAS unsigned char* lds, int b, int h) {
    constexpr int DK = ML ? 256 : 128;
    int tid_ = threadIdx.x; asm volatile("" : "+v"(tid_));
    const int tid = tid_, lane = tid & 63, wave = __builtin_amdgcn_readfirstlane(tid >> 6);
    unsigned char* ws = a.ws;
    const bf16* P = (const bf16*)(ws + WS_PROJ); const float* gates = (const float*)(ws + WS_GATES);
    const int row0 = MP + b * 8, bh = b * 4 + h;
    LAS float* qT = (LAS float*)lds;
    LAS float* wkT = qT + 2048;
    LAS float* kT = wkT + 2048;
    LAS float* vS = kT + 2048;
    LAS float* red = vS + 2048;
    LAS float* sm = red + 16384;
    __syncthreads();
    float aS[8], Mt[8], bS[8]; float m0 = 0.f, dec = 1.f;
    if (ML) {
        m0 = a.in[I_M][bh]; float bs = 0.f, M = m0;
#pragma unroll
        for (int t = 0; t < 8; ++t) { const float mi = gates[(size_t)(row0 + t) * 32 + h], mf = gates[(size_t)(row0 + t) * 32 + 4 + h];
            bs += logsig(mf + a.in[I_BF][h]); bS[t] = bs; aS[t] = mi + a.in[I_BI][h] - bs; M = fmaxf(M, aS[t]); Mt[t] = M; }
        dec = __expf(m0 - Mt[7]);
        if (tid == 0) {
#pragma unroll
            for (int t = 0; t < 8; ++t) { sm[200 + t] = aS[t]; sm[208 + t] = Mt[t]; sm[216 + t] = bS[t]; } }
        if (tid < 256) { const int d = tid;
#pragma unroll
            for (int t = 0; t < 8; ++t) { const float qv = bf2f(P[(size_t)(row0 + t) * NPROJ + C_MQ + h * 256 + d]), kv = bf2f(P[(size_t)(row0 + t) * NPROJ + C_MK + h * 256 + d]) * (1.f / 16.f);
                qT[d * 8 + t] = qv; kT[d * 8 + t] = kv; wkT[d * 8 + t] = kv * __expf(aS[t] - Mt[7]); } }
    } else {
        if (tid < 128) { const int d = tid; float up[16];
#pragma unroll
            for (int j = 0; j < 16; ++j) up[j] = a.in[I_AUP][j * 512 + h * 128 + d];
            const float ab = a.in[I_AB][h * 128 + d];
            float bc[8]; float bs = 0.f;
#pragma unroll
            for (int t = 0; t < 8; ++t) { float z = ab;
#pragma unroll
                for (int j = 0; j < 16; ++j) z += gates[(size_t)(row0 + t) * 32 + 8 + j] * up[j];
                bs += logsig(z) * (1.f / 16.f); bc[t] = bs; }
            sm[72 + d] = __expf(bs);
#pragma unroll
            for (int t = 0; t < 8; ++t) { const float qv = bf2f(P[(size_t)(row0 + t) * NPROJ + C_GQ + h * 128 + d]), kv = bf2f(P[(size_t)(row0 + t) * NPROJ + C_GK + h * 128 + d]);
                qT[d * 8 + t] = qv * 0.08838834764831845f * __expf(bc[t]); kT[d * 8 + t] = kv * __expf(-bc[t]); wkT[d * 8 + t] = kv * __expf(bs - bc[t]); } }
    }
    { const int t = tid >> 6; const u32x2 w = *(const u32x2*)(P + (size_t)(row0 + t) * NPROJ + (ML ? C_MV : C_GV) + h * 256 + 4 * lane);
      *(LAS f32x4*)(vS + t * 256 + 4 * lane) = (f32x4){bflo(w.x), bfhi(w.x), bflo(w.y), bfhi(w.y)}; }
    __syncthreads();
    float prow, qn = 0.f;
    { const int s8 = lane & 7, part = lane >> 3; float sd = 0.f;
#pragma unroll 8
      for (int i = 0; i < DK / 8; ++i) { const int d = 8 * i + part; sd += qT[d * 8 + wave] * kT[d * 8 + s8]; }
      sd += __shfl_xor(sd, 8); sd += __shfl_xor(sd, 16); sd += __shfl_xor(sd, 32);
      if (ML) prow = (s8 <= wave) ? sd * __expf(sm[200 + s8] - sm[208 + wave]) : 0.f; else prow = (s8 <= wave) ? sd : 0.f; }
    if (ML) { const float* n0 = a.in[I_N] + (size_t)bh * 256; float sd = 0.f;
#pragma unroll
      for (int i = 0; i < 4; ++i) { const int d = lane + 64 * i; sd += qT[d * 8 + wave] * n0[d]; }
      qn = wave_sum(sd); }
    const float* C0 = a.in[ML ? I_C : I_S] + (size_t)bh * DK * 256;
    float* C1 = a.out + (ML ? O_SC : O_SS) + (size_t)bh * DK * 256;
    f32x4 v[8], acc[8];
#pragma unroll
    for (int s = 0; s < 8; ++s) { v[s] = *(const LAS f32x4*)(vS + s * 256 + 4 * lane); acc[s] = (f32x4){0.f, 0.f, 0.f, 0.f}; }
#pragma unroll 8
    for (int i = 0; i < DK / 8; ++i) { const int d = wave + 8 * i;
        const f32x4 cv = __builtin_nontemporal_load((const f32x4*)(C0 + (size_t)d * 256 + 4 * lane));
        const f32x4 q0 = *(const LAS f32x4*)(qT + d * 8), q1 = *(const LAS f32x4*)(qT + d * 8 + 4), k0 = *(const LAS f32x4*)(wkT + d * 8), k1 = *(const LAS f32x4*)(wkT + d * 8 + 4);
        const float dd = ML ? dec : sm[72 + d];
        acc[0] += cv * q0[0]; acc[1] += cv * q0[1]; acc[2] += cv * q0[2]; acc[3] += cv * q0[3]; acc[4] += cv * q1[0]; acc[5] += cv * q1[1]; acc[6] += cv * q1[2]; acc[7] += cv * q1[3];
        f32x4 cn = cv * dd;
        cn += v[0] * k0[0]; cn += v[1] * k0[1]; cn += v[2] * k0[2]; cn += v[3] * k0[3]; cn += v[4] * k1[0]; cn += v[5] * k1[1]; cn += v[6] * k1[2]; cn += v[7] * k1[3];
        __builtin_nontemporal_store(cn, (f32x4*)(C1 + (size_t)d * 256 + 4 * lane)); }
#pragma unroll
    for (int s = 0; s < 8; ++s) *(LAS f32x4*)(red + (wave * 8 + s) * 256 + 4 * lane) = acc[s];
    __syncthreads();
    const int t = wave;
    f32x4 qc = {0.f, 0.f, 0.f, 0.f};
#pragma unroll
    for (int w = 0; w < 8; ++w) qc += *(const LAS f32x4*)(red + (w * 8 + t) * 256 + 4 * lane);
    float wint = 1.f, den = 0.f, Mtt = 0.f, btt = 0.f;
    if (ML) { Mtt = sm[208 + t]; btt = sm[216 + t]; wint = __expf(m0 - Mtt); }
    f32x4 num = qc * wint;
#pragma unroll
    for (int s = 0; s < 8; ++s) { const float p = __shfl(prow, s); num += v[s] * p; den += p; }
    if (ML) { den += wint * qn; const float fl = fmaxf(fabsf(den), __expf(-(btt + Mtt))); num = num * (1.f / fl); }
    const float rn = rsqrtf(wave_sum(dot4(num, num)) * (1.f / 256.f) + EPS);
    const f32x4 w = *(const f32x4*)(a.in[ML ? I_MHW : I_GHW] + h * 256 + 4 * lane);
    const u32x2 gw = *(const u32x2*)(P + (size_t)(row0 + t) * NPROJ + (ML ? C_MO : C_GR) + h * 256 + 4 * lane);
    const float g0 = bflo(gw.x), g1 = bfhi(gw.x), g2 = bflo(gw.y), g3 = bfhi(gw.y);
    float o0 = num[0] * rn * w[0], o1 = num[1] * rn * w[1], o2 = num[2] * rn * w[2], o3 = num[3] * rn * w[3];
    if (ML) { o0 *= sigm(g0); o1 *= sigm(g1); o2 *= sigm(g2); o3 *= sigm(g3); } else { o0 *= g0 * sigm(g0); o1 *= g1 * sigm(g1); o2 *= g2 * sigm(g2); o3 *= g3 * sigm(g3); }
    u32x2 o; o.x = cvt_pk_bf16(o0, o1); o.y = cvt_pk_bf16(o2, o3);
    *(u32x2*)((bf16*)(ws + (ML ? WS_YM : WS_YG)) + (size_t)(row0 + t) * 1024 + h * 256 + 4 * lane) = o;
    if (ML) {
        if (tid < 256) { float s = dec * a.in[I_N][(size_t)bh * 256 + tid];
#pragma unroll
            for (int q = 0; q < 8; ++q) s += wkT[tid * 8 + q];
            a.out[O_SN + (size_t)bh * 256 + tid] = s; }
        if (tid == 0) a.out[O_SM + bh] = bS[7] + Mt[7];
    }
}

__device__ __forceinline__ void rstd_phase(const Args& a, int vcu, int G) {
    const float* part = (const float*)(a.ws + WS_PART); float* rstd = (float*)(a.ws + WS_RSTD);
    for (int row = vcu * NTHR + threadIdx.x; row < MT; row += G * NTHR) { float s = 0.f;
#pragma unroll
        for (int i = 0; i < 8; ++i) s += sum4(*(const f32x4*)(part + (size_t)row * 32 + 4 * i));
        rstd[row] = rsqrtf(s * (1.f / DM) + EPS); }
}
__device__ __forceinline__ void act_phase(const Args& a, int vcu, int G) {
    unsigned char* ws = a.ws; const bf16* U = (const bf16*)(ws + WS_U); bf16* Gb = (bf16*)(ws + WS_G);
    const float* cw = a.in[I_CW]; const float* cb = a.in[I_CB]; const float* cst = a.in[I_CONV];
    const size_t total = (size_t)MT * (DFF / 8);
    int tid_ = threadIdx.x; asm volatile("" : "+v"(tid_));
    for (size_t idx = (size_t)vcu * NTHR + tid_; idx < total; idx += (size_t)G * NTHR) {
        const int row = (int)(idx / (DFF / 8)), col = (int)(idx % (DFF / 8)) * 8;
        int t; const float* st = nullptr;
        if (row < MP) t = row & (TP - 1); else { const int rr = row - MP; t = rr & 7; st = cst + (size_t)(rr >> 3) * 2 * DFF + col; }
        float u0[8], u1[8], u2[8], g[8];
        { const u32x4 w = *(const u32x4*)(U + (size_t)row * DFF + col); u2[0] = bflo(w.x); u2[1] = bfhi(w.x); u2[2] = bflo(w.y); u2[3] = bfhi(w.y); u2[4] = bflo(w.z); u2[5] = bfhi(w.z); u2[6] = bflo(w.w); u2[7] = bfhi(w.w); }
        { const u32x4 w = *(const u32x4*)(Gb + (size_t)row * DFF + col); g[0] = bflo(w.x); g[1] = bfhi(w.x); g[2] = bflo(w.y); g[3] = bfhi(w.y); g[4] = bflo(w.z); g[5] = bfhi(w.z); g[6] = bflo(w.w); g[7] = bfhi(w.w); }
        if (t >= 1) { const u32x4 w = *(const u32x4*)(U + (size_t)(row - 1) * DFF + col); u1[0] = bflo(w.x); u1[1] = bfhi(w.x); u1[2] = bflo(w.y); u1[3] = bfhi(w.y); u1[4] = bflo(w.z); u1[5] = bfhi(w.z); u1[6] = bflo(w.w); u1[7] = bfhi(w.w); }
        else {
#pragma unroll
            for (int i = 0; i < 8; ++i) u1[i] = st ? st[DFF + i] : 0.f; }
        if (t >= 2) { const u32x4 w = *(const u32x4*)(U + (size_t)(row - 2) * DFF + col); u0[0] = bflo(w.x); u0[1] = bfhi(w.x); u0[2] = bflo(w.y); u0[3] = bfhi(w.y); u0[4] = bflo(w.z); u0[5] = bfhi(w.z); u0[6] = bflo(w.w); u0[7] = bfhi(w.w); }
        else {
#pragma unroll
            for (int i = 0; i < 8; ++i) u0[i] = st ? st[(size_t)t * DFF + i] : 0.f; }
        float o[8];
#pragma unroll
        for (int i = 0; i < 8; ++i) { const float uc = cb[col + i] + cw[col + i] * u0[i] + cw[DFF + col + i] * u1[i] + cw[2 * DFF + col + i] * u2[i]; o[i] = gelu_tanh(uc) * g[i]; }
        u32x4 w; w.x = cvt_pk_bf16(o[0], o[1]); w.y = cvt_pk_bf16(o[2], o[3]); w.z = cvt_pk_bf16(o[4], o[5]); w.w = cvt_pk_bf16(o[6], o[7]);
        *(u32x4*)(Gb + (size_t)row * DFF + col) = w;
    }
}
__device__ __forceinline__ void final_norm(const Args& a, int vcu, int G) {
    int tid_ = threadIdx.x; asm volatile("" : "+v"(tid_));
    const int tid = tid_, lane = tid & 63, wave = tid >> 6;
    const float* part = (const float*)(a.ws + WS_PART); const float* fw = a.in[I_FNW];
    for (int m = vcu * NWAVES + wave; m < MT; m += G * NWAVES) {
        float s = (lane < 32) ? part[(size_t)m * 32 + lane] : 0.f; s = wave_sum(s);
        const float r = rsqrtf(s * (1.f / DM) + EPS);
        float* row = a.out + (size_t)m * DM;
#pragma unroll
        for (int j = 0; j < 8; ++j) { const f32x4 v = *(const f32x4*)(row + 4 * lane + 256 * j), w = *(const f32x4*)(fw + 4 * lane + 256 * j);
            *(f32x4*)(row + 4 * lane + 256 * j) = (f32x4){v[0] * r * w[0], v[1] * r * w[1], v[2] * r * w[2], v[3] * r * w[3]}; }
    }
}

#define XB_TMO      128
#define XB_XCNT(j)  (256  + 64 * (j))
#define XB_XSUB(j)  (1280 + 64 * (j))
#define XB_XGEN(j)  (2304 + 64 * (j))
#define XB_TOP      3328
#define XB_TOPGEN   3392
#define XCD_BAR_WORDS 3456
#define XB_SPIN_CAP (1u << 18)

__device__ __forceinline__ unsigned xb_ld(unsigned* p)              { return __hip_atomic_load(p, __ATOMIC_RELAXED, __HIP_MEMORY_SCOPE_AGENT); }
__device__ __forceinline__ unsigned xb_add(unsigned* p, unsigned v) { return __hip_atomic_fetch_add(p, v, __ATOMIC_RELAXED, __HIP_MEMORY_SCOPE_AGENT); }
__device__ __forceinline__ unsigned xb_xcc_id() { return (unsigned)__builtin_amdgcn_s_getreg((3 << 11) | 20) & 0xFu; }
#define XB_SPIN(cond, bar) do { unsigned _sp = 0; while (cond) { __builtin_amdgcn_s_sleep(1); \
    if ((++_sp & 255u) == 0u) { if (xb_ld(&(bar)[XB_TMO])) break; if (_sp > XB_SPIN_CAP) { atomicAdd(&(bar)[XB_TMO], 1u); break; } } } } while (0)

struct XcdBarrier {
    unsigned* bar; unsigned x;
    volatile LAS unsigned* st;
};

__device__ __forceinline__ XcdBarrier xcd_barrier_post(unsigned* bar, volatile LAS unsigned* st) {
    XcdBarrier b; b.bar = bar; b.x = xb_xcc_id(); b.st = st;
    if (threadIdx.x == 0) (void)xb_add(&bar[XB_XCNT(b.x)], 1u);
    return b;
}
__device__ __forceinline__ void xcd_barrier_complete(unsigned* bar, unsigned x, unsigned& nloc, unsigned& nx) {
    const unsigned G = gridDim.x * gridDim.y * gridDim.z;
    unsigned sum, cnt, mine, sp = 0u;
    for (;;) {
        sum = 0u; cnt = 0u; mine = 0u;
#pragma unroll
        for (unsigned j = 0; j < 16; ++j) { const unsigned c = xb_ld(&bar[XB_XCNT(j)]); sum += c; cnt += (c > 0u) ? 1u : 0u; mine = (j == x) ? c : mine; }
        if (sum == G) break;
        __builtin_amdgcn_s_sleep(1);
        if ((++sp & 255u) == 0u) { if (xb_ld(&bar[XB_TMO])) break; if (sp > XB_SPIN_CAP) { atomicAdd(&bar[XB_TMO], 1u); break; } }
    }
    nloc = mine > 0u ? mine : 1u; nx = cnt > 0u ? cnt : 1u;
}

__device__ __forceinline__ void xcd_barrier(const XcdBarrier& b) {
    asm volatile("s_waitcnt vmcnt(0)" ::: "memory");
    __syncthreads();
    if (threadIdx.x == 0) {
        unsigned* bar = b.bar;
        __builtin_amdgcn_s_waitcnt(0);
        unsigned nloc = b.st[0], nx = b.st[1];
        if (nloc == 0u) { xcd_barrier_complete(bar, b.x, nloc, nx); b.st[0] = nloc; b.st[1] = nx; }
        const unsigned old = xb_add(&bar[XB_XSUB(b.x)], 1u);
        const unsigned gen = old / nloc;
        if (old + 1u == (gen + 1u) * nloc) {
            __builtin_amdgcn_fence(__ATOMIC_RELEASE, "agent");
            asm volatile("s_waitcnt vmcnt(0)" ::: "memory");
            const unsigned og = xb_add(&bar[XB_TOP], 1u);
            const unsigned tg = og / nx;
            if (og + 1u == (tg + 1u) * nx) xb_add(&bar[XB_TOPGEN], 1u);
            else XB_SPIN(xb_ld(&bar[XB_TOPGEN]) == tg, bar);
            __builtin_amdgcn_fence(__ATOMIC_ACQUIRE, "agent");
            xb_add(&bar[XB_XGEN(b.x)], 1u);
            asm volatile("s_waitcnt vmcnt(0)" ::: "memory");
        } else {
            XB_SPIN(xb_ld(&bar[XB_XGEN(b.x)]) == gen, bar);
            __builtin_amdgcn_fence(__ATOMIC_ACQUIRE, "agent");
            asm volatile("s_waitcnt vmcnt(0)" ::: "memory");
        }
    }
    __syncthreads();
}

constexpr int N_PHASES = 12;
__global__ void __launch_bounds__(NTHR) fwd_kernel(Args args) {
    extern __shared__ __attribute__((aligned(16))) unsigned char lds_raw[];
    LAS unsigned char* lds = (LAS unsigned char*)lds_raw;
    cg::grid_group grid = cg::this_grid();
    volatile LAS unsigned* bst = (volatile LAS unsigned*)(lds + LDS_BYTES - 16);
    if (threadIdx.x < 4) bst[threadIdx.x] = 0u;
    __syncthreads();
    XcdBarrier xbar = xcd_barrier_post((unsigned*)args.ws, bst);
    const int G = gridDim.x, bx = blockIdx.x;
    const int vcu = (G % 8 == 0) ? (bx % 8) * (G / 8) + bx / 8 : bx;
    const int lo = args.ph_lo, hi = args.ph_hi;
    unsigned char* ws = args.ws;
#ifndef USE_CG_SYNC
#define USE_CG_SYNC 0
#endif
#ifndef DOUBLE_MASK
#define DOUBLE_MASK 0
#endif
#define REP(k) for (int rep_ = 0; rep_ < 1 + ((DOUBLE_MASK >> (k)) & 1); ++rep_)
#ifndef BIS
#define BIS 15
#endif
#ifndef PHASE_MASK
#define PHASE_MASK 0xfff
#endif
#define IN(k) (((PHASE_MASK >> (k)) & 1) && lo <= (k) && (k) < hi)
#define SEAM(k) do { if (IN(k) && IN((k) + 1)) { if (USE_CG_SYNC || lo < 0) grid.sync(); else xcd_barrier(xbar); } } while (0)
    if (IN(0)) REP(0) { p0_prologue(args, lds, vcu, G); __syncthreads(); }
    SEAM(0);
    if (IN(1)) REP(1) {
        pg8::Gemm g{(const bf16*)(ws + WS_XN), (const bf16*)(ws + WS_WIN), nullptr, nullptr, MT, NPROJ_PAD, DM}; pg8::StaticOrder S; S.init(MT, NPROJ_PAD, G, bx);
        EpiProj E{(bf16*)(ws + WS_PROJ), (float*)(ws + WS_GATES)};
        pg8::gemm_phase<EpiProj, pg8::StaticOrder, true, true>(lds, g, S, E);
    }
    SEAM(1);
    if (IN(2)) REP(2) {
        for (int it = bx; it < 1536; it += G) {
            if (it < 512) { if (BIS & 1) sample_item<true>(args, lds, it >> 2, it & 3); }
            else if (it < 1024) { if (BIS & 2) sample_item<false>(args, lds, (it - 512) >> 2, (it - 512) & 3); }
            else if (it < 1280) { if (BIS & 4) chunk_state<true>(args, lds, (it - 1024) >> 4, (it - 1024) & 15); }
            else { if (BIS & 8) chunk_state<false>(args, lds, (it - 1280) >> 4, (it - 1280) & 15); }
        }
    }
    SEAM(2);
    if (IN(3)) REP(3) { for (int it = bx; it < 768; it += G) { if (it < 512) scan_mlstm(args, it); else scan_gla(args, it - 512); } }
    SEAM(3);
    if (IN(4)) REP(4) { for (int it = bx; it < 512; it += G) { if (it < 256) { if (BIS & 1) chunk_out<true>(args, lds, it >> 4, it & 15); } else { if (BIS & 2) chunk_out<false>(args, lds, (it - 256) >> 4, (it - 256) & 15); } } __syncthreads(); }
    SEAM(4);
    if (IN(5)) REP(5) {
        pg8::Gemm g{(const bf16*)(ws + WS_YM), (const bf16*)(ws + WS_WA), (const bf16*)(ws + WS_YG), (const bf16*)(ws + WS_WB), MT, DM, 1024}; pg8::TwoSegOrder S; S.S.init(MT, DM, G, bx);
        EpiBranch E{(const bf16*)(ws + WS_PROJ), (bf16*)(ws + WS_XN)};
        pg8::gemm_phase<EpiBranch, pg8::TwoSegOrder, true, true>(lds, g, S, E);
    }
    SEAM(5);
    if (IN(6)) REP(6) {
        pg8::Gemm g{(const bf16*)(ws + WS_XN), (const bf16*)(ws + WS_WO), nullptr, nullptr, MT, DM, DM}; pg8::StaticOrder S; S.init(MT, DM, G, bx);
        EpiOut E{args.in[I_XP], args.in[I_XS], (float*)(ws + WS_X1), (bf16*)(ws + WS_X1W), args.in[I_NFFN], (float*)(ws + WS_PART)};
        pg8::gemm_phase<EpiOut, pg8::StaticOrder, true, true>(lds, g, S, E);
    }
    SEAM(6);
    if (IN(7)) REP(7) rstd_phase(args, vcu, G);
    SEAM(7);
    if (IN(8)) REP(8) {
        pg8::Gemm g{(const bf16*)(ws + WS_X1W), (const bf16*)(ws + WS_WUG), nullptr, nullptr, MT, 2 * DFF, DM}; pg8::StaticOrder S; S.init(MT, 2 * DFF, G, bx);
        EpiUG E{(const float*)(ws + WS_RSTD), (bf16*)(ws + WS_U), (bf16*)(ws + WS_G), args.out};
        pg8::gemm_phase<EpiUG, pg8::StaticOrder, true, true>(lds, g, S, E);
    }
    SEAM(8);
    if (IN(9)) REP(9) act_phase(args, vcu, G);
    SEAM(9);
    if (IN(10)) REP(10) {
        pg8::Gemm g{(const bf16*)(ws + WS_G), (const bf16*)(ws + WS_WD), nullptr, nullptr, MT, DM, DFF}; pg8::StaticOrder S; S.init(MT, DM, G, bx);
        EpiDown E{(const float*)(ws + WS_X1), args.out, (float*)(ws + WS_PART)};
        pg8::gemm_phase<EpiDown, pg8::StaticOrder, true, true>(lds, g, S, E);
    }
    SEAM(10);
    if (IN(11)) REP(11) final_norm(args, vcu, G);
#ifdef EXTRA_SYNCS
    for (int i_ = 0; i_ < EXTRA_SYNCS; ++i_) xcd_barrier(xbar);
#endif
#undef IN
#undef SEAM
}

extern "C" void kernel_launch(void* const* d_in, const int* in_sizes, int n_in, void* d_out, int out_size, void* d_ws, size_t ws_size, hipStream_t stream) {
    static int grid = 0;
    if (grid == 0) {
        if (n_in != 25 || ws_size < WS_END) { fprintf(stderr, "kernel_launch: unexpected n_in %d / ws_size %zu (need %zu)\n", n_in, ws_size, (size_t)WS_END); grid = -1; return; }
        int dev = 0, cus = 0, per_cu = 0;
        (void)hipGetDevice(&dev); (void)hipDeviceGetAttribute(&cus, hipDeviceAttributeMultiprocessorCount, dev);
        if (hipFuncSetAttribute((const void*)fwd_kernel, hipFuncAttributeMaxDynamicSharedMemorySize, LDS_BYTES) != hipSuccess) { fprintf(stderr, "kernel_launch: hipFuncSetAttribute failed\n"); grid = -1; return; }
        if (hipOccupancyMaxActiveBlocksPerMultiprocessor(&per_cu, (const void*)fwd_kernel, NTHR, LDS_BYTES) != hipSuccess || per_cu < 1) { fprintf(stderr, "kernel_launch: occupancy query says %d\n", per_cu); per_cu = 1; }
        (void)hipGetLastError();
        grid = cus * 1;
        if (grid <= 0) grid = 256;
    }
    if (grid < 0) return;
    if (hipMemsetAsync(d_ws, 0, 65536, stream) != hipSuccess) { fprintf(stderr, "kernel_launch: memset failed\n"); return; }
    Args a{};
    for (int i = 0; i < 25; ++i) a.in[i] = (const float*)d_in[i];
    a.out = (float*)d_out; a.ws = (unsigned char*)d_ws;
    if (MK_N_LAUNCHES == 1) {
        a.ph_lo = 0; a.ph_hi = N_PHASES;
        void* kargs[] = {&a};
        hipError_t e = hipLaunchCooperativeKernel((const void*)fwd_kernel, dim3(grid), dim3(NTHR), kargs, LDS_BYTES, stream);
        if (e != hipSuccess) fprintf(stderr, "kernel_launch: cooperative launch failed: %s (grid %d)\n", hipGetErrorString(e), grid);
    } else {
        for (int p = 0; p < N_PHASES; ++p) { a.ph_lo = p; a.ph_hi = p + 1; hipLaunchKernelGGL(fwd_kernel, dim3(grid), dim3(NTHR), LDS_BYTES, stream, a); }
    }
}
```

```cpp
#include <hip/hip_runtime.h>
#include <hip/hip_cooperative_groups.h>
#include <cstdio>
#include <cstdint>
namespace cg = cooperative_groups;

#ifndef MK_N_LAUNCHES
#define MK_N_LAUNCHES 1
#endif

namespace pg8 {
#define PG8_LAS __attribute__((address_space(3)))
typedef unsigned short bf16_t;
typedef short bf16x8 __attribute__((ext_vector_type(8)));
typedef float f32x4 __attribute__((ext_vector_type(4)));
typedef unsigned u32x4 __attribute__((ext_vector_type(4)));
constexpr int BM = 256, BK = 64, HALF = 128, HTB = HALF * BK * 2  , STAGE_BYTES = 8 * HTB, NXCD = 8, WGM = 8;

__host__ __device__ __forceinline__ int lds_byte(int r, int c) { const int st = (r >> 4) * 2 + (c >> 5), rr = r & 15, cc = c & 31, ob = rr * 64 + cc * 2; return st * 1024 + (ob ^ (((ob >> 9) & 1) << 5)); }
__host__ __device__ __forceinline__ void stage_rc(int b, int& R, int& C) { const int st = b / 1024, sb = b % 1024, swz = sb ^ (((sb >> 9) & 1) << 5); R = (st >> 1) * 16 + swz / 64; C = (st & 1) * 32 + (swz % 64) / 2; }
__host__ __device__ __forceinline__ int perm32(int rho) { const int n = rho >> 4, i = rho & 15; return 8 * (i >> 2) + 4 * n + (i & 3); }

struct Unit { int pm, pn, seg; };
struct Gemm { const bf16_t* A; const bf16_t* Bt; const bf16_t* A2; const bf16_t* Bt2; int M, N, K; };

struct StaticOrder {
    int nM, nN, nwg, G, c;
    __host__ __device__ void init(int M, int N, int G_, int c_) { nM = M / BM; nN = N / BM; nwg = nM * nN; G = G_; c = c_; }
    __host__ __device__ bool next(int i, Unit& u) const {
        const long L = (long)i * G + c; if (L >= nwg) return false;
        int wgid = (int)L; { const int q = nwg / NXCD, r = nwg % NXCD, xcd = wgid % NXCD, off = wgid / NXCD; wgid = (xcd < r ? xcd * (q + 1) : r * (q + 1) + (xcd - r) * q) + off; }
        const int nig = WGM * nN, gid = wgid / nig, fm = gid * WGM, gsz = (nM - fm) < WGM ? (nM - fm) : WGM;
        u.pm = fm + ((wgid % nig) % gsz); u.pn = (wgid % nig) / gsz; u.seg = 0; return true;
    }
};
struct TwoSegOrder {
    StaticOrder S;
    __host__ __device__ bool next(int i, Unit& u) const { if (!S.next(i >> 1, u)) return false; u.seg = i & 1; return true; }
};

__device__ __forceinline__ unsigned cvt_pk_bf16(float lo, float hi) { unsigned r; asm volatile("v_cvt_pk_bf16_f32 %0, %1, %2" : "=v"(r) : "v"(lo), "v"(hi)); return r; }

template <class Epi, class Sched, bool ALIGN_EPI = false, bool SP2 = false>
__device__ __forceinline__ void gemm_phase(PG8_LAS unsigned char* lds, const Gemm g, const Sched& S, const Epi& E) {
    int tid_ = threadIdx.x; asm volatile("" : "+v"(tid_));
    const int tid = tid_, wid = __builtin_amdgcn_readfirstlane(tid >> 6), lane = tid & 63, wr = wid >> 2, wc = wid & 3, fr = lane & 15, fq = lane >> 4;
    const int K = g.K, nt = K / BK;
    unsigned voffA[2], voffB[2];
#pragma unroll
    for (int i = 0; i < 2; ++i) { int R, C; stage_rc(tid * 16 + i * 8192, R, C); const int Rb = Epi::PERM ? ((R & ~31) + perm32(R & 31)) : R;
        voffA[i] = (unsigned)(R * K + C) * 2u; voffB[i] = (unsigned)(Rb * K + C) * 2u; }
    const size_t kstep = (size_t)(BK * 2);
    const size_t hstep = (size_t)HALF * K * 2;
    const size_t tstep = 2 * hstep;
    const unsigned ldsw = (unsigned)wid * 1024u;
    const int aoff = lds_byte(wr * 64 + fr, fq * 8), boff = lds_byte(wc * 32 + fr, fq * 8);
#define PG8_SA(b, h) (((b) * 2 + (h)) * HTB)
#define PG8_SB(b, h) ((4 + (b) * 2 + (h)) * HTB)
#define PG8_STAGE(bufoff, gbase, voff) do { _Pragma("unroll") for (int _i = 0; _i < 2; ++_i) \
        __builtin_amdgcn_global_load_lds((const unsigned*)((const char*)(gbase) + (voff)[_i]), (PG8_LAS unsigned*)(lds + (bufoff) + ldsw + _i * 8192), 16, 0, 0); } while (0)
#define PG8_LDA(dst, b, h) do { _Pragma("unroll") for (int m = 0; m < 4; ++m) _Pragma("unroll") for (int k = 0; k < 2; ++k) dst[m][k] = *(const PG8_LAS bf16x8*)(lds + PG8_SA(b, h) + aoff + m * 2048 + k * 1024); } while (0)
#define PG8_LDB(dst, b, h) do { _Pragma("unroll") for (int n = 0; n < 2; ++n) _Pragma("unroll") for (int k = 0; k < 2; ++k) dst[n][k] = *(const PG8_LAS bf16x8*)(lds + PG8_SB(b, h) + boff + n * 2048 + k * 1024); } while (0)
#define PG8_MMA(ai, bj, At, Bt) do { __builtin_amdgcn_s_setprio(1); _Pragma("unroll") for (int m = 0; m < 4; ++m) _Pragma("unroll") for (int n = 0; n < 2; ++n) _Pragma("unroll") for (int k = 0; k < 2; ++k) \
        acc[ai][bj][m][n] = __builtin_amdgcn_mfma_f32_16x16x32_bf16(Bt[n][k], At[m][k], acc[ai][bj][m][n], 0, 0, 0); __builtin_amdgcn_s_setprio(0); } while (0)
#define PG8_WAIT_V(n) asm volatile("s_waitcnt vmcnt(" #n ")" ::: "memory")
#define PG8_WAIT_L(n) asm volatile("s_waitcnt lgkmcnt(" #n ")" ::: "memory")
#define PG8_BAR __builtin_amdgcn_s_barrier()
#define PG8_SCHED __builtin_amdgcn_sched_barrier(0)
    Unit cur, nxt; int ui = 0;
    if (!S.next(0, cur)) return;
    f32x4 acc[2][2][4][2];
#pragma unroll
    for (int a = 0; a < 2; ++a)
#pragma unroll
        for (int b = 0; b < 2; ++b)
#pragma unroll
            for (int m = 0; m < 4; ++m)
#pragma unroll
                for (int n = 0; n < 2; ++n) acc[a][b][m][n] = (f32x4){0.f, 0.f, 0.f, 0.f};
    bf16x8 At[4][2], B0[2][2], B1[2][2];
    const char* cA = (const char*)(cur.seg ? g.A2 : g.A) + (size_t)cur.pm * tstep; const char* cB = (const char*)(cur.seg ? g.Bt2 : g.Bt) + (size_t)cur.pn * tstep;
    if constexpr (SP2) {
        PG8_STAGE(PG8_SB(0, 0), cB, voffB); PG8_STAGE(PG8_SB(0, 1), cB + hstep, voffB); PG8_STAGE(PG8_SA(0, 0), cA, voffA); PG8_STAGE(PG8_SA(0, 1), cA + hstep, voffA);
        if (wr == 1) PG8_BAR;
        PG8_WAIT_V(2); PG8_BAR;
        PG8_STAGE(PG8_SB(1, 0), cB + kstep, voffB); PG8_STAGE(PG8_SA(1, 0), cA + kstep, voffA); PG8_STAGE(PG8_SB(1, 1), cB + hstep + kstep, voffB);
        PG8_WAIT_V(6); PG8_BAR;
    } else {
        PG8_STAGE(PG8_SB(0, 0), cB, voffB); PG8_STAGE(PG8_SA(0, 0), cA, voffA); PG8_STAGE(PG8_SB(0, 1), cB + hstep, voffB); PG8_STAGE(PG8_SA(0, 1), cA + hstep, voffA);
        if (wr == 1) PG8_BAR;
        PG8_WAIT_V(4); PG8_BAR;
        PG8_STAGE(PG8_SB(1, 0), cB + kstep, voffB); PG8_STAGE(PG8_SA(1, 0), cA + kstep, voffA); PG8_STAGE(PG8_SB(1, 1), cB + hstep + kstep, voffB);
        PG8_WAIT_V(6); PG8_BAR;
    }
    for (;;) {
        const bool has_next = S.next(ui + 1, nxt);
        const char* nA = has_next ? (const char*)(nxt.seg ? g.A2 : g.A) + (size_t)nxt.pm * tstep : cA; const char* nB = has_next ? (const char*)(nxt.seg ? g.Bt2 : g.Bt) + (size_t)nxt.pn * tstep : cB;
        for (int t = 0; t < nt; t += 2) {
            const bool last = (t == nt - 2);
            const char* a1 = cA + (size_t)(t + 1) * kstep;
            const char* a2 = last ? nA : cA + (size_t)(t + 2) * kstep; const char* b2 = last ? nB : cB + (size_t)(t + 2) * kstep;
            const char* a3 = a2 + kstep; const char* b3 = b2 + kstep;
            if constexpr (SP2) {
            PG8_LDB(B0, 0, 0); PG8_LDB(B1, 0, 1); PG8_SCHED; PG8_LDA(At, 0, 0); PG8_STAGE(PG8_SA(1, 1), a1 + hstep, voffA);
            PG8_WAIT_V(8); PG8_WAIT_L(0); PG8_BAR; PG8_MMA(0, 0, At, B0); PG8_MMA(0, 1, At, B1); PG8_BAR; PG8_SCHED;
            PG8_LDA(At, 0, 1); PG8_STAGE(PG8_SB(0, 0), b2, voffB); PG8_STAGE(PG8_SB(0, 1), b2 + hstep, voffB); PG8_STAGE(PG8_SA(0, 0), a2, voffA);
            PG8_WAIT_V(8); PG8_WAIT_L(0); PG8_BAR; PG8_MMA(1, 0, At, B0); PG8_MMA(1, 1, At, B1); PG8_BAR; PG8_SCHED;
            PG8_LDB(B0, 1, 0); PG8_LDB(B1, 1, 1); PG8_SCHED; PG8_LDA(At, 1, 0); PG8_STAGE(PG8_SA(0, 1), a2 + hstep, voffA);
            PG8_WAIT_V(8); PG8_WAIT_L(0); PG8_BAR; PG8_MMA(0, 0, At, B0); PG8_MMA(0, 1, At, B1); PG8_BAR; PG8_SCHED;
            PG8_LDA(At, 1, 1); PG8_STAGE(PG8_SB(1, 0), b3, voffB); PG8_STAGE(PG8_SB(1, 1), b3 + hstep, voffB); PG8_STAGE(PG8_SA(1, 0), a3, voffA);
            PG8_WAIT_V(8); PG8_WAIT_L(0); PG8_BAR; PG8_MMA(1, 0, At, B0); PG8_MMA(1, 1, At, B1); PG8_BAR; PG8_SCHED;
            } else {
            PG8_LDB(B0, 0, 0); PG8_SCHED; PG8_LDA(At, 0, 0); PG8_STAGE(PG8_SA(1, 1), a1 + hstep, voffA);
            PG8_WAIT_L(8); PG8_BAR; PG8_WAIT_L(0); PG8_MMA(0, 0, At, B0); PG8_BAR; PG8_SCHED;
            PG8_LDB(B1, 0, 1); PG8_STAGE(PG8_SB(0, 0), b2, voffB);
            PG8_BAR; PG8_WAIT_L(0); PG8_MMA(0, 1, At, B1); PG8_BAR;
            PG8_LDA(At, 0, 1); PG8_STAGE(PG8_SA(0, 0), a2, voffA);
            PG8_BAR; PG8_WAIT_L(0); PG8_MMA(1, 0, At, B0); PG8_BAR; PG8_SCHED;
            PG8_STAGE(PG8_SB(0, 1), b2 + hstep, voffB);
            PG8_WAIT_V(6); PG8_BAR; PG8_MMA(1, 1, At, B1); PG8_BAR;
            PG8_LDB(B0, 1, 0); PG8_SCHED; PG8_LDA(At, 1, 0); PG8_STAGE(PG8_SA(0, 1), a2 + hstep, voffA);
            PG8_WAIT_L(8); PG8_BAR; PG8_WAIT_L(0); PG8_MMA(0, 0, At, B0); PG8_BAR; PG8_SCHED;
            PG8_LDB(B1, 1, 1); PG8_STAGE(PG8_SB(1, 0), b3, voffB);
            PG8_BAR; PG8_WAIT_L(0); PG8_MMA(0, 1, At, B1); PG8_BAR;
            PG8_LDA(At, 1, 1); PG8_STAGE(PG8_SA(1, 0), a3, voffA);
            PG8_BAR; PG8_WAIT_L(0); PG8_MMA(1, 0, At, B0); PG8_BAR; PG8_SCHED;
            PG8_STAGE(PG8_SB(1, 1), b3 + hstep, voffB);
            PG8_WAIT_V(6); PG8_BAR; PG8_MMA(1, 1, At, B1); PG8_BAR;
            }
        }
        if constexpr (ALIGN_EPI) { if (wr == 0) PG8_BAR; }
        E(acc, cur, wr, wc, fr, fq);
        if (!has_next) break;
        if (nxt.seg == 0)
#pragma unroll
        for (int a = 0; a < 2; ++a)
#pragma unroll
            for (int b = 0; b < 2; ++b)
#pragma unroll
                for (int m = 0; m < 4; ++m)
#pragma unroll
                    for (int n = 0; n < 2; ++n) acc[a][b][m][n] = (f32x4){0.f, 0.f, 0.f, 0.f};
        cur = nxt; cA = nA; cB = nB; ++ui;
        if constexpr (ALIGN_EPI) { if (wr == 1) PG8_BAR; }
    }
    PG8_WAIT_V(0);
    if constexpr (!ALIGN_EPI) { if (wr == 0) PG8_BAR; }
    PG8_BAR;
#undef PG8_SA
#undef PG8_SB
#undef PG8_STAGE
#undef PG8_LDA
#undef PG8_LDB
#undef PG8_MMA
#undef PG8_WAIT_V
#undef PG8_WAIT_L
#undef PG8_BAR
#undef PG8_SCHED
}
}

#define LAS __attribute__((address_space(3)))
typedef unsigned short bf16;
typedef short bf16x8 __attribute__((ext_vector_type(8)));
typedef float f32x4 __attribute__((ext_vector_type(4)));
typedef unsigned u32x4 __attribute__((ext_vector_type(4)));
typedef unsigned u32x2 __attribute__((ext_vector_type(2)));
using pg8::cvt_pk_bf16;

constexpr int NWAVES = 8, NTHR = 512;
constexpr int DM = 2048, MP = 8192, MS = 1024, MT = 9216, TP = 2048, TS = 8;
constexpr int NIN = 11288, NPROJ = 11264, NPROJ_PAD = 11520, DFF = 5632;
constexpr int C_MQ = 0, C_MK = 1024, C_MV = 2048, C_MO = 3072, C_GQ = 4096, C_GK = 4608, C_GV = 5120, C_GR = 6144, C_GA = 7168, C_GB = 9216;
constexpr float EPS = 1e-6f;
constexpr int NCH = 16;
constexpr int LDS_BYTES = 147456;

constexpr size_t O_YP = 0, O_YS = 16777216, O_PC = 18874368, O_PN = 19922944, O_PM = 19927040, O_PS = 19927056, O_PCONV = 20451344,
                 O_SC = 20496400, O_SN = 54050832, O_SM = 54181904, O_SS = 54182416, O_SCONV = 70959632;

constexpr size_t MiB = 1u << 20;
constexpr size_t WS_GATES = 64 * 1024;
constexpr size_t WS_PART = WS_GATES + (size_t)MT * 32 * 4;
constexpr size_t WS_DN = WS_PART + (size_t)MT * 32 * 4;
constexpr size_t WS_NPREV = WS_DN + 256 * 256 * 4;
constexpr size_t WS_CHS = WS_NPREV + 256 * 256 * 2;
constexpr size_t WS_BEND = WS_CHS + 256 * 2 * 4;
constexpr size_t WS_RSTD = WS_BEND + 256 * 128 * 4;
static_assert(WS_RSTD + MT * 4 <= 4 * MiB, "small region");
constexpr size_t WS_WIN = 4 * MiB;
constexpr size_t WS_WA = WS_WIN + (size_t)NPROJ_PAD * DM * 2;
constexpr size_t WS_WB = WS_WA + (size_t)2048 * 1024 * 2;
constexpr size_t WS_WO = WS_WB + (size_t)2048 * 1024 * 2;
constexpr size_t WS_WUG = WS_WO + (size_t)2048 * 2048 * 2;
constexpr size_t WS_WD = WS_WUG + (size_t)2 * DFF * DM * 2;
constexpr size_t WS_R1 = WS_WD + (size_t)DM * DFF * 2;
static_assert(WS_R1 == 131 * MiB, "map");
constexpr size_t WS_XN = WS_R1;
constexpr size_t WS_X1W = WS_R1 + 36 * MiB;
constexpr size_t WS_X1 = WS_R1 + 72 * MiB;
constexpr size_t WS_DC = WS_R1;
constexpr size_t WS_DS = WS_R1 + 64 * MiB;
constexpr size_t WS_CT = WS_R1 + 96 * MiB;
constexpr size_t WS_ST = WS_R1 + 128 * MiB;
constexpr size_t WS_YM = WS_R1 + 144 * MiB;
constexpr size_t WS_YG = WS_YM + 18 * MiB;
constexpr size_t WS_PROJ = WS_YG + 18 * MiB;
constexpr size_t WS_U = WS_PROJ, WS_G = WS_PROJ + 99 * MiB;
constexpr size_t WS_END = WS_PROJ + 198 * MiB;
static_assert(WS_END == 509 * MiB, "map");

struct Args {
    const float* in[25]; float* out; unsigned char* ws; int ph_lo, ph_hi;
};
enum { I_XP = 0, I_XS, I_C, I_N, I_M, I_S, I_CONV, I_WIN, I_BI, I_BF, I_AUP, I_AB, I_MHW, I_GHW, I_WA, I_WB, I_WO, I_NMIX, I_NFFN, I_WUP, I_WGATE, I_CW, I_CB, I_WDOWN, I_FNW };

__device__ __forceinline__ float bf2f(unsigned short b) { return __builtin_bit_cast(float, (unsigned)b << 16); }
__device__ __forceinline__ float bflo(unsigned w) { return __builtin_bit_cast(float, w << 16); }
__device__ __forceinline__ float bfhi(unsigned w) { return __builtin_bit_cast(float, w & 0xffff0000u); }
__device__ __forceinline__ unsigned short f2bf(float f) { return (unsigned short)(cvt_pk_bf16(f, 0.f) & 0xffffu); }
__device__ __forceinline__ float logsig(float z) { return fminf(z, 0.f) - log1pf(__expf(-fabsf(z))); }
__device__ __forceinline__ float sigm(float z) { return 1.f / (1.f + __expf(-z)); }
__device__ __forceinline__ float wave_sum(float v) {
#pragma unroll
    for (int o = 1; o < 64; o <<= 1) v += __shfl_xor(v, o);
    return v;
}
__device__ __forceinline__ float wave_max(float v) {
#pragma unroll
    for (int o = 1; o < 64; o <<= 1) v = fmaxf(v, __shfl_xor(v, o));
    return v;
}
__device__ __forceinline__ float sum4(f32x4 v) { return (v.x + v.y) + (v.z + v.w); }
__device__ __forceinline__ float dot4(f32x4 a, f32x4 b) { return (a.x * b.x + a.y * b.y) + (a.z * b.z + a.w * b.w); }
__device__ __forceinline__ float gelu_tanh(float v) { const float u = 0.7978845608028654f * (v + 0.044715f * v * v * v); return v * sigm(2.f * u); }

typedef f32x4 AccT[2][2][4][2];
struct EpiProj {
    static constexpr bool PERM = true;
    bf16* P; float* gates;
    __device__ __forceinline__ void operator()(AccT& acc, const pg8::Unit& u, int wr, int wc, int fr, int fq) const {
        const int row0 = u.pm * 256 + wr * 64 + fr;
        if (u.pn < 44) {
            const int col0 = u.pn * 256 + wc * 32 + 8 * fq;
#pragma unroll
            for (int ai = 0; ai < 2; ++ai)
#pragma unroll
                for (int m = 0; m < 4; ++m) { bf16* rowp = P + (size_t)(row0 + ai * 128 + m * 16) * NPROJ + col0;
#pragma unroll
                    for (int bj = 0; bj < 2; ++bj) { const f32x4 v0 = acc[ai][bj][m][0], v1 = acc[ai][bj][m][1]; u32x4 w;
                        w.x = cvt_pk_bf16(v0[0], v0[1]); w.y = cvt_pk_bf16(v0[2], v0[3]); w.z = cvt_pk_bf16(v1[0], v1[1]); w.w = cvt_pk_bf16(v1[2], v1[3]);
                        *(u32x4*)(rowp + bj * 128) = w; } }
        } else if (wc == 0) {
#pragma unroll
            for (int ai = 0; ai < 2; ++ai)
#pragma unroll
                for (int m = 0; m < 4; ++m) { float* rowp = gates + (size_t)(row0 + ai * 128 + m * 16) * 32 + 8 * fq;
                    *(f32x4*)rowp = acc[ai][0][m][0]; *(f32x4*)(rowp + 4) = acc[ai][0][m][1]; }
        }
    }
};
struct EpiBranch {
    static constexpr bool PERM = true;
    const bf16* P; bf16* O;
    __device__ __forceinline__ void operator()(AccT& acc, const pg8::Unit& u, int wr, int wc, int fr, int fq) const {
        const int row0 = u.pm * 256 + wr * 64 + fr, col0 = u.pn * 256 + wc * 32 + 8 * fq;
#pragma unroll
        for (int ai = 0; ai < 2; ++ai)
#pragma unroll
            for (int m = 0; m < 4; ++m) { const int row = row0 + ai * 128 + m * 16;
#pragma unroll
                for (int bj = 0; bj < 2; ++bj) { const int col = col0 + bj * 128;
                    const u32x4 ga = *(const u32x4*)(P + (size_t)row * NPROJ + C_GA + col), gb = *(const u32x4*)(P + (size_t)row * NPROJ + C_GB + col);
                    float fa[8] = {bflo(ga.x), bfhi(ga.x), bflo(ga.y), bfhi(ga.y), bflo(ga.z), bfhi(ga.z), bflo(ga.w), bfhi(ga.w)};
                    float fb[8] = {bflo(gb.x), bfhi(gb.x), bflo(gb.y), bfhi(gb.y), bflo(gb.z), bfhi(gb.z), bflo(gb.w), bfhi(gb.w)};
                    if (u.seg == 0) {
#pragma unroll
                        for (int i = 0; i < 8; ++i) { const float r = (1.f + __expf(-fb[i])) / (1.f + __expf(-fa[i])); acc[ai][bj][m][i >> 2][i & 3] *= r; }
                    } else {
                        float o[8];
#pragma unroll
                        for (int i = 0; i < 8; ++i) o[i] = acc[ai][bj][m][i >> 2][i & 3] * sigm(fb[i]);
                        u32x4 w; w.x = cvt_pk_bf16(o[0], o[1]); w.y = cvt_pk_bf16(o[2], o[3]); w.z = cvt_pk_bf16(o[4], o[5]); w.w = cvt_pk_bf16(o[6], o[7]);
                        *(u32x4*)(O + (size_t)row * DM + col) = w;
                    } } }
    }
};
struct EpiOut {
    static constexpr bool PERM = true;
    const float* xp; const float* xs; float* X1; bf16* X1W; const float* nw; float* part;
    __device__ __forceinline__ void operator()(AccT& acc, const pg8::Unit& u, int wr, int wc, int fr, int fq) const {
        const int row0 = u.pm * 256 + wr * 64 + fr, col0 = u.pn * 256 + wc * 32 + 8 * fq;
#pragma unroll
        for (int ai = 0; ai < 2; ++ai)
#pragma unroll
            for (int m = 0; m < 4; ++m) { const int row = row0 + ai * 128 + m * 16;
                const float* xrow = row < MP ? xp + (size_t)row * DM : xs + (size_t)(row - MP) * DM;
                float ss = 0.f;
#pragma unroll
                for (int bj = 0; bj < 2; ++bj) { const int col = col0 + bj * 128;
                    const f32x4 v0 = acc[ai][bj][m][0] + *(const f32x4*)(xrow + col), v1 = acc[ai][bj][m][1] + *(const f32x4*)(xrow + col + 4);
                    *(f32x4*)(X1 + (size_t)row * DM + col) = v0; *(f32x4*)(X1 + (size_t)row * DM + col + 4) = v1;
                    ss += dot4(v0, v0) + dot4(v1, v1);
                    const f32x4 w0 = *(const f32x4*)(nw + col), w1 = *(const f32x4*)(nw + col + 4);
                    u32x4 w; w.x = cvt_pk_bf16(v0[0] * w0[0], v0[1] * w0[1]); w.y = cvt_pk_bf16(v0[2] * w0[2], v0[3] * w0[3]);
                    w.z = cvt_pk_bf16(v1[0] * w1[0], v1[1] * w1[1]); w.w = cvt_pk_bf16(v1[2] * w1[2], v1[3] * w1[3]);
                    *(u32x4*)(X1W + (size_t)row * DM + col) = w; }
                ss += __shfl_xor(ss, 16); ss += __shfl_xor(ss, 32);
                if (fq == 0) part[(size_t)row * 32 + u.pn * 4 + wc] = ss; }
    }
};
#define DPP_MOV(ctrl, oldv, srcv) __builtin_bit_cast(float, __builtin_amdgcn_update_dpp(__builtin_bit_cast(int, (float)(oldv)), __builtin_bit_cast(int, (float)(srcv)), (ctrl), 0xf, 0xf, false))
struct EpiUGAct {
    static constexpr bool PERM = true;
    const float* rstd; bf16* ACT; float* out; const float* cw; const float* cb; const float* cst; float* ub; LAS float* xch;
    __device__ __forceinline__ void operator()(AccT& acc, const pg8::Unit& u, int wr, int wc, int fr, int fq) const {
        const int row0 = u.pm * 256 + wr * 64 + fr, col = u.pn * 128 + wc * 32 + 8 * fq;
        const bool sample = u.pm >= 32;
#pragma unroll
        for (int ai = 0; ai < 2; ++ai)
#pragma unroll
            for (int m = 0; m < 4; ++m) { const int row = row0 + ai * 128 + m * 16;
                const float r = rstd[row];
                acc[ai][0][m][0] = acc[ai][0][m][0] * r; acc[ai][0][m][1] = acc[ai][0][m][1] * r; acc[ai][1][m][0] = acc[ai][1][m][0] * r; acc[ai][1][m][1] = acc[ai][1][m][1] * r;
                float* cs = nullptr;
                if (row < MP) { const int t = row & (TP - 1); if (t >= TP - 2) cs = out + O_PCONV + ((size_t)(row >> 11) * 2 + (t - (TP - 2))) * DFF + col; }
                else { const int rr = row - MP, t = rr & 7; if (t >= 6) cs = out + O_SCONV + ((size_t)(rr >> 3) * 2 + (t - 6)) * DFF + col; }
                if (cs) { *(f32x4*)cs = acc[ai][0][m][0]; *(f32x4*)(cs + 4) = acc[ai][0][m][1]; } }
        if (fr >= 14) {
#pragma unroll
            for (int ai = 0; ai < 2; ++ai) { LAS float* p = xch + ((((ai * 2 + wr) * 4 + wc) * 2 + (fr - 14)) * 4 + fq) * 8; *(LAS f32x4*)p = acc[ai][0][3][0]; *(LAS f32x4*)(p + 4) = acc[ai][0][3][1]; }
            if (!sample && wr == 1) { float* p = ub + ((size_t)u.pm * 6 + (fr - 14)) * DFF + col; *(f32x4*)p = acc[1][0][3][0]; *(f32x4*)(p + 4) = acc[1][0][3][1]; }
        }
        if (!sample && wr == 0 && fr < 2) { float* p = ub + ((size_t)u.pm * 6 + 2 + fr) * DFF + col; *(f32x4*)p = acc[0][0][0][0]; *(f32x4*)(p + 4) = acc[0][0][0][1];
            p += 2 * DFF; *(f32x4*)p = acc[0][1][0][0]; *(f32x4*)(p + 4) = acc[0][1][0][1]; }
        asm volatile("s_waitcnt lgkmcnt(0)" ::: "memory"); __builtin_amdgcn_s_barrier();
        const f32x4 k0a = *(const f32x4*)(cw + col), k0b = *(const f32x4*)(cw + col + 4), k1a = *(const f32x4*)(cw + DFF + col), k1b = *(const f32x4*)(cw + DFF + col + 4);
        const f32x4 k2a = *(const f32x4*)(cw + 2 * DFF + col), k2b = *(const f32x4*)(cw + 2 * DFF + col + 4), cba = *(const f32x4*)(cb + col), cbb = *(const f32x4*)(cb + col + 4);
#pragma unroll
        for (int ai = 0; ai < 2; ++ai) {
            f32x4 pe0 = {0.f, 0.f, 0.f, 0.f}, pe1 = {0.f, 0.f, 0.f, 0.f};
            if (!(ai == 0 && wr == 0) && fr >= 14) { const int sai = (wr == 1) ? ai : ai - 1, swr = wr ^ 1;
                const LAS float* p = xch + ((((sai * 2 + swr) * 4 + wc) * 2 + (fr - 14)) * 4 + fq) * 8; pe0 = *(const LAS f32x4*)p; pe1 = *(const LAS f32x4*)(p + 4); }
#pragma unroll
            for (int m = 0; m < 4; ++m) { const int row = row0 + ai * 128 + m * 16;
                const f32x4 c0 = acc[ai][0][m][0], c1 = acc[ai][0][m][1], v0 = m ? acc[ai][0][m ? m - 1 : 0][0] : pe0, v1 = m ? acc[ai][0][m ? m - 1 : 0][1] : pe1;
                float cur[8] = {c0[0], c0[1], c0[2], c0[3], c1[0], c1[1], c1[2], c1[3]}, prv[8] = {v0[0], v0[1], v0[2], v0[3], v1[0], v1[1], v1[2], v1[3]};
                float p1[8], p2[8];
#pragma unroll
                for (int i = 0; i < 8; ++i) { const float y1 = DPP_MOV(0x121, 0.f, prv[i]); p1[i] = DPP_MOV(0x111, y1, cur[i]); const float y2 = DPP_MOV(0x122, 0.f, prv[i]); p2[i] = DPP_MOV(0x112, y2, cur[i]); }
                if (sample) { const int t = fr & 7;
                    if (t < 2) { const float* st = cst + (size_t)((row - MP) >> 3) * 2 * DFF + col;
                        const f32x4 s1a = *(const f32x4*)(st + DFF), s1b = *(const f32x4*)(st + DFF + 4);
                        if (t == 0) { const f32x4 s0a = *(const f32x4*)st, s0b = *(const f32x4*)(st + 4);
#pragma unroll
                            for (int i = 0; i < 4; ++i) { p1[i] = s1a[i]; p1[4 + i] = s1b[i]; p2[i] = s0a[i]; p2[4 + i] = s0b[i]; } }
                        else {
#pragma unroll
                            for (int i = 0; i < 4; ++i) { p2[i] = s1a[i]; p2[4 + i] = s1b[i]; } } } }
                const f32x4 g0 = acc[ai][1][m][0], g1 = acc[ai][1][m][1];
                float o[8];
#pragma unroll
                for (int i = 0; i < 4; ++i) { o[i] = gelu_tanh(cba[i] + k0a[i] * p2[i] + k1a[i] * p1[i] + k2a[i] * cur[i]) * g0[i];
                    o[4 + i] = gelu_tanh(cbb[i] + k0b[i] * p2[4 + i] + k1b[i] * p1[4 + i] + k2b[i] * cur[4 + i]) * g1[i]; }
                u32x4 w; w.x = cvt_pk_bf16(o[0], o[1]); w.y = cvt_pk_bf16(o[2], o[3]); w.z = cvt_pk_bf16(o[4], o[5]); w.w = cvt_pk_bf16(o[6], o[7]);
                *(u32x4*)(ACT + (size_t)row * DFF + col) = w; }
        }
    }
};
struct EpiDown {
    static constexpr bool PERM = true;
    const float* X1; float* out; float* part;
    __device__ __forceinline__ void operator()(AccT& acc, const pg8::Unit& u, int wr, int wc, int fr, int fq) const {
        const int row0 = u.pm * 256 + wr * 64 + fr, col0 = u.pn * 256 + wc * 32 + 8 * fq;
#pragma unroll
        for (int ai = 0; ai < 2; ++ai)
#pragma unroll
            for (int m = 0; m < 4; ++m) { const int row = row0 + ai * 128 + m * 16; float ss = 0.f;
#pragma unroll
                for (int bj = 0; bj < 2; ++bj) { const int col = col0 + bj * 128;
                    const f32x4 v0 = acc[ai][bj][m][0] + *(const f32x4*)(X1 + (size_t)row * DM + col), v1 = acc[ai][bj][m][1] + *(const f32x4*)(X1 + (size_t)row * DM + col + 4);
                    *(f32x4*)(out + (size_t)row * DM + col) = v0; *(f32x4*)(out + (size_t)row * DM + col + 4) = v1;
                    ss += dot4(v0, v0) + dot4(v1, v1); }
                ss += __shfl_xor(ss, 16); ss += __shfl_xor(ss, 32);
                if (fq == 0) part[(size_t)row * 32 + u.pn * 4 + wc] = ss; }
    }
};

template <class ColPtr>
__device__ __forceinline__ void transpose_item(const ColPtr& cp, int K, int srcN, bf16* WT, LAS float* scr, int kb, int nb, int lane) {
    const int k0 = 64 * kb, n0 = 64 * nb, kr = lane >> 4, n4 = (lane & 15) * 4;
    const float* src = cp(n0 + n4);
    f32x4 v[16];
#pragma unroll
    for (int i = 0; i < 16; ++i) v[i] = src ? *(const f32x4*)(src + (size_t)(k0 + 4 * i + kr) * srcN) : (f32x4){0.f, 0.f, 0.f, 0.f};
#pragma unroll
    for (int i = 0; i < 16; ++i) { LAS float* d = scr + (4 * i + kr) * 65 + n4; d[0] = v[i][0]; d[1] = v[i][1]; d[2] = v[i][2]; d[3] = v[i][3]; }
    asm volatile("s_waitcnt lgkmcnt(0)" ::: "memory");
    const int c = lane & 7;
#pragma unroll
    for (int j = 0; j < 8; ++j) { const int n = (lane >> 3) + 8 * j; const LAS float* s = scr + (8 * c) * 65 + n;
        u32x4 o; o.x = cvt_pk_bf16(s[0 * 65], s[1 * 65]); o.y = cvt_pk_bf16(s[2 * 65], s[3 * 65]); o.z = cvt_pk_bf16(s[4 * 65], s[5 * 65]); o.w = cvt_pk_bf16(s[6 * 65], s[7 * 65]);
        *(u32x4*)(WT + (size_t)(n0 + n) * K + k0 + 8 * c) = o; }
    asm volatile("s_waitcnt lgkmcnt(0)" ::: "memory");
}
struct ColWin { const float* W; __device__ __forceinline__ const float* operator()(int n) const {
    int c; if (n < 4096) c = n; else if (n < 7168) c = n + 8; else if (n < 11264) c = n + 24; else if (n < 11272) c = 4096 + (n - 11264); else if (n < 11288) c = 7176 + (n - 11272); else return nullptr;
    return W + c; } };
struct ColPlain { const float* W; __device__ __forceinline__ const float* operator()(int n) const { return W + n; } };
struct ColUG { const float* Wu; const float* Wg; __device__ __forceinline__ const float* operator()(int n) const { const int pn = n >> 8, w = n & 255; return w < 128 ? Wu + pn * 128 + w : Wg + pn * 128 + (w - 128); } };

__device__ __forceinline__ void p0_prologue(const Args& a, LAS unsigned char* lds, int vcu, int G) {
    int tid_ = threadIdx.x; asm volatile("" : "+v"(tid_));
    const int tid = tid_, lane = tid & 63, wave = __builtin_amdgcn_readfirstlane(tid >> 6);
    LAS float* scr = (LAS float*)(lds + wave * 16640);
    const int gw = vcu * NWAVES + wave, NGW = G * NWAVES;
    unsigned char* ws = a.ws;
    constexpr int I_WIN_ = 32 * (NPROJ_PAD / 64), I_A = 16 * 32, I_O = 32 * 32, I_UG = 32 * (2 * DFF / 64), I_D = (DFF / 64) * 32;
    constexpr int NITEMS = I_WIN_ + 2 * I_A + I_O + I_UG + I_D;
    for (int it = gw; it < NITEMS; it += NGW) {
        int r = it;
        if (r < I_WIN_) { ColWin cp{a.in[I_WIN]}; const int nblk = NPROJ_PAD / 64; transpose_item(cp, DM, NIN, (bf16*)(ws + WS_WIN), scr, r / nblk, r % nblk, lane); continue; } r -= I_WIN_;
        if (r < I_A) { ColPlain cp{a.in[I_WA]}; transpose_item(cp, 1024, DM, (bf16*)(ws + WS_WA), scr, r / 32, r % 32, lane); continue; } r -= I_A;
        if (r < I_A) { ColPlain cp{a.in[I_WB]}; transpose_item(cp, 1024, DM, (bf16*)(ws + WS_WB), scr, r / 32, r % 32, lane); continue; } r -= I_A;
        if (r < I_O) { ColPlain cp{a.in[I_WO]}; transpose_item(cp, DM, DM, (bf16*)(ws + WS_WO), scr, r / 32, r % 32, lane); continue; } r -= I_O;
        if (r < I_UG) { ColUG cp{a.in[I_WUP], a.in[I_WGATE]}; const int nblk = 2 * DFF / 64; transpose_item(cp, DM, DFF, (bf16*)(ws + WS_WUG), scr, r / nblk, r % nblk, lane); continue; } r -= I_UG;
        { ColPlain cp{a.in[I_WDOWN]}; transpose_item(cp, DFF, DM, (bf16*)(ws + WS_WD), scr, r / 32, r % 32, lane); }
    }
    const float* nw = a.in[I_NMIX]; bf16* XN = (bf16*)(ws + WS_XN);
    for (int m = gw; m < MT; m += NGW) {
        const float* xrow = m < MP ? a.in[I_XP] + (size_t)m * DM : a.in[I_XS] + (size_t)(m - MP) * DM;
        f32x4 v[8]; float s = 0.f;
#pragma unroll
        for (int j = 0; j < 8; ++j) { v[j] = *(const f32x4*)(xrow + 4 * lane + 256 * j); s += dot4(v[j], v[j]); }
        const float r = rsqrtf(wave_sum(s) * (1.f / DM) + EPS);
#pragma unroll
        for (int j = 0; j < 8; ++j) { const f32x4 w = *(const f32x4*)(nw + 4 * lane + 256 * j); u32x2 o; o.x = cvt_pk_bf16(v[j][0] * r * w[0], v[j][1] * r * w[1]); o.y = cvt_pk_bf16(v[j][2] * r * w[2], v[j][3] * r * w[3]);
            *(u32x2*)(XN + (size_t)m * DM + 4 * lane + 256 * j) = o; }
    }
}

__device__ __forceinline__ void stage_v(LAS bf16* Vs, const bf16* P, int row0, int colbase, int tid) {
#pragma unroll
    for (int i = 0; i < 8; ++i) { const int idx = tid + NTHR * i, s = idx >> 5, p = idx & 31;
        *(LAS u32x4*)(Vs + s * 272 + p * 8) = *(const u32x4*)(P + (size_t)(row0 + s) * NPROJ + colbase + 8 * p); }
}
typedef short v4i16_t __attribute__((ext_vector_type(4)));
__device__ __forceinline__ u32x2 tr64(const LAS bf16* p) { return __builtin_bit_cast(u32x2, __builtin_amdgcn_ds_read_tr16_b64_v4i16((LAS v4i16_t*)p)); }
__device__ __forceinline__ bf16x8 tr_frag(const LAS bf16* img, int RS, int c0, int ks, int lane) {
    const int g = lane >> 4, q = (lane & 15) >> 2, p = lane & 3;
    const LAS bf16* a = img + (32 * ks + 4 * g + q) * RS + c0 + 4 * p;
    const u32x2 lo = tr64(a), hi = tr64(a + 16 * RS);
    u32x4 w; w.x = lo.x; w.y = lo.y; w.z = hi.x; w.w = hi.y;
    return __builtin_bit_cast(bf16x8, w);
}
__device__ __forceinline__ float wave_iscan_add(float v, int lane) {
#pragma unroll
    for (int o = 1; o < 64; o <<= 1) { const float t = __shfl_up(v, o); if (lane >= o) v += t; }
    return v;
}
__device__ __forceinline__ float wave_iscan_max(float v, int lane) {
#pragma unroll
    for (int o = 1; o < 64; o <<= 1) { const float t = __shfl_up(v, o); if (lane >= o) v = fmaxf(v, t); }
    return v;
}

__device__ __forceinline__ void gla_logdecay(const Args& a, const float* gates, int row0, int h, LAS float* galS, LAS float* segS, int tid, float (&la)[32], float& off, float& tot) {
    const int d = tid & 127, seg = tid >> 7;
    { const int t = tid >> 2, q = tid & 3; *(LAS f32x4*)(galS + t * 16 + q * 4) = *(const f32x4*)(gates + (size_t)(row0 + t) * 32 + 8 + q * 4); }
    float up[16];
#pragma unroll
    for (int j = 0; j < 16; ++j) up[j] = a.in[I_AUP][j * 512 + h * 128 + d];
    const float ab = a.in[I_AB][h * 128 + d];
    __syncthreads();
    float ssum = 0.f;
#pragma unroll
    for (int i = 0; i < 32; ++i) { const int t = seg * 32 + i; float z = ab;
#pragma unroll
        for (int q = 0; q < 4; ++q) { const f32x4 g = *(const LAS f32x4*)(galS + t * 16 + q * 4); z += g[0] * up[4 * q] + g[1] * up[4 * q + 1] + g[2] * up[4 * q + 2] + g[3] * up[4 * q + 3]; }
        la[i] = logsig(z) * (1.f / 16.f); ssum += la[i]; }
    segS[seg * 128 + d] = ssum;
    __syncthreads();
    off = 0.f; tot = 0.f;
#pragma unroll
    for (int s = 0; s < 4; ++s) { const float v = segS[s * 128 + d]; tot += v; off += (s < seg) ? v : 0.f; }
}

template <bool ML>
__device__ __forceinline__ void chunk_state(const Args& a, LAS unsigned char* lds, int bh, int c) {
    constexpr int DK = ML ? 256 : 128, NDT = DK / 16, RSK = DK + 16;
    int tid_ = threadIdx.x; asm volatile("" : "+v"(tid_));
    const int tid = tid_, lane = tid & 63, wave = __builtin_amdgcn_readfirstlane(tid >> 6), fr = lane & 15, fq = lane >> 4;
    const int b = bh >> 2, h = bh & 3, row0 = b * TP + c * 128, item = bh * NCH + c;
    unsigned char* ws = a.ws;
    const bf16* P = (const bf16*)(ws + WS_PROJ); const float* gates = (const float*)(ws + WS_GATES);
    LAS bf16* Ks = (LAS bf16*)lds; LAS bf16* Vs = (LAS bf16*)(lds + 69632); LAS float* sc = (LAS float*)(lds + 139264);
    __syncthreads();
    stage_v(Vs, P, row0, (ML ? C_MV : C_GV) + h * 256, tid);
    if (ML) {
        if (wave == 0) {
            const int t0 = 2 * lane;
            const float lf0 = logsig(gates[(size_t)(row0 + t0) * 32 + 4 + h] + a.in[I_BF][h]), lf1 = logsig(gates[(size_t)(row0 + t0 + 1) * 32 + 4 + h] + a.in[I_BF][h]);
            const float i0 = gates[(size_t)(row0 + t0) * 32 + h] + a.in[I_BI][h], i1 = gates[(size_t)(row0 + t0 + 1) * 32 + h] + a.in[I_BI][h];
            const float pr = lf0 + lf1, S = wave_iscan_add(pr, lane), ex = S - pr;
            const float ah0 = i0 - (ex + lf0), ah1 = i1 - S;
            const float Ah = wave_max(fmaxf(ah0, ah1));
            sc[t0] = __expf(ah0 - Ah) * (1.f / 16.f); sc[t0 + 1] = __expf(ah1 - Ah) * (1.f / 16.f);
            if (lane == 63) { float* chs = (float*)(ws + WS_CHS); chs[item * 2] = Ah; chs[item * 2 + 1] = S; }
        }
        __syncthreads();
#pragma unroll
        for (int i = 0; i < 8; ++i) { const int idx = tid + NTHR * i, s = idx >> 5, dp = idx & 31; const float w = sc[s];
            const u32x4 v = *(const u32x4*)(P + (size_t)(row0 + s) * NPROJ + C_MK + h * 256 + 8 * dp);
            u32x4 o; o.x = cvt_pk_bf16(bflo(v.x) * w, bfhi(v.x) * w); o.y = cvt_pk_bf16(bflo(v.y) * w, bfhi(v.y) * w); o.z = cvt_pk_bf16(bflo(v.z) * w, bfhi(v.z) * w); o.w = cvt_pk_bf16(bflo(v.w) * w, bfhi(v.w) * w);
            *(LAS u32x4*)(Ks + s * RSK + 8 * dp) = o; }
    } else {
        float la[32], off, tot;
        LAS float* galS = (LAS float*)(lds + 36864); gla_logdecay(a, gates, row0, h, galS, galS + 2048, tid, la, off, tot);
        const int d = tid & 127, seg = tid >> 7;
        if (seg == 0) ((float*)(ws + WS_BEND))[item * 128 + d] = tot;
        float bcur = off;
#pragma unroll
        for (int i = 0; i < 32; ++i) { const int t = seg * 32 + i; bcur += la[i];
            const float kv = bf2f(P[(size_t)(row0 + t) * NPROJ + C_GK + h * 128 + d]);
            Ks[t * RSK + d] = f2bf(kv * __expf(tot - bcur)); }
    }
    __syncthreads();
    f32x4 acc[2][NDT];
#pragma unroll
    for (int e = 0; e < 2; ++e)
#pragma unroll
        for (int d = 0; d < NDT; ++d) acc[e][d] = (f32x4){0.f, 0.f, 0.f, 0.f};
#pragma unroll
    for (int ks = 0; ks < 4; ++ks) {
        bf16x8 vb[2];
#pragma unroll
        for (int e = 0; e < 2; ++e) vb[e] = tr_frag(Vs, 272, wave * 32 + e * 16, ks, lane);
#pragma unroll
        for (int d = 0; d < NDT; ++d) { const bf16x8 ka = tr_frag(Ks, RSK, d * 16, ks, lane);
#pragma unroll
            for (int e = 0; e < 2; ++e) acc[e][d] = __builtin_amdgcn_mfma_f32_16x16x32_bf16(ka, vb[e], acc[e][d], 0, 0, 0); }
    }
    float* dst = (float*)(ws + (ML ? WS_DC : WS_DS)) + (size_t)item * 256 * DK;
#pragma unroll
    for (int e = 0; e < 2; ++e)
#pragma unroll
        for (int d = 0; d < NDT; ++d) *(f32x4*)(dst + (size_t)(wave * 32 + e * 16 + fr) * DK + d * 16 + 4 * fq) = acc[e][d];
    if (ML && tid < 256) { float s = 0.f;
#pragma unroll 16
        for (int i = 0; i < 128; ++i) s += bf2f(Ks[i * RSK + tid]);
        ((float*)(ws + WS_DN))[item * 256 + tid] = s; }
}

__device__ __forceinline__ void scan_mlstm(const Args& a, int j) {
    int tid_ = threadIdx.x; asm volatile("" : "+v"(tid_));
    const int tid = tid_, bh = j >> 5, eb = j & 31;
    unsigned char* ws = a.ws;
    const float* chs = (const float*)(ws + WS_CHS);
    const int e = eb * 8 + (tid >> 6), d4 = (tid & 63) * 4;
    const float* dC = (const float*)(ws + WS_DC) + (size_t)bh * NCH * 65536 + (size_t)e * 256 + d4;
    bf16* CT = (bf16*)(ws + WS_CT) + (size_t)bh * NCH * 65536 + (size_t)e * 256 + d4;
    f32x4 Cv = {0.f, 0.f, 0.f, 0.f}; float Fs = 0.f, Mp = 0.f;
    const bool do_n = (eb == 0 && tid < 256);
    float nv = 0.f;
    f32x4 dv[NCH];
#pragma unroll
    for (int c = 0; c < NCH; ++c) dv[c] = *(const f32x4*)(dC + (size_t)c * 65536);
#pragma unroll
    for (int c = 0; c < NCH; ++c) {
        u32x2 o; o.x = cvt_pk_bf16(Cv[0], Cv[1]); o.y = cvt_pk_bf16(Cv[2], Cv[3]); *(u32x2*)(CT + (size_t)c * 65536) = o;
        if (do_n) ((bf16*)(ws + WS_NPREV))[(bh * NCH + c) * 256 + tid] = f2bf(nv);
        const float Ah = chs[(bh * NCH + c) * 2], bt = chs[(bh * NCH + c) * 2 + 1];
        const float Ac = Ah - Fs, Mn = fmaxf(Mp, Ac), f1 = __expf(Mp - Mn), f2 = __expf(Ac - Mn);
        Cv = Cv * f1 + dv[c] * f2;
        if (do_n) nv = nv * f1 + ((const float*)(ws + WS_DN))[(bh * NCH + c) * 256 + tid] * f2;
        Mp = Mn; Fs += bt;
    }
    float* oC = a.out + O_PC + (size_t)bh * 65536;
#pragma unroll
    for (int i = 0; i < 4; ++i) oC[(size_t)(d4 + i) * 256 + e] = Cv[i];
    if (do_n) a.out[O_PN + bh * 256 + tid] = nv;
    if (eb == 0 && tid == 0) a.out[O_PM + bh] = Fs + Mp;
}
__device__ __forceinline__ void scan_gla(const Args& a, int j) {
    int tid_ = threadIdx.x; asm volatile("" : "+v"(tid_));
    const int tid = tid_, bh = j >> 4, eb = j & 15;
    unsigned char* ws = a.ws;
    const float* bend = (const float*)(ws + WS_BEND);
    const int ee = eb * 16 + (tid >> 5), d4 = (tid & 31) * 4;
    const float* dS = (const float*)(ws + WS_DS) + (size_t)bh * NCH * 32768 + (size_t)ee * 128 + d4;
    bf16* ST = (bf16*)(ws + WS_ST) + (size_t)bh * NCH * 32768 + (size_t)ee * 128 + d4;
    f32x4 Sv = {0.f, 0.f, 0.f, 0.f};
    f32x4 dv[NCH];
#pragma unroll
    for (int c = 0; c < NCH; ++c) dv[c] = *(const f32x4*)(dS + (size_t)c * 32768);
#pragma unroll
    for (int c = 0; c < NCH; ++c) {
        u32x2 o; o.x = cvt_pk_bf16(Sv[0], Sv[1]); o.y = cvt_pk_bf16(Sv[2], Sv[3]); *(u32x2*)(ST + (size_t)c * 32768) = o;
        const f32x4 be = *(const f32x4*)(bend + (bh * NCH + c) * 128 + d4);
        Sv[0] = Sv[0] * __expf(be[0]) + dv[c][0]; Sv[1] = Sv[1] * __expf(be[1]) + dv[c][1]; Sv[2] = Sv[2] * __expf(be[2]) + dv[c][2]; Sv[3] = Sv[3] * __expf(be[3]) + dv[c][3];
    }
    float* oS = a.out + O_PS + (size_t)bh * 32768;
#pragma unroll
    for (int i = 0; i < 4; ++i) oS[(size_t)(d4 + i) * 256 + ee] = Sv[i];
}

template <bool ML>
__device__ __forceinline__ void chunk_out(const Args& a, LAS unsigned char* lds, int bh, int c) {
    constexpr int DK = ML ? 256 : 128, QS = DK + 8, NKK = DK / 32;
    int tid_ = threadIdx.x; asm volatile("" : "+v"(tid_));
    const int tid = tid_, lane = tid & 63, wave = __builtin_amdgcn_readfirstlane(tid >> 6), fr = lane & 15, fq = lane >> 4;
    const int b = bh >> 2, h = bh & 3, row0 = b * TP + c * 128, item = bh * NCH + c;
    unsigned char* ws = a.ws;
    const bf16* P = (const bf16*)(ws + WS_PROJ); const float* gates = (const float*)(ws + WS_GATES);
    LAS bf16* Qs = (LAS bf16*)lds; LAS bf16* Ks = Qs + 128 * QS;
    LAS float* sc = (LAS float*)(lds + 143616);
    __syncthreads();
    if (ML) {
        if (wave == 0) {
            const float* chs = (const float*)(ws + WS_CHS);
            const float Ahc = lane < NCH ? chs[(bh * NCH + lane) * 2] : 0.f, btc = lane < NCH ? chs[(bh * NCH + lane) * 2 + 1] : 0.f;
            const float fsx = wave_iscan_add(btc, lane) - btc;
            const float Mp = fmaxf(0.f, wave_max(lane < c ? Ahc - fsx : -3.0e38f)), Fs = wave_sum(lane < c ? btc : 0.f);
            const int t0 = 2 * lane;
            const float lf0 = logsig(gates[(size_t)(row0 + t0) * 32 + 4 + h] + a.in[I_BF][h]), lf1 = logsig(gates[(size_t)(row0 + t0 + 1) * 32 + 4 + h] + a.in[I_BF][h]);
            const float i0 = gates[(size_t)(row0 + t0) * 32 + h] + a.in[I_BI][h], i1 = gates[(size_t)(row0 + t0 + 1) * 32 + h] + a.in[I_BI][h];
            const float pr = lf0 + lf1, S = wave_iscan_add(pr, lane), b0 = S - lf1, b1 = S;
            const float a0 = i0 - b0 - Fs, a1 = i1 - b1 - Fs;
            const float cm = wave_iscan_max(fmaxf(a0, a1), lane); float exm = __shfl_up(cm, 1); if (lane == 0) exm = -3.0e38f;
            const float M0 = fmaxf(fmaxf(Mp, exm), a0), M1 = fmaxf(M0, a1);
            sc[t0] = a0; sc[t0 + 1] = a1; sc[128 + t0] = M0; sc[128 + t0 + 1] = M1; sc[256 + t0] = __expf(Mp - M0); sc[256 + t0 + 1] = __expf(Mp - M1);
            sc[384 + t0] = __expf(-(Fs + b0 + M0)); sc[384 + t0 + 1] = __expf(-(Fs + b1 + M1));
        }
#pragma unroll
        for (int i = 0; i < 8; ++i) { const int idx = tid + NTHR * i, t = idx >> 5, p = idx & 31;
            *(LAS u32x4*)(Qs + t * QS + p * 8) = *(const u32x4*)(P + (size_t)(row0 + t) * NPROJ + C_MQ + h * 256 + p * 8);
            *(LAS u32x4*)(Ks + t * QS + p * 8) = *(const u32x4*)(P + (size_t)(row0 + t) * NPROJ + C_MK + h * 256 + p * 8); }
    } else {
        float la[32], off, tot;
        LAS float* galS = (LAS float*)(lds + 69632); LAS float* segS = galS + 128 * 16;
        gla_logdecay(a, gates, row0, h, galS, segS, tid, la, off, tot);
        const int d = tid & 127, seg = tid >> 7;
        float bcur = off;
#pragma unroll
        for (int i = 0; i < 32; ++i) { const int t = seg * 32 + i; bcur += la[i];
            const float qv = bf2f(P[(size_t)(row0 + t) * NPROJ + C_GQ + h * 128 + d]), kv = bf2f(P[(size_t)(row0 + t) * NPROJ + C_GK + h * 128 + d]);
            Qs[t * QS + d] = f2bf(qv * 0.08838834764831845f * __expf(bcur)); Ks[t * QS + d] = f2bf(kv * __expf(-bcur)); }
    }
    __syncthreads();
    bf16x8 qf[NKK];
#pragma unroll
    for (int kk = 0; kk < NKK; ++kk) qf[kk] = *(const LAS bf16x8*)(Qs + (wave * 16 + fr) * QS + kk * 32 + fq * 8);
    const int t = wave * 16 + fr;
    u32x2 pb[8]; float den = 0.f;
    {
        const float Mt = ML ? sc[128 + t] : 0.f;
#pragma unroll
        for (int st = 0; st < 8; ++st) { f32x4 s = {0.f, 0.f, 0.f, 0.f};
#pragma unroll
            for (int kk = 0; kk < NKK; ++kk) { const bf16x8 kf = *(const LAS bf16x8*)(Ks + (st * 16 + fr) * QS + kk * 32 + fq * 8); s = __builtin_amdgcn_mfma_f32_16x16x32_bf16(kf, qf[kk], s, 0, 0, 0); }
            float p[4];
            f32x4 as4 = {0.f, 0.f, 0.f, 0.f}; if (ML) as4 = *(const LAS f32x4*)(sc + st * 16 + 4 * fq);
#pragma unroll
            for (int r = 0; r < 4; ++r) { const int si = st * 16 + 4 * fq + r;
                const float e = ML ? s[r] * (1.f / 16.f) * __expf(fminf(as4[r] - Mt, 0.f)) : s[r];
                p[r] = (si <= t) ? e : 0.f;
                den += p[r]; }
            pb[st].x = cvt_pk_bf16(p[0], p[1]); pb[st].y = cvt_pk_bf16(p[2], p[3]);
            __builtin_amdgcn_sched_barrier(0); }
    }
    __syncthreads();
    LAS bf16* Cl = (LAS bf16*)lds;
    if (ML) {
        const bf16* CT = (const bf16*)(ws + WS_CT) + (size_t)item * 65536;
#pragma unroll
        for (int i = 0; i < 16; ++i) { const int idx = tid + NTHR * i, e = idx >> 5, p = idx & 31; *(LAS u32x4*)(Cl + e * QS + p * 8) = *(const u32x4*)(CT + (size_t)e * 256 + p * 8); }
        { const int e = tid >> 5, p = tid & 31; u32x4 v = {0u, 0u, 0u, 0u};
          if (e == 0) v = *(const u32x4*)((const bf16*)(ws + WS_NPREV) + (size_t)item * 256 + p * 8);
          *(LAS u32x4*)(Cl + (256 + e) * QS + p * 8) = v; }
    } else {
        const bf16* ST = (const bf16*)(ws + WS_ST) + (size_t)item * 32768;
#pragma unroll
        for (int i = 0; i < 8; ++i) { const int idx = tid + NTHR * i, e = idx >> 4, p = idx & 15; *(LAS u32x4*)(Cl + e * QS + p * 8) = *(const u32x4*)(ST + (size_t)e * 128 + p * 8); }
    }
    __syncthreads();
    f32x4 acc[16];
#pragma unroll
    for (int et = 0; et < 16; ++et) { acc[et] = (f32x4){0.f, 0.f, 0.f, 0.f};
#pragma unroll
        for (int kk = 0; kk < NKK; ++kk) { const bf16x8 cf = *(const LAS bf16x8*)(Cl + (et * 16 + fr) * QS + kk * 32 + fq * 8); acc[et] = __builtin_amdgcn_mfma_f32_16x16x32_bf16(cf, qf[kk], acc[et], 0, 0, 0); }
        if ((et & 1) == 1) __builtin_amdgcn_sched_barrier(0); }
    float wint = 1.f, qn = 0.f;
    if (ML) {
        f32x4 dn = {0.f, 0.f, 0.f, 0.f};
#pragma unroll
        for (int kk = 0; kk < NKK; ++kk) { const bf16x8 nf = *(const LAS bf16x8*)(Cl + (256 + fr) * QS + kk * 32 + fq * 8); dn = __builtin_amdgcn_mfma_f32_16x16x32_bf16(nf, qf[kk], dn, 0, 0, 0); }
        qn = __shfl(dn[0], fr);
        wint = sc[256 + t];
#pragma unroll
        for (int et = 0; et < 16; ++et) acc[et] = acc[et] * wint;
    }
    __syncthreads();
    LAS bf16* Vs = (LAS bf16*)lds;
    stage_v(Vs, P, row0, (ML ? C_MV : C_GV) + h * 256, tid);
    __syncthreads();
#pragma unroll
    for (int ks = 0; ks < 4; ++ks) {
        u32x4 pw; pw.x = pb[2 * ks].x; pw.y = pb[2 * ks].y; pw.z = pb[2 * ks + 1].x; pw.w = pb[2 * ks + 1].y;
        const bf16x8 pf = __builtin_bit_cast(bf16x8, pw);
#pragma unroll
        for (int et = 0; et < 16; ++et) { acc[et] = __builtin_amdgcn_mfma_f32_16x16x32_bf16(tr_frag(Vs, 272, et * 16, ks, lane), pf, acc[et], 0, 0, 0); if ((et & 3) == 3) __builtin_amdgcn_sched_barrier(0); }
    }
    float inv = 1.f;
    if (ML) { den += __shfl_xor(den, 16); den += __shfl_xor(den, 32); den += wint * qn; inv = 1.f / fmaxf(fabsf(den), sc[384 + t]); }
    float ss = 0.f;
#pragma unroll
    for (int et = 0; et < 16; ++et) { acc[et] = acc[et] * inv; ss += dot4(acc[et], acc[et]); }
    ss += __shfl_xor(ss, 16); ss += __shfl_xor(ss, 32);
    const float rn = rsqrtf(ss * (1.f / 256.f) + EPS);
    const float* hw = a.in[ML ? I_MHW : I_GHW] + h * 256;
    const bf16* gp = P + (size_t)(row0 + t) * NPROJ + (ML ? C_MO : C_GR) + h * 256;
    bf16* yp = (bf16*)(ws + (ML ? WS_YM : WS_YG)) + (size_t)(row0 + t) * 1024 + h * 256;
#pragma unroll
    for (int et = 0; et < 16; ++et) { const int e = et * 16 + 4 * fq;
        const u32x2 gw = *(const u32x2*)(gp + e); const f32x4 w = *(const f32x4*)(hw + e);
        const float g0 = bflo(gw.x), g1 = bfhi(gw.x), g2 = bflo(gw.y), g3 = bfhi(gw.y);
        float o0 = acc[et][0] * rn * w[0], o1 = acc[et][1] * rn * w[1], o2 = acc[et][2] * rn * w[2], o3 = acc[et][3] * rn * w[3];
        if (ML) { o0 *= sigm(g0); o1 *= sigm(g1); o2 *= sigm(g2); o3 *= sigm(g3); } else { o0 *= g0 * sigm(g0); o1 *= g1 * sigm(g1); o2 *= g2 * sigm(g2); o3 *= g3 * sigm(g3); }
        u32x2 o; o.x = cvt_pk_bf16(o0, o1); o.y = cvt_pk_bf16(o2, o3); *(u32x2*)(yp + e) = o;
        if ((et & 3) == 3) __builtin_amdgcn_sched_barrier(0); }
}

template <bool ML>
__device__ __forceinline__ void sample_item(const Args& a, LAS unsigned char* lds, int b, int h) {
    constexpr int DK = ML ? 256 : 128;
    int tid_ = threadIdx.x; asm volatile("" : "+v"(tid_));
    const int tid = tid_, lane = tid & 63, wave = __builtin_amdgcn_readfirstlane(tid >> 6);
    unsigned char* ws = a.ws;
    const bf16* P = (const bf16*)(ws + WS_PROJ); const float* gates = (const float*)(ws + WS_GATES);
    const int row0 = MP + b * 8, bh = b * 4 + h;
    LAS float* qT = (LAS float*)lds;
    LAS float* wkT = qT + 2048;
    LAS float* kT = wkT + 2048;
    LAS float* vS = kT + 2048;
    LAS float* red = vS + 2048;
    LAS float* sm = red + 16384;
    __syncthreads();
    float aS[8], Mt[8], bS[8]; float m0 = 0.f, dec = 1.f;
    if (ML) {
        m0 = a.in[I_M][bh]; float bs = 0.f, M = m0;
#pragma unroll
        for (int t = 0; t < 8; ++t) { const float mi = gates[(size_t)(row0 + t) * 32 + h], mf = gates[(size_t)(row0 + t) * 32 + 4 + h];
            bs += logsig(mf + a.in[I_BF][h]); bS[t] = bs; aS[t] = mi + a.in[I_BI][h] - bs; M = fmaxf(M, aS[t]); Mt[t] = M; }
        dec = __expf(m0 - Mt[7]);
        if (tid == 0) {
#pragma unroll
            for (int t = 0; t < 8; ++t) { sm[200 + t] = aS[t]; sm[208 + t] = Mt[t]; sm[216 + t] = bS[t]; } }
        if (tid < 256) { const int d = tid;
#pragma unroll
            for (int t = 0; t < 8; ++t) { const float qv = bf2f(P[(size_t)(row0 + t) * NPROJ + C_MQ + h * 256 + d]), kv = bf2f(P[(size_t)(row0 + t) * NPROJ + C_MK + h * 256 + d]) * (1.f / 16.f);
                qT[d * 8 + t] = qv; kT[d * 8 + t] = kv; wkT[d * 8 + t] = kv * __expf(aS[t] - Mt[7]); } }
    } else {
        if (tid < 128) { const int d = tid; float up[16];
#pragma unroll
            for (int j = 0; j < 16; ++j) up[j] = a.in[I_AUP][j * 512 + h * 128 + d];
            const float ab = a.in[I_AB][h * 128 + d];
            float bc[8]; float bs = 0.f;
#pragma unroll
            for (int t = 0; t < 8; ++t) { float z = ab;
#pragma unroll
                for (int j = 0; j < 16; ++j) z += gates[(size_t)(row0 + t) * 32 + 8 + j] * up[j];
                bs += logsig(z) * (1.f / 16.f); bc[t] = bs; }
            sm[72 + d] = __expf(bs);
#pragma unroll
            for (int t = 0; t < 8; ++t) { const float qv = bf2f(P[(size_t)(row0 + t) * NPROJ + C_GQ + h * 128 + d]), kv = bf2f(P[(size_t)(row0 + t) * NPROJ + C_GK + h * 128 + d]);
                qT[d * 8 + t] = qv * 0.08838834764831845f * __expf(bc[t]); kT[d * 8 + t] = kv * __expf(-bc[t]); wkT[d * 8 + t] = kv * __expf(bs - bc[t]); } }
    }
    { const int t = tid >> 6; const u32x2 w = *(const u32x2*)(P + (size_t)(row0 + t) * NPROJ + (ML ? C_MV : C_GV) + h * 256 + 4 * lane);
      *(LAS f32x4*)(vS + t * 256 + 4 * lane) = (f32x4){bflo(w.x), bfhi(w.x), bflo(w.y), bfhi(w.y)}; }
    __syncthreads();
    float prow, qn = 0.f;
    { const int s8 = lane & 7, part = lane >> 3; float sd = 0.f;
#pragma unroll 8
      for (int i = 0; i < DK / 8; ++i) { const int d = 8 * i + part; sd += qT[d * 8 + wave] * kT[d * 8 + s8]; }
      sd += __shfl_xor(sd, 8); sd += __shfl_xor(sd, 16); sd += __shfl_xor(sd, 32);
      if (ML) prow = (s8 <= wave) ? sd * __expf(sm[200 + s8] - sm[208 + wave]) : 0.f; else prow = (s8 <= wave) ? sd : 0.f; }
    if (ML) { const float* n0 = a.in[I_N] + (size_t)bh * 256; float sd = 0.f;
#pragma unroll
      for (int i = 0; i < 4; ++i) { const int d = lane + 64 * i; sd += qT[d * 8 + wave] * n0[d]; }
      qn = wave_sum(sd); }
    const float* C0 = a.in[ML ? I_C : I_S] + (size_t)bh * DK * 256;
    float* C1 = a.out + (ML ? O_SC : O_SS) + (size_t)bh * DK * 256;
    f32x4 v[8], acc[8];
#pragma unroll
    for (int s = 0; s < 8; ++s) { v[s] = *(const LAS f32x4*)(vS + s * 256 + 4 * lane); acc[s] = (f32x4){0.f, 0.f, 0.f, 0.f}; }
#pragma unroll 8
    for (int i = 0; i < DK / 8; ++i) { const int d = wave + 8 * i;
        const f32x4 cv = __builtin_nontemporal_load((const f32x4*)(C0 + (size_t)d * 256 + 4 * lane));
        const f32x4 q0 = *(const LAS f32x4*)(qT + d * 8), q1 = *(const LAS f32x4*)(qT + d * 8 + 4), k0 = *(const LAS f32x4*)(wkT + d * 8), k1 = *(const LAS f32x4*)(wkT + d * 8 + 4);
        const float dd = ML ? dec : sm[72 + d];
        acc[0] += cv * q0[0]; acc[1] += cv * q0[1]; acc[2] += cv * q0[2]; acc[3] += cv * q0[3]; acc[4] += cv * q1[0]; acc[5] += cv * q1[1]; acc[6] += cv * q1[2]; acc[7] += cv * q1[3];
        f32x4 cn = cv * dd;
        cn += v[0] * k0[0]; cn += v[1] * k0[1]; cn += v[2] * k0[2]; cn += v[3] * k0[3]; cn += v[4] * k1[0]; cn += v[5] * k1[1]; cn += v[6] * k1[2]; cn += v[7] * k1[3];
        __builtin_nontemporal_store(cn, (f32x4*)(C1 + (size_t)d * 256 + 4 * lane)); }
#pragma unroll
    for (int s = 0; s < 8; ++s) *(LAS f32x4*)(red + (wave * 8 + s) * 256 + 4 * lane) = acc[s];
    __syncthreads();
    const int t = wave;
    f32x4 qc = {0.f, 0.f, 0.f, 0.f};
#pragma unroll
    for (int w = 0; w < 8; ++w) qc += *(const LAS f32x4*)(red + (w * 8 + t) * 256 + 4 * lane);
    float wint = 1.f, den = 0.f, Mtt = 0.f, btt = 0.f;
    if (ML) { Mtt = sm[208 + t]; btt = sm[216 + t]; wint = __expf(m0 - Mtt); }
    f32x4 num = qc * wint;
#pragma unroll
    for (int s = 0; s < 8; ++s) { const float p = __shfl(prow, s); num += v[s] * p; den += p; }
    if (ML) { den += wint * qn; const float fl = fmaxf(fabsf(den), __expf(-(btt + Mtt))); num = num * (1.f / fl); }
    const float rn = rsqrtf(wave_sum(dot4(num, num)) * (1.f / 256.f) + EPS);
    const f32x4 w = *(const f32x4*)(a.in[ML ? I_MHW : I_GHW] + h * 256 + 4 * lane);
    const u32x2 gw = *(const u32x2*)(P + (size_t)(row0 + t) * NPROJ + (ML ? C_MO : C_GR) + h * 256 + 4 * lane);
    const float g0 = bflo(gw.x), g1 = bfhi(gw.x), g2 = bflo(gw.y), g3 = bfhi(gw.y);
    float o0 = num[0] * rn * w[0], o1 = num[1] * rn * w[1], o2 = num[2] * rn * w[2], o3 = num[3] * rn * w[3];
    if (ML) { o0 *= sigm(g0); o1 *= sigm(g1); o2 *= sigm(g2); o3 *= sigm(g3); } else { o0 *= g0 * sigm(g0); o1 *= g1 * sigm(g1); o2 *= g2 * sigm(g2); o3 *= g3 * sigm(g3); }
    u32x2 o; o.x = cvt_pk_bf16(o0, o1); o.y = cvt_pk_bf16(o2, o3);
    *(u32x2*)((bf16*)(ws + (ML ? WS_YM : WS_YG)) + (size_t)(row0 + t) * 1024 + h * 256 + 4 * lane) = o;
    if (ML) {
        if (tid < 256) { float s = dec * a.in[I_N][(size_t)bh * 256 + tid];
#pragma unroll
            for (int q = 0; q < 8; ++q) s += wkT[tid * 8 + q];
            a.out[O_SN + (size_t)bh * 256 + tid] = s; }
        if (tid == 0) a.out[O_SM + bh] = bS[7] + Mt[7];
    }
}

__device__ __forceinline__ void rstd_phase(const Args& a, int vcu, int G) {
    const float* part = (const float*)(a.ws + WS_PART); float* rstd = (float*)(a.ws + WS_RSTD);
    for (int row = vcu * NTHR + threadIdx.x; row < MT; row += G * NTHR) { float s = 0.f;
#pragma unroll
        for (int i = 0; i < 8; ++i) s += sum4(*(const f32x4*)(part + (size_t)row * 32 + 4 * i));
        rstd[row] = rsqrtf(s * (1.f / DM) + EPS); }
}
__device__ __forceinline__ void act_fixup(const Args& a, int vcu, int G) {
    unsigned char* ws = a.ws; const float* ub = (const float*)(ws + WS_U); bf16* ACT = (bf16*)(ws + WS_G);
    const float* cw = a.in[I_CW]; const float* cb = a.in[I_CB];
    int tid_ = threadIdx.x; asm volatile("" : "+v"(tid_));
    for (int idx = vcu * NTHR + tid_; idx < 28 * DFF; idx += G * NTHR) {
        const int k = idx / DFF, col = idx % DFF, pm = (k / 7) * 8 + 1 + (k % 7);
        const float um2 = ub[((size_t)(pm - 1) * 6 + 0) * DFF + col], um1 = ub[((size_t)(pm - 1) * 6 + 1) * DFF + col];
        const float u0 = ub[((size_t)pm * 6 + 2) * DFF + col], u1 = ub[((size_t)pm * 6 + 3) * DFF + col], g0 = ub[((size_t)pm * 6 + 4) * DFF + col], g1 = ub[((size_t)pm * 6 + 5) * DFF + col];
        const float c0 = cw[col], c1 = cw[DFF + col], c2 = cw[2 * DFF + col], bb = cb[col];
        ACT[(size_t)(pm * 256) * DFF + col] = f2bf(gelu_tanh(bb + c0 * um2 + c1 * um1 + c2 * u0) * g0);
        ACT[(size_t)(pm * 256 + 1) * DFF + col] = f2bf(gelu_tanh(bb + c0 * um1 + c1 * u0 + c2 * u1) * g1);
    }
}
__device__ __forceinline__ void final_norm(const Args& a, int vcu, int G) {
    int tid_ = threadIdx.x; asm volatile("" : "+v"(tid_));
    const int tid = tid_, lane = tid & 63, wave = tid >> 6;
    const float* part = (const float*)(a.ws + WS_PART); const float* fw = a.in[I_FNW];
    for (int m = vcu * NWAVES + wave; m < MT; m += G * NWAVES) {
        float s = (lane < 32) ? part[(size_t)m * 32 + lane] : 0.f; s = wave_sum(s);
        const float r = rsqrtf(s * (1.f / DM) + EPS);
        float* row = a.out + (size_t)m * DM;
#pragma unroll
        for (int j = 0; j < 8; ++j) { const f32x4 v = *(const f32x4*)(row + 4 * lane + 256 * j), w = *(const f32x4*)(fw + 4 * lane + 256 * j);
            *(f32x4*)(row + 4 * lane + 256 * j) = (f32x4){v[0] * r * w[0], v[1] * r * w[1], v[2] * r * w[2], v[3] * r * w[3]}; }
    }
}

#define XB_TMO      128
#define XB_XCNT(j)  (256  + 64 * (j))
#define XB_XSUB(j)  (1280 + 64 * (j))
#define XB_XGEN(j)  (2304 + 64 * (j))
#define XB_TOP      3328
#define XB_TOPGEN   3392
#define XCD_BAR_WORDS 3456
#define XB_SPIN_CAP (1u << 18)

__device__ __forceinline__ unsigned xb_ld(unsigned* p)              { return __hip_atomic_load(p, __ATOMIC_RELAXED, __HIP_MEMORY_SCOPE_AGENT); }
__device__ __forceinline__ unsigned xb_add(unsigned* p, unsigned v) { return __hip_atomic_fetch_add(p, v, __ATOMIC_RELAXED, __HIP_MEMORY_SCOPE_AGENT); }
__device__ __forceinline__ unsigned xb_xcc_id() { return (unsigned)__builtin_amdgcn_s_getreg((3 << 11) | 20) & 0xFu; }
#define XB_SPIN(cond, bar) do { unsigned _sp = 0; while (cond) { __builtin_amdgcn_s_sleep(1); \
    if ((++_sp & 255u) == 0u) { if (xb_ld(&(bar)[XB_TMO])) break; if (_sp > XB_SPIN_CAP) { atomicAdd(&(bar)[XB_TMO], 1u); break; } } } } while (0)

struct XcdBarrier {
    unsigned* bar; unsigned x;
    volatile LAS unsigned* st;
};

__device__ __forceinline__ XcdBarrier xcd_barrier_post(unsigned* bar, volatile LAS unsigned* st) {
    XcdBarrier b; b.bar = bar; b.x = xb_xcc_id(); b.st = st;
    if (threadIdx.x == 0) (void)xb_add(&bar[XB_XCNT(b.x)], 1u);
    return b;
}
__device__ __forceinline__ void xcd_barrier_complete(unsigned* bar, unsigned x, unsigned& nloc, unsigned& nx) {
    const unsigned G = gridDim.x * gridDim.y * gridDim.z;
    unsigned sum, cnt, mine, sp = 0u;
    for (;;) {
        sum = 0u; cnt = 0u; mine = 0u;
#pragma unroll
        for (unsigned j = 0; j < 16; ++j) { const unsigned c = xb_ld(&bar[XB_XCNT(j)]); sum += c; cnt += (c > 0u) ? 1u : 0u; mine = (j == x) ? c : mine; }
        if (sum == G) break;
        __builtin_amdgcn_s_sleep(1);
        if ((++sp & 255u) == 0u) { if (xb_ld(&bar[XB_TMO])) break; if (sp > XB_SPIN_CAP) { atomicAdd(&bar[XB_TMO], 1u); break; } }
    }
    nloc = mine > 0u ? mine : 1u; nx = cnt > 0u ? cnt : 1u;
}

__device__ __forceinline__ void xcd_barrier(const XcdBarrier& b) {
    asm volatile("s_waitcnt vmcnt(0)" ::: "memory");
    __syncthreads();
    if (threadIdx.x == 0) {
        unsigned* bar = b.bar;
        __builtin_amdgcn_s_waitcnt(0);
        unsigned nloc = b.st[0], nx = b.st[1];
        if (nloc == 0u) { xcd_barrier_complete(bar, b.x, nloc, nx); b.st[0] = nloc; b.st[1] = nx; }
        const unsigned old = xb_add(&bar[XB_XSUB(b.x)], 1u);
        const unsigned gen = old / nloc;
        if (old + 1u == (gen + 1u) * nloc) {
            __builtin_amdgcn_fence(__ATOMIC_RELEASE, "agent");
            asm volatile("s_waitcnt vmcnt(0)" ::: "memory");
            const unsigned og = xb_add(&bar[XB_TOP], 1u);
            const unsigned tg = og / nx;
            if (og + 1u == (tg + 1u) * nx) xb_add(&bar[XB_TOPGEN], 1u);
            else XB_SPIN(xb_ld(&bar[XB_TOPGEN]) == tg, bar);
            __builtin_amdgcn_fence(__ATOMIC_ACQUIRE, "agent");
            xb_add(&bar[XB_XGEN(b.x)], 1u);
            asm volatile("s_waitcnt vmcnt(0)" ::: "memory");
        } else {
            XB_SPIN(xb_ld(&bar[XB_XGEN(b.x)]) == gen, bar);
            __builtin_amdgcn_fence(__ATOMIC_ACQUIRE, "agent");
            asm volatile("s_waitcnt vmcnt(0)" ::: "memory");
        }
    }
    __syncthreads();
}

constexpr int N_PHASES = 12;
__global__ void __launch_bounds__(NTHR) fwd_kernel(Args args) {
    extern __shared__ __attribute__((aligned(16))) unsigned char lds_raw[];
    LAS unsigned char* lds = (LAS unsigned char*)lds_raw;
    cg::grid_group grid = cg::this_grid();
    volatile LAS unsigned* bst = (volatile LAS unsigned*)(lds + LDS_BYTES - 16);
    if (threadIdx.x < 4) bst[threadIdx.x] = 0u;
    __syncthreads();
    XcdBarrier xbar = xcd_barrier_post((unsigned*)args.ws, bst);
    const int G = gridDim.x, bx = blockIdx.x;
    const int vcu = (G % 8 == 0) ? (bx % 8) * (G / 8) + bx / 8 : bx;
    const int lo = args.ph_lo, hi = args.ph_hi;
    unsigned char* ws = args.ws;
#ifndef USE_CG_SYNC
#define USE_CG_SYNC 0
#endif
#ifndef DOUBLE_MASK
#define DOUBLE_MASK 0
#endif
#define REP(k) for (int rep_ = 0; rep_ < 1 + ((DOUBLE_MASK >> (k)) & 1); ++rep_)
#ifndef DBL_P2
#define DBL_P2 0
#endif
#ifndef BIS
#define BIS 15
#endif
#ifndef PHASE_MASK
#define PHASE_MASK 0xfff
#endif
#define IN(k) (((PHASE_MASK >> (k)) & 1) && lo <= (k) && (k) < hi)
#define SEAM(k) do { if (IN(k) && IN((k) + 1)) { if (USE_CG_SYNC || lo < 0) grid.sync(); else xcd_barrier(xbar); } } while (0)
    if (IN(0)) REP(0) { p0_prologue(args, lds, vcu, G); __syncthreads(); }
    SEAM(0);
    if (IN(1)) REP(1) {
        pg8::Gemm g{(const bf16*)(ws + WS_XN), (const bf16*)(ws + WS_WIN), nullptr, nullptr, MT, NPROJ_PAD, DM}; pg8::StaticOrder S; S.init(MT, NPROJ_PAD, G, bx);
        EpiProj E{(bf16*)(ws + WS_PROJ), (float*)(ws + WS_GATES)};
        pg8::gemm_phase<EpiProj, pg8::StaticOrder, true, true>(lds, g, S, E);
    }
    SEAM(1);
    if (IN(2)) REP(2) {
        for (int it = bx; it < 1536; it += G) {
            if (it < 512) { for (int r_ = 0; r_ < 1 + (DBL_P2 & 1); ++r_) sample_item<true>(args, lds, it >> 2, it & 3); }
            else if (it < 1024) { for (int r_ = 0; r_ < 1 + ((DBL_P2 >> 1) & 1); ++r_) sample_item<false>(args, lds, (it - 512) >> 2, (it - 512) & 3); }
            else if (it < 1280) { for (int r_ = 0; r_ < 1 + ((DBL_P2 >> 2) & 1); ++r_) chunk_state<true>(args, lds, (it - 1024) >> 4, (it - 1024) & 15); }
            else { for (int r_ = 0; r_ < 1 + ((DBL_P2 >> 3) & 1); ++r_) chunk_state<false>(args, lds, (it - 1280) >> 4, (it - 1280) & 15); }
        }
    }
    SEAM(2);
    if (IN(3)) REP(3) { for (int it = bx; it < 768; it += G) { if (it < 512) scan_mlstm(args, it); else scan_gla(args, it - 512); } }
    SEAM(3);
    if (IN(4)) REP(4) { for (int it = bx; it < 512; it += G) { if (it < 256) { if (BIS & 1) chunk_out<true>(args, lds, it >> 4, it & 15); } else { if (BIS & 2) chunk_out<false>(args, lds, (it - 256) >> 4, (it - 256) & 15); } } __syncthreads(); }
    SEAM(4);
    if (IN(5)) REP(5) {
        pg8::Gemm g{(const bf16*)(ws + WS_YM), (const bf16*)(ws + WS_WA), (const bf16*)(ws + WS_YG), (const bf16*)(ws + WS_WB), MT, DM, 1024}; pg8::TwoSegOrder S; S.S.init(MT, DM, G, bx);
        EpiBranch E{(const bf16*)(ws + WS_PROJ), (bf16*)(ws + WS_XN)};
        pg8::gemm_phase<EpiBranch, pg8::TwoSegOrder, true, true>(lds, g, S, E);
    }
    SEAM(5);
    if (IN(6)) REP(6) {
        pg8::Gemm g{(const bf16*)(ws + WS_XN), (const bf16*)(ws + WS_WO), nullptr, nullptr, MT, DM, DM}; pg8::StaticOrder S; S.init(MT, DM, G, bx);
        EpiOut E{args.in[I_XP], args.in[I_XS], (float*)(ws + WS_X1), (bf16*)(ws + WS_X1W), args.in[I_NFFN], (float*)(ws + WS_PART)};
        pg8::gemm_phase<EpiOut, pg8::StaticOrder, true, true>(lds, g, S, E);
    }
    SEAM(6);
    if (IN(7)) REP(7) rstd_phase(args, vcu, G);
    SEAM(7);
    if (IN(8)) REP(8) {
        pg8::Gemm g{(const bf16*)(ws + WS_X1W), (const bf16*)(ws + WS_WUG), nullptr, nullptr, MT, 2 * DFF, DM}; pg8::StaticOrder S; S.init(MT, 2 * DFF, G, bx);
        EpiUGAct E{(const float*)(ws + WS_RSTD), (bf16*)(ws + WS_G), args.out, args.in[I_CW], args.in[I_CB], args.in[I_CONV], (float*)(ws + WS_U), (LAS float*)(lds + 131072)};
        pg8::gemm_phase<EpiUGAct, pg8::StaticOrder, true, true>(lds, g, S, E);
    }
    SEAM(8);
    if (IN(9)) REP(9) act_fixup(args, vcu, G);
    SEAM(9);
    if (IN(10)) REP(10) {
        pg8::Gemm g{(const bf16*)(ws + WS_G), (const bf16*)(ws + WS_WD), nullptr, nullptr, MT, DM, DFF}; pg8::StaticOrder S; S.init(MT, DM, G, bx);
        EpiDown E{(const float*)(ws + WS_X1), args.out, (float*)(ws + WS_PART)};
        pg8::gemm_phase<EpiDown, pg8::StaticOrder, true, true>(lds, g, S, E);
    }
    SEAM(10);
    if (IN(11)) REP(11) final_norm(args, vcu, G);
#ifdef EXTRA_SYNCS
    for (int i_ = 0; i_ < EXTRA_SYNCS; ++i_) xcd_barrier(xbar);
#endif
#undef IN
#undef SEAM
}

extern "C" void kernel_launch(void* const* d_in, const int* in_sizes, int n_in, void* d_out, int out_size, void* d_ws, size_t ws_size, hipStream_t stream) {
    static int grid = 0;
    if (grid == 0) {
        if (n_in != 25 || ws_size < WS_END) { fprintf(stderr, "kernel_launch: unexpected n_in %d / ws_size %zu (need %zu)\n", n_in, ws_size, (size_t)WS_END); grid = -1; return; }
        int dev = 0, cus = 0, per_cu = 0;
        (void)hipGetDevice(&dev); (void)hipDeviceGetAttribute(&cus, hipDeviceAttributeMultiprocessorCount, dev);
        if (hipFuncSetAttribute((const void*)fwd_kernel, hipFuncAttributeMaxDynamicSharedMemorySize, LDS_BYTES) != hipSuccess) { fprintf(stderr, "kernel_launch: hipFuncSetAttribute failed\n"); grid = -1; return; }
        if (hipOccupancyMaxActiveBlocksPerMultiprocessor(&per_cu, (const void*)fwd_kernel, NTHR, LDS_BYTES) != hipSuccess || per_cu < 1) { fprintf(stderr, "kernel_launch: occupancy query says %d\n", per_cu); per_cu = 1; }
        (void)hipGetLastError();
        grid = cus * 1;
        if (grid <= 0) grid = 256;
    }
    if (grid < 0) return;
    if (hipMemsetAsync(d_ws, 0, 65536, stream) != hipSuccess) { fprintf(stderr, "kernel_launch: memset failed\n"); return; }
    Args a{};
    for (int i = 0; i < 25; ++i) a.in[i] = (const float*)d_in[i];
    a.out = (float*)d_out; a.ws = (unsigned char*)d_ws;
    if (MK_N_LAUNCHES == 1) {
        a.ph_lo = 0; a.ph_hi = N_PHASES;
        void* kargs[] = {&a};
        hipError_t e = hipLaunchCooperativeKernel((const void*)fwd_kernel, dim3(grid), dim3(NTHR), kargs, LDS_BYTES, stream);
        if (e != hipSuccess) fprintf(stderr, "kernel_launch: cooperative launch failed: %s (grid %d)\n", hipGetErrorString(e), grid);
    } else {
        for (int p = 0; p < N_PHASES; ++p) { a.ph_lo = p; a.ph_hi = p + 1; hipLaunchKernelGGL(fwd_kernel, dim3(grid), dim3(NTHR), LDS_BYTES, stream, a); }
    }
}
```

```cpp
#include <hip/hip_runtime.h>
#include <hip/hip_cooperative_groups.h>
#include <cstdio>
#include <cstdint>
namespace cg = cooperative_groups;

#ifndef MK_N_LAUNCHES
#define MK_N_LAUNCHES 1
#endif

namespace pg8 {
#define PG8_LAS __attribute__((address_space(3)))
typedef unsigned short bf16_t;
typedef short bf16x8 __attribute__((ext_vector_type(8)));
typedef float f32x4 __attribute__((ext_vector_type(4)));
typedef unsigned u32x4 __attribute__((ext_vector_type(4)));
constexpr int BM = 256, BK = 64, HALF = 128, HTB = HALF * BK * 2  , STAGE_BYTES = 8 * HTB, NXCD = 8, WGM = 8;

__host__ __device__ __forceinline__ int lds_byte(int r, int c) { const int st = (r >> 4) * 2 + (c >> 5), rr = r & 15, cc = c & 31, ob = rr * 64 + cc * 2; return st * 1024 + (ob ^ (((ob >> 9) & 1) << 5)); }
__host__ __device__ __forceinline__ void stage_rc(int b, int& R, int& C) { const int st = b / 1024, sb = b % 1024, swz = sb ^ (((sb >> 9) & 1) << 5); R = (st >> 1) * 16 + swz / 64; C = (st & 1) * 32 + (swz % 64) / 2; }
__host__ __device__ __forceinline__ int perm32(int rho) { const int n = rho >> 4, i = rho & 15; return 8 * (i >> 2) + 4 * n + (i & 3); }

struct Unit { int pm, pn, seg, kt0, nkt, tail; };
struct Gemm { const bf16_t* A; const bf16_t* Bt; const bf16_t* A2; const bf16_t* Bt2; int M, N, K; };

struct StaticOrder {
    int nM, nN, nwg, G, c;
    __host__ __device__ void init(int M, int N, int G_, int c_) { nM = M / BM; nN = N / BM; nwg = nM * nN; G = G_; c = c_; }
    __host__ __device__ bool next(int i, Unit& u) const { return at((long)i * G + c, u); }
    __host__ __device__ bool at(long L, Unit& u) const {
        if (L >= nwg) return false;
        int wgid = (int)L; { const int q = nwg / NXCD, r = nwg % NXCD, xcd = wgid % NXCD, off = wgid / NXCD; wgid = (xcd < r ? xcd * (q + 1) : r * (q + 1) + (xcd - r) * q) + off; }
        const int nig = WGM * nN, gid = wgid / nig, fm = gid * WGM, gsz = (nM - fm) < WGM ? (nM - fm) : WGM;
        u.pm = fm + ((wgid % nig) % gsz); u.pn = (wgid % nig) / gsz; u.seg = 0; u.kt0 = 0; u.nkt = -1; u.tail = -1; return true;
    }
};
struct DownOrder {
    StaticOrder S; bool split;
    __host__ __device__ bool next(int i, Unit& u) const {
        if (!split) return S.next(i, u);
        if (i == 0) return S.at(S.c, u);
        if (i > 1) return false;
        const int tt = S.c >> 3, sl = S.c & 7;
        if (!S.at(256 + tt, u)) return false;
        u.kt0 = 11 * sl + (sl & 1); u.nkt = (sl & 1) ? 10 : 12; u.tail = tt * 8 + sl; return true;
    }
};
struct TwoSegOrder {
    StaticOrder S;
    __host__ __device__ bool next(int i, Unit& u) const { if (!S.next(i >> 1, u)) return false; u.seg = i & 1; return true; }
};

__device__ __forceinline__ unsigned cvt_pk_bf16(float lo, float hi) { unsigned r; asm volatile("v_cvt_pk_bf16_f32 %0, %1, %2" : "=v"(r) : "v"(lo), "v"(hi)); return r; }

template <class Epi, class Sched, bool ALIGN_EPI = false, bool SP2 = false>
__device__ __forceinline__ void gemm_phase(PG8_LAS unsigned char* lds, const Gemm g, const Sched& S, const Epi& E) {
    int tid_ = threadIdx.x; asm volatile("" : "+v"(tid_));
    const int tid = tid_, wid = __builtin_amdgcn_readfirstlane(tid >> 6), lane = tid & 63, wr = wid >> 2, wc = wid & 3, fr = lane & 15, fq = lane >> 4;
    const int K = g.K, ntf = K / BK;
    unsigned voffA[2], voffB[2];
#pragma unroll
    for (int i = 0; i < 2; ++i) { int R, C; stage_rc(tid * 16 + i * 8192, R, C); const int Rb = Epi::PERM ? ((R & ~31) + perm32(R & 31)) : R;
        voffA[i] = (unsigned)(R * K + C) * 2u; voffB[i] = (unsigned)(Rb * K + C) * 2u; }
    const size_t kstep = (size_t)(BK * 2);
    const size_t hstep = (size_t)HALF * K * 2;
    const size_t tstep = 2 * hstep;
    const unsigned ldsw = (unsigned)wid * 1024u;
    const int aoff = lds_byte(wr * 64 + fr, fq * 8), boff = lds_byte(wc * 32 + fr, fq * 8);
#define PG8_SA(b, h) (((b) * 2 + (h)) * HTB)
#define PG8_SB(b, h) ((4 + (b) * 2 + (h)) * HTB)
#define PG8_STAGE(bufoff, gbase, voff) do { _Pragma("unroll") for (int _i = 0; _i < 2; ++_i) \
        __builtin_amdgcn_global_load_lds((const unsigned*)((const char*)(gbase) + (voff)[_i]), (PG8_LAS unsigned*)(lds + (bufoff) + ldsw + _i * 8192), 16, 0, 0); } while (0)
#define PG8_LDA(dst, b, h) do { _Pragma("unroll") for (int m = 0; m < 4; ++m) _Pragma("unroll") for (int k = 0; k < 2; ++k) dst[m][k] = *(const PG8_LAS bf16x8*)(lds + PG8_SA(b, h) + aoff + m * 2048 + k * 1024); } while (0)
#define PG8_LDB(dst, b, h) do { _Pragma("unroll") for (int n = 0; n < 2; ++n) _Pragma("unroll") for (int k = 0; k < 2; ++k) dst[n][k] = *(const PG8_LAS bf16x8*)(lds + PG8_SB(b, h) + boff + n * 2048 + k * 1024); } while (0)
#define PG8_MMA(ai, bj, At, Bt) do { __builtin_amdgcn_s_setprio(1); _Pragma("unroll") for (int m = 0; m < 4; ++m) _Pragma("unroll") for (int n = 0; n < 2; ++n) _Pragma("unroll") for (int k = 0; k < 2; ++k) \
        acc[ai][bj][m][n] = __builtin_amdgcn_mfma_f32_16x16x32_bf16(Bt[n][k], At[m][k], acc[ai][bj][m][n], 0, 0, 0); __builtin_amdgcn_s_setprio(0); } while (0)
#define PG8_WAIT_V(n) asm volatile("s_waitcnt vmcnt(" #n ")" ::: "memory")
#define PG8_WAIT_L(n) asm volatile("s_waitcnt lgkmcnt(" #n ")" ::: "memory")
#define PG8_BAR __builtin_amdgcn_s_barrier()
#define PG8_SCHED __builtin_amdgcn_sched_barrier(0)
    Unit cur, nxt; int ui = 0;
    if (!S.next(0, cur)) return;
    f32x4 acc[2][2][4][2];
#pragma unroll
    for (int a = 0; a < 2; ++a)
#pragma unroll
        for (int b = 0; b < 2; ++b)
#pragma unroll
            for (int m = 0; m < 4; ++m)
#pragma unroll
                for (int n = 0; n < 2; ++n) acc[a][b][m][n] = (f32x4){0.f, 0.f, 0.f, 0.f};
    bf16x8 At[4][2], B0[2][2], B1[2][2];
    const char* cA = (const char*)(cur.seg ? g.A2 : g.A) + (size_t)cur.pm * tstep + (size_t)cur.kt0 * kstep; const char* cB = (const char*)(cur.seg ? g.Bt2 : g.Bt) + (size_t)cur.pn * tstep + (size_t)cur.kt0 * kstep;
    if constexpr (SP2) {
        PG8_STAGE(PG8_SB(0, 0), cB, voffB); PG8_STAGE(PG8_SB(0, 1), cB + hstep, voffB); PG8_STAGE(PG8_SA(0, 0), cA, voffA); PG8_STAGE(PG8_SA(0, 1), cA + hstep, voffA);
        if (wr == 1) PG8_BAR;
        PG8_WAIT_V(2); PG8_BAR;
        PG8_STAGE(PG8_SB(1, 0), cB + kstep, voffB); PG8_STAGE(PG8_SA(1, 0), cA + kstep, voffA); PG8_STAGE(PG8_SB(1, 1), cB + hstep + kstep, voffB);
        PG8_WAIT_V(6); PG8_BAR;
    } else {
        PG8_STAGE(PG8_SB(0, 0), cB, voffB); PG8_STAGE(PG8_SA(0, 0), cA, voffA); PG8_STAGE(PG8_SB(0, 1), cB + hstep, voffB); PG8_STAGE(PG8_SA(0, 1), cA + hstep, voffA);
        if (wr == 1) PG8_BAR;
        PG8_WAIT_V(4); PG8_BAR;
        PG8_STAGE(PG8_SB(1, 0), cB + kstep, voffB); PG8_STAGE(PG8_SA(1, 0), cA + kstep, voffA); PG8_STAGE(PG8_SB(1, 1), cB + hstep + kstep, voffB);
        PG8_WAIT_V(6); PG8_BAR;
    }
    for (;;) {
        const bool has_next = S.next(ui + 1, nxt);
        const char* nA = has_next ? (const char*)(nxt.seg ? g.A2 : g.A) + (size_t)nxt.pm * tstep + (size_t)nxt.kt0 * kstep : cA; const char* nB = has_next ? (const char*)(nxt.seg ? g.Bt2 : g.Bt) + (size_t)nxt.pn * tstep + (size_t)nxt.kt0 * kstep : cB;
        const int nt = cur.nkt > 0 ? cur.nkt : ntf;
        for (int t = 0; t < nt; t += 2) {
            const bool last = (t == nt - 2);
            const char* a1 = cA + (size_t)(t + 1) * kstep;
            const char* a2 = last ? nA : cA + (size_t)(t + 2) * kstep; const char* b2 = last ? nB : cB + (size_t)(t + 2) * kstep;
            const char* a3 = a2 + kstep; const char* b3 = b2 + kstep;
            if constexpr (SP2) {
            PG8_LDB(B0, 0, 0); PG8_LDB(B1, 0, 1); PG8_SCHED; PG8_LDA(At, 0, 0); PG8_STAGE(PG8_SA(1, 1), a1 + hstep, voffA);
            PG8_WAIT_V(8); PG8_WAIT_L(0); PG8_BAR; PG8_MMA(0, 0, At, B0); PG8_MMA(0, 1, At, B1); PG8_BAR; PG8_SCHED;
            PG8_LDA(At, 0, 1); PG8_STAGE(PG8_SB(0, 0), b2, voffB); PG8_STAGE(PG8_SB(0, 1), b2 + hstep, voffB); PG8_STAGE(PG8_SA(0, 0), a2, voffA);
            PG8_WAIT_V(8); PG8_WAIT_L(0); PG8_BAR; PG8_MMA(1, 0, At, B0); PG8_MMA(1, 1, At, B1); PG8_BAR; PG8_SCHED;
            PG8_LDB(B0, 1, 0); PG8_LDB(B1, 1, 1); PG8_SCHED; PG8_LDA(At, 1, 0); PG8_STAGE(PG8_SA(0, 1), a2 + hstep, voffA);
            PG8_WAIT_V(8); PG8_WAIT_L(0); PG8_BAR; PG8_MMA(0, 0, At, B0); PG8_MMA(0, 1, At, B1); PG8_BAR; PG8_SCHED;
            PG8_LDA(At, 1, 1); PG8_STAGE(PG8_SB(1, 0), b3, voffB); PG8_STAGE(PG8_SB(1, 1), b3 + hstep, voffB); PG8_STAGE(PG8_SA(1, 0), a3, voffA);
            PG8_WAIT_V(8); PG8_WAIT_L(0); PG8_BAR; PG8_MMA(1, 0, At, B0); PG8_MMA(1, 1, At, B1); PG8_BAR; PG8_SCHED;
            } else {
            PG8_LDB(B0, 0, 0); PG8_SCHED; PG8_LDA(At, 0, 0); PG8_STAGE(PG8_SA(1, 1), a1 + hstep, voffA);
            PG8_WAIT_L(8); PG8_BAR; PG8_WAIT_L(0); PG8_MMA(0, 0, At, B0); PG8_BAR; PG8_SCHED;
            PG8_LDB(B1, 0, 1); PG8_STAGE(PG8_SB(0, 0), b2, voffB);
            PG8_BAR; PG8_WAIT_L(0); PG8_MMA(0, 1, At, B1); PG8_BAR;
            PG8_LDA(At, 0, 1); PG8_STAGE(PG8_SA(0, 0), a2, voffA);
            PG8_BAR; PG8_WAIT_L(0); PG8_MMA(1, 0, At, B0); PG8_BAR; PG8_SCHED;
            PG8_STAGE(PG8_SB(0, 1), b2 + hstep, voffB);
            PG8_WAIT_V(6); PG8_BAR; PG8_MMA(1, 1, At, B1); PG8_BAR;
            PG8_LDB(B0, 1, 0); PG8_SCHED; PG8_LDA(At, 1, 0); PG8_STAGE(PG8_SA(0, 1), a2 + hstep, voffA);
            PG8_WAIT_L(8); PG8_BAR; PG8_WAIT_L(0); PG8_MMA(0, 0, At, B0); PG8_BAR; PG8_SCHED;
            PG8_LDB(B1, 1, 1); PG8_STAGE(PG8_SB(1, 0), b3, voffB);
            PG8_BAR; PG8_WAIT_L(0); PG8_MMA(0, 1, At, B1); PG8_BAR;
            PG8_LDA(At, 1, 1); PG8_STAGE(PG8_SA(1, 0), a3, voffA);
            PG8_BAR; PG8_WAIT_L(0); PG8_MMA(1, 0, At, B0); PG8_BAR; PG8_SCHED;
            PG8_STAGE(PG8_SB(1, 1), b3 + hstep, voffB);
            PG8_WAIT_V(6); PG8_BAR; PG8_MMA(1, 1, At, B1); PG8_BAR;
            }
        }
        if constexpr (ALIGN_EPI) { if (wr == 0) PG8_BAR; }
        E(acc, cur, wr, wc, fr, fq);
        if (!has_next) break;
        if (nxt.seg == 0)
#pragma unroll
        for (int a = 0; a < 2; ++a)
#pragma unroll
            for (int b = 0; b < 2; ++b)
#pragma unroll
                for (int m = 0; m < 4; ++m)
#pragma unroll
                    for (int n = 0; n < 2; ++n) acc[a][b][m][n] = (f32x4){0.f, 0.f, 0.f, 0.f};
        cur = nxt; cA = nA; cB = nB; ++ui;
        if constexpr (ALIGN_EPI) { if (wr == 1) PG8_BAR; }
    }
    PG8_WAIT_V(0);
    if constexpr (!ALIGN_EPI) { if (wr == 0) PG8_BAR; }
    PG8_BAR;
#undef PG8_SA
#undef PG8_SB
#undef PG8_STAGE
#undef PG8_LDA
#undef PG8_LDB
#undef PG8_MMA
#undef PG8_WAIT_V
#undef PG8_WAIT_L
#undef PG8_BAR
#undef PG8_SCHED
}
}

#define LAS __attribute__((address_space(3)))
typedef unsigned short bf16;
typedef short bf16x8 __attribute__((ext_vector_type(8)));
typedef float f32x4 __attribute__((ext_vector_type(4)));
typedef unsigned u32x4 __attribute__((ext_vector_type(4)));
typedef unsigned u32x2 __attribute__((ext_vector_type(2)));
using pg8::cvt_pk_bf16;

constexpr int NWAVES = 8, NTHR = 512;
constexpr int DM = 2048, MP = 8192, MS = 1024, MT = 9216, TP = 2048, TS = 8;
constexpr int NIN = 11288, NPROJ = 11264, NPROJ_PAD = 11520, DFF = 5632;
constexpr int C_MQ = 0, C_MK = 1024, C_MV = 2048, C_MO = 3072, C_GQ = 4096, C_GK = 4608, C_GV = 5120, C_GR = 6144, C_GA = 7168, C_GB = 9216;
constexpr float EPS = 1e-6f;
constexpr int NCH = 16;
constexpr int LDS_BYTES = 147456;

constexpr size_t O_YP = 0, O_YS = 16777216, O_PC = 18874368, O_PN = 19922944, O_PM = 19927040, O_PS = 19927056, O_PCONV = 20451344,
                 O_SC = 20496400, O_SN = 54050832, O_SM = 54181904, O_SS = 54182416, O_SCONV = 70959632;

constexpr size_t MiB = 1u << 20;
constexpr size_t WS_GATES = 64 * 1024;
constexpr size_t WS_PART = WS_GATES + (size_t)MT * 32 * 4;
constexpr size_t WS_DN = WS_PART + (size_t)MT * 32 * 4;
constexpr size_t WS_NPREV = WS_DN + 256 * 256 * 4;
constexpr size_t WS_CHS = WS_NPREV + 256 * 256 * 2;
constexpr size_t WS_BEND = WS_CHS + 256 * 2 * 4;
constexpr size_t WS_RSTD = WS_BEND + 256 * 128 * 4;
static_assert(WS_RSTD + MT * 4 <= 4 * MiB, "small region");
constexpr size_t WS_WIN = 4 * MiB;
constexpr size_t WS_WA = WS_WIN + (size_t)NPROJ_PAD * DM * 2;
constexpr size_t WS_WB = WS_WA + (size_t)2048 * 1024 * 2;
constexpr size_t WS_WO = WS_WB + (size_t)2048 * 1024 * 2;
constexpr size_t WS_WUG = WS_WO + (size_t)2048 * 2048 * 2;
constexpr size_t WS_WD = WS_WUG + (size_t)2 * DFF * DM * 2;
constexpr size_t WS_R1 = WS_WD + (size_t)DM * DFF * 2;
static_assert(WS_R1 == 131 * MiB, "map");
constexpr size_t WS_XN = WS_R1;
constexpr size_t WS_X1W = WS_R1 + 36 * MiB;
constexpr size_t WS_X1 = WS_R1 + 72 * MiB;
constexpr size_t WS_DC = WS_R1;
constexpr size_t WS_DS = WS_R1 + 64 * MiB;
constexpr size_t WS_CT = WS_R1 + 96 * MiB;
constexpr size_t WS_ST = WS_R1 + 128 * MiB;
constexpr size_t WS_YM = WS_R1 + 144 * MiB;
constexpr size_t WS_YG = WS_YM + 18 * MiB;
constexpr size_t WS_PROJ = WS_YG + 18 * MiB;
constexpr size_t WS_U = WS_PROJ, WS_G = WS_PROJ + 99 * MiB;
constexpr size_t WS_END = WS_PROJ + 198 * MiB;
static_assert(WS_END == 509 * MiB, "map");

struct Args {
    const float* in[25]; float* out; unsigned char* ws; int ph_lo, ph_hi;
};
enum { I_XP = 0, I_XS, I_C, I_N, I_M, I_S, I_CONV, I_WIN, I_BI, I_BF, I_AUP, I_AB, I_MHW, I_GHW, I_WA, I_WB, I_WO, I_NMIX, I_NFFN, I_WUP, I_WGATE, I_CW, I_CB, I_WDOWN, I_FNW };

__device__ __forceinline__ float bf2f(unsigned short b) { return __builtin_bit_cast(float, (unsigned)b << 16); }
__device__ __forceinline__ float bflo(unsigned w) { return __builtin_bit_cast(float, w << 16); }
__device__ __forceinline__ float bfhi(unsigned w) { return __builtin_bit_cast(float, w & 0xffff0000u); }
__device__ __forceinline__ unsigned short f2bf(float f) { return (unsigned short)(cvt_pk_bf16(f, 0.f) & 0xffffu); }
__device__ __forceinline__ float logsig(float z) { return fminf(z, 0.f) - log1pf(__expf(-fabsf(z))); }
__device__ __forceinline__ float sigm(float z) { return 1.f / (1.f + __expf(-z)); }
__device__ __forceinline__ float wave_sum(float v) {
#pragma unroll
    for (int o = 1; o < 64; o <<= 1) v += __shfl_xor(v, o);
    return v;
}
__device__ __forceinline__ float wave_max(float v) {
#pragma unroll
    for (int o = 1; o < 64; o <<= 1) v = fmaxf(v, __shfl_xor(v, o));
    return v;
}
__device__ __forceinline__ float sum4(f32x4 v) { return (v.x + v.y) + (v.z + v.w); }
__device__ __forceinline__ float dot4(f32x4 a, f32x4 b) { return (a.x * b.x + a.y * b.y) + (a.z * b.z + a.w * b.w); }
__device__ __forceinline__ float gelu_tanh(float v) { const float u = 0.7978845608028654f * (v + 0.044715f * v * v * v); return v * sigm(2.f * u); }

typedef f32x4 AccT[2][2][4][2];
struct EpiProj {
    static constexpr bool PERM = true;
    bf16* P; float* gates;
    __device__ __forceinline__ void operator()(AccT& acc, const pg8::Unit& u, int wr, int wc, int fr, int fq) const {
        const int row0 = u.pm * 256 + wr * 64 + fr;
        if (u.pn < 44) {
            const int col0 = u.pn * 256 + wc * 32 + 8 * fq;
#pragma unroll
            for (int ai = 0; ai < 2; ++ai)
#pragma unroll
                for (int m = 0; m < 4; ++m) { bf16* rowp = P + (size_t)(row0 + ai * 128 + m * 16) * NPROJ + col0;
#pragma unroll
                    for (int bj = 0; bj < 2; ++bj) { const f32x4 v0 = acc[ai][bj][m][0], v1 = acc[ai][bj][m][1]; u32x4 w;
                        w.x = cvt_pk_bf16(v0[0], v0[1]); w.y = cvt_pk_bf16(v0[2], v0[3]); w.z = cvt_pk_bf16(v1[0], v1[1]); w.w = cvt_pk_bf16(v1[2], v1[3]);
                        *(u32x4*)(rowp + bj * 128) = w; } }
        } else if (wc == 0) {
#pragma unroll
            for (int ai = 0; ai < 2; ++ai)
#pragma unroll
                for (int m = 0; m < 4; ++m) { float* rowp = gates + (size_t)(row0 + ai * 128 + m * 16) * 32 + 8 * fq;
                    *(f32x4*)rowp = acc[ai][0][m][0]; *(f32x4*)(rowp + 4) = acc[ai][0][m][1]; }
        }
    }
};
struct EpiBranch {
    static constexpr bool PERM = true;
    const bf16* P; bf16* O;
    __device__ __forceinline__ void operator()(AccT& acc, const pg8::Unit& u, int wr, int wc, int fr, int fq) const {
        const int row0 = u.pm * 256 + wr * 64 + fr, col0 = u.pn * 256 + wc * 32 + 8 * fq;
#pragma unroll
        for (int ai = 0; ai < 2; ++ai)
#pragma unroll
            for (int m = 0; m < 4; ++m) { const int row = row0 + ai * 128 + m * 16;
#pragma unroll
                for (int bj = 0; bj < 2; ++bj) { const int col = col0 + bj * 128;
                    const u32x4 ga = *(const u32x4*)(P + (size_t)row * NPROJ + C_GA + col), gb = *(const u32x4*)(P + (size_t)row * NPROJ + C_GB + col);
                    float fa[8] = {bflo(ga.x), bfhi(ga.x), bflo(ga.y), bfhi(ga.y), bflo(ga.z), bfhi(ga.z), bflo(ga.w), bfhi(ga.w)};
                    float fb[8] = {bflo(gb.x), bfhi(gb.x), bflo(gb.y), bfhi(gb.y), bflo(gb.z), bfhi(gb.z), bflo(gb.w), bfhi(gb.w)};
                    if (u.seg == 0) {
#pragma unroll
                        for (int i = 0; i < 8; ++i) { const float r = (1.f + __expf(-fb[i])) / (1.f + __expf(-fa[i])); acc[ai][bj][m][i >> 2][i & 3] *= r; }
                    } else {
                        float o[8];
#pragma unroll
                        for (int i = 0; i < 8; ++i) o[i] = acc[ai][bj][m][i >> 2][i & 3] * sigm(fb[i]);
                        u32x4 w; w.x = cvt_pk_bf16(o[0], o[1]); w.y = cvt_pk_bf16(o[2], o[3]); w.z = cvt_pk_bf16(o[4], o[5]); w.w = cvt_pk_bf16(o[6], o[7]);
                        *(u32x4*)(O + (size_t)row * DM + col) = w;
                    } } }
    }
};
struct EpiOut {
    static constexpr bool PERM = true;
    const float* xp; const float* xs; float* X1; bf16* X1W; const float* nw; float* part;
    __device__ __forceinline__ void operator()(AccT& acc, const pg8::Unit& u, int wr, int wc, int fr, int fq) const {
        const int row0 = u.pm * 256 + wr * 64 + fr, col0 = u.pn * 256 + wc * 32 + 8 * fq;
#pragma unroll
        for (int ai = 0; ai < 2; ++ai)
#pragma unroll
            for (int m = 0; m < 4; ++m) { const int row = row0 + ai * 128 + m * 16;
                const float* xrow = row < MP ? xp + (size_t)row * DM : xs + (size_t)(row - MP) * DM;
                float ss = 0.f;
#pragma unroll
                for (int bj = 0; bj < 2; ++bj) { const int col = col0 + bj * 128;
                    const f32x4 v0 = acc[ai][bj][m][0] + *(const f32x4*)(xrow + col), v1 = acc[ai][bj][m][1] + *(const f32x4*)(xrow + col + 4);
                    *(f32x4*)(X1 + (size_t)row * DM + col) = v0; *(f32x4*)(X1 + (size_t)row * DM + col + 4) = v1;
                    ss += dot4(v0, v0) + dot4(v1, v1);
                    const f32x4 w0 = *(const f32x4*)(nw + col), w1 = *(const f32x4*)(nw + col + 4);
                    u32x4 w; w.x = cvt_pk_bf16(v0[0] * w0[0], v0[1] * w0[1]); w.y = cvt_pk_bf16(v0[2] * w0[2], v0[3] * w0[3]);
                    w.z = cvt_pk_bf16(v1[0] * w1[0], v1[1] * w1[1]); w.w = cvt_pk_bf16(v1[2] * w1[2], v1[3] * w1[3]);
                    *(u32x4*)(X1W + (size_t)row * DM + col) = w; }
                ss += __shfl_xor(ss, 16); ss += __shfl_xor(ss, 32);
                if (fq == 0) part[(size_t)row * 32 + u.pn * 4 + wc] = ss; }
    }
};
#define DPP_MOV(ctrl, oldv, srcv) __builtin_bit_cast(float, __builtin_amdgcn_update_dpp(__builtin_bit_cast(int, (float)(oldv)), __builtin_bit_cast(int, (float)(srcv)), (ctrl), 0xf, 0xf, false))
struct EpiUGAct {
    static constexpr bool PERM = true;
    const float* rstd; bf16* ACT; float* out; const float* cw; const float* cb; const float* cst; float* ub; LAS float* xch;
    __device__ __forceinline__ void operator()(AccT& acc, const pg8::Unit& u, int wr, int wc, int fr, int fq) const {
        const int row0 = u.pm * 256 + wr * 64 + fr, col = u.pn * 128 + wc * 32 + 8 * fq;
        const bool sample = u.pm >= 32;
#pragma unroll
        for (int ai = 0; ai < 2; ++ai)
#pragma unroll
            for (int m = 0; m < 4; ++m) { const int row = row0 + ai * 128 + m * 16;
                const float r = rstd[row];
                acc[ai][0][m][0] = acc[ai][0][m][0] * r; acc[ai][0][m][1] = acc[ai][0][m][1] * r; acc[ai][1][m][0] = acc[ai][1][m][0] * r; acc[ai][1][m][1] = acc[ai][1][m][1] * r;
                float* cs = nullptr;
                if (row < MP) { const int t = row & (TP - 1); if (t >= TP - 2) cs = out + O_PCONV + ((size_t)(row >> 11) * 2 + (t - (TP - 2))) * DFF + col; }
                else { const int rr = row - MP, t = rr & 7; if (t >= 6) cs = out + O_SCONV + ((size_t)(rr >> 3) * 2 + (t - 6)) * DFF + col; }
                if (cs) { *(f32x4*)cs = acc[ai][0][m][0]; *(f32x4*)(cs + 4) = acc[ai][0][m][1]; } }
        if (fr >= 14) {
#pragma unroll
            for (int ai = 0; ai < 2; ++ai) { LAS float* p = xch + ((((ai * 2 + wr) * 4 + wc) * 2 + (fr - 14)) * 4 + fq) * 8; *(LAS f32x4*)p = acc[ai][0][3][0]; *(LAS f32x4*)(p + 4) = acc[ai][0][3][1]; }
            if (!sample && wr == 1) { float* p = ub + ((size_t)u.pm * 6 + (fr - 14)) * DFF + col; *(f32x4*)p = acc[1][0][3][0]; *(f32x4*)(p + 4) = acc[1][0][3][1]; }
        }
        if (!sample && wr == 0 && fr < 2) { float* p = ub + ((size_t)u.pm * 6 + 2 + fr) * DFF + col; *(f32x4*)p = acc[0][0][0][0]; *(f32x4*)(p + 4) = acc[0][0][0][1];
            p += 2 * DFF; *(f32x4*)p = acc[0][1][0][0]; *(f32x4*)(p + 4) = acc[0][1][0][1]; }
        asm volatile("s_waitcnt lgkmcnt(0)" ::: "memory"); __builtin_amdgcn_s_barrier();
        const f32x4 k0a = *(const f32x4*)(cw + col), k0b = *(const f32x4*)(cw + col + 4), k1a = *(const f32x4*)(cw + DFF + col), k1b = *(const f32x4*)(cw + DFF + col + 4);
        const f32x4 k2a = *(const f32x4*)(cw + 2 * DFF + col), k2b = *(const f32x4*)(cw + 2 * DFF + col + 4), cba = *(const f32x4*)(cb + col), cbb = *(const f32x4*)(cb + col + 4);
#pragma unroll
        for (int ai = 0; ai < 2; ++ai) {
            f32x4 pe0 = {0.f, 0.f, 0.f, 0.f}, pe1 = {0.f, 0.f, 0.f, 0.f};
            if (!(ai == 0 && wr == 0) && fr >= 14) { const int sai = (wr == 1) ? ai : ai - 1, swr = wr ^ 1;
                const LAS float* p = xch + ((((sai * 2 + swr) * 4 + wc) * 2 + (fr - 14)) * 4 + fq) * 8; pe0 = *(const LAS f32x4*)p; pe1 = *(const LAS f32x4*)(p + 4); }
#pragma unroll
            for (int m = 0; m < 4; ++m) { const int row = row0 + ai * 128 + m * 16;
                const f32x4 c0 = acc[ai][0][m][0], c1 = acc[ai][0][m][1], v0 = m ? acc[ai][0][m ? m - 1 : 0][0] : pe0, v1 = m ? acc[ai][0][m ? m - 1 : 0][1] : pe1;
                float cur[8] = {c0[0], c0[1], c0[2], c0[3], c1[0], c1[1], c1[2], c1[3]}, prv[8] = {v0[0], v0[1], v0[2], v0[3], v1[0], v1[1], v1[2], v1[3]};
                float p1[8], p2[8];
#pragma unroll
                for (int i = 0; i < 8; ++i) { const float y1 = DPP_MOV(0x121, 0.f, prv[i]); p1[i] = DPP_MOV(0x111, y1, cur[i]); const float y2 = DPP_MOV(0x122, 0.f, prv[i]); p2[i] = DPP_MOV(0x112, y2, cur[i]); }
                if (sample) { const int t = fr & 7;
                    if (t < 2) { const float* st = cst + (size_t)((row - MP) >> 3) * 2 * DFF + col;
                        const f32x4 s1a = *(const f32x4*)(st + DFF), s1b = *(const f32x4*)(st + DFF + 4);
                        if (t == 0) { const f32x4 s0a = *(const f32x4*)st, s0b = *(const f32x4*)(st + 4);
#pragma unroll
                            for (int i = 0; i < 4; ++i) { p1[i] = s1a[i]; p1[4 + i] = s1b[i]; p2[i] = s0a[i]; p2[4 + i] = s0b[i]; } }
                        else {
#pragma unroll
                            for (int i = 0; i < 4; ++i) { p2[i] = s1a[i]; p2[4 + i] = s1b[i]; } } } }
                const f32x4 g0 = acc[ai][1][m][0], g1 = acc[ai][1][m][1];
                float o[8];
#pragma unroll
                for (int i = 0; i < 4; ++i) { o[i] = gelu_tanh(cba[i] + k0a[i] * p2[i] + k1a[i] * p1[i] + k2a[i] * cur[i]) * g0[i];
                    o[4 + i] = gelu_tanh(cbb[i] + k0b[i] * p2[4 + i] + k1b[i] * p1[4 + i] + k2b[i] * cur[4 + i]) * g1[i]; }
                u32x4 w; w.x = cvt_pk_bf16(o[0], o[1]); w.y = cvt_pk_bf16(o[2], o[3]); w.z = cvt_pk_bf16(o[4], o[5]); w.w = cvt_pk_bf16(o[6], o[7]);
                *(u32x4*)(ACT + (size_t)row * DFF + col) = w; }
        }
    }
};
struct EpiDown {
    static constexpr bool PERM = true;
    const float* X1; float* out; float* tailp;
    __device__ __forceinline__ void operator()(AccT& acc, const pg8::Unit& u, int wr, int wc, int fr, int fq) const {
        if (u.tail < 0) {
            const int row0 = u.pm * 256 + wr * 64 + fr, col0 = u.pn * 256 + wc * 32 + 8 * fq;
#pragma unroll
            for (int ai = 0; ai < 2; ++ai)
#pragma unroll
                for (int m = 0; m < 4; ++m) { const int row = row0 + ai * 128 + m * 16;
#pragma unroll
                    for (int bj = 0; bj < 2; ++bj) { const int col = col0 + bj * 128;
                        const f32x4 v0 = acc[ai][bj][m][0] + *(const f32x4*)(X1 + (size_t)row * DM + col), v1 = acc[ai][bj][m][1] + *(const f32x4*)(X1 + (size_t)row * DM + col + 4);
                        *(f32x4*)(out + (size_t)row * DM + col) = v0; *(f32x4*)(out + (size_t)row * DM + col + 4) = v1; } }
        } else {
            float* tp = tailp + (size_t)u.tail * 65536 + (wr * 64 + fr) * 256 + wc * 32 + 8 * fq;
#pragma unroll
            for (int ai = 0; ai < 2; ++ai)
#pragma unroll
                for (int m = 0; m < 4; ++m)
#pragma unroll
                    for (int bj = 0; bj < 2; ++bj) { float* p = tp + (ai * 128 + m * 16) * 256 + bj * 128; *(f32x4*)p = acc[ai][bj][m][0]; *(f32x4*)(p + 4) = acc[ai][bj][m][1]; }
        }
    }
};

template <class ColPtr>
__device__ __forceinline__ void transpose_item(const ColPtr& cp, int K, int srcN, bf16* WT, LAS float* scr, int kb, int nb, int lane) {
    const int k0 = 64 * kb, n0 = 64 * nb, kr = lane >> 4, n4 = (lane & 15) * 4;
    const float* src = cp(n0 + n4);
    f32x4 v[16];
#pragma unroll
    for (int i = 0; i < 16; ++i) v[i] = src ? *(const f32x4*)(src + (size_t)(k0 + 4 * i + kr) * srcN) : (f32x4){0.f, 0.f, 0.f, 0.f};
#pragma unroll
    for (int i = 0; i < 16; ++i) { LAS float* d = scr + (4 * i + kr) * 65 + n4; d[0] = v[i][0]; d[1] = v[i][1]; d[2] = v[i][2]; d[3] = v[i][3]; }
    asm volatile("s_waitcnt lgkmcnt(0)" ::: "memory");
    const int c = lane & 7;
#pragma unroll
    for (int j = 0; j < 8; ++j) { const int n = (lane >> 3) + 8 * j; const LAS float* s = scr + (8 * c) * 65 + n;
        u32x4 o; o.x = cvt_pk_bf16(s[0 * 65], s[1 * 65]); o.y = cvt_pk_bf16(s[2 * 65], s[3 * 65]); o.z = cvt_pk_bf16(s[4 * 65], s[5 * 65]); o.w = cvt_pk_bf16(s[6 * 65], s[7 * 65]);
        *(u32x4*)(WT + (size_t)(n0 + n) * K + k0 + 8 * c) = o; }
    asm volatile("s_waitcnt lgkmcnt(0)" ::: "memory");
}
struct ColWin { const float* W; __device__ __forceinline__ const float* operator()(int n) const {
    int c; if (n < 4096) c = n; else if (n < 7168) c = n + 8; else if (n < 11264) c = n + 24; else if (n < 11272) c = 4096 + (n - 11264); else if (n < 11288) c = 7176 + (n - 11272); else return nullptr;
    return W + c; } };
struct ColPlain { const float* W; __device__ __forceinline__ const float* operator()(int n) const { return W + n; } };
struct ColUG { const float* Wu; const float* Wg; __device__ __forceinline__ const float* operator()(int n) const { const int pn = n >> 8, w = n & 255; return w < 128 ? Wu + pn * 128 + w : Wg + pn * 128 + (w - 128); } };

__device__ __forceinline__ void p0_prologue(const Args& a, LAS unsigned char* lds, int vcu, int G) {
    int tid_ = threadIdx.x; asm volatile("" : "+v"(tid_));
    const int tid = tid_, lane = tid & 63, wave = __builtin_amdgcn_readfirstlane(tid >> 6);
    LAS float* scr = (LAS float*)(lds + wave * 16640);
    const int gw = vcu * NWAVES + wave, NGW = G * NWAVES;
    unsigned char* ws = a.ws;
    constexpr int I_WIN_ = 32 * (NPROJ_PAD / 64), I_A = 16 * 32, I_O = 32 * 32, I_UG = 32 * (2 * DFF / 64), I_D = (DFF / 64) * 32;
    constexpr int NITEMS = I_WIN_ + 2 * I_A + I_O + I_UG + I_D;
    for (int it = gw; it < NITEMS; it += NGW) {
        int r = it;
        if (r < I_WIN_) { ColWin cp{a.in[I_WIN]}; const int nblk = NPROJ_PAD / 64; transpose_item(cp, DM, NIN, (bf16*)(ws + WS_WIN), scr, r / nblk, r % nblk, lane); continue; } r -= I_WIN_;
        if (r < I_A) { ColPlain cp{a.in[I_WA]}; transpose_item(cp, 1024, DM, (bf16*)(ws + WS_WA), scr, r / 32, r % 32, lane); continue; } r -= I_A;
        if (r < I_A) { ColPlain cp{a.in[I_WB]}; transpose_item(cp, 1024, DM, (bf16*)(ws + WS_WB), scr, r / 32, r % 32, lane); continue; } r -= I_A;
        if (r < I_O) { ColPlain cp{a.in[I_WO]}; transpose_item(cp, DM, DM, (bf16*)(ws + WS_WO), scr, r / 32, r % 32, lane); continue; } r -= I_O;
        if (r < I_UG) { ColUG cp{a.in[I_WUP], a.in[I_WGATE]}; const int nblk = 2 * DFF / 64; transpose_item(cp, DM, DFF, (bf16*)(ws + WS_WUG), scr, r / nblk, r % nblk, lane); continue; } r -= I_UG;
        { ColPlain cp{a.in[I_WDOWN]}; transpose_item(cp, DFF, DM, (bf16*)(ws + WS_WD), scr, r / 32, r % 32, lane); }
    }
    const float* nw = a.in[I_NMIX]; bf16* XN = (bf16*)(ws + WS_XN);
    for (int m = gw; m < MT; m += NGW) {
        const float* xrow = m < MP ? a.in[I_XP] + (size_t)m * DM : a.in[I_XS] + (size_t)(m - MP) * DM;
        f32x4 v[8]; float s = 0.f;
#pragma unroll
        for (int j = 0; j < 8; ++j) { v[j] = *(const f32x4*)(xrow + 4 * lane + 256 * j); s += dot4(v[j], v[j]); }
        const float r = rsqrtf(wave_sum(s) * (1.f / DM) + EPS);
#pragma unroll
        for (int j = 0; j < 8; ++j) { const f32x4 w = *(const f32x4*)(nw + 4 * lane + 256 * j); u32x2 o; o.x = cvt_pk_bf16(v[j][0] * r * w[0], v[j][1] * r * w[1]); o.y = cvt_pk_bf16(v[j][2] * r * w[2], v[j][3] * r * w[3]);
            *(u32x2*)(XN + (size_t)m * DM + 4 * lane + 256 * j) = o; }
    }
}

__device__ __forceinline__ void stage_v(LAS bf16* Vs, const bf16* P, int row0, int colbase, int tid) {
#pragma unroll
    for (int i = 0; i < 8; ++i) { const int idx = tid + NTHR * i, s = idx >> 5, p = idx & 31;
        *(LAS u32x4*)(Vs + s * 272 + p * 8) = *(const u32x4*)(P + (size_t)(row0 + s) * NPROJ + colbase + 8 * p); }
}
typedef short v4i16_t __attribute__((ext_vector_type(4)));
__device__ __forceinline__ u32x2 tr64(const LAS bf16* p) { return __builtin_bit_cast(u32x2, __builtin_amdgcn_ds_read_tr16_b64_v4i16((LAS v4i16_t*)p)); }
__device__ __forceinline__ bf16x8 tr_frag(const LAS bf16* img, int RS, int c0, int ks, int lane) {
    const int g = lane >> 4, q = (lane & 15) >> 2, p = lane & 3;
    const LAS bf16* a = img + (32 * ks + 4 * g + q) * RS + c0 + 4 * p;
    const u32x2 lo = tr64(a), hi = tr64(a + 16 * RS);
    u32x4 w; w.x = lo.x; w.y = lo.y; w.z = hi.x; w.w = hi.y;
    return __builtin_bit_cast(bf16x8, w);
}
__device__ __forceinline__ float wave_iscan_add(float v, int lane) {
#pragma unroll
    for (int o = 1; o < 64; o <<= 1) { const float t = __shfl_up(v, o); if (lane >= o) v += t; }
    return v;
}
__device__ __forceinline__ float wave_iscan_max(float v, int lane) {
#pragma unroll
    for (int o = 1; o < 64; o <<= 1) { const float t = __shfl_up(v, o); if (lane >= o) v = fmaxf(v, t); }
    return v;
}

__device__ __forceinline__ void gla_logdecay(const Args& a, const float* gates, int row0, int h, LAS float* galS, LAS float* segS, int tid, float (&la)[32], float& off, float& tot) {
    const int d = tid & 127, seg = tid >> 7;
    { const int t = tid >> 2, q = tid & 3; *(LAS f32x4*)(galS + t * 16 + q * 4) = *(const f32x4*)(gates + (size_t)(row0 + t) * 32 + 8 + q * 4); }
    float up[16];
#pragma unroll
    for (int j = 0; j < 16; ++j) up[j] = a.in[I_AUP][j * 512 + h * 128 + d];
    const float ab = a.in[I_AB][h * 128 + d];
    __syncthreads();
    float ssum = 0.f;
#pragma unroll
    for (int i = 0; i < 32; ++i) { const int t = seg * 32 + i; float z = ab;
#pragma unroll
        for (int q = 0; q < 4; ++q) { const f32x4 g = *(const LAS f32x4*)(galS + t * 16 + q * 4); z += g[0] * up[4 * q] + g[1] * up[4 * q + 1] + g[2] * up[4 * q + 2] + g[3] * up[4 * q + 3]; }
        la[i] = logsig(z) * (1.f / 16.f); ssum += la[i]; }
    segS[seg * 128 + d] = ssum;
    __syncthreads();
    off = 0.f; tot = 0.f;
#pragma unroll
    for (int s = 0; s < 4; ++s) { const float v = segS[s * 128 + d]; tot += v; off += (s < seg) ? v : 0.f; }
}

template <bool ML>
__device__ __forceinline__ void chunk_state(const Args& a, LAS unsigned char* lds, int bh, int c) {
    constexpr int DK = ML ? 256 : 128, NDT = DK / 16, RSK = DK + 16;
    int tid_ = threadIdx.x; asm volatile("" : "+v"(tid_));
    const int tid = tid_, lane = tid & 63, wave = __builtin_amdgcn_readfirstlane(tid >> 6), fr = lane & 15, fq = lane >> 4;
    const int b = bh >> 2, h = bh & 3, row0 = b * TP + c * 128, item = bh * NCH + c;
    unsigned char* ws = a.ws;
    const bf16* P = (const bf16*)(ws + WS_PROJ); const float* gates = (const float*)(ws + WS_GATES);
    LAS bf16* Ks = (LAS bf16*)lds; LAS bf16* Vs = (LAS bf16*)(lds + 69632); LAS float* sc = (LAS float*)(lds + 139264);
    __syncthreads();
    stage_v(Vs, P, row0, (ML ? C_MV : C_GV) + h * 256, tid);
    if (ML) {
        if (wave == 0) {
            const int t0 = 2 * lane;
            const float lf0 = logsig(gates[(size_t)(row0 + t0) * 32 + 4 + h] + a.in[I_BF][h]), lf1 = logsig(gates[(size_t)(row0 + t0 + 1) * 32 + 4 + h] + a.in[I_BF][h]);
            const float i0 = gates[(size_t)(row0 + t0) * 32 + h] + a.in[I_BI][h], i1 = gates[(size_t)(row0 + t0 + 1) * 32 + h] + a.in[I_BI][h];
            const float pr = lf0 + lf1, S = wave_iscan_add(pr, lane), ex = S - pr;
            const float ah0 = i0 - (ex + lf0), ah1 = i1 - S;
            const float Ah = wave_max(fmaxf(ah0, ah1));
            sc[t0] = __expf(ah0 - Ah) * (1.f / 16.f); sc[t0 + 1] = __expf(ah1 - Ah) * (1.f / 16.f);
            if (lane == 63) { float* chs = (float*)(ws + WS_CHS); chs[item * 2] = Ah; chs[item * 2 + 1] = S; }
        }
        __syncthreads();
#pragma unroll
        for (int i = 0; i < 8; ++i) { const int idx = tid + NTHR * i, s = idx >> 5, dp = idx & 31; const float w = sc[s];
            const u32x4 v = *(const u32x4*)(P + (size_t)(row0 + s) * NPROJ + C_MK + h * 256 + 8 * dp);
            u32x4 o; o.x = cvt_pk_bf16(bflo(v.x) * w, bfhi(v.x) * w); o.y = cvt_pk_bf16(bflo(v.y) * w, bfhi(v.y) * w); o.z = cvt_pk_bf16(bflo(v.z) * w, bfhi(v.z) * w); o.w = cvt_pk_bf16(bflo(v.w) * w, bfhi(v.w) * w);
            *(LAS u32x4*)(Ks + s * RSK + 8 * dp) = o; }
    } else {
        float la[32], off, tot;
        LAS float* galS = (LAS float*)(lds + 36864); gla_logdecay(a, gates, row0, h, galS, galS + 2048, tid, la, off, tot);
        const int d = tid & 127, seg = tid >> 7;
        if (seg == 0) ((float*)(ws + WS_BEND))[item * 128 + d] = tot;
        float bcur = off;
#pragma unroll
        for (int i = 0; i < 32; ++i) { const int t = seg * 32 + i; bcur += la[i];
            const float kv = bf2f(P[(size_t)(row0 + t) * NPROJ + C_GK + h * 128 + d]);
            Ks[t * RSK + d] = f2bf(kv * __expf(tot - bcur)); }
    }
    __syncthreads();
    f32x4 acc[2][NDT];
#pragma unroll
    for (int e = 0; e < 2; ++e)
#pragma unroll
        for (int d = 0; d < NDT; ++d) acc[e][d] = (f32x4){0.f, 0.f, 0.f, 0.f};
#pragma unroll
    for (int ks = 0; ks < 4; ++ks) {
        bf16x8 vb[2];
#pragma unroll
        for (int e = 0; e < 2; ++e) vb[e] = tr_frag(Vs, 272, wave * 32 + e * 16, ks, lane);
#pragma unroll
        for (int d = 0; d < NDT; ++d) { const bf16x8 ka = tr_frag(Ks, RSK, d * 16, ks, lane);
#pragma unroll
            for (int e = 0; e < 2; ++e) acc[e][d] = __builtin_amdgcn_mfma_f32_16x16x32_bf16(ka, vb[e], acc[e][d], 0, 0, 0); }
    }
    float* dst = (float*)(ws + (ML ? WS_DC : WS_DS)) + (size_t)item * 256 * DK;
#pragma unroll
    for (int e = 0; e < 2; ++e)
#pragma unroll
        for (int d = 0; d < NDT; ++d) *(f32x4*)(dst + (size_t)(wave * 32 + e * 16 + fr) * DK + d * 16 + 4 * fq) = acc[e][d];
    if (ML && tid < 256) { float s = 0.f;
#pragma unroll 16
        for (int i = 0; i < 128; ++i) s += bf2f(Ks[i * RSK + tid]);
        ((float*)(ws + WS_DN))[item * 256 + tid] = s; }
}

__device__ __forceinline__ void scan_mlstm(const Args& a, int j) {
    int tid_ = threadIdx.x; asm volatile("" : "+v"(tid_));
    const int tid = tid_, bh = j >> 5, eb = j & 31;
    unsigned char* ws = a.ws;
    const float* chs = (const float*)(ws + WS_CHS);
    const int e = eb * 8 + (tid >> 6), d4 = (tid & 63) * 4;
    const float* dC = (const float*)(ws + WS_DC) + (size_t)bh * NCH * 65536 + (size_t)e * 256 + d4;
    bf16* CT = (bf16*)(ws + WS_CT) + (size_t)bh * NCH * 65536 + (size_t)e * 256 + d4;
    f32x4 Cv = {0.f, 0.f, 0.f, 0.f}; float Fs = 0.f, Mp = 0.f;
    const bool do_n = (eb == 0 && tid < 256);
    float nv = 0.f;
    f32x4 dv[NCH];
#pragma unroll
    for (int c = 0; c < NCH; ++c) dv[c] = *(const f32x4*)(dC + (size_t)c * 65536);
#pragma unroll
    for (int c = 0; c < NCH; ++c) {
        u32x2 o; o.x = cvt_pk_bf16(Cv[0], Cv[1]); o.y = cvt_pk_bf16(Cv[2], Cv[3]); *(u32x2*)(CT + (size_t)c * 65536) = o;
        if (do_n) ((bf16*)(ws + WS_NPREV))[(bh * NCH + c) * 256 + tid] = f2bf(nv);
        const float Ah = chs[(bh * NCH + c) * 2], bt = chs[(bh * NCH + c) * 2 + 1];
        const float Ac = Ah - Fs, Mn = fmaxf(Mp, Ac), f1 = __expf(Mp - Mn), f2 = __expf(Ac - Mn);
        Cv = Cv * f1 + dv[c] * f2;
        if (do_n) nv = nv * f1 + ((const float*)(ws + WS_DN))[(bh * NCH + c) * 256 + tid] * f2;
        Mp = Mn; Fs += bt;
    }
    float* oC = a.out + O_PC + (size_t)bh * 65536;
#pragma unroll
    for (int i = 0; i < 4; ++i) oC[(size_t)(d4 + i) * 256 + e] = Cv[i];
    if (do_n) a.out[O_PN + bh * 256 + tid] = nv;
    if (eb == 0 && tid == 0) a.out[O_PM + bh] = Fs + Mp;
}
__device__ __forceinline__ void scan_gla(const Args& a, int j) {
    int tid_ = threadIdx.x; asm volatile("" : "+v"(tid_));
    const int tid = tid_, bh = j >> 4, eb = j & 15;
    unsigned char* ws = a.ws;
    const float* bend = (const float*)(ws + WS_BEND);
    const int ee = eb * 16 + (tid >> 5), d4 = (tid & 31) * 4;
    const float* dS = (const float*)(ws + WS_DS) + (size_t)bh * NCH * 32768 + (size_t)ee * 128 + d4;
    bf16* ST = (bf16*)(ws + WS_ST) + (size_t)bh * NCH * 32768 + (size_t)ee * 128 + d4;
    f32x4 Sv = {0.f, 0.f, 0.f, 0.f};
    f32x4 dv[NCH];
#pragma unroll
    for (int c = 0; c < NCH; ++c) dv[c] = *(const f32x4*)(dS + (size_t)c * 32768);
#pragma unroll
    for (int c = 0; c < NCH; ++c) {
        u32x2 o; o.x = cvt_pk_bf16(Sv[0], Sv[1]); o.y = cvt_pk_bf16(Sv[2], Sv[3]); *(u32x2*)(ST + (size_t)c * 32768) = o;
        const f32x4 be = *(const f32x4*)(bend + (bh * NCH + c) * 128 + d4);
        Sv[0] = Sv[0] * __expf(be[0]) + dv[c][0]; Sv[1] = Sv[1] * __expf(be[1]) + dv[c][1]; Sv[2] = Sv[2] * __expf(be[2]) + dv[c][2]; Sv[3] = Sv[3] * __expf(be[3]) + dv[c][3];
    }
    float* oS = a.out + O_PS + (size_t)bh * 32768;
#pragma unroll
    for (int i = 0; i < 4; ++i) oS[(size_t)(d4 + i) * 256 + ee] = Sv[i];
}

template <bool ML>
__device__ __forceinline__ void chunk_out(const Args& a, LAS unsigned char* lds, int bh, int c) {
    constexpr int DK = ML ? 256 : 128, QS = DK + 8, NKK = DK / 32;
    int tid_ = threadIdx.x; asm volatile("" : "+v"(tid_));
    const int tid = tid_, lane = tid & 63, wave = __builtin_amdgcn_readfirstlane(tid >> 6), fr = lane & 15, fq = lane >> 4;
    const int b = bh >> 2, h = bh & 3, row0 = b * TP + c * 128, item = bh * NCH + c;
    unsigned char* ws = a.ws;
    const bf16* P = (const bf16*)(ws + WS_PROJ); const float* gates = (const float*)(ws + WS_GATES);
    LAS bf16* Qs = (LAS bf16*)lds; LAS bf16* Ks = Qs + 128 * QS;
    LAS float* sc = (LAS float*)(lds + 143616);
    __syncthreads();
    if (ML) {
        if (wave == 0) {
            const float* chs = (const float*)(ws + WS_CHS);
            const float Ahc = lane < NCH ? chs[(bh * NCH + lane) * 2] : 0.f, btc = lane < NCH ? chs[(bh * NCH + lane) * 2 + 1] : 0.f;
            const float fsx = wave_iscan_add(btc, lane) - btc;
            const float Mp = fmaxf(0.f, wave_max(lane < c ? Ahc - fsx : -3.0e38f)), Fs = wave_sum(lane < c ? btc : 0.f);
            const int t0 = 2 * lane;
            const float lf0 = logsig(gates[(size_t)(row0 + t0) * 32 + 4 + h] + a.in[I_BF][h]), lf1 = logsig(gates[(size_t)(row0 + t0 + 1) * 32 + 4 + h] + a.in[I_BF][h]);
            const float i0 = gates[(size_t)(row0 + t0) * 32 + h] + a.in[I_BI][h], i1 = gates[(size_t)(row0 + t0 + 1) * 32 + h] + a.in[I_BI][h];
            const float pr = lf0 + lf1, S = wave_iscan_add(pr, lane), b0 = S - lf1, b1 = S;
            const float a0 = i0 - b0 - Fs, a1 = i1 - b1 - Fs;
            const float cm = wave_iscan_max(fmaxf(a0, a1), lane); float exm = __shfl_up(cm, 1); if (lane == 0) exm = -3.0e38f;
            const float M0 = fmaxf(fmaxf(Mp, exm), a0), M1 = fmaxf(M0, a1);
            sc[t0] = a0; sc[t0 + 1] = a1; sc[128 + t0] = M0; sc[128 + t0 + 1] = M1; sc[256 + t0] = __expf(Mp - M0); sc[256 + t0 + 1] = __expf(Mp - M1);
            sc[384 + t0] = __expf(-(Fs + b0 + M0)); sc[384 + t0 + 1] = __expf(-(Fs + b1 + M1));
        }
#pragma unroll
        for (int i = 0; i < 8; ++i) { const int idx = tid + NTHR * i, t = idx >> 5, p = idx & 31;
            *(LAS u32x4*)(Qs + t * QS + p * 8) = *(const u32x4*)(P + (size_t)(row0 + t) * NPROJ + C_MQ + h * 256 + p * 8);
            *(LAS u32x4*)(Ks + t * QS + p * 8) = *(const u32x4*)(P + (size_t)(row0 + t) * NPROJ + C_MK + h * 256 + p * 8); }
    } else {
        float la[32], off, tot;
        LAS float* galS = (LAS float*)(lds + 69632); LAS float* segS = galS + 128 * 16;
        gla_logdecay(a, gates, row0, h, galS, segS, tid, la, off, tot);
        const int d = tid & 127, seg = tid >> 7;
        float bcur = off;
#pragma unroll
        for (int i = 0; i < 32; ++i) { const int t = seg * 32 + i; bcur += la[i];
            const float qv = bf2f(P[(size_t)(row0 + t) * NPROJ + C_GQ + h * 128 + d]), kv = bf2f(P[(size_t)(row0 + t) * NPROJ + C_GK + h * 128 + d]);
            Qs[t * QS + d] = f2bf(qv * 0.08838834764831845f * __expf(bcur)); Ks[t * QS + d] = f2bf(kv * __expf(-bcur)); }
    }
    __syncthreads();
    bf16x8 qf[NKK];
#pragma unroll
    for (int kk = 0; kk < NKK; ++kk) qf[kk] = *(const LAS bf16x8*)(Qs + (wave * 16 + fr) * QS + kk * 32 + fq * 8);
    const int t = wave * 16 + fr;
    u32x2 pb[8]; float den = 0.f;
    {
        const float Mt = ML ? sc[128 + t] : 0.f;
#pragma unroll
        for (int st = 0; st < 8; ++st) { f32x4 s = {0.f, 0.f, 0.f, 0.f};
#pragma unroll
            for (int kk = 0; kk < NKK; ++kk) { const bf16x8 kf = *(const LAS bf16x8*)(Ks + (st * 16 + fr) * QS + kk * 32 + fq * 8); s = __builtin_amdgcn_mfma_f32_16x16x32_bf16(kf, qf[kk], s, 0, 0, 0); }
            float p[4];
            f32x4 as4 = {0.f, 0.f, 0.f, 0.f}; if (ML) as4 = *(const LAS f32x4*)(sc + st * 16 + 4 * fq);
#pragma unroll
            for (int r = 0; r < 4; ++r) { const int si = st * 16 + 4 * fq + r;
                const float e = ML ? s[r] * (1.f / 16.f) * __expf(fminf(as4[r] - Mt, 0.f)) : s[r];
                p[r] = (si <= t) ? e : 0.f;
                den += p[r]; }
            pb[st].x = cvt_pk_bf16(p[0], p[1]); pb[st].y = cvt_pk_bf16(p[2], p[3]);
            __builtin_amdgcn_sched_barrier(0); }
    }
    __syncthreads();
    LAS bf16* Cl = (LAS bf16*)lds;
    if (ML) {
        const bf16* CT = (const bf16*)(ws + WS_CT) + (size_t)item * 65536;
#pragma unroll
        for (int i = 0; i < 16; ++i) { const int idx = tid + NTHR * i, e = idx >> 5, p = idx & 31; *(LAS u32x4*)(Cl + e * QS + p * 8) = *(const u32x4*)(CT + (size_t)e * 256 + p * 8); }
        { const int e = tid >> 5, p = tid & 31; u32x4 v = {0u, 0u, 0u, 0u};
          if (e == 0) v = *(const u32x4*)((const bf16*)(ws + WS_NPREV) + (size_t)item * 256 + p * 8);
          *(LAS u32x4*)(Cl + (256 + e) * QS + p * 8) = v; }
    } else {
        const bf16* ST = (const bf16*)(ws + WS_ST) + (size_t)item * 32768;
#pragma unroll
        for (int i = 0; i < 8; ++i) { const int idx = tid + NTHR * i, e = idx >> 4, p = idx & 15; *(LAS u32x4*)(Cl + e * QS + p * 8) = *(const u32x4*)(ST + (size_t)e * 128 + p * 8); }
    }
    __syncthreads();
    f32x4 acc[16];
#pragma unroll
    for (int et = 0; et < 16; ++et) { acc[et] = (f32x4){0.f, 0.f, 0.f, 0.f};
#pragma unroll
        for (int kk = 0; kk < NKK; ++kk) { const bf16x8 cf = *(const LAS bf16x8*)(Cl + (et * 16 + fr) * QS + kk * 32 + fq * 8); acc[et] = __builtin_amdgcn_mfma_f32_16x16x32_bf16(cf, qf[kk], acc[et], 0, 0, 0); }
        if ((et & 1) == 1) __builtin_amdgcn_sched_barrier(0); }
    float wint = 1.f, qn = 0.f;
    if (ML) {
        f32x4 dn = {0.f, 0.f, 0.f, 0.f};
#pragma unroll
        for (int kk = 0; kk < NKK; ++kk) { const bf16x8 nf = *(const LAS bf16x8*)(Cl + (256 + fr) * QS + kk * 32 + fq * 8); dn = __builtin_amdgcn_mfma_f32_16x16x32_bf16(nf, qf[kk], dn, 0, 0, 0); }
        qn = __shfl(dn[0], fr);
        wint = sc[256 + t];
#pragma unroll
        for (int et = 0; et < 16; ++et) acc[et] = acc[et] * wint;
    }
    __syncthreads();
    LAS bf16* Vs = (LAS bf16*)lds;
    stage_v(Vs, P, row0, (ML ? C_MV : C_GV) + h * 256, tid);
    __syncthreads();
#pragma unroll
    for (int ks = 0; ks < 4; ++ks) {
        u32x4 pw; pw.x = pb[2 * ks].x; pw.y = pb[2 * ks].y; pw.z = pb[2 * ks + 1].x; pw.w = pb[2 * ks + 1].y;
        const bf16x8 pf = __builtin_bit_cast(bf16x8, pw);
#pragma unroll
        for (int et = 0; et < 16; ++et) { acc[et] = __builtin_amdgcn_mfma_f32_16x16x32_bf16(tr_frag(Vs, 272, et * 16, ks, lane), pf, acc[et], 0, 0, 0); if ((et & 3) == 3) __builtin_amdgcn_sched_barrier(0); }
    }
    float inv = 1.f;
    if (ML) { den += __shfl_xor(den, 16); den += __shfl_xor(den, 32); den += wint * qn; inv = 1.f / fmaxf(fabsf(den), sc[384 + t]); }
    float ss = 0.f;
#pragma unroll
    for (int et = 0; et < 16; ++et) { acc[et] = acc[et] * inv; ss += dot4(acc[et], acc[et]); }
    ss += __shfl_xor(ss, 16); ss += __shfl_xor(ss, 32);
    const float rn = rsqrtf(ss * (1.f / 256.f) + EPS);
    const float* hw = a.in[ML ? I_MHW : I_GHW] + h * 256;
    const bf16* gp = P + (size_t)(row0 + t) * NPROJ + (ML ? C_MO : C_GR) + h * 256;
    bf16* yp = (bf16*)(ws + (ML ? WS_YM : WS_YG)) + (size_t)(row0 + t) * 1024 + h * 256;
#pragma unroll
    for (int et = 0; et < 16; ++et) { const int e = et * 16 + 4 * fq;
        const u32x2 gw = *(const u32x2*)(gp + e); const f32x4 w = *(const f32x4*)(hw + e);
        const float g0 = bflo(gw.x), g1 = bfhi(gw.x), g2 = bflo(gw.y), g3 = bfhi(gw.y);
        float o0 = acc[et][0] * rn * w[0], o1 = acc[et][1] * rn * w[1], o2 = acc[et][2] * rn * w[2], o3 = acc[et][3] * rn * w[3];
        if (ML) { o0 *= sigm(g0); o1 *= sigm(g1); o2 *= sigm(g2); o3 *= sigm(g3); } else { o0 *= g0 * sigm(g0); o1 *= g1 * sigm(g1); o2 *= g2 * sigm(g2); o3 *= g3 * sigm(g3); }
        u32x2 o; o.x = cvt_pk_bf16(o0, o1); o.y = cvt_pk_bf16(o2, o3); *(u32x2*)(yp + e) = o;
        if ((et & 3) == 3) __builtin_amdgcn_sched_barrier(0); }
}

template <bool ML>
__device__ __forceinline__ void sample_item(const Args& a, LAS unsigned char* lds, int b, int h) {
    constexpr int DK = ML ? 256 : 128;
    int tid_ = threadIdx.x; asm volatile("" : "+v"(tid_));
    const int tid = tid_, lane = tid & 63, wave = __builtin_amdgcn_readfirstlane(tid >> 6);
    unsigned char* ws = a.ws;
    const bf16* P = (const bf16*)(ws + WS_PROJ); const float* gates = (const float*)(ws + WS_GATES);
    const int row0 = MP + b * 8, bh = b * 4 + h;
    LAS float* qT = (LAS float*)lds;
    LAS float* wkT = qT + 2048;
    LAS float* kT = wkT + 2048;
    LAS float* vS = kT + 2048;
    LAS float* red = vS + 2048;
    LAS float* sm = red + 16384;
    __syncthreads();
    float aS[8], Mt[8], bS[8]; float m0 = 0.f, dec = 1.f;
    if (ML) {
        m0 = a.in[I_M][bh]; float bs = 0.f, M = m0;
#pragma unroll
        for (int t = 0; t < 8; ++t) { const float mi = gates[(size_t)(row0 + t) * 32 + h], mf = gates[(size_t)(row0 + t) * 32 + 4 + h];
            bs += logsig(mf + a.in[I_BF][h]); bS[t] = bs; aS[t] = mi + a.in[I_BI][h] - bs; M = fmaxf(M, aS[t]); Mt[t] = M; }
        dec = __expf(m0 - Mt[7]);
        if (tid == 0) {
#pragma unroll
            for (int t = 0; t < 8; ++t) { sm[200 + t] = aS[t]; sm[208 + t] = Mt[t]; sm[216 + t] = bS[t]; } }
        if (tid < 256) { const int d = tid;
#pragma unroll
            for (int t = 0; t < 8; ++t) { const float qv = bf2f(P[(size_t)(row0 + t) * NPROJ + C_MQ + h * 256 + d]), kv = bf2f(P[(size_t)(row0 + t) * NPROJ + C_MK + h * 256 + d]) * (1.f / 16.f);
                qT[d * 8 + t] = qv; kT[d * 8 + t] = kv; wkT[d * 8 + t] = kv * __expf(aS[t] - Mt[7]); } }
    } else {
        if (tid < 128) { const int d = tid; float up[16];
#pragma unroll
            for (int j = 0; j < 16; ++j) up[j] = a.in[I_AUP][j * 512 + h * 128 + d];
            const float ab = a.in[I_AB][h * 128 + d];
            float bc[8]; float bs = 0.f;
#pragma unroll
            for (int t = 0; t < 8; ++t) { float z = ab;
#pragma unroll
                for (int j = 0; j < 16; ++j) z += gates[(size_t)(row0 + t) * 32 + 8 + j] * up[j];
                bs += logsig(z) * (1.f / 16.f); bc[t] = bs; }
            sm[72 + d] = __expf(bs);
#pragma unroll
            for (int t = 0; t < 8; ++t) { const float qv = bf2f(P[(size_t)(row0 + t) * NPROJ + C_GQ + h * 128 + d]), kv = bf2f(P[(size_t)(row0 + t) * NPROJ + C_GK + h * 128 + d]);
                qT[d * 8 + t] = qv * 0.08838834764831845f * __expf(bc[t]); kT[d * 8 + t] = kv * __expf(-bc[t]); wkT[d * 8 + t] = kv * __expf(bs - bc[t]); } }
    }
    { const int t = tid >> 6; const u32x2 w = *(const u32x2*)(P + (size_t)(row0 + t) * NPROJ + (ML ? C_MV : C_GV) + h * 256 + 4 * lane);
      *(LAS f32x4*)(vS + t * 256 + 4 * lane) = (f32x4){bflo(w.x), bfhi(w.x), bflo(w.y), bfhi(w.y)}; }
    __syncthreads();
    float prow, qn = 0.f;
    { const int s8 = lane & 7, part = lane >> 3; float sd = 0.f;
#pragma unroll 8
      for (int i = 0; i < DK / 8; ++i) { const int d = 8 * i + part; sd += qT[d * 8 + wave] * kT[d * 8 + s8]; }
      sd += __shfl_xor(sd, 8); sd += __shfl_xor(sd, 16); sd += __shfl_xor(sd, 32);
      if (ML) prow = (s8 <= wave) ? sd * __expf(sm[200 + s8] - sm[208 + wave]) : 0.f; else prow = (s8 <= wave) ? sd : 0.f; }
    if (ML) { const float* n0 = a.in[I_N] + (size_t)bh * 256; float sd = 0.f;
#pragma unroll
      for (int i = 0; i < 4; ++i) { const int d = lane + 64 * i; sd += qT[d * 8 + wave] * n0[d]; }
      qn = wave_sum(sd); }
    const float* C0 = a.in[ML ? I_C : I_S] + (size_t)bh * DK * 256;
    float* C1 = a.out + (ML ? O_SC : O_SS) + (size_t)bh * DK * 256;
    f32x4 v[8], acc[8];
#pragma unroll
    for (int s = 0; s < 8; ++s) { v[s] = *(const LAS f32x4*)(vS + s * 256 + 4 * lane); acc[s] = (f32x4){0.f, 0.f, 0.f, 0.f}; }
#pragma unroll 8
    for (int i = 0; i < DK / 8; ++i) { const int d = wave + 8 * i;
        const f32x4 cv = __builtin_nontemporal_load((const f32x4*)(C0 + (size_t)d * 256 + 4 * lane));
        const f32x4 q0 = *(const LAS f32x4*)(qT + d * 8), q1 = *(const LAS f32x4*)(qT + d * 8 + 4), k0 = *(const LAS f32x4*)(wkT + d * 8), k1 = *(const LAS f32x4*)(wkT + d * 8 + 4);
        const float dd = ML ? dec : sm[72 + d];
        acc[0] += cv * q0[0]; acc[1] += cv * q0[1]; acc[2] += cv * q0[2]; acc[3] += cv * q0[3]; acc[4] += cv * q1[0]; acc[5] += cv * q1[1]; acc[6] += cv * q1[2]; acc[7] += cv * q1[3];
        f32x4 cn = cv * dd;
        cn += v[0] * k0[0]; cn += v[1] * k0[1]; cn += v[2] * k0[2]; cn += v[3] * k0[3]; cn += v[4] * k1[0]; cn += v[5] * k1[1]; cn += v[6] * k1[2]; cn += v[7] * k1[3];
        __builtin_nontemporal_store(cn, (f32x4*)(C1 + (size_t)d * 256 + 4 * lane)); }
#pragma unroll
    for (int s = 0; s < 8; ++s) *(LAS f32x4*)(red + (wave * 8 + s) * 256 + 4 * lane) = acc[s];
    __syncthreads();
    const int t = wave;
    f32x4 qc = {0.f, 0.f, 0.f, 0.f};
#pragma unroll
    for (int w = 0; w < 8; ++w) qc += *(const LAS f32x4*)(red + (w * 8 + t) * 256 + 4 * lane);
    float wint = 1.f, den = 0.f, Mtt = 0.f, btt = 0.f;
    if (ML) { Mtt = sm[208 + t]; btt = sm[216 + t]; wint = __expf(m0 - Mtt); }
    f32x4 num = qc * wint;
#pragma unroll
    for (int s = 0; s < 8; ++s) { const float p = __shfl(prow, s); num += v[s] * p; den += p; }
    if (ML) { den += wint * qn; const float fl = fmaxf(fabsf(den), __expf(-(btt + Mtt))); num = num * (1.f / fl); }
    const float rn = rsqrtf(wave_sum(dot4(num, num)) * (1.f / 256.f) + EPS);
    const f32x4 w = *(const f32x4*)(a.in[ML ? I_MHW : I_GHW] + h * 256 + 4 * lane);
    const u32x2 gw = *(const u32x2*)(P + (size_t)(row0 + t) * NPROJ + (ML ? C_MO : C_GR) + h * 256 + 4 * lane);
    const float g0 = bflo(gw.x), g1 = bfhi(gw.x), g2 = bflo(gw.y), g3 = bfhi(gw.y);
    float o0 = num[0] * rn * w[0], o1 = num[1] * rn * w[1], o2 = num[2] * rn * w[2], o3 = num[3] * rn * w[3];
    if (ML) { o0 *= sigm(g0); o1 *= sigm(g1); o2 *= sigm(g2); o3 *= sigm(g3); } else { o0 *= g0 * sigm(g0); o1 *= g1 * sigm(g1); o2 *= g2 * sigm(g2); o3 *= g3 * sigm(g3); }
    u32x2 o; o.x = cvt_pk_bf16(o0, o1); o.y = cvt_pk_bf16(o2, o3);
    *(u32x2*)((bf16*)(ws + (ML ? WS_YM : WS_YG)) + (size_t)(row0 + t) * 1024 + h * 256 + 4 * lane) = o;
    if (ML) {
        if (tid < 256) { float s = dec * a.in[I_N][(size_t)bh * 256 + tid];
#pragma unroll
            for (int q = 0; q < 8; ++q) s += wkT[tid * 8 + q];
            a.out[O_SN + (size_t)bh * 256 + tid] = s; }
        if (tid == 0) a.out[O_SM + bh] = bS[7] + Mt[7];
    }
}

__device__ __forceinline__ void rstd_phase(const Args& a, int vcu, int G) {
    const float* part = (const float*)(a.ws + WS_PART); float* rstd = (float*)(a.ws + WS_RSTD);
    for (int row = vcu * NTHR + threadIdx.x; row < MT; row += G * NTHR) { float s = 0.f;
#pragma unroll
        for (int i = 0; i < 8; ++i) s += sum4(*(const f32x4*)(part + (size_t)row * 32 + 4 * i));
        rstd[row] = rsqrtf(s * (1.f / DM) + EPS); }
}
__device__ __forceinline__ void act_fixup(const Args& a, int vcu, int G) {
    unsigned char* ws = a.ws; const float* ub = (const float*)(ws + WS_U); bf16* ACT = (bf16*)(ws + WS_G);
    const float* cw = a.in[I_CW]; const float* cb = a.in[I_CB];
    int tid_ = threadIdx.x; asm volatile("" : "+v"(tid_));
    for (int idx = vcu * NTHR + tid_; idx < 28 * DFF; idx += G * NTHR) {
        const int k = idx / DFF, col = idx % DFF, pm = (k / 7) * 8 + 1 + (k % 7);
        const float um2 = ub[((size_t)(pm - 1) * 6 + 0) * DFF + col], um1 = ub[((size_t)(pm - 1) * 6 + 1) * DFF + col];
        const float u0 = ub[((size_t)pm * 6 + 2) * DFF + col], u1 = ub[((size_t)pm * 6 + 3) * DFF + col], g0 = ub[((size_t)pm * 6 + 4) * DFF + col], g1 = ub[((size_t)pm * 6 + 5) * DFF + col];
        const float c0 = cw[col], c1 = cw[DFF + col], c2 = cw[2 * DFF + col], bb = cb[col];
        ACT[(size_t)(pm * 256) * DFF + col] = f2bf(gelu_tanh(bb + c0 * um2 + c1 * um1 + c2 * u0) * g0);
        ACT[(size_t)(pm * 256 + 1) * DFF + col] = f2bf(gelu_tanh(bb + c0 * um1 + c1 * u0 + c2 * u1) * g1);
    }
}
__device__ __forceinline__ void final_norm(const Args& a, int vcu, int G) {
    int tid_ = threadIdx.x; asm volatile("" : "+v"(tid_));
    const int tid = tid_, lane = tid & 63, wave = tid >> 6;
    const float* fw = a.in[I_FNW]; const float* X1 = (const float*)(a.ws + WS_X1); const float* tailp = (const float*)(a.ws + WS_U);
    const bool split = (G == 256);
    int tpm = -1, tpn = -1;
    if (split && lane < 32) { pg8::StaticOrder S; S.init(MT, DM, G, 0); pg8::Unit u; if (S.at(256 + lane, u)) { tpm = u.pm; tpn = u.pn; } }
    for (int m = vcu * NWAVES + wave; m < MT; m += G * NWAVES) {
        const int pm = m >> 8;
        float* row = a.out + (size_t)m * DM;
        f32x4 v[8]; float ss = 0.f;
#pragma unroll
        for (int j = 0; j < 8; ++j) {
            const unsigned long long mask = __ballot(tpm == pm && tpn == j);
            if (mask == 0ull) v[j] = *(const f32x4*)(row + 4 * lane + 256 * j);
            else { const int tt = __ffsll((long long)mask) - 1;
                v[j] = *(const f32x4*)(X1 + (size_t)m * DM + 4 * lane + 256 * j);
                const float* tp = tailp + (size_t)tt * 8 * 65536 + (m & 255) * 256 + 4 * lane;
#pragma unroll
                for (int sl = 0; sl < 8; ++sl) v[j] += *(const f32x4*)(tp + (size_t)sl * 65536); }
            ss += dot4(v[j], v[j]); }
        const float r = rsqrtf(wave_sum(ss) * (1.f / DM) + EPS);
#pragma unroll
        for (int j = 0; j < 8; ++j) { const f32x4 w = *(const f32x4*)(fw + 4 * lane + 256 * j);
            *(f32x4*)(row + 4 * lane + 256 * j) = (f32x4){v[j][0] * r * w[0], v[j][1] * r * w[1], v[j][2] * r * w[2], v[j][3] * r * w[3]}; }
    }
}

#define XB_TMO      128
#define XB_XCNT(j)  (256  + 64 * (j))
#define XB_XSUB(j)  (1280 + 64 * (j))
#define XB_XGEN(j)  (2304 + 64 * (j))
#define XB_TOP      3328
#define XB_TOPGEN   3392
#define XCD_BAR_WORDS 3456
#define XB_SPIN_CAP (1u << 18)

__device__ __forceinline__ unsigned xb_ld(unsigned* p)              { return __hip_atomic_load(p, __ATOMIC_RELAXED, __HIP_MEMORY_SCOPE_AGENT); }
__device__ __forceinline__ unsigned xb_add(unsigned* p, unsigned v) { return __hip_atomic_fetch_add(p, v, __ATOMIC_RELAXED, __HIP_MEMORY_SCOPE_AGENT); }
__device__ __forceinline__ unsigned xb_xcc_id() { return (unsigned)__builtin_amdgcn_s_getreg((3 << 11) | 20) & 0xFu; }
#define XB_SPIN(cond, bar) do { unsigned _sp = 0; while (cond) { __builtin_amdgcn_s_sleep(1); \
    if ((++_sp & 255u) == 0u) { if (xb_ld(&(bar)[XB_TMO])) break; if (_sp > XB_SPIN_CAP) { atomicAdd(&(bar)[XB_TMO], 1u); break; } } } } while (0)

struct XcdBarrier {
    unsigned* bar; unsigned x;
    volatile LAS unsigned* st;
};

__device__ __forceinline__ XcdBarrier xcd_barrier_post(unsigned* bar, volatile LAS unsigned* st) {
    XcdBarrier b; b.bar = bar; b.x = xb_xcc_id(); b.st = st;
    if (threadIdx.x == 0) (void)xb_add(&bar[XB_XCNT(b.x)], 1u);
    return b;
}
__device__ __forceinline__ void xcd_barrier_complete(unsigned* bar, unsigned x, unsigned& nloc, unsigned& nx) {
    const unsigned G = gridDim.x * gridDim.y * gridDim.z;
    unsigned sum, cnt, mine, sp = 0u;
    for (;;) {
        sum = 0u; cnt = 0u; mine = 0u;
#pragma unroll
        for (unsigned j = 0; j < 16; ++j) { const unsigned c = xb_ld(&bar[XB_XCNT(j)]); sum += c; cnt += (c > 0u) ? 1u : 0u; mine = (j == x) ? c : mine; }
        if (sum == G) break;
        __builtin_amdgcn_s_sleep(1);
        if ((++sp & 255u) == 0u) { if (xb_ld(&bar[XB_TMO])) break; if (sp > XB_SPIN_CAP) { atomicAdd(&bar[XB_TMO], 1u); break; } }
    }
    nloc = mine > 0u ? mine : 1u; nx = cnt > 0u ? cnt : 1u;
}

__device__ __forceinline__ void xcd_barrier(const XcdBarrier& b) {
    asm volatile("s_waitcnt vmcnt(0)" ::: "memory");
    __syncthreads();
    if (threadIdx.x == 0) {
        unsigned* bar = b.bar;
        __builtin_amdgcn_s_waitcnt(0);
        unsigned nloc = b.st[0], nx = b.st[1];
        if (nloc == 0u) { xcd_barrier_complete(bar, b.x, nloc, nx); b.st[0] = nloc; b.st[1] = nx; }
        const unsigned old = xb_add(&bar[XB_XSUB(b.x)], 1u);
        const unsigned gen = old / nloc;
        if (old + 1u == (gen + 1u) * nloc) {
            __builtin_amdgcn_fence(__ATOMIC_RELEASE, "agent");
            asm volatile("s_waitcnt vmcnt(0)" ::: "memory");
            const unsigned og = xb_add(&bar[XB_TOP], 1u);
            const unsigned tg = og / nx;
            if (og + 1u == (tg + 1u) * nx) xb_add(&bar[XB_TOPGEN], 1u);
            else XB_SPIN(xb_ld(&bar[XB_TOPGEN]) == tg, bar);
            __builtin_amdgcn_fence(__ATOMIC_ACQUIRE, "agent");
            xb_add(&bar[XB_XGEN(b.x)], 1u);
            asm volatile("s_waitcnt vmcnt(0)" ::: "memory");
        } else {
            XB_SPIN(xb_ld(&bar[XB_XGEN(b.x)]) == gen, bar);
            __builtin_amdgcn_fence(__ATOMIC_ACQUIRE, "agent");
            asm volatile("s_waitcnt vmcnt(0)" ::: "memory");
        }
    }
    __syncthreads();
}

constexpr int N_PHASES = 12;
__global__ void __launch_bounds__(NTHR) fwd_kernel(Args args) {
    extern __shared__ __attribute__((aligned(16))) unsigned char lds_raw[];
    LAS unsigned char* lds = (LAS unsigned char*)lds_raw;
    cg::grid_group grid = cg::this_grid();
    volatile LAS unsigned* bst = (volatile LAS unsigned*)(lds + LDS_BYTES - 16);
    if (threadIdx.x < 4) bst[threadIdx.x] = 0u;
    __syncthreads();
    XcdBarrier xbar = xcd_barrier_post((unsigned*)args.ws, bst);
    const int G = gridDim.x, bx = blockIdx.x;
    const int vcu = (G % 8 == 0) ? (bx % 8) * (G / 8) + bx / 8 : bx;
    const int lo = args.ph_lo, hi = args.ph_hi;
    unsigned char* ws = args.ws;
#ifndef USE_CG_SYNC
#define USE_CG_SYNC 0
#endif
#ifndef DOUBLE_MASK
#define DOUBLE_MASK 0
#endif
#define REP(k) for (int rep_ = 0; rep_ < 1 + ((DOUBLE_MASK >> (k)) & 1); ++rep_)
#ifndef DBL_P2
#define DBL_P2 0
#endif
#ifndef BIS
#define BIS 15
#endif
#ifndef PHASE_MASK
#define PHASE_MASK 0xfff
#endif
#define IN(k) (((PHASE_MASK >> (k)) & 1) && lo <= (k) && (k) < hi)
#define SEAM(k) do { if (IN(k) && IN((k) + 1)) { if (USE_CG_SYNC || lo < 0) grid.sync(); else xcd_barrier(xbar); } } while (0)
    if (IN(0)) REP(0) { p0_prologue(args, lds, vcu, G); __syncthreads(); }
    SEAM(0);
    if (IN(1)) REP(1) {
        pg8::Gemm g{(const bf16*)(ws + WS_XN), (const bf16*)(ws + WS_WIN), nullptr, nullptr, MT, NPROJ_PAD, DM}; pg8::StaticOrder S; S.init(MT, NPROJ_PAD, G, bx);
        EpiProj E{(bf16*)(ws + WS_PROJ), (float*)(ws + WS_GATES)};
        pg8::gemm_phase<EpiProj, pg8::StaticOrder, true, true>(lds, g, S, E);
    }
    SEAM(1);
    if (IN(2)) REP(2) {
        for (int it = bx; it < 1536; it += G) {
            if (it < 512) { for (int r_ = 0; r_ < 1 + (DBL_P2 & 1); ++r_) sample_item<true>(args, lds, it >> 2, it & 3); }
            else if (it < 1024) { for (int r_ = 0; r_ < 1 + ((DBL_P2 >> 1) & 1); ++r_) sample_item<false>(args, lds, (it - 512) >> 2, (it - 512) & 3); }
            else if (it < 1280) { for (int r_ = 0; r_ < 1 + ((DBL_P2 >> 2) & 1); ++r_) chunk_state<true>(args, lds, (it - 1024) >> 4, (it - 1024) & 15); }
            else { for (int r_ = 0; r_ < 1 + ((DBL_P2 >> 3) & 1); ++r_) chunk_state<false>(args, lds, (it - 1280) >> 4, (it - 1280) & 15); }
        }
    }
    SEAM(2);
    if (IN(3)) REP(3) { for (int it = bx; it < 768; it += G) { if (it < 512) scan_mlstm(args, it); else scan_gla(args, it - 512); } }
    SEAM(3);
    if (IN(4)) REP(4) { for (int it = bx; it < 512; it += G) { if (it < 256) { if (BIS & 1) chunk_out<true>(args, lds, it >> 4, it & 15); } else { if (BIS & 2) chunk_out<false>(args, lds, (it - 256) >> 4, (it - 256) & 15); } } __syncthreads(); }
    SEAM(4);
    if (IN(5)) REP(5) {
        pg8::Gemm g{(const bf16*)(ws + WS_YM), (const bf16*)(ws + WS_WA), (const bf16*)(ws + WS_YG), (const bf16*)(ws + WS_WB), MT, DM, 1024}; pg8::TwoSegOrder S; S.S.init(MT, DM, G, bx);
        EpiBranch E{(const bf16*)(ws + WS_PROJ), (bf16*)(ws + WS_XN)};
        pg8::gemm_phase<EpiBranch, pg8::TwoSegOrder, true, true>(lds, g, S, E);
    }
    SEAM(5);
    if (IN(6)) REP(6) {
        pg8::Gemm g{(const bf16*)(ws + WS_XN), (const bf16*)(ws + WS_WO), nullptr, nullptr, MT, DM, DM}; pg8::StaticOrder S; S.init(MT, DM, G, bx);
        EpiOut E{args.in[I_XP], args.in[I_XS], (float*)(ws + WS_X1), (bf16*)(ws + WS_X1W), args.in[I_NFFN], (float*)(ws + WS_PART)};
        pg8::gemm_phase<EpiOut, pg8::StaticOrder, true, true>(lds, g, S, E);
    }
    SEAM(6);
    if (IN(7)) REP(7) rstd_phase(args, vcu, G);
    SEAM(7);
    if (IN(8)) REP(8) {
        pg8::Gemm g{(const bf16*)(ws + WS_X1W), (const bf16*)(ws + WS_WUG), nullptr, nullptr, MT, 2 * DFF, DM}; pg8::StaticOrder S; S.init(MT, 2 * DFF, G, bx);
        EpiUGAct E{(const float*)(ws + WS_RSTD), (bf16*)(ws + WS_G), args.out, args.in[I_CW], args.in[I_CB], args.in[I_CONV], (float*)(ws + WS_U), (LAS float*)(lds + 131072)};
        pg8::gemm_phase<EpiUGAct, pg8::StaticOrder, true, true>(lds, g, S, E);
    }
    SEAM(8);
    if (IN(9)) REP(9) act_fixup(args, vcu, G);
    SEAM(9);
    if (IN(10)) REP(10) {
        pg8::Gemm g{(const bf16*)(ws + WS_G), (const bf16*)(ws + WS_WD), nullptr, nullptr, MT, DM, DFF}; pg8::DownOrder S; S.S.init(MT, DM, G, bx); S.split = (G == 256);
        EpiDown E{(const float*)(ws + WS_X1), args.out, (float*)(ws + WS_U)};
        pg8::gemm_phase<EpiDown, pg8::DownOrder, true, true>(lds, g, S, E);
    }
    SEAM(10);
    if (IN(11)) REP(11) final_norm(args, vcu, G);
#ifdef EXTRA_SYNCS
    for (int i_ = 0; i_ < EXTRA_SYNCS; ++i_) xcd_barrier(xbar);
#endif
#undef IN
#undef SEAM
}

extern "C" void kernel_launch(void* const* d_in, const int* in_sizes, int n_in, void* d_out, int out_size, void* d_ws, size_t ws_size, hipStream_t stream) {
    static int grid = 0;
    if (grid == 0) {
        if (n_in != 25 || ws_size < WS_END) { fprintf(stderr, "kernel_launch: unexpected n_in %d / ws_size %zu (need %zu)\n", n_in, ws_size, (size_t)WS_END); grid = -1; return; }
        int dev = 0, cus = 0, per_cu = 0;
        (void)hipGetDevice(&dev); (void)hipDeviceGetAttribute(&cus, hipDeviceAttributeMultiprocessorCount, dev);
        if (hipFuncSetAttribute((const void*)fwd_kernel, hipFuncAttributeMaxDynamicSharedMemorySize, LDS_BYTES) != hipSuccess) { fprintf(stderr, "kernel_launch: hipFuncSetAttribute failed\n"); grid = -1; return; }
        if (hipOccupancyMaxActiveBlocksPerMultiprocessor(&per_cu, (const void*)fwd_kernel, NTHR, LDS_BYTES) != hipSuccess || per_cu < 1) { fprintf(stderr, "kernel_launch: occupancy query says %d\n", per_cu); per_cu = 1; }
        (void)hipGetLastError();
        grid = cus * 1;
        if (grid <= 0) grid = 256;
    }
    if (grid < 0) return;
    if (hipMemsetAsync(d_ws, 0, 65536, stream) != hipSuccess) { fprintf(stderr, "kernel_launch: memset failed\n"); return; }
    Args a{};
    for (int i = 0; i < 25; ++i) a.in[i] = (const float*)d_in[i];
    a.out = (float*)d_out; a.ws = (unsigned char*)d_ws;
    if (MK_N_LAUNCHES == 1) {
        a.ph_lo = 0; a.ph_hi = N_PHASES;
        void* kargs[] = {&a};
        hipError_t e = hipLaunchCooperativeKernel((const void*)fwd_kernel, dim3(grid), dim3(NTHR), kargs, LDS_BYTES, stream);
        if (e != hipSuccess) fprintf(stderr, "kernel_launch: cooperative launch failed: %s (grid %d)\n", hipGetErrorString(e), grid);
    } else {
        for (int p = 0; p < N_PHASES; ++p) { a.ph_lo = p; a.ph_hi = p + 1; hipLaunchKernelGGL(fwd_kernel, dim3(grid), dim3(NTHR), LDS_BYTES, stream, a); }
    }
}
```

```cpp
#include <hip/hip_runtime.h>
#include <hip/hip_cooperative_groups.h>
#include <cstdio>
#include <cstdint>
namespace cg = cooperative_groups;

#ifndef MK_N_LAUNCHES
#define MK_N_LAUNCHES 1
#endif

namespace pg8 {
#define PG8_LAS __attribute__((address_space(3)))
typedef unsigned short bf16_t;
typedef short bf16x8 __attribute__((ext_vector_type(8)));
typedef float f32x4 __attribute__((ext_vector_type(4)));
typedef unsigned u32x4 __attribute__((ext_vector_type(4)));
constexpr int BM = 256, BK = 64, HALF = 128, HTB = HALF * BK * 2  , STAGE_BYTES = 8 * HTB, NXCD = 8, WGM = 8;

__host__ __device__ __forceinline__ int lds_byte(int r, int c) { const int st = (r >> 4) * 2 + (c >> 5), rr = r & 15, cc = c & 31, ob = rr * 64 + cc * 2; return st * 1024 + (ob ^ (((ob >> 9) & 1) << 5)); }
__host__ __device__ __forceinline__ void stage_rc(int b, int& R, int& C) { const int st = b / 1024, sb = b % 1024, swz = sb ^ (((sb >> 9) & 1) << 5); R = (st >> 1) * 16 + swz / 64; C = (st & 1) * 32 + (swz % 64) / 2; }
__host__ __device__ __forceinline__ int perm32(int rho) { const int n = rho >> 4, i = rho & 15; return 8 * (i >> 2) + 4 * n + (i & 3); }

struct Unit { int pm, pn, seg, kt0, nkt, tail; };
struct Gemm { const bf16_t* A; const bf16_t* Bt; const bf16_t* A2; const bf16_t* Bt2; int M, N, K; };

struct StaticOrder {
    int nM, nN, nwg, G, c;
    __host__ __device__ void init(int M, int N, int G_, int c_) { nM = M / BM; nN = N / BM; nwg = nM * nN; G = G_; c = c_; }
    __host__ __device__ bool next(int i, Unit& u) const { return at((long)i * G + c, u); }
    __host__ __device__ bool at(long L, Unit& u) const {
        if (L >= nwg) return false;
        int wgid = (int)L; { const int q = nwg / NXCD, r = nwg % NXCD, xcd = wgid % NXCD, off = wgid / NXCD; wgid = (xcd < r ? xcd * (q + 1) : r * (q + 1) + (xcd - r) * q) + off; }
        const int nig = WGM * nN, gid = wgid / nig, fm = gid * WGM, gsz = (nM - fm) < WGM ? (nM - fm) : WGM;
        u.pm = fm + ((wgid % nig) % gsz); u.pn = (wgid % nig) / gsz; u.seg = 0; u.kt0 = 0; u.nkt = -1; u.tail = -1; return true;
    }
};
struct DownOrder {
    StaticOrder S; bool split;
    __host__ __device__ bool next(int i, Unit& u) const {
        if (!split) return S.next(i, u);
        if (i == 0) return S.at(S.c, u);
        if (i > 1) return false;
        const int tt = S.c >> 3, sl = S.c & 7;
        if (!S.at(256 + tt, u)) return false;
        u.kt0 = 11 * sl + (sl & 1); u.nkt = (sl & 1) ? 10 : 12; u.tail = tt * 8 + sl; return true;
    }
};
template <int NSEG, int KT>
struct SplitRowsOrder {
    StaticOrder S; bool split;
    __host__ __device__ bool next(int i, Unit& u) const {
        if (!split) { if (!S.next(i / NSEG, u)) return false; u.seg = i % NSEG; return true; }
        if (i < NSEG) { if (!S.at(S.c, u)) return false; u.seg = i; return true; }
        if (i >= 2 * NSEG) return false;
        const int tt = S.c >> 3, sl = S.c & 7;
        u.pm = 32 + (tt >> 3); u.pn = tt & 7; u.seg = i - NSEG; u.kt0 = (KT / 8) * sl; u.nkt = KT / 8; u.tail = tt * 8 + sl; return true;
    }
};
struct TwoSegOrder {
    StaticOrder S;
    __host__ __device__ bool next(int i, Unit& u) const { if (!S.next(i >> 1, u)) return false; u.seg = i & 1; return true; }
};

__device__ __forceinline__ unsigned cvt_pk_bf16(float lo, float hi) { unsigned r; asm volatile("v_cvt_pk_bf16_f32 %0, %1, %2" : "=v"(r) : "v"(lo), "v"(hi)); return r; }

template <class Epi, class Sched, bool ALIGN_EPI = false, bool SP2 = false>
__device__ __forceinline__ void gemm_phase(PG8_LAS unsigned char* lds, const Gemm g, const Sched& S, const Epi& E) {
    int tid_ = threadIdx.x; asm volatile("" : "+v"(tid_));
    const int tid = tid_, wid = __builtin_amdgcn_readfirstlane(tid >> 6), lane = tid & 63, wr = wid >> 2, wc = wid & 3, fr = lane & 15, fq = lane >> 4;
    const int K = g.K, ntf = K / BK;
    unsigned voffA[2], voffB[2];
#pragma unroll
    for (int i = 0; i < 2; ++i) { int R, C; stage_rc(tid * 16 + i * 8192, R, C); const int Rb = Epi::PERM ? ((R & ~31) + perm32(R & 31)) : R;
        voffA[i] = (unsigned)(R * K + C) * 2u; voffB[i] = (unsigned)(Rb * K + C) * 2u; }
    const size_t kstep = (size_t)(BK * 2);
    const size_t hstep = (size_t)HALF * K * 2;
    const size_t tstep = 2 * hstep;
    const unsigned ldsw = (unsigned)wid * 1024u;
    const int aoff = lds_byte(wr * 64 + fr, fq * 8), boff = lds_byte(wc * 32 + fr, fq * 8);
#define PG8_SA(b, h) (((b) * 2 + (h)) * HTB)
#define PG8_SB(b, h) ((4 + (b) * 2 + (h)) * HTB)
#define PG8_STAGE(bufoff, gbase, voff) do { _Pragma("unroll") for (int _i = 0; _i < 2; ++_i) \
        __builtin_amdgcn_global_load_lds((const unsigned*)((const char*)(gbase) + (voff)[_i]), (PG8_LAS unsigned*)(lds + (bufoff) + ldsw + _i * 8192), 16, 0, 0); } while (0)
#define PG8_LDA(dst, b, h) do { _Pragma("unroll") for (int m = 0; m < 4; ++m) _Pragma("unroll") for (int k = 0; k < 2; ++k) dst[m][k] = *(const PG8_LAS bf16x8*)(lds + PG8_SA(b, h) + aoff + m * 2048 + k * 1024); } while (0)
#define PG8_LDB(dst, b, h) do { _Pragma("unroll") for (int n = 0; n < 2; ++n) _Pragma("unroll") for (int k = 0; k < 2; ++k) dst[n][k] = *(const PG8_LAS bf16x8*)(lds + PG8_SB(b, h) + boff + n * 2048 + k * 1024); } while (0)
#define PG8_MMA(ai, bj, At, Bt) do { __builtin_amdgcn_s_setprio(1); _Pragma("unroll") for (int m = 0; m < 4; ++m) _Pragma("unroll") for (int n = 0; n < 2; ++n) _Pragma("unroll") for (int k = 0; k < 2; ++k) \
        acc[ai][bj][m][n] = __builtin_amdgcn_mfma_f32_16x16x32_bf16(Bt[n][k], At[m][k], acc[ai][bj][m][n], 0, 0, 0); __builtin_amdgcn_s_setprio(0); } while (0)
#define PG8_WAIT_V(n) asm volatile("s_waitcnt vmcnt(" #n ")" ::: "memory")
#define PG8_WAIT_L(n) asm volatile("s_waitcnt lgkmcnt(" #n ")" ::: "memory")
#define PG8_BAR __builtin_amdgcn_s_barrier()
#define PG8_SCHED __builtin_amdgcn_sched_barrier(0)
    Unit cur, nxt; int ui = 0;
    if (!S.next(0, cur)) return;
    f32x4 acc[2][2][4][2];
#pragma unroll
    for (int a = 0; a < 2; ++a)
#pragma unroll
        for (int b = 0; b < 2; ++b)
#pragma unroll
            for (int m = 0; m < 4; ++m)
#pragma unroll
                for (int n = 0; n < 2; ++n) acc[a][b][m][n] = (f32x4){0.f, 0.f, 0.f, 0.f};
    bf16x8 At[4][2], B0[2][2], B1[2][2];
    const char* cA = (const char*)(cur.seg ? g.A2 : g.A) + (size_t)cur.pm * tstep + (size_t)cur.kt0 * kstep; const char* cB = (const char*)(cur.seg ? g.Bt2 : g.Bt) + (size_t)cur.pn * tstep + (size_t)cur.kt0 * kstep;
    if constexpr (SP2) {
        PG8_STAGE(PG8_SB(0, 0), cB, voffB); PG8_STAGE(PG8_SB(0, 1), cB + hstep, voffB); PG8_STAGE(PG8_SA(0, 0), cA, voffA); PG8_STAGE(PG8_SA(0, 1), cA + hstep, voffA);
        if (wr == 1) PG8_BAR;
        PG8_WAIT_V(2); PG8_BAR;
        PG8_STAGE(PG8_SB(1, 0), cB + kstep, voffB); PG8_STAGE(PG8_SA(1, 0), cA + kstep, voffA); PG8_STAGE(PG8_SB(1, 1), cB + hstep + kstep, voffB);
        PG8_WAIT_V(6); PG8_BAR;
    } else {
        PG8_STAGE(PG8_SB(0, 0), cB, voffB); PG8_STAGE(PG8_SA(0, 0), cA, voffA); PG8_STAGE(PG8_SB(0, 1), cB + hstep, voffB); PG8_STAGE(PG8_SA(0, 1), cA + hstep, voffA);
        if (wr == 1) PG8_BAR;
        PG8_WAIT_V(4); PG8_BAR;
        PG8_STAGE(PG8_SB(1, 0), cB + kstep, voffB); PG8_STAGE(PG8_SA(1, 0), cA + kstep, voffA); PG8_STAGE(PG8_SB(1, 1), cB + hstep + kstep, voffB);
        PG8_WAIT_V(6); PG8_BAR;
    }
    for (;;) {
        const bool has_next = S.next(ui + 1, nxt);
        const char* nA = has_next ? (const char*)(nxt.seg ? g.A2 : g.A) + (size_t)nxt.pm * tstep + (size_t)nxt.kt0 * kstep : cA; const char* nB = has_next ? (const char*)(nxt.seg ? g.Bt2 : g.Bt) + (size_t)nxt.pn * tstep + (size_t)nxt.kt0 * kstep : cB;
        const int nt = cur.nkt > 0 ? cur.nkt : ntf;
        for (int t = 0; t < nt; t += 2) {
            const bool last = (t == nt - 2);
            const char* a1 = cA + (size_t)(t + 1) * kstep;
            const char* a2 = last ? nA : cA + (size_t)(t + 2) * kstep; const char* b2 = last ? nB : cB + (size_t)(t + 2) * kstep;
            const char* a3 = a2 + kstep; const char* b3 = b2 + kstep;
            if constexpr (SP2) {
            PG8_LDB(B0, 0, 0); PG8_LDB(B1, 0, 1); PG8_SCHED; PG8_LDA(At, 0, 0); PG8_STAGE(PG8_SA(1, 1), a1 + hstep, voffA);
            PG8_WAIT_V(8); PG8_WAIT_L(0); PG8_BAR; PG8_MMA(0, 0, At, B0); PG8_MMA(0, 1, At, B1); PG8_BAR; PG8_SCHED;
            PG8_LDA(At, 0, 1); PG8_STAGE(PG8_SB(0, 0), b2, voffB); PG8_STAGE(PG8_SB(0, 1), b2 + hstep, voffB); PG8_STAGE(PG8_SA(0, 0), a2, voffA);
            PG8_WAIT_V(8); PG8_WAIT_L(0); PG8_BAR; PG8_MMA(1, 0, At, B0); PG8_MMA(1, 1, At, B1); PG8_BAR; PG8_SCHED;
            PG8_LDB(B0, 1, 0); PG8_LDB(B1, 1, 1); PG8_SCHED; PG8_LDA(At, 1, 0); PG8_STAGE(PG8_SA(0, 1), a2 + hstep, voffA);
            PG8_WAIT_V(8); PG8_WAIT_L(0); PG8_BAR; PG8_MMA(0, 0, At, B0); PG8_MMA(0, 1, At, B1); PG8_BAR; PG8_SCHED;
            PG8_LDA(At, 1, 1); PG8_STAGE(PG8_SB(1, 0), b3, voffB); PG8_STAGE(PG8_SB(1, 1), b3 + hstep, voffB); PG8_STAGE(PG8_SA(1, 0), a3, voffA);
            PG8_WAIT_V(8); PG8_WAIT_L(0); PG8_BAR; PG8_MMA(1, 0, At, B0); PG8_MMA(1, 1, At, B1); PG8_BAR; PG8_SCHED;
            } else {
            PG8_LDB(B0, 0, 0); PG8_SCHED; PG8_LDA(At, 0, 0); PG8_STAGE(PG8_SA(1, 1), a1 + hstep, voffA);
            PG8_WAIT_L(8); PG8_BAR; PG8_WAIT_L(0); PG8_MMA(0, 0, At, B0); PG8_BAR; PG8_SCHED;
            PG8_LDB(B1, 0, 1); PG8_STAGE(PG8_SB(0, 0), b2, voffB);
            PG8_BAR; PG8_WAIT_L(0); PG8_MMA(0, 1, At, B1); PG8_BAR;
            PG8_LDA(At, 0, 1); PG8_STAGE(PG8_SA(0, 0), a2, voffA);
            PG8_BAR; PG8_WAIT_L(0); PG8_MMA(1, 0, At, B0); PG8_BAR; PG8_SCHED;
            PG8_STAGE(PG8_SB(0, 1), b2 + hstep, voffB);
            PG8_WAIT_V(6); PG8_BAR; PG8_MMA(1, 1, At, B1); PG8_BAR;
            PG8_LDB(B0, 1, 0); PG8_SCHED; PG8_LDA(At, 1, 0); PG8_STAGE(PG8_SA(0, 1), a2 + hstep, voffA);
            PG8_WAIT_L(8); PG8_BAR; PG8_WAIT_L(0); PG8_MMA(0, 0, At, B0); PG8_BAR; PG8_SCHED;
            PG8_LDB(B1, 1, 1); PG8_STAGE(PG8_SB(1, 0), b3, voffB);
            PG8_BAR; PG8_WAIT_L(0); PG8_MMA(0, 1, At, B1); PG8_BAR;
            PG8_LDA(At, 1, 1); PG8_STAGE(PG8_SA(1, 0), a3, voffA);
            PG8_BAR; PG8_WAIT_L(0); PG8_MMA(1, 0, At, B0); PG8_BAR; PG8_SCHED;
            PG8_STAGE(PG8_SB(1, 1), b3 + hstep, voffB);
            PG8_WAIT_V(6); PG8_BAR; PG8_MMA(1, 1, At, B1); PG8_BAR;
            }
        }
        if constexpr (ALIGN_EPI) { if (wr == 0) PG8_BAR; }
        E(acc, cur, wr, wc, fr, fq);
        if (!has_next) break;
        if (nxt.seg == 0)
#pragma unroll
        for (int a = 0; a < 2; ++a)
#pragma unroll
            for (int b = 0; b < 2; ++b)
#pragma unroll
                for (int m = 0; m < 4; ++m)
#pragma unroll
                    for (int n = 0; n < 2; ++n) acc[a][b][m][n] = (f32x4){0.f, 0.f, 0.f, 0.f};
        cur = nxt; cA = nA; cB = nB; ++ui;
        if constexpr (ALIGN_EPI) { if (wr == 1) PG8_BAR; }
    }
    PG8_WAIT_V(0);
    if constexpr (!ALIGN_EPI) { if (wr == 0) PG8_BAR; }
    PG8_BAR;
#undef PG8_SA
#undef PG8_SB
#undef PG8_STAGE
#undef PG8_LDA
#undef PG8_LDB
#undef PG8_MMA
#undef PG8_WAIT_V
#undef PG8_WAIT_L
#undef PG8_BAR
#undef PG8_SCHED
}
}

#define LAS __attribute__((address_space(3)))
typedef unsigned short bf16;
typedef short bf16x8 __attribute__((ext_vector_type(8)));
typedef float f32x4 __attribute__((ext_vector_type(4)));
typedef unsigned u32x4 __attribute__((ext_vector_type(4)));
typedef unsigned u32x2 __attribute__((ext_vector_type(2)));
using pg8::cvt_pk_bf16;

constexpr int NWAVES = 8, NTHR = 512;
constexpr int DM = 2048, MP = 8192, MS = 1024, MT = 9216, TP = 2048, TS = 8;
constexpr int NIN = 11288, NPROJ = 11264, NPROJ_PAD = 11520, DFF = 5632;
constexpr int C_MQ = 0, C_MK = 1024, C_MV = 2048, C_MO = 3072, C_GQ = 4096, C_GK = 4608, C_GV = 5120, C_GR = 6144, C_GA = 7168, C_GB = 9216;
constexpr float EPS = 1e-6f;
constexpr int NCH = 16;
constexpr int LDS_BYTES = 147456;

constexpr size_t O_YP = 0, O_YS = 16777216, O_PC = 18874368, O_PN = 19922944, O_PM = 19927040, O_PS = 19927056, O_PCONV = 20451344,
                 O_SC = 20496400, O_SN = 54050832, O_SM = 54181904, O_SS = 54182416, O_SCONV = 70959632;

constexpr size_t MiB = 1u << 20;
constexpr size_t WS_GATES = 64 * 1024;
constexpr size_t WS_PART = WS_GATES + (size_t)MT * 32 * 4;
constexpr size_t WS_DN = WS_PART + (size_t)MT * 32 * 4;
constexpr size_t WS_NPREV = WS_DN + 256 * 256 * 4;
constexpr size_t WS_CHS = WS_NPREV + 256 * 256 * 2;
constexpr size_t WS_BEND = WS_CHS + 256 * 2 * 4;
constexpr size_t WS_RSTD = WS_BEND + 256 * 128 * 4;
static_assert(WS_RSTD + MT * 4 <= 4 * MiB, "small region");
constexpr size_t WS_WIN = 4 * MiB;
constexpr size_t WS_WA = WS_WIN + (size_t)NPROJ_PAD * DM * 2;
constexpr size_t WS_WB = WS_WA + (size_t)2048 * 1024 * 2;
constexpr size_t WS_WO = WS_WB + (size_t)2048 * 1024 * 2;
constexpr size_t WS_WUG = WS_WO + (size_t)2048 * 2048 * 2;
constexpr size_t WS_WD = WS_WUG + (size_t)2 * DFF * DM * 2;
constexpr size_t WS_R1 = WS_WD + (size_t)DM * DFF * 2;
static_assert(WS_R1 == 131 * MiB, "map");
constexpr size_t WS_XN = WS_R1;
constexpr size_t WS_X1W = WS_R1 + 36 * MiB;
constexpr size_t WS_X1 = WS_R1 + 72 * MiB;
constexpr size_t WS_DC = WS_R1;
constexpr size_t WS_DS = WS_R1 + 64 * MiB;
constexpr size_t WS_CT = WS_R1 + 96 * MiB;
constexpr size_t WS_ST = WS_R1 + 128 * MiB;
constexpr size_t WS_YM = WS_R1 + 144 * MiB;
constexpr size_t WS_YG = WS_YM + 18 * MiB;
constexpr size_t WS_PROJ = WS_YG + 18 * MiB;
constexpr size_t WS_U = WS_PROJ, WS_G = WS_PROJ + 99 * MiB;
constexpr size_t WS_END = WS_PROJ + 198 * MiB;
static_assert(WS_END == 509 * MiB, "map");

struct Args {
    const float* in[25]; float* out; unsigned char* ws; int ph_lo, ph_hi;
};
enum { I_XP = 0, I_XS, I_C, I_N, I_M, I_S, I_CONV, I_WIN, I_BI, I_BF, I_AUP, I_AB, I_MHW, I_GHW, I_WA, I_WB, I_WO, I_NMIX, I_NFFN, I_WUP, I_WGATE, I_CW, I_CB, I_WDOWN, I_FNW };

__device__ __forceinline__ float bf2f(unsigned short b) { return __builtin_bit_cast(float, (unsigned)b << 16); }
__device__ __forceinline__ float bflo(unsigned w) { return __builtin_bit_cast(float, w << 16); }
__device__ __forceinline__ float bfhi(unsigned w) { return __builtin_bit_cast(float, w & 0xffff0000u); }
__device__ __forceinline__ unsigned short f2bf(float f) { return (unsigned short)(cvt_pk_bf16(f, 0.f) & 0xffffu); }
__device__ __forceinline__ float logsig(float z) { return fminf(z, 0.f) - log1pf(__expf(-fabsf(z))); }
__device__ __forceinline__ float sigm(float z) { return 1.f / (1.f + __expf(-z)); }
__device__ __forceinline__ float wave_sum(float v) {
#pragma unroll
    for (int o = 1; o < 64; o <<= 1) v += __shfl_xor(v, o);
    return v;
}
__device__ __forceinline__ float wave_max(float v) {
#pragma unroll
    for (int o = 1; o < 64; o <<= 1) v = fmaxf(v, __shfl_xor(v, o));
    return v;
}
__device__ __forceinline__ float sum4(f32x4 v) { return (v.x + v.y) + (v.z + v.w); }
__device__ __forceinline__ float dot4(f32x4 a, f32x4 b) { return (a.x * b.x + a.y * b.y) + (a.z * b.z + a.w * b.w); }
__device__ __forceinline__ float gelu_tanh(float v) { const float u = 0.7978845608028654f * (v + 0.044715f * v * v * v); return v * sigm(2.f * u); }

typedef f32x4 AccT[2][2][4][2];
struct EpiProj {
    static constexpr bool PERM = true;
    bf16* P; float* gates;
    __device__ __forceinline__ void operator()(AccT& acc, const pg8::Unit& u, int wr, int wc, int fr, int fq) const {
        const int row0 = u.pm * 256 + wr * 64 + fr;
        if (u.pn < 44) {
            const int col0 = u.pn * 256 + wc * 32 + 8 * fq;
#pragma unroll
            for (int ai = 0; ai < 2; ++ai)
#pragma unroll
                for (int m = 0; m < 4; ++m) { bf16* rowp = P + (size_t)(row0 + ai * 128 + m * 16) * NPROJ + col0;
#pragma unroll
                    for (int bj = 0; bj < 2; ++bj) { const f32x4 v0 = acc[ai][bj][m][0], v1 = acc[ai][bj][m][1]; u32x4 w;
                        w.x = cvt_pk_bf16(v0[0], v0[1]); w.y = cvt_pk_bf16(v0[2], v0[3]); w.z = cvt_pk_bf16(v1[0], v1[1]); w.w = cvt_pk_bf16(v1[2], v1[3]);
                        *(u32x4*)(rowp + bj * 128) = w; } }
        } else if (wc == 0) {
#pragma unroll
            for (int ai = 0; ai < 2; ++ai)
#pragma unroll
                for (int m = 0; m < 4; ++m) { float* rowp = gates + (size_t)(row0 + ai * 128 + m * 16) * 32 + 8 * fq;
                    *(f32x4*)rowp = acc[ai][0][m][0]; *(f32x4*)(rowp + 4) = acc[ai][0][m][1]; }
        }
    }
};
struct EpiBranch {
    static constexpr bool PERM = true;
    const bf16* P; bf16* O;
    __device__ __forceinline__ void operator()(AccT& acc, const pg8::Unit& u, int wr, int wc, int fr, int fq) const {
        const int row0 = u.pm * 256 + wr * 64 + fr, col0 = u.pn * 256 + wc * 32 + 8 * fq;
#pragma unroll
        for (int ai = 0; ai < 2; ++ai)
#pragma unroll
            for (int m = 0; m < 4; ++m) { const int row = row0 + ai * 128 + m * 16;
#pragma unroll
                for (int bj = 0; bj < 2; ++bj) { const int col = col0 + bj * 128;
                    const u32x4 ga = *(const u32x4*)(P + (size_t)row * NPROJ + C_GA + col), gb = *(const u32x4*)(P + (size_t)row * NPROJ + C_GB + col);
                    float fa[8] = {bflo(ga.x), bfhi(ga.x), bflo(ga.y), bfhi(ga.y), bflo(ga.z), bfhi(ga.z), bflo(ga.w), bfhi(ga.w)};
                    float fb[8] = {bflo(gb.x), bfhi(gb.x), bflo(gb.y), bfhi(gb.y), bflo(gb.z), bfhi(gb.z), bflo(gb.w), bfhi(gb.w)};
                    if (u.seg == 0) {
#pragma unroll
                        for (int i = 0; i < 8; ++i) { const float r = (1.f + __expf(-fb[i])) / (1.f + __expf(-fa[i])); acc[ai][bj][m][i >> 2][i & 3] *= r; }
                    } else {
                        float o[8];
#pragma unroll
                        for (int i = 0; i < 8; ++i) o[i] = acc[ai][bj][m][i >> 2][i & 3] * sigm(fb[i]);
                        u32x4 w; w.x = cvt_pk_bf16(o[0], o[1]); w.y = cvt_pk_bf16(o[2], o[3]); w.z = cvt_pk_bf16(o[4], o[5]); w.w = cvt_pk_bf16(o[6], o[7]);
                        *(u32x4*)(O + (size_t)row * DM + col) = w;
                    } } }
    }
};
struct EpiOut {
    static constexpr bool PERM = true;
    const float* xp; const float* xs; float* X1; bf16* X1W; const float* nw; float* part; float* tailp;
    __device__ __forceinline__ void operator()(AccT& acc, const pg8::Unit& u, int wr, int wc, int fr, int fq) const {
        const int row0 = u.pm * 256 + wr * 64 + fr, col0 = u.pn * 256 + wc * 32 + 8 * fq;
        if (u.tail >= 0) {
            float* tp = tailp + (size_t)u.tail * 65536 + (wr * 64 + fr) * 256 + wc * 32 + 8 * fq;
#pragma unroll
            for (int ai = 0; ai < 2; ++ai)
#pragma unroll
                for (int m = 0; m < 4; ++m)
#pragma unroll
                    for (int bj = 0; bj < 2; ++bj) { float* p = tp + (ai * 128 + m * 16) * 256 + bj * 128; *(f32x4*)p = acc[ai][bj][m][0]; *(f32x4*)(p + 4) = acc[ai][bj][m][1]; }
            return;
        }
#pragma unroll
        for (int ai = 0; ai < 2; ++ai)
#pragma unroll
            for (int m = 0; m < 4; ++m) { const int row = row0 + ai * 128 + m * 16;
                const float* xrow = row < MP ? xp + (size_t)row * DM : xs + (size_t)(row - MP) * DM;
                float ss = 0.f;
#pragma unroll
                for (int bj = 0; bj < 2; ++bj) { const int col = col0 + bj * 128;
                    const f32x4 v0 = acc[ai][bj][m][0] + *(const f32x4*)(xrow + col), v1 = acc[ai][bj][m][1] + *(const f32x4*)(xrow + col + 4);
                    *(f32x4*)(X1 + (size_t)row * DM + col) = v0; *(f32x4*)(X1 + (size_t)row * DM + col + 4) = v1;
                    ss += dot4(v0, v0) + dot4(v1, v1);
                    const f32x4 w0 = *(const f32x4*)(nw + col), w1 = *(const f32x4*)(nw + col + 4);
                    u32x4 w; w.x = cvt_pk_bf16(v0[0] * w0[0], v0[1] * w0[1]); w.y = cvt_pk_bf16(v0[2] * w0[2], v0[3] * w0[3]);
                    w.z = cvt_pk_bf16(v1[0] * w1[0], v1[1] * w1[1]); w.w = cvt_pk_bf16(v1[2] * w1[2], v1[3] * w1[3]);
                    *(u32x4*)(X1W + (size_t)row * DM + col) = w; }
                ss += __shfl_xor(ss, 16); ss += __shfl_xor(ss, 32);
                if (fq == 0) part[(size_t)row * 32 + u.pn * 4 + wc] = ss; }
    }
};
#define DPP_MOV(ctrl, oldv, srcv) __builtin_bit_cast(float, __builtin_amdgcn_update_dpp(__builtin_bit_cast(int, (float)(oldv)), __builtin_bit_cast(int, (float)(srcv)), (ctrl), 0xf, 0xf, false))
struct EpiUGAct {
    static constexpr bool PERM = true;
    const float* rstd; bf16* ACT; float* out; const float* cw; const float* cb; const float* cst; float* ub; LAS float* xch;
    __device__ __forceinline__ void operator()(AccT& acc, const pg8::Unit& u, int wr, int wc, int fr, int fq) const {
        const int row0 = u.pm * 256 + wr * 64 + fr, col = u.pn * 128 + wc * 32 + 8 * fq;
        const bool sample = u.pm >= 32;
#pragma unroll
        for (int ai = 0; ai < 2; ++ai)
#pragma unroll
            for (int m = 0; m < 4; ++m) { const int row = row0 + ai * 128 + m * 16;
                const float r = rstd[row];
                acc[ai][0][m][0] = acc[ai][0][m][0] * r; acc[ai][0][m][1] = acc[ai][0][m][1] * r; acc[ai][1][m][0] = acc[ai][1][m][0] * r; acc[ai][1][m][1] = acc[ai][1][m][1] * r;
                float* cs = nullptr;
                if (row < MP) { const int t = row & (TP - 1); if (t >= TP - 2) cs = out + O_PCONV + ((size_t)(row >> 11) * 2 + (t - (TP - 2))) * DFF + col; }
                else { const int rr = row - MP, t = rr & 7; if (t >= 6) cs = out + O_SCONV + ((size_t)(rr >> 3) * 2 + (t - 6)) * DFF + col; }
                if (cs) { *(f32x4*)cs = acc[ai][0][m][0]; *(f32x4*)(cs + 4) = acc[ai][0][m][1]; } }
        if (fr >= 14) {
#pragma unroll
            for (int ai = 0; ai < 2; ++ai) { LAS float* p = xch + ((((ai * 2 + wr) * 4 + wc) * 2 + (fr - 14)) * 4 + fq) * 8; *(LAS f32x4*)p = acc[ai][0][3][0]; *(LAS f32x4*)(p + 4) = acc[ai][0][3][1]; }
            if (!sample && wr == 1) { float* p = ub + ((size_t)u.pm * 6 + (fr - 14)) * DFF + col; *(f32x4*)p = acc[1][0][3][0]; *(f32x4*)(p + 4) = acc[1][0][3][1]; }
        }
        if (!sample && wr == 0 && fr < 2) { float* p = ub + ((size_t)u.pm * 6 + 2 + fr) * DFF + col; *(f32x4*)p = acc[0][0][0][0]; *(f32x4*)(p + 4) = acc[0][0][0][1];
            p += 2 * DFF; *(f32x4*)p = acc[0][1][0][0]; *(f32x4*)(p + 4) = acc[0][1][0][1]; }
        asm volatile("s_waitcnt lgkmcnt(0)" ::: "memory"); __builtin_amdgcn_s_barrier();
        const f32x4 k0a = *(const f32x4*)(cw + col), k0b = *(const f32x4*)(cw + col + 4), k1a = *(const f32x4*)(cw + DFF + col), k1b = *(const f32x4*)(cw + DFF + col + 4);
        const f32x4 k2a = *(const f32x4*)(cw + 2 * DFF + col), k2b = *(const f32x4*)(cw + 2 * DFF + col + 4), cba = *(const f32x4*)(cb + col), cbb = *(const f32x4*)(cb + col + 4);
#pragma unroll
        for (int ai = 0; ai < 2; ++ai) {
            f32x4 pe0 = {0.f, 0.f, 0.f, 0.f}, pe1 = {0.f, 0.f, 0.f, 0.f};
            if (!(ai == 0 && wr == 0) && fr >= 14) { const int sai = (wr == 1) ? ai : ai - 1, swr = wr ^ 1;
                const LAS float* p = xch + ((((sai * 2 + swr) * 4 + wc) * 2 + (fr - 14)) * 4 + fq) * 8; pe0 = *(const LAS f32x4*)p; pe1 = *(const LAS f32x4*)(p + 4); }
#pragma unroll
            for (int m = 0; m < 4; ++m) { const int row = row0 + ai * 128 + m * 16;
                const f32x4 c0 = acc[ai][0][m][0], c1 = acc[ai][0][m][1], v0 = m ? acc[ai][0][m ? m - 1 : 0][0] : pe0, v1 = m ? acc[ai][0][m ? m - 1 : 0][1] : pe1;
                float cur[8] = {c0[0], c0[1], c0[2], c0[3], c1[0], c1[1], c1[2], c1[3]}, prv[8] = {v0[0], v0[1], v0[2], v0[3], v1[0], v1[1], v1[2], v1[3]};
                float p1[8], p2[8];
#pragma unroll
                for (int i = 0; i < 8; ++i) { const float y1 = DPP_MOV(0x121, 0.f, prv[i]); p1[i] = DPP_MOV(0x111, y1, cur[i]); const float y2 = DPP_MOV(0x122, 0.f, prv[i]); p2[i] = DPP_MOV(0x112, y2, cur[i]); }
                if (sample) { const int t = fr & 7;
                    if (t < 2) { const float* st = cst + (size_t)((row - MP) >> 3) * 2 * DFF + col;
                        const f32x4 s1a = *(const f32x4*)(st + DFF), s1b = *(const f32x4*)(st + DFF + 4);
                        if (t == 0) { const f32x4 s0a = *(const f32x4*)st, s0b = *(const f32x4*)(st + 4);
#pragma unroll
                            for (int i = 0; i < 4; ++i) { p1[i] = s1a[i]; p1[4 + i] = s1b[i]; p2[i] = s0a[i]; p2[4 + i] = s0b[i]; } }
                        else {
#pragma unroll
                            for (int i = 0; i < 4; ++i) { p2[i] = s1a[i]; p2[4 + i] = s1b[i]; } } } }
                const f32x4 g0 = acc[ai][1][m][0], g1 = acc[ai][1][m][1];
                float o[8];
#pragma unroll
                for (int i = 0; i < 4; ++i) { o[i] = gelu_tanh(cba[i] + k0a[i] * p2[i] + k1a[i] * p1[i] + k2a[i] * cur[i]) * g0[i];
                    o[4 + i] = gelu_tanh(cbb[i] + k0b[i] * p2[4 + i] + k1b[i] * p1[4 + i] + k2b[i] * cur[4 + i]) * g1[i]; }
                u32x4 w; w.x = cvt_pk_bf16(o[0], o[1]); w.y = cvt_pk_bf16(o[2], o[3]); w.z = cvt_pk_bf16(o[4], o[5]); w.w = cvt_pk_bf16(o[6], o[7]);
                *(u32x4*)(ACT + (size_t)row * DFF + col) = w; }
        }
    }
};
struct EpiDown {
    static constexpr bool PERM = true;
    const float* X1; float* out; float* tailp;
    __device__ __forceinline__ void operator()(AccT& acc, const pg8::Unit& u, int wr, int wc, int fr, int fq) const {
        if (u.tail < 0) {
            const int row0 = u.pm * 256 + wr * 64 + fr, col0 = u.pn * 256 + wc * 32 + 8 * fq;
#pragma unroll
            for (int ai = 0; ai < 2; ++ai)
#pragma unroll
                for (int m = 0; m < 4; ++m) { const int row = row0 + ai * 128 + m * 16;
#pragma unroll
                    for (int bj = 0; bj < 2; ++bj) { const int col = col0 + bj * 128;
                        const f32x4 v0 = acc[ai][bj][m][0] + *(const f32x4*)(X1 + (size_t)row * DM + col), v1 = acc[ai][bj][m][1] + *(const f32x4*)(X1 + (size_t)row * DM + col + 4);
                        *(f32x4*)(out + (size_t)row * DM + col) = v0; *(f32x4*)(out + (size_t)row * DM + col + 4) = v1; } }
        } else {
            float* tp = tailp + (size_t)u.tail * 65536 + (wr * 64 + fr) * 256 + wc * 32 + 8 * fq;
#pragma unroll
            for (int ai = 0; ai < 2; ++ai)
#pragma unroll
                for (int m = 0; m < 4; ++m)
#pragma unroll
                    for (int bj = 0; bj < 2; ++bj) { float* p = tp + (ai * 128 + m * 16) * 256 + bj * 128; *(f32x4*)p = acc[ai][bj][m][0]; *(f32x4*)(p + 4) = acc[ai][bj][m][1]; }
        }
    }
};

template <class ColPtr>
__device__ __forceinline__ void transpose_item(const ColPtr& cp, int K, int srcN, bf16* WT, LAS float* scr, int kb, int nb, int lane) {
    const int k0 = 64 * kb, n0 = 64 * nb, kr = lane >> 4, n4 = (lane & 15) * 4;
    const float* src = cp(n0 + n4);
    f32x4 v[16];
#pragma unroll
    for (int i = 0; i < 16; ++i) v[i] = src ? *(const f32x4*)(src + (size_t)(k0 + 4 * i + kr) * srcN) : (f32x4){0.f, 0.f, 0.f, 0.f};
#pragma unroll
    for (int i = 0; i < 16; ++i) { LAS float* d = scr + (4 * i + kr) * 65 + n4; d[0] = v[i][0]; d[1] = v[i][1]; d[2] = v[i][2]; d[3] = v[i][3]; }
    asm volatile("s_waitcnt lgkmcnt(0)" ::: "memory");
    const int c = lane & 7;
#pragma unroll
    for (int j = 0; j < 8; ++j) { const int n = (lane >> 3) + 8 * j; const LAS float* s = scr + (8 * c) * 65 + n;
        u32x4 o; o.x = cvt_pk_bf16(s[0 * 65], s[1 * 65]); o.y = cvt_pk_bf16(s[2 * 65], s[3 * 65]); o.z = cvt_pk_bf16(s[4 * 65], s[5 * 65]); o.w = cvt_pk_bf16(s[6 * 65], s[7 * 65]);
        *(u32x4*)(WT + (size_t)(n0 + n) * K + k0 + 8 * c) = o; }
    asm volatile("s_waitcnt lgkmcnt(0)" ::: "memory");
}
struct ColWin { const float* W; __device__ __forceinline__ const float* operator()(int n) const {
    int c; if (n < 4096) c = n; else if (n < 7168) c = n + 8; else if (n < 11264) c = n + 24; else if (n < 11272) c = 4096 + (n - 11264); else if (n < 11288) c = 7176 + (n - 11272); else return nullptr;
    return W + c; } };
struct ColPlain { const float* W; __device__ __forceinline__ const float* operator()(int n) const { return W + n; } };
struct ColUG { const float* Wu; const float* Wg; __device__ __forceinline__ const float* operator()(int n) const { const int pn = n >> 8, w = n & 255; return w < 128 ? Wu + pn * 128 + w : Wg + pn * 128 + (w - 128); } };

__device__ __forceinline__ void p0_prologue(const Args& a, LAS unsigned char* lds, int gwg, int nwgs, int mode) {
    int tid_ = threadIdx.x; asm volatile("" : "+v"(tid_));
    const int tid = tid_, lane = tid & 63, wave = __builtin_amdgcn_readfirstlane(tid >> 6);
    LAS float* scr = (LAS float*)(lds + wave * 16640);
    const int gw = gwg * NWAVES + wave, NGW = nwgs * NWAVES;
    unsigned char* ws = a.ws;
    constexpr int I_WIN_ = 32 * (NPROJ_PAD / 64), I_A = 16 * 32, I_O = 32 * 32, I_UG = 32 * (2 * DFF / 64), I_D = (DFF / 64) * 32;
    constexpr int NITEMS = I_WIN_ + 2 * I_A + I_O + I_UG + I_D;
    const int it0 = mode == 0 ? 0 : I_WIN_, it1 = mode == 0 ? I_WIN_ : NITEMS;
    for (int it = it0 + gw; it < it1; it += NGW) {
        int r = it;
        if (r < I_WIN_) { ColWin cp{a.in[I_WIN]}; const int nblk = NPROJ_PAD / 64; transpose_item(cp, DM, NIN, (bf16*)(ws + WS_WIN), scr, r / nblk, r % nblk, lane); continue; } r -= I_WIN_;
        if (r < I_A) { ColPlain cp{a.in[I_WA]}; transpose_item(cp, 1024, DM, (bf16*)(ws + WS_WA), scr, r / 32, r % 32, lane); continue; } r -= I_A;
        if (r < I_A) { ColPlain cp{a.in[I_WB]}; transpose_item(cp, 1024, DM, (bf16*)(ws + WS_WB), scr, r / 32, r % 32, lane); continue; } r -= I_A;
        if (r < I_O) { ColPlain cp{a.in[I_WO]}; transpose_item(cp, DM, DM, (bf16*)(ws + WS_WO), scr, r / 32, r % 32, lane); continue; } r -= I_O;
        if (r < I_UG) { ColUG cp{a.in[I_WUP], a.in[I_WGATE]}; const int nblk = 2 * DFF / 64; transpose_item(cp, DM, DFF, (bf16*)(ws + WS_WUG), scr, r / nblk, r % nblk, lane); continue; } r -= I_UG;
        { ColPlain cp{a.in[I_WDOWN]}; transpose_item(cp, DFF, DM, (bf16*)(ws + WS_WD), scr, r / 32, r % 32, lane); }
    }
    const float* nw = a.in[I_NMIX]; bf16* XN = (bf16*)(ws + WS_XN);
    if (mode == 0)
    for (int m = gw; m < MT; m += NGW) {
        const float* xrow = m < MP ? a.in[I_XP] + (size_t)m * DM : a.in[I_XS] + (size_t)(m - MP) * DM;
        f32x4 v[8]; float s = 0.f;
#pragma unroll
        for (int j = 0; j < 8; ++j) { v[j] = *(const f32x4*)(xrow + 4 * lane + 256 * j); s += dot4(v[j], v[j]); }
        const float r = rsqrtf(wave_sum(s) * (1.f / DM) + EPS);
#pragma unroll
        for (int j = 0; j < 8; ++j) { const f32x4 w = *(const f32x4*)(nw + 4 * lane + 256 * j); u32x2 o; o.x = cvt_pk_bf16(v[j][0] * r * w[0], v[j][1] * r * w[1]); o.y = cvt_pk_bf16(v[j][2] * r * w[2], v[j][3] * r * w[3]);
            *(u32x2*)(XN + (size_t)m * DM + 4 * lane + 256 * j) = o; }
    }
}

__device__ __forceinline__ void stage_v(LAS bf16* Vs, const bf16* P, int row0, int colbase, int tid) {
#pragma unroll
    for (int i = 0; i < 8; ++i) { const int idx = tid + NTHR * i, s = idx >> 5, p = idx & 31;
        *(LAS u32x4*)(Vs + s * 272 + p * 8) = *(const u32x4*)(P + (size_t)(row0 + s) * NPROJ + colbase + 8 * p); }
}
typedef short v4i16_t __attribute__((ext_vector_type(4)));
__device__ __forceinline__ u32x2 tr64(const LAS bf16* p) { return __builtin_bit_cast(u32x2, __builtin_amdgcn_ds_read_tr16_b64_v4i16((LAS v4i16_t*)p)); }
__device__ __forceinline__ bf16x8 tr_frag(const LAS bf16* img, int RS, int c0, int ks, int lane) {
    const int g = lane >> 4, q = (lane & 15) >> 2, p = lane & 3;
    const LAS bf16* a = img + (32 * ks + 4 * g + q) * RS + c0 + 4 * p;
    const u32x2 lo = tr64(a), hi = tr64(a + 16 * RS);
    u32x4 w; w.x = lo.x; w.y = lo.y; w.z = hi.x; w.w = hi.y;
    return __builtin_bit_cast(bf16x8, w);
}
__device__ __forceinline__ float wave_iscan_add(float v, int lane) {
#pragma unroll
    for (int o = 1; o < 64; o <<= 1) { const float t = __shfl_up(v, o); if (lane >= o) v += t; }
    return v;
}
__device__ __forceinline__ float wave_iscan_max(float v, int lane) {
#pragma unroll
    for (int o = 1; o < 64; o <<= 1) { const float t = __shfl_up(v, o); if (lane >= o) v = fmaxf(v, t); }
    return v;
}

__device__ __forceinline__ void gla_logdecay(const Args& a, const float* gates, int row0, int h, LAS float* galS, LAS float* segS, int tid, float (&la)[32], float& off, float& tot) {
    const int d = tid & 127, seg = tid >> 7;
    { const int t = tid >> 2, q = tid & 3; *(LAS f32x4*)(galS + t * 16 + q * 4) = *(const f32x4*)(gates + (size_t)(row0 + t) * 32 + 8 + q * 4); }
    float up[16];
#pragma unroll
    for (int j = 0; j < 16; ++j) up[j] = a.in[I_AUP][j * 512 + h * 128 + d];
    const float ab = a.in[I_AB][h * 128 + d];
    __syncthreads();
    float ssum = 0.f;
#pragma unroll
    for (int i = 0; i < 32; ++i) { const int t = seg * 32 + i; float z = ab;
#pragma unroll
        for (int q = 0; q < 4; ++q) { const f32x4 g = *(const LAS f32x4*)(galS + t * 16 + q * 4); z += g[0] * up[4 * q] + g[1] * up[4 * q + 1] + g[2] * up[4 * q + 2] + g[3] * up[4 * q + 3]; }
        la[i] = logsig(z) * (1.f / 16.f); ssum += la[i]; }
    segS[seg * 128 + d] = ssum;
    __syncthreads();
    off = 0.f; tot = 0.f;
#pragma unroll
    for (int s = 0; s < 4; ++s) { const float v = segS[s * 128 + d]; tot += v; off += (s < seg) ? v : 0.f; }
}

template <bool ML>
__device__ __forceinline__ void chunk_state(const Args& a, LAS unsigned char* lds, int bh, int c) {
    constexpr int DK = ML ? 256 : 128, NDT = DK / 16, RSK = DK + 16;
    int tid_ = threadIdx.x; asm volatile("" : "+v"(tid_));
    const int tid = tid_, lane = tid & 63, wave = __builtin_amdgcn_readfirstlane(tid >> 6), fr = lane & 15, fq = lane >> 4;
    const int b = bh >> 2, h = bh & 3, row0 = b * TP + c * 128, item = bh * NCH + c;
    unsigned char* ws = a.ws;
    const bf16* P = (const bf16*)(ws + WS_PROJ); const float* gates = (const float*)(ws + WS_GATES);
    LAS bf16* Ks = (LAS bf16*)lds; LAS bf16* Vs = (LAS bf16*)(lds + 69632); LAS float* sc = (LAS float*)(lds + 139264);
    __syncthreads();
    stage_v(Vs, P, row0, (ML ? C_MV : C_GV) + h * 256, tid);
    if (ML) {
        if (wave == 0) {
            const int t0 = 2 * lane;
            const float lf0 = logsig(gates[(size_t)(row0 + t0) * 32 + 4 + h] + a.in[I_BF][h]), lf1 = logsig(gates[(size_t)(row0 + t0 + 1) * 32 + 4 + h] + a.in[I_BF][h]);
            const float i0 = gates[(size_t)(row0 + t0) * 32 + h] + a.in[I_BI][h], i1 = gates[(size_t)(row0 + t0 + 1) * 32 + h] + a.in[I_BI][h];
            const float pr = lf0 + lf1, S = wave_iscan_add(pr, lane), ex = S - pr;
            const float ah0 = i0 - (ex + lf0), ah1 = i1 - S;
            const float Ah = wave_max(fmaxf(ah0, ah1));
            sc[t0] = __expf(ah0 - Ah) * (1.f / 16.f); sc[t0 + 1] = __expf(ah1 - Ah) * (1.f / 16.f);
            if (lane == 63) { float* chs = (float*)(ws + WS_CHS); chs[item * 2] = Ah; chs[item * 2 + 1] = S; }
        }
        __syncthreads();
#pragma unroll
        for (int i = 0; i < 8; ++i) { const int idx = tid + NTHR * i, s = idx >> 5, dp = idx & 31; const float w = sc[s];
            const u32x4 v = *(const u32x4*)(P + (size_t)(row0 + s) * NPROJ + C_MK + h * 256 + 8 * dp);
            u32x4 o; o.x = cvt_pk_bf16(bflo(v.x) * w, bfhi(v.x) * w); o.y = cvt_pk_bf16(bflo(v.y) * w, bfhi(v.y) * w); o.z = cvt_pk_bf16(bflo(v.z) * w, bfhi(v.z) * w); o.w = cvt_pk_bf16(bflo(v.w) * w, bfhi(v.w) * w);
            *(LAS u32x4*)(Ks + s * RSK + 8 * dp) = o; }
    } else {
        float la[32], off, tot;
        LAS float* galS = (LAS float*)(lds + 36864); gla_logdecay(a, gates, row0, h, galS, galS + 2048, tid, la, off, tot);
        const int d = tid & 127, seg = tid >> 7;
        if (seg == 0) ((float*)(ws + WS_BEND))[item * 128 + d] = tot;
        float bcur = off;
#pragma unroll
        for (int i = 0; i < 32; ++i) { const int t = seg * 32 + i; bcur += la[i];
            const float kv = bf2f(P[(size_t)(row0 + t) * NPROJ + C_GK + h * 128 + d]);
            Ks[t * RSK + d] = f2bf(kv * __expf(tot - bcur)); }
    }
    __syncthreads();
    f32x4 acc[2][NDT];
#pragma unroll
    for (int e = 0; e < 2; ++e)
#pragma unroll
        for (int d = 0; d < NDT; ++d) acc[e][d] = (f32x4){0.f, 0.f, 0.f, 0.f};
#pragma unroll
    for (int ks = 0; ks < 4; ++ks) {
        bf16x8 vb[2];
#pragma unroll
        for (int e = 0; e < 2; ++e) vb[e] = tr_frag(Vs, 272, wave * 32 + e * 16, ks, lane);
#pragma unroll
        for (int d = 0; d < NDT; ++d) { const bf16x8 ka = tr_frag(Ks, RSK, d * 16, ks, lane);
#pragma unroll
            for (int e = 0; e < 2; ++e) acc[e][d] = __builtin_amdgcn_mfma_f32_16x16x32_bf16(ka, vb[e], acc[e][d], 0, 0, 0); }
    }
    float* dst = (float*)(ws + (ML ? WS_DC : WS_DS)) + (size_t)item * 256 * DK;
#pragma unroll
    for (int e = 0; e < 2; ++e)
#pragma unroll
        for (int d = 0; d < NDT; ++d) *(f32x4*)(dst + (size_t)(wave * 32 + e * 16 + fr) * DK + d * 16 + 4 * fq) = acc[e][d];
    if (ML && tid < 256) { float s = 0.f;
#pragma unroll 16
        for (int i = 0; i < 128; ++i) s += bf2f(Ks[i * RSK + tid]);
        ((float*)(ws + WS_DN))[item * 256 + tid] = s; }
}

__device__ __forceinline__ void scan_mlstm(const Args& a, int j) {
    int tid_ = threadIdx.x; asm volatile("" : "+v"(tid_));
    const int tid = tid_, bh = j >> 5, eb = j & 31;
    unsigned char* ws = a.ws;
    const float* chs = (const float*)(ws + WS_CHS);
    const int e = eb * 8 + (tid >> 6), d4 = (tid & 63) * 4;
    const float* dC = (const float*)(ws + WS_DC) + (size_t)bh * NCH * 65536 + (size_t)e * 256 + d4;
    bf16* CT = (bf16*)(ws + WS_CT) + (size_t)bh * NCH * 65536 + (size_t)e * 256 + d4;
    f32x4 Cv = {0.f, 0.f, 0.f, 0.f}; float Fs = 0.f, Mp = 0.f;
    const bool do_n = (eb == 0 && tid < 256);
    float nv = 0.f;
    f32x4 dv[NCH];
#pragma unroll
    for (int c = 0; c < NCH; ++c) dv[c] = *(const f32x4*)(dC + (size_t)c * 65536);
#pragma unroll
    for (int c = 0; c < NCH; ++c) {
        u32x2 o; o.x = cvt_pk_bf16(Cv[0], Cv[1]); o.y = cvt_pk_bf16(Cv[2], Cv[3]); *(u32x2*)(CT + (size_t)c * 65536) = o;
        if (do_n) ((bf16*)(ws + WS_NPREV))[(bh * NCH + c) * 256 + tid] = f2bf(nv);
        const float Ah = chs[(bh * NCH + c) * 2], bt = chs[(bh * NCH + c) * 2 + 1];
        const float Ac = Ah - Fs, Mn = fmaxf(Mp, Ac), f1 = __expf(Mp - Mn), f2 = __expf(Ac - Mn);
        Cv = Cv * f1 + dv[c] * f2;
        if (do_n) nv = nv * f1 + ((const float*)(ws + WS_DN))[(bh * NCH + c) * 256 + tid] * f2;
        Mp = Mn; Fs += bt;
    }
    float* oC = a.out + O_PC + (size_t)bh * 65536;
#pragma unroll
    for (int i = 0; i < 4; ++i) oC[(size_t)(d4 + i) * 256 + e] = Cv[i];
    if (do_n) a.out[O_PN + bh * 256 + tid] = nv;
    if (eb == 0 && tid == 0) a.out[O_PM + bh] = Fs + Mp;
}
__device__ __forceinline__ void scan_gla(const Args& a, int j) {
    int tid_ = threadIdx.x; asm volatile("" : "+v"(tid_));
    const int tid = tid_, bh = j >> 4, eb = j & 15;
    unsigned char* ws = a.ws;
    const float* bend = (const float*)(ws + WS_BEND);
    const int ee = eb * 16 + (tid >> 5), d4 = (tid & 31) * 4;
    const float* dS = (const float*)(ws + WS_DS) + (size_t)bh * NCH * 32768 + (size_t)ee * 128 + d4;
    bf16* ST = (bf16*)(ws + WS_ST) + (size_t)bh * NCH * 32768 + (size_t)ee * 128 + d4;
    f32x4 Sv = {0.f, 0.f, 0.f, 0.f};
    f32x4 dv[NCH];
#pragma unroll
    for (int c = 0; c < NCH; ++c) dv[c] = *(const f32x4*)(dS + (size_t)c * 32768);
#pragma unroll
    for (int c = 0; c < NCH; ++c) {
        u32x2 o; o.x = cvt_pk_bf16(Sv[0], Sv[1]); o.y = cvt_pk_bf16(Sv[2], Sv[3]); *(u32x2*)(ST + (size_t)c * 32768) = o;
        const f32x4 be = *(const f32x4*)(bend + (bh * NCH + c) * 128 + d4);
        Sv[0] = Sv[0] * __expf(be[0]) + dv[c][0]; Sv[1] = Sv[1] * __expf(be[1]) + dv[c][1]; Sv[2] = Sv[2] * __expf(be[2]) + dv[c][2]; Sv[3] = Sv[3] * __expf(be[3]) + dv[c][3];
    }
    float* oS = a.out + O_PS + (size_t)bh * 32768;
#pragma unroll
    for (int i = 0; i < 4; ++i) oS[(size_t)(d4 + i) * 256 + ee] = Sv[i];
}

template <bool ML>
__device__ __forceinline__ void chunk_out(const Args& a, LAS unsigned char* lds, int bh, int c) {
    constexpr int DK = ML ? 256 : 128, QS = DK + 8, NKK = DK / 32;
    int tid_ = threadIdx.x; asm volatile("" : "+v"(tid_));
    const int tid = tid_, lane = tid & 63, wave = __builtin_amdgcn_readfirstlane(tid >> 6), fr = lane & 15, fq = lane >> 4;
    const int b = bh >> 2, h = bh & 3, row0 = b * TP + c * 128, item = bh * NCH + c;
    unsigned char* ws = a.ws;
    const bf16* P = (const bf16*)(ws + WS_PROJ); const float* gates = (const float*)(ws + WS_GATES);
    LAS bf16* Qs = (LAS bf16*)lds; LAS bf16* Ks = Qs + 128 * QS;
    LAS float* sc = (LAS float*)(lds + 143616);
    __syncthreads();
    if (ML) {
        if (wave == 0) {
            const float* chs = (const float*)(ws + WS_CHS);
            const float Ahc = lane < NCH ? chs[(bh * NCH + lane) * 2] : 0.f, btc = lane < NCH ? chs[(bh * NCH + lane) * 2 + 1] : 0.f;
            const float fsx = wave_iscan_add(btc, lane) - btc;
            const float Mp = fmaxf(0.f, wave_max(lane < c ? Ahc - fsx : -3.0e38f)), Fs = wave_sum(lane < c ? btc : 0.f);
            const int t0 = 2 * lane;
            const float lf0 = logsig(gates[(size_t)(row0 + t0) * 32 + 4 + h] + a.in[I_BF][h]), lf1 = logsig(gates[(size_t)(row0 + t0 + 1) * 32 + 4 + h] + a.in[I_BF][h]);
            const float i0 = gates[(size_t)(row0 + t0) * 32 + h] + a.in[I_BI][h], i1 = gates[(size_t)(row0 + t0 + 1) * 32 + h] + a.in[I_BI][h];
            const float pr = lf0 + lf1, S = wave_iscan_add(pr, lane), b0 = S - lf1, b1 = S;
            const float a0 = i0 - b0 - Fs, a1 = i1 - b1 - Fs;
            const float cm = wave_iscan_max(fmaxf(a0, a1), lane); float exm = __shfl_up(cm, 1); if (lane == 0) exm = -3.0e38f;
            const float M0 = fmaxf(fmaxf(Mp, exm), a0), M1 = fmaxf(M0, a1);
            sc[t0] = a0; sc[t0 + 1] = a1; sc[128 + t0] = M0; sc[128 + t0 + 1] = M1; sc[256 + t0] = __expf(Mp - M0); sc[256 + t0 + 1] = __expf(Mp - M1);
            sc[384 + t0] = __expf(-(Fs + b0 + M0)); sc[384 + t0 + 1] = __expf(-(Fs + b1 + M1));
        }
#pragma unroll
        for (int i = 0; i < 8; ++i) { const int idx = tid + NTHR * i, t = idx >> 5, p = idx & 31;
            *(LAS u32x4*)(Qs + t * QS + p * 8) = *(const u32x4*)(P + (size_t)(row0 + t) * NPROJ + C_MQ + h * 256 + p * 8);
            *(LAS u32x4*)(Ks + t * QS + p * 8) = *(const u32x4*)(P + (size_t)(row0 + t) * NPROJ + C_MK + h * 256 + p * 8); }
    } else {
        float la[32], off, tot;
        LAS float* galS = (LAS float*)(lds + 69632); LAS float* segS = galS + 128 * 16;
        gla_logdecay(a, gates, row0, h, galS, segS, tid, la, off, tot);
        const int d = tid & 127, seg = tid >> 7;
        float bcur = off;
#pragma unroll
        for (int i = 0; i < 32; ++i) { const int t = seg * 32 + i; bcur += la[i];
            const float qv = bf2f(P[(size_t)(row0 + t) * NPROJ + C_GQ + h * 128 + d]), kv = bf2f(P[(size_t)(row0 + t) * NPROJ + C_GK + h * 128 + d]);
            Qs[t * QS + d] = f2bf(qv * 0.08838834764831845f * __expf(bcur)); Ks[t * QS + d] = f2bf(kv * __expf(-bcur)); }
    }
    __syncthreads();
    bf16x8 qf[NKK];
#pragma unroll
    for (int kk = 0; kk < NKK; ++kk) qf[kk] = *(const LAS bf16x8*)(Qs + (wave * 16 + fr) * QS + kk * 32 + fq * 8);
    const int t = wave * 16 + fr;
    u32x2 pb[8]; float den = 0.f;
    {
        const float Mt = ML ? sc[128 + t] : 0.f;
#pragma unroll
        for (int st = 0; st < 8; ++st) { f32x4 s = {0.f, 0.f, 0.f, 0.f};
#pragma unroll
            for (int kk = 0; kk < NKK; ++kk) { const bf16x8 kf = *(const LAS bf16x8*)(Ks + (st * 16 + fr) * QS + kk * 32 + fq * 8); s = __builtin_amdgcn_mfma_f32_16x16x32_bf16(kf, qf[kk], s, 0, 0, 0); }
            float p[4];
            f32x4 as4 = {0.f, 0.f, 0.f, 0.f}; if (ML) as4 = *(const LAS f32x4*)(sc + st * 16 + 4 * fq);
#pragma unroll
            for (int r = 0; r < 4; ++r) { const int si = st * 16 + 4 * fq + r;
                const float e = ML ? s[r] * (1.f / 16.f) * __expf(fminf(as4[r] - Mt, 0.f)) : s[r];
                p[r] = (si <= t) ? e : 0.f;
                den += p[r]; }
            pb[st].x = cvt_pk_bf16(p[0], p[1]); pb[st].y = cvt_pk_bf16(p[2], p[3]);
            __builtin_amdgcn_sched_barrier(0); }
    }
    __syncthreads();
    LAS bf16* Cl = (LAS bf16*)lds;
    if (ML) {
        const bf16* CT = (const bf16*)(ws + WS_CT) + (size_t)item * 65536;
#pragma unroll
        for (int i = 0; i < 16; ++i) { const int idx = tid + NTHR * i, e = idx >> 5, p = idx & 31; *(LAS u32x4*)(Cl + e * QS + p * 8) = *(const u32x4*)(CT + (size_t)e * 256 + p * 8); }
        { const int e = tid >> 5, p = tid & 31; u32x4 v = {0u, 0u, 0u, 0u};
          if (e == 0) v = *(const u32x4*)((const bf16*)(ws + WS_NPREV) + (size_t)item * 256 + p * 8);
          *(LAS u32x4*)(Cl + (256 + e) * QS + p * 8) = v; }
    } else {
        const bf16* ST = (const bf16*)(ws + WS_ST) + (size_t)item * 32768;
#pragma unroll
        for (int i = 0; i < 8; ++i) { const int idx = tid + NTHR * i, e = idx >> 4, p = idx & 15; *(LAS u32x4*)(Cl + e * QS + p * 8) = *(const u32x4*)(ST + (size_t)e * 128 + p * 8); }
    }
    __syncthreads();
    f32x4 acc[16];
#pragma unroll
    for (int et = 0; et < 16; ++et) { acc[et] = (f32x4){0.f, 0.f, 0.f, 0.f};
#pragma unroll
        for (int kk = 0; kk < NKK; ++kk) { const bf16x8 cf = *(const LAS bf16x8*)(Cl + (et * 16 + fr) * QS + kk * 32 + fq * 8); acc[et] = __builtin_amdgcn_mfma_f32_16x16x32_bf16(cf, qf[kk], acc[et], 0, 0, 0); }
        if ((et & 1) == 1) __builtin_amdgcn_sched_barrier(0); }
    float wint = 1.f, qn = 0.f;
    if (ML) {
        f32x4 dn = {0.f, 0.f, 0.f, 0.f};
#pragma unroll
        for (int kk = 0; kk < NKK; ++kk) { const bf16x8 nf = *(const LAS bf16x8*)(Cl + (256 + fr) * QS + kk * 32 + fq * 8); dn = __builtin_amdgcn_mfma_f32_16x16x32_bf16(nf, qf[kk], dn, 0, 0, 0); }
        qn = __shfl(dn[0], fr);
        wint = sc[256 + t];
#pragma unroll
        for (int et = 0; et < 16; ++et) acc[et] = acc[et] * wint;
    }
    __syncthreads();
    LAS bf16* Vs = (LAS bf16*)lds;
    stage_v(Vs, P, row0, (ML ? C_MV : C_GV) + h * 256, tid);
    __syncthreads();
#pragma unroll
    for (int ks = 0; ks < 4; ++ks) {
        u32x4 pw; pw.x = pb[2 * ks].x; pw.y = pb[2 * ks].y; pw.z = pb[2 * ks + 1].x; pw.w = pb[2 * ks + 1].y;
        const bf16x8 pf = __builtin_bit_cast(bf16x8, pw);
#pragma unroll
        for (int et = 0; et < 16; ++et) { acc[et] = __builtin_amdgcn_mfma_f32_16x16x32_bf16(tr_frag(Vs, 272, et * 16, ks, lane), pf, acc[et], 0, 0, 0); if ((et & 3) == 3) __builtin_amdgcn_sched_barrier(0); }
    }
    float inv = 1.f;
    if (ML) { den += __shfl_xor(den, 16); den += __shfl_xor(den, 32); den += wint * qn; inv = 1.f / fmaxf(fabsf(den), sc[384 + t]); }
    float ss = 0.f;
#pragma unroll
    for (int et = 0; et < 16; ++et) { acc[et] = acc[et] * inv; ss += dot4(acc[et], acc[et]); }
    ss += __shfl_xor(ss, 16); ss += __shfl_xor(ss, 32);
    const float rn = rsqrtf(ss * (1.f / 256.f) + EPS);
    const float* hw = a.in[ML ? I_MHW : I_GHW] + h * 256;
    const bf16* gp = P + (size_t)(row0 + t) * NPROJ + (ML ? C_MO : C_GR) + h * 256;
    bf16* yp = (bf16*)(ws + (ML ? WS_YM : WS_YG)) + (size_t)(row0 + t) * 1024 + h * 256;
#pragma unroll
    for (int et = 0; et < 16; ++et) { const int e = et * 16 + 4 * fq;
        const u32x2 gw = *(const u32x2*)(gp + e); const f32x4 w = *(const f32x4*)(hw + e);
        const float g0 = bflo(gw.x), g1 = bfhi(gw.x), g2 = bflo(gw.y), g3 = bfhi(gw.y);
        float o0 = acc[et][0] * rn * w[0], o1 = acc[et][1] * rn * w[1], o2 = acc[et][2] * rn * w[2], o3 = acc[et][3] * rn * w[3];
        if (ML) { o0 *= sigm(g0); o1 *= sigm(g1); o2 *= sigm(g2); o3 *= sigm(g3); } else { o0 *= g0 * sigm(g0); o1 *= g1 * sigm(g1); o2 *= g2 * sigm(g2); o3 *= g3 * sigm(g3); }
        u32x2 o; o.x = cvt_pk_bf16(o0, o1); o.y = cvt_pk_bf16(o2, o3); *(u32x2*)(yp + e) = o;
        if ((et & 3) == 3) __builtin_amdgcn_sched_barrier(0); }
}

template <bool ML>
__device__ __forceinline__ void sample_item(const Args& a, LAS unsigned char* lds, int b, int h) {
    constexpr int DK = ML ? 256 : 128;
    int tid_ = threadIdx.x; asm volatile("" : "+v"(tid_));
    const int tid = tid_, lane = tid & 63, wave = __builtin_amdgcn_readfirstlane(tid >> 6);
    unsigned char* ws = a.ws;
    const bf16* P = (const bf16*)(ws + WS_PROJ); const float* gates = (const float*)(ws + WS_GATES);
    const int row0 = MP + b * 8, bh = b * 4 + h;
    LAS float* qT = (LAS float*)lds;
    LAS float* wkT = qT + 2048;
    LAS float* kT = wkT + 2048;
    LAS float* vS = kT + 2048;
    LAS float* red = vS + 2048;
    LAS float* sm = red + 16384;
    __syncthreads();
    float aS[8], Mt[8], bS[8]; float m0 = 0.f, dec = 1.f;
    if (ML) {
        m0 = a.in[I_M][bh]; float bs = 0.f, M = m0;
#pragma unroll
        for (int t = 0; t < 8; ++t) { const float mi = gates[(size_t)(row0 + t) * 32 + h], mf = gates[(size_t)(row0 + t) * 32 + 4 + h];
            bs += logsig(mf + a.in[I_BF][h]); bS[t] = bs; aS[t] = mi + a.in[I_BI][h] - bs; M = fmaxf(M, aS[t]); Mt[t] = M; }
        dec = __expf(m0 - Mt[7]);
        if (tid == 0) {
#pragma unroll
            for (int t = 0; t < 8; ++t) { sm[200 + t] = aS[t]; sm[208 + t] = Mt[t]; sm[216 + t] = bS[t]; } }
        if (tid < 256) { const int d = tid;
#pragma unroll
            for (int t = 0; t < 8; ++t) { const float qv = bf2f(P[(size_t)(row0 + t) * NPROJ + C_MQ + h * 256 + d]), kv = bf2f(P[(size_t)(row0 + t) * NPROJ + C_MK + h * 256 + d]) * (1.f / 16.f);
                qT[d * 8 + t] = qv; kT[d * 8 + t] = kv; wkT[d * 8 + t] = kv * __expf(aS[t] - Mt[7]); } }
    } else {
        if (tid < 128) { const int d = tid; float up[16];
#pragma unroll
            for (int j = 0; j < 16; ++j) up[j] = a.in[I_AUP][j * 512 + h * 128 + d];
            const float ab = a.in[I_AB][h * 128 + d];
            float bc[8]; float bs = 0.f;
#pragma unroll
            for (int t = 0; t < 8; ++t) { float z = ab;
#pragma unroll
                for (int j = 0; j < 16; ++j) z += gates[(size_t)(row0 + t) * 32 + 8 + j] * up[j];
                bs += logsig(z) * (1.f / 16.f); bc[t] = bs; }
            sm[72 + d] = __expf(bs);
#pragma unroll
            for (int t = 0; t < 8; ++t) { const float qv = bf2f(P[(size_t)(row0 + t) * NPROJ + C_GQ + h * 128 + d]), kv = bf2f(P[(size_t)(row0 + t) * NPROJ + C_GK + h * 128 + d]);
                qT[d * 8 + t] = qv * 0.08838834764831845f * __expf(bc[t]); kT[d * 8 + t] = kv * __expf(-bc[t]); wkT[d * 8 + t] = kv * __expf(bs - bc[t]); } }
    }
    { const int t = tid >> 6; const u32x2 w = *(const u32x2*)(P + (size_t)(row0 + t) * NPROJ + (ML ? C_MV : C_GV) + h * 256 + 4 * lane);
      *(LAS f32x4*)(vS + t * 256 + 4 * lane) = (f32x4){bflo(w.x), bfhi(w.x), bflo(w.y), bfhi(w.y)}; }
    __syncthreads();
    float prow, qn = 0.f;
    { const int s8 = lane & 7, part = lane >> 3; float sd = 0.f;
#pragma unroll 8
      for (int i = 0; i < DK / 8; ++i) { const int d = 8 * i + part; sd += qT[d * 8 + wave] * kT[d * 8 + s8]; }
      sd += __shfl_xor(sd, 8); sd += __shfl_xor(sd, 16); sd += __shfl_xor(sd, 32);
      if (ML) prow = (s8 <= wave) ? sd * __expf(sm[200 + s8] - sm[208 + wave]) : 0.f; else prow = (s8 <= wave) ? sd : 0.f; }
    if (ML) { const float* n0 = a.in[I_N] + (size_t)bh * 256; float sd = 0.f;
#pragma unroll
      for (int i = 0; i < 4; ++i) { const int d = lane + 64 * i; sd += qT[d * 8 + wave] * n0[d]; }
      qn = wave_sum(sd); }
    const float* C0 = a.in[ML ? I_C : I_S] + (size_t)bh * DK * 256;
    float* C1 = a.out + (ML ? O_SC : O_SS) + (size_t)bh * DK * 256;
    f32x4 v[8], acc[8];
#pragma unroll
    for (int s = 0; s < 8; ++s) { v[s] = *(const LAS f32x4*)(vS + s * 256 + 4 * lane); acc[s] = (f32x4){0.f, 0.f, 0.f, 0.f}; }
#pragma unroll 8
    for (int i = 0; i < DK / 8; ++i) { const int d = wave + 8 * i;
        const f32x4 cv = __builtin_nontemporal_load((const f32x4*)(C0 + (size_t)d * 256 + 4 * lane));
        const f32x4 q0 = *(const LAS f32x4*)(qT + d * 8), q1 = *(const LAS f32x4*)(qT + d * 8 + 4), k0 = *(const LAS f32x4*)(wkT + d * 8), k1 = *(const LAS f32x4*)(wkT + d * 8 + 4);
        const float dd = ML ? dec : sm[72 + d];
        acc[0] += cv * q0[0]; acc[1] += cv * q0[1]; acc[2] += cv * q0[2]; acc[3] += cv * q0[3]; acc[4] += cv * q1[0]; acc[5] += cv * q1[1]; acc[6] += cv * q1[2]; acc[7] += cv * q1[3];
        f32x4 cn = cv * dd;
        cn += v[0] * k0[0]; cn += v[1] * k0[1]; cn += v[2] * k0[2]; cn += v[3] * k0[3]; cn += v[4] * k1[0]; cn += v[5] * k1[1]; cn += v[6] * k1[2]; cn += v[7] * k1[3];
        __builtin_nontemporal_store(cn, (f32x4*)(C1 + (size_t)d * 256 + 4 * lane)); }
#pragma unroll
    for (int s = 0; s < 8; ++s) *(LAS f32x4*)(red + (wave * 8 + s) * 256 + 4 * lane) = acc[s];
    __syncthreads();
    const int t = wave;
    f32x4 qc = {0.f, 0.f, 0.f, 0.f};
#pragma unroll
    for (int w = 0; w < 8; ++w) qc += *(const LAS f32x4*)(red + (w * 8 + t) * 256 + 4 * lane);
    float wint = 1.f, den = 0.f, Mtt = 0.f, btt = 0.f;
    if (ML) { Mtt = sm[208 + t]; btt = sm[216 + t]; wint = __expf(m0 - Mtt); }
    f32x4 num = qc * wint;
#pragma unroll
    for (int s = 0; s < 8; ++s) { const float p = __shfl(prow, s); num += v[s] * p; den += p; }
    if (ML) { den += wint * qn; const float fl = fmaxf(fabsf(den), __expf(-(btt + Mtt))); num = num * (1.f / fl); }
    const float rn = rsqrtf(wave_sum(dot4(num, num)) * (1.f / 256.f) + EPS);
    const f32x4 w = *(const f32x4*)(a.in[ML ? I_MHW : I_GHW] + h * 256 + 4 * lane);
    const u32x2 gw = *(const u32x2*)(P + (size_t)(row0 + t) * NPROJ + (ML ? C_MO : C_GR) + h * 256 + 4 * lane);
    const float g0 = bflo(gw.x), g1 = bfhi(gw.x), g2 = bflo(gw.y), g3 = bfhi(gw.y);
    float o0 = num[0] * rn * w[0], o1 = num[1] * rn * w[1], o2 = num[2] * rn * w[2], o3 = num[3] * rn * w[3];
    if (ML) { o0 *= sigm(g0); o1 *= sigm(g1); o2 *= sigm(g2); o3 *= sigm(g3); } else { o0 *= g0 * sigm(g0); o1 *= g1 * sigm(g1); o2 *= g2 * sigm(g2); o3 *= g3 * sigm(g3); }
    u32x2 o; o.x = cvt_pk_bf16(o0, o1); o.y = cvt_pk_bf16(o2, o3);
    *(u32x2*)((bf16*)(ws + (ML ? WS_YM : WS_YG)) + (size_t)(row0 + t) * 1024 + h * 256 + 4 * lane) = o;
    if (ML) {
        if (tid < 256) { float s = dec * a.in[I_N][(size_t)bh * 256 + tid];
#pragma unroll
            for (int q = 0; q < 8; ++q) s += wkT[tid * 8 + q];
            a.out[O_SN + (size_t)bh * 256 + tid] = s; }
        if (tid == 0) a.out[O_SM + bh] = bS[7] + Mt[7];
    }
}

__device__ __forceinline__ void rstd_phase(const Args& a, int vcu, int G) {
    int tid_ = threadIdx.x; asm volatile("" : "+v"(tid_));
    const int tid = tid_, lane = tid & 63, wave = tid >> 6;
    const float* part = (const float*)(a.ws + WS_PART); float* rstd = (float*)(a.ws + WS_RSTD);
    const bool split = (G == 256); const int nplain = split ? MP : MT;
    for (int row = vcu * NTHR + tid; row < nplain; row += G * NTHR) { float s = 0.f;
#pragma unroll
        for (int i = 0; i < 8; ++i) s += sum4(*(const f32x4*)(part + (size_t)row * 32 + 4 * i));
        rstd[row] = rsqrtf(s * (1.f / DM) + EPS); }
    if (split) {
        const float* tailp = (const float*)(a.ws + WS_PROJ); const float* nw = a.in[I_NFFN]; float* X1 = (float*)(a.ws + WS_X1); bf16* X1W = (bf16*)(a.ws + WS_X1W);
        for (int rr = vcu * NWAVES + wave; rr < MS; rr += G * NWAVES) { const int m = MP + rr, pmo = rr >> 8;
            f32x4 v[8]; float ss = 0.f;
#pragma unroll
            for (int j = 0; j < 8; ++j) { v[j] = *(const f32x4*)(a.in[I_XS] + (size_t)rr * DM + 4 * lane + 256 * j);
                const float* tp = tailp + (size_t)(pmo * 8 + j) * 8 * 65536 + (rr & 255) * 256 + 4 * lane;
#pragma unroll
                for (int sl = 0; sl < 8; ++sl) v[j] += *(const f32x4*)(tp + (size_t)sl * 65536);
                ss += dot4(v[j], v[j]); }
            ss = wave_sum(ss);
            if (lane == 0) rstd[m] = rsqrtf(ss * (1.f / DM) + EPS);
#pragma unroll
            for (int j = 0; j < 8; ++j) { const f32x4 w = *(const f32x4*)(nw + 4 * lane + 256 * j);
                *(f32x4*)(X1 + (size_t)m * DM + 4 * lane + 256 * j) = v[j];
                u32x2 o; o.x = cvt_pk_bf16(v[j][0] * w[0], v[j][1] * w[1]); o.y = cvt_pk_bf16(v[j][2] * w[2], v[j][3] * w[3]);
                *(u32x2*)(X1W + (size_t)m * DM + 4 * lane + 256 * j) = o; }
        }
    }
}
__device__ __forceinline__ void act_fixup(const Args& a, int vcu, int G) {
    unsigned char* ws = a.ws; const float* ub = (const float*)(ws + WS_U); bf16* ACT = (bf16*)(ws + WS_G);
    const float* cw = a.in[I_CW]; const float* cb = a.in[I_CB];
    int tid_ = threadIdx.x; asm volatile("" : "+v"(tid_));
    for (int idx = vcu * NTHR + tid_; idx < 28 * DFF; idx += G * NTHR) {
        const int k = idx / DFF, col = idx % DFF, pm = (k / 7) * 8 + 1 + (k % 7);
        const float um2 = ub[((size_t)(pm - 1) * 6 + 0) * DFF + col], um1 = ub[((size_t)(pm - 1) * 6 + 1) * DFF + col];
        const float u0 = ub[((size_t)pm * 6 + 2) * DFF + col], u1 = ub[((size_t)pm * 6 + 3) * DFF + col], g0 = ub[((size_t)pm * 6 + 4) * DFF + col], g1 = ub[((size_t)pm * 6 + 5) * DFF + col];
        const float c0 = cw[col], c1 = cw[DFF + col], c2 = cw[2 * DFF + col], bb = cb[col];
        ACT[(size_t)(pm * 256) * DFF + col] = f2bf(gelu_tanh(bb + c0 * um2 + c1 * um1 + c2 * u0) * g0);
        ACT[(size_t)(pm * 256 + 1) * DFF + col] = f2bf(gelu_tanh(bb + c0 * um1 + c1 * u0 + c2 * u1) * g1);
    }
}
__device__ __forceinline__ void final_norm(const Args& a, int vcu, int G) {
    int tid_ = threadIdx.x; asm volatile("" : "+v"(tid_));
    const int tid = tid_, lane = tid & 63, wave = tid >> 6;
    const float* fw = a.in[I_FNW]; const float* X1 = (const float*)(a.ws + WS_X1); const float* tailp = (const float*)(a.ws + WS_U);
    const bool split = (G == 256);
    int tpm = -1, tpn = -1;
    if (split && lane < 32) { pg8::StaticOrder S; S.init(MT, DM, G, 0); pg8::Unit u; if (S.at(256 + lane, u)) { tpm = u.pm; tpn = u.pn; } }
    for (int m = vcu * NWAVES + wave; m < MT; m += G * NWAVES) {
        const int pm = m >> 8;
        float* row = a.out + (size_t)m * DM;
        f32x4 v[8]; float ss = 0.f;
#pragma unroll
        for (int j = 0; j < 8; ++j) {
            const unsigned long long mask = __ballot(tpm == pm && tpn == j);
            if (mask == 0ull) v[j] = *(const f32x4*)(row + 4 * lane + 256 * j);
            else { const int tt = __ffsll((long long)mask) - 1;
                v[j] = *(const f32x4*)(X1 + (size_t)m * DM + 4 * lane + 256 * j);
                const float* tp = tailp + (size_t)tt * 8 * 65536 + (m & 255) * 256 + 4 * lane;
#pragma unroll
                for (int sl = 0; sl < 8; ++sl) v[j] += *(const f32x4*)(tp + (size_t)sl * 65536); }
            ss += dot4(v[j], v[j]); }
        const float r = rsqrtf(wave_sum(ss) * (1.f / DM) + EPS);
#pragma unroll
        for (int j = 0; j < 8; ++j) { const f32x4 w = *(const f32x4*)(fw + 4 * lane + 256 * j);
            *(f32x4*)(row + 4 * lane + 256 * j) = (f32x4){v[j][0] * r * w[0], v[j][1] * r * w[1], v[j][2] * r * w[2], v[j][3] * r * w[3]}; }
    }
}

#define XB_TMO      128
#define XB_XCNT(j)  (256  + 64 * (j))
#define XB_XSUB(j)  (1280 + 64 * (j))
#define XB_XGEN(j)  (2304 + 64 * (j))
#define XB_TOP      3328
#define XB_TOPGEN   3392
#define XCD_BAR_WORDS 3456
#define XB_SPIN_CAP (1u << 18)

__device__ __forceinline__ unsigned xb_ld(unsigned* p)              { return __hip_atomic_load(p, __ATOMIC_RELAXED, __HIP_MEMORY_SCOPE_AGENT); }
__device__ __forceinline__ unsigned xb_add(unsigned* p, unsigned v) { return __hip_atomic_fetch_add(p, v, __ATOMIC_RELAXED, __HIP_MEMORY_SCOPE_AGENT); }
__device__ __forceinline__ unsigned xb_xcc_id() { return (unsigned)__builtin_amdgcn_s_getreg((3 << 11) | 20) & 0xFu; }
#define XB_SPIN(cond, bar) do { unsigned _sp = 0; while (cond) { __builtin_amdgcn_s_sleep(1); \
    if ((++_sp & 255u) == 0u) { if (xb_ld(&(bar)[XB_TMO])) break; if (_sp > XB_SPIN_CAP) { atomicAdd(&(bar)[XB_TMO], 1u); break; } } } } while (0)

struct XcdBarrier {
    unsigned* bar; unsigned x;
    volatile LAS unsigned* st;
};

__device__ __forceinline__ XcdBarrier xcd_barrier_post(unsigned* bar, volatile LAS unsigned* st) {
    XcdBarrier b; b.bar = bar; b.x = xb_xcc_id(); b.st = st;
    if (threadIdx.x == 0) (void)xb_add(&bar[XB_XCNT(b.x)], 1u);
    return b;
}
__device__ __forceinline__ void xcd_barrier_complete(unsigned* bar, unsigned x, unsigned& nloc, unsigned& nx) {
    const unsigned G = gridDim.x * gridDim.y * gridDim.z;
    unsigned sum, cnt, mine, sp = 0u;
    for (;;) {
        sum = 0u; cnt = 0u; mine = 0u;
#pragma unroll
        for (unsigned j = 0; j < 16; ++j) { const unsigned c = xb_ld(&bar[XB_XCNT(j)]); sum += c; cnt += (c > 0u) ? 1u : 0u; mine = (j == x) ? c : mine; }
        if (sum == G) break;
        __builtin_amdgcn_s_sleep(1);
        if ((++sp & 255u) == 0u) { if (xb_ld(&bar[XB_TMO])) break; if (sp > XB_SPIN_CAP) { atomicAdd(&bar[XB_TMO], 1u); break; } }
    }
    nloc = mine > 0u ? mine : 1u; nx = cnt > 0u ? cnt : 1u;
}

__device__ __forceinline__ void xcd_barrier(const XcdBarrier& b) {
    asm volatile("s_waitcnt vmcnt(0)" ::: "memory");
    __syncthreads();
    if (threadIdx.x == 0) {
        unsigned* bar = b.bar;
        __builtin_amdgcn_s_waitcnt(0);
        unsigned nloc = b.st[0], nx = b.st[1];
        if (nloc == 0u) { xcd_barrier_complete(bar, b.x, nloc, nx); b.st[0] = nloc; b.st[1] = nx; }
        const unsigned old = xb_add(&bar[XB_XSUB(b.x)], 1u);
        const unsigned gen = old / nloc;
        if (old + 1u == (gen + 1u) * nloc) {
            __builtin_amdgcn_fence(__ATOMIC_RELEASE, "agent");
            asm volatile("s_waitcnt vmcnt(0)" ::: "memory");
            const unsigned og = xb_add(&bar[XB_TOP], 1u);
            const unsigned tg = og / nx;
            if (og + 1u == (tg + 1u) * nx) xb_add(&bar[XB_TOPGEN], 1u);
            else XB_SPIN(xb_ld(&bar[XB_TOPGEN]) == tg, bar);
            __builtin_amdgcn_fence(__ATOMIC_ACQUIRE, "agent");
            xb_add(&bar[XB_XGEN(b.x)], 1u);
            asm volatile("s_waitcnt vmcnt(0)" ::: "memory");
        } else {
            XB_SPIN(xb_ld(&bar[XB_XGEN(b.x)]) == gen, bar);
            __builtin_amdgcn_fence(__ATOMIC_ACQUIRE, "agent");
            asm volatile("s_waitcnt vmcnt(0)" ::: "memory");
        }
    }
    __syncthreads();
}

constexpr int N_PHASES = 12;
__global__ void __launch_bounds__(NTHR) fwd_kernel(Args args) {
    extern __shared__ __attribute__((aligned(16))) unsigned char lds_raw[];
    LAS unsigned char* lds = (LAS unsigned char*)lds_raw;
    cg::grid_group grid = cg::this_grid();
    volatile LAS unsigned* bst = (volatile LAS unsigned*)(lds + LDS_BYTES - 16);
    if (threadIdx.x < 4) bst[threadIdx.x] = 0u;
    __syncthreads();
    XcdBarrier xbar = xcd_barrier_post((unsigned*)args.ws, bst);
    const int G = gridDim.x, bx = blockIdx.x;
    const int vcu = (G % 8 == 0) ? (bx % 8) * (G / 8) + bx / 8 : bx;
    const int lo = args.ph_lo, hi = args.ph_hi;
    unsigned char* ws = args.ws;
#ifndef USE_CG_SYNC
#define USE_CG_SYNC 0
#endif
#ifndef DOUBLE_MASK
#define DOUBLE_MASK 0
#endif
#define REP(k) for (int rep_ = 0; rep_ < 1 + ((DOUBLE_MASK >> (k)) & 1); ++rep_)
#ifndef DBL_P2
#define DBL_P2 0
#endif
#ifndef BIS
#define BIS 15
#endif
#ifndef PHASE_MASK
#define PHASE_MASK 0xfff
#endif
#define IN(k) (((PHASE_MASK >> (k)) & 1) && lo <= (k) && (k) < hi)
#define SEAM(k) do { if (IN(k) && IN((k) + 1)) { if (USE_CG_SYNC || lo < 0) grid.sync(); else xcd_barrier(xbar); } } while (0)
    if (IN(0)) REP(0) { p0_prologue(args, lds, vcu, G, 0); __syncthreads(); }
    SEAM(0);
    if (IN(1)) REP(1) {
        pg8::Gemm g{(const bf16*)(ws + WS_XN), (const bf16*)(ws + WS_WIN), nullptr, nullptr, MT, NPROJ_PAD, DM}; pg8::StaticOrder S; S.init(MT, NPROJ_PAD, G, bx);
        EpiProj E{(bf16*)(ws + WS_PROJ), (float*)(ws + WS_GATES)};
        pg8::gemm_phase<EpiProj, pg8::StaticOrder, true, true>(lds, g, S, E);
        { const int rem = S.nwg % G, nidle = rem ? G - rem : G, idx = rem ? bx - rem : bx;
          if (idx >= 0) p0_prologue(args, lds, idx, nidle, 1); }
        __syncthreads();
    }
    SEAM(1);
    if (IN(2)) REP(2) {
        for (int it = bx; it < 1536; it += G) {
            if (it < 512) { for (int r_ = 0; r_ < 1 + (DBL_P2 & 1); ++r_) sample_item<true>(args, lds, it >> 2, it & 3); }
            else if (it < 1024) { for (int r_ = 0; r_ < 1 + ((DBL_P2 >> 1) & 1); ++r_) sample_item<false>(args, lds, (it - 512) >> 2, (it - 512) & 3); }
            else if (it < 1280) { for (int r_ = 0; r_ < 1 + ((DBL_P2 >> 2) & 1); ++r_) chunk_state<true>(args, lds, (it - 1024) >> 4, (it - 1024) & 15); }
            else { for (int r_ = 0; r_ < 1 + ((DBL_P2 >> 3) & 1); ++r_) chunk_state<false>(args, lds, (it - 1280) >> 4, (it - 1280) & 15); }
        }
    }
    SEAM(2);
    if (IN(3)) REP(3) { for (int it = bx; it < 768; it += G) { if (it < 512) scan_mlstm(args, it); else scan_gla(args, it - 512); } }
    SEAM(3);
    if (IN(4)) REP(4) { for (int it = bx; it < 512; it += G) { if (it < 256) { if (BIS & 1) chunk_out<true>(args, lds, it >> 4, it & 15); } else { if (BIS & 2) chunk_out<false>(args, lds, (it - 256) >> 4, (it - 256) & 15); } } __syncthreads(); }
    SEAM(4);
    if (IN(5)) REP(5) {
        pg8::Gemm g{(const bf16*)(ws + WS_YM), (const bf16*)(ws + WS_WA), (const bf16*)(ws + WS_YG), (const bf16*)(ws + WS_WB), MT, DM, 1024}; pg8::TwoSegOrder S; S.S.init(MT, DM, G, bx);
        EpiBranch E{(const bf16*)(ws + WS_PROJ), (bf16*)(ws + WS_XN)};
        pg8::gemm_phase<EpiBranch, pg8::TwoSegOrder, true, true>(lds, g, S, E);
    }
    SEAM(5);
    if (IN(6)) REP(6) {
        pg8::Gemm g{(const bf16*)(ws + WS_XN), (const bf16*)(ws + WS_WO), nullptr, nullptr, MT, DM, DM}; pg8::SplitRowsOrder<1, 32> S; S.split = (G == 256); S.S.init(S.split ? MP : MT, DM, G, bx);
        EpiOut E{args.in[I_XP], args.in[I_XS], (float*)(ws + WS_X1), (bf16*)(ws + WS_X1W), args.in[I_NFFN], (float*)(ws + WS_PART), (float*)(ws + WS_PROJ)};
        pg8::gemm_phase<EpiOut, pg8::SplitRowsOrder<1, 32>, true, true>(lds, g, S, E);
    }
    SEAM(6);
    if (IN(7)) REP(7) rstd_phase(args, vcu, G);
    SEAM(7);
    if (IN(8)) REP(8) {
        pg8::Gemm g{(const bf16*)(ws + WS_X1W), (const bf16*)(ws + WS_WUG), nullptr, nullptr, MT, 2 * DFF, DM}; pg8::StaticOrder S; S.init(MT, 2 * DFF, G, bx);
        EpiUGAct E{(const float*)(ws + WS_RSTD), (bf16*)(ws + WS_G), args.out, args.in[I_CW], args.in[I_CB], args.in[I_CONV], (float*)(ws + WS_U), (LAS float*)(lds + 131072)};
        pg8::gemm_phase<EpiUGAct, pg8::StaticOrder, true, true>(lds, g, S, E);
    }
    SEAM(8);
    if (IN(9)) REP(9) act_fixup(args, vcu, G);
    SEAM(9);
    if (IN(10)) REP(10) {
        pg8::Gemm g{(const bf16*)(ws + WS_G), (const bf16*)(ws + WS_WD), nullptr, nullptr, MT, DM, DFF}; pg8::DownOrder S; S.S.init(MT, DM, G, bx); S.split = (G == 256);
        EpiDown E{(const float*)(ws + WS_X1), args.out, (float*)(ws + WS_U)};
        pg8::gemm_phase<EpiDown, pg8::DownOrder, true, true>(lds, g, S, E);
    }
    SEAM(10);
    if (IN(11)) REP(11) final_norm(args, vcu, G);
#ifdef EXTRA_SYNCS
    for (int i_ = 0; i_ < EXTRA_SYNCS; ++i_) xcd_barrier(xbar);
#endif
#undef IN
#undef SEAM
}

extern "C" void kernel_launch(void* const* d_in, const int* in_sizes, int n_in, void* d_out, int out_size, void* d_ws, size_t ws_size, hipStream_t stream) {
    static int grid = 0;
    if (grid == 0) {
        if (n_in != 25 || ws_size < WS_END) { fprintf(stderr, "kernel_launch: unexpected n_in %d / ws_size %zu (need %zu)\n", n_in, ws_size, (size_t)WS_END); grid = -1; return; }
        int dev = 0, cus = 0, per_cu = 0;
        (void)hipGetDevice(&dev); (void)hipDeviceGetAttribute(&cus, hipDeviceAttributeMultiprocessorCount, dev);
        if (hipFuncSetAttribute((const void*)fwd_kernel, hipFuncAttributeMaxDynamicSharedMemorySize, LDS_BYTES) != hipSuccess) { fprintf(stderr, "kernel_launch: hipFuncSetAttribute failed\n"); grid = -1; return; }
        if (hipOccupancyMaxActiveBlocksPerMultiprocessor(&per_cu, (const void*)fwd_kernel, NTHR, LDS_BYTES) != hipSuccess || per_cu < 1) { fprintf(stderr, "kernel_launch: occupancy query says %d\n", per_cu); per_cu = 1; }
        (void)hipGetLastError();
        grid = cus * 1;
        if (grid <= 0) grid = 256;
    }
    if (grid < 0) return;
    if (hipMemsetAsync(d_ws, 0, 65536, stream) != hipSuccess) { fprintf(stderr, "kernel_launch: memset failed\n"); return; }
    Args a{};
    for (int i = 0; i < 25; ++i) a.in[i] = (const float*)d_in[i];
    a.out = (float*)d_out; a.ws = (unsigned char*)d_ws;
    if (MK_N_LAUNCHES == 1) {
        a.ph_lo = 0; a.ph_hi = N_PHASES;
        void* kargs[] = {&a};
        hipError_t e = hipLaunchCooperativeKernel((const void*)fwd_kernel, dim3(grid), dim3(NTHR), kargs, LDS_BYTES, stream);
        if (e != hipSuccess) fprintf(stderr, "kernel_launch: cooperative launch failed: %s (grid %d)\n", hipGetErrorString(e), grid);
    } else {
        for (int p = 0; p < N_PHASES; ++p) { a.ph_lo = p; a.ph_hi = p + 1; hipLaunchKernelGGL(fwd_kernel, dim3(grid), dim3(NTHR), LDS_BYTES, stream, a); }
    }
}
```

```cpp
#include <hip/hip_runtime.h>
#include <hip/hip_cooperative_groups.h>
#include <cstdio>
#include <cstdint>
namespace cg = cooperative_groups;

#ifndef MK_N_LAUNCHES
#define MK_N_LAUNCHES 1
#endif

namespace pg8 {
#define PG8_LAS __attribute__((address_space(3)))
typedef unsigned short bf16_t;
typedef short bf16x8 __attribute__((ext_vector_type(8)));
typedef float f32x4 __attribute__((ext_vector_type(4)));
typedef unsigned u32x4 __attribute__((ext_vector_type(4)));
constexpr int BM = 256, BK = 64, HALF = 128, HTB = HALF * BK * 2  , STAGE_BYTES = 8 * HTB, NXCD = 8, WGM = 8;

__host__ __device__ __forceinline__ int lds_byte(int r, int c) { const int st = (r >> 4) * 2 + (c >> 5), rr = r & 15, cc = c & 31, ob = rr * 64 + cc * 2; return st * 1024 + (ob ^ (((ob >> 9) & 1) << 5)); }
__host__ __device__ __forceinline__ void stage_rc(int b, int& R, int& C) { const int st = b / 1024, sb = b % 1024, swz = sb ^ (((sb >> 9) & 1) << 5); R = (st >> 1) * 16 + swz / 64; C = (st & 1) * 32 + (swz % 64) / 2; }
__host__ __device__ __forceinline__ int perm32(int rho) { const int n = rho >> 4, i = rho & 15; return 8 * (i >> 2) + 4 * n + (i & 3); }

struct Unit { int pm, pn, seg, kt0, nkt, tail; };
struct Gemm { const bf16_t* A; const bf16_t* Bt; const bf16_t* A2; const bf16_t* Bt2; int M, N, K; };

struct StaticOrder {
    int nM, nN, nwg, G, c;
    __host__ __device__ void init(int M, int N, int G_, int c_) { nM = M / BM; nN = N / BM; nwg = nM * nN; G = G_; c = c_; }
    __host__ __device__ bool next(int i, Unit& u) const { return at((long)i * G + c, u); }
    __host__ __device__ bool at(long L, Unit& u) const {
        if (L >= nwg) return false;
        int wgid = (int)L; { const int q = nwg / NXCD, r = nwg % NXCD, xcd = wgid % NXCD, off = wgid / NXCD; wgid = (xcd < r ? xcd * (q + 1) : r * (q + 1) + (xcd - r) * q) + off; }
        const int nig = WGM * nN, gid = wgid / nig, fm = gid * WGM, gsz = (nM - fm) < WGM ? (nM - fm) : WGM;
        u.pm = fm + ((wgid % nig) % gsz); u.pn = (wgid % nig) / gsz; u.seg = 0; u.kt0 = 0; u.nkt = -1; u.tail = -1; return true;
    }
};
struct DownOrder {
    StaticOrder S; bool split;
    __host__ __device__ bool next(int i, Unit& u) const {
        if (!split) return S.next(i, u);
        if (i == 0) return S.at(S.c, u);
        if (i > 1) return false;
        const int tt = S.c >> 3, sl = S.c & 7;
        if (!S.at(256 + tt, u)) return false;
        u.kt0 = 11 * sl + (sl & 1); u.nkt = (sl & 1) ? 10 : 12; u.tail = tt * 8 + sl; return true;
    }
};
template <int NSEG, int KT>
struct SplitRowsOrder {
    StaticOrder S; bool split;
    __host__ __device__ bool next(int i, Unit& u) const {
        if (!split) { if (!S.next(i / NSEG, u)) return false; u.seg = i % NSEG; return true; }
        if (i < NSEG) { if (!S.at(S.c, u)) return false; u.seg = i; return true; }
        if (i >= 2 * NSEG) return false;
        const int tt = S.c >> 3, sl = S.c & 7;
        u.pm = 32 + (tt >> 3); u.pn = tt & 7; u.seg = i - NSEG; u.kt0 = (KT / 8) * sl; u.nkt = KT / 8; u.tail = tt * 8 + sl; return true;
    }
};
struct TwoSegOrder {
    StaticOrder S;
    __host__ __device__ bool next(int i, Unit& u) const { if (!S.next(i >> 1, u)) return false; u.seg = i & 1; return true; }
};

__device__ __forceinline__ unsigned cvt_pk_bf16(float lo, float hi) { unsigned r; asm volatile("v_cvt_pk_bf16_f32 %0, %1, %2" : "=v"(r) : "v"(lo), "v"(hi)); return r; }

template <class Epi, class Sched, bool ALIGN_EPI = false, bool SP2 = false>
__device__ __forceinline__ void gemm_phase(PG8_LAS unsigned char* lds, const Gemm g, const Sched& S, const Epi& E) {
    int tid_ = threadIdx.x; asm volatile("" : "+v"(tid_));
    const int tid = tid_, wid = __builtin_amdgcn_readfirstlane(tid >> 6), lane = tid & 63, wr = wid >> 2, wc = wid & 3, fr = lane & 15, fq = lane >> 4;
    const int K = g.K, ntf = K / BK;
    unsigned voffA[2], voffB[2];
#pragma unroll
    for (int i = 0; i < 2; ++i) { int R, C; stage_rc(tid * 16 + i * 8192, R, C); const int Rb = Epi::PERM ? ((R & ~31) + perm32(R & 31)) : R;
        voffA[i] = (unsigned)(R * K + C) * 2u; voffB[i] = (unsigned)(Rb * K + C) * 2u; }
    const size_t kstep = (size_t)(BK * 2);
    const size_t hstep = (size_t)HALF * K * 2;
    const size_t tstep = 2 * hstep;
    const unsigned ldsw = (unsigned)wid * 1024u;
    const int aoff = lds_byte(wr * 64 + fr, fq * 8), boff = lds_byte(wc * 32 + fr, fq * 8);
#define PG8_SA(b, h) (((b) * 2 + (h)) * HTB)
#define PG8_SB(b, h) ((4 + (b) * 2 + (h)) * HTB)
#define PG8_STAGE(bufoff, gbase, voff) do { _Pragma("unroll") for (int _i = 0; _i < 2; ++_i) \
        __builtin_amdgcn_global_load_lds((const unsigned*)((const char*)(gbase) + (voff)[_i]), (PG8_LAS unsigned*)(lds + (bufoff) + ldsw + _i * 8192), 16, 0, 0); } while (0)
#define PG8_LDA(dst, b, h) do { _Pragma("unroll") for (int m = 0; m < 4; ++m) _Pragma("unroll") for (int k = 0; k < 2; ++k) dst[m][k] = *(const PG8_LAS bf16x8*)(lds + PG8_SA(b, h) + aoff + m * 2048 + k * 1024); } while (0)
#define PG8_LDB(dst, b, h) do { _Pragma("unroll") for (int n = 0; n < 2; ++n) _Pragma("unroll") for (int k = 0; k < 2; ++k) dst[n][k] = *(const PG8_LAS bf16x8*)(lds + PG8_SB(b, h) + boff + n * 2048 + k * 1024); } while (0)
#define PG8_MMA(ai, bj, At, Bt) do { __builtin_amdgcn_s_setprio(1); _Pragma("unroll") for (int m = 0; m < 4; ++m) _Pragma("unroll") for (int n = 0; n < 2; ++n) _Pragma("unroll") for (int k = 0; k < 2; ++k) \
        acc[ai][bj][m][n] = __builtin_amdgcn_mfma_f32_16x16x32_bf16(Bt[n][k], At[m][k], acc[ai][bj][m][n], 0, 0, 0); __builtin_amdgcn_s_setprio(0); } while (0)
#define PG8_WAIT_V(n) asm volatile("s_waitcnt vmcnt(" #n ")" ::: "memory")
#define PG8_WAIT_L(n) asm volatile("s_waitcnt lgkmcnt(" #n ")" ::: "memory")
#define PG8_BAR __builtin_amdgcn_s_barrier()
#define PG8_SCHED __builtin_amdgcn_sched_barrier(0)
    Unit cur, nxt; int ui = 0;
    if (!S.next(0, cur)) return;
    f32x4 acc[2][2][4][2];
#pragma unroll
    for (int a = 0; a < 2; ++a)
#pragma unroll
        for (int b = 0; b < 2; ++b)
#pragma unroll
            for (int m = 0; m < 4; ++m)
#pragma unroll
                for (int n = 0; n < 2; ++n) acc[a][b][m][n] = (f32x4){0.f, 0.f, 0.f, 0.f};
    bf16x8 At[4][2], B0[2][2], B1[2][2];
    const char* cA = (const char*)(cur.seg ? g.A2 : g.A) + (size_t)cur.pm * tstep + (size_t)cur.kt0 * kstep; const char* cB = (const char*)(cur.seg ? g.Bt2 : g.Bt) + (size_t)cur.pn * tstep + (size_t)cur.kt0 * kstep;
    if constexpr (SP2) {
        PG8_STAGE(PG8_SB(0, 0), cB, voffB); PG8_STAGE(PG8_SB(0, 1), cB + hstep, voffB); PG8_STAGE(PG8_SA(0, 0), cA, voffA); PG8_STAGE(PG8_SA(0, 1), cA + hstep, voffA);
        if (wr == 1) PG8_BAR;
        PG8_WAIT_V(2); PG8_BAR;
        PG8_STAGE(PG8_SB(1, 0), cB + kstep, voffB); PG8_STAGE(PG8_SA(1, 0), cA + kstep, voffA); PG8_STAGE(PG8_SB(1, 1), cB + hstep + kstep, voffB);
        PG8_WAIT_V(6); PG8_BAR;
    } else {
        PG8_STAGE(PG8_SB(0, 0), cB, voffB); PG8_STAGE(PG8_SA(0, 0), cA, voffA); PG8_STAGE(PG8_SB(0, 1), cB + hstep, voffB); PG8_STAGE(PG8_SA(0, 1), cA + hstep, voffA);
        if (wr == 1) PG8_BAR;
        PG8_WAIT_V(4); PG8_BAR;
        PG8_STAGE(PG8_SB(1, 0), cB + kstep, voffB); PG8_STAGE(PG8_SA(1, 0), cA + kstep, voffA); PG8_STAGE(PG8_SB(1, 1), cB + hstep + kstep, voffB);
        PG8_WAIT_V(6); PG8_BAR;
    }
    for (;;) {
        const bool has_next = S.next(ui + 1, nxt);
        const char* nA = has_next ? (const char*)(nxt.seg ? g.A2 : g.A) + (size_t)nxt.pm * tstep + (size_t)nxt.kt0 * kstep : cA; const char* nB = has_next ? (const char*)(nxt.seg ? g.Bt2 : g.Bt) + (size_t)nxt.pn * tstep + (size_t)nxt.kt0 * kstep : cB;
        const int nt = cur.nkt > 0 ? cur.nkt : ntf;
        for (int t = 0; t < nt; t += 2) {
            const bool last = (t == nt - 2);
            const char* a1 = cA + (size_t)(t + 1) * kstep;
            const char* a2 = last ? nA : cA + (size_t)(t + 2) * kstep; const char* b2 = last ? nB : cB + (size_t)(t + 2) * kstep;
            const char* a3 = a2 + kstep; const char* b3 = b2 + kstep;
            if constexpr (SP2) {
            PG8_LDB(B0, 0, 0); PG8_LDB(B1, 0, 1); PG8_SCHED; PG8_LDA(At, 0, 0); PG8_STAGE(PG8_SA(1, 1), a1 + hstep, voffA);
            PG8_WAIT_V(8); PG8_WAIT_L(0); PG8_BAR; PG8_MMA(0, 0, At, B0); PG8_MMA(0, 1, At, B1); PG8_BAR; PG8_SCHED;
            PG8_LDA(At, 0, 1); PG8_STAGE(PG8_SB(0, 0), b2, voffB); PG8_STAGE(PG8_SB(0, 1), b2 + hstep, voffB); PG8_STAGE(PG8_SA(0, 0), a2, voffA);
            PG8_WAIT_V(8); PG8_WAIT_L(0); PG8_BAR; PG8_MMA(1, 0, At, B0); PG8_MMA(1, 1, At, B1); PG8_BAR; PG8_SCHED;
            PG8_LDB(B0, 1, 0); PG8_LDB(B1, 1, 1); PG8_SCHED; PG8_LDA(At, 1, 0); PG8_STAGE(PG8_SA(0, 1), a2 + hstep, voffA);
            PG8_WAIT_V(8); PG8_WAIT_L(0); PG8_BAR; PG8_MMA(0, 0, At, B0); PG8_MMA(0, 1, At, B1); PG8_BAR; PG8_SCHED;
            PG8_LDA(At, 1, 1); PG8_STAGE(PG8_SB(1, 0), b3, voffB); PG8_STAGE(PG8_SB(1, 1), b3 + hstep, voffB); PG8_STAGE(PG8_SA(1, 0), a3, voffA);
            PG8_WAIT_V(8); PG8_WAIT_L(0); PG8_BAR; PG8_MMA(1, 0, At, B0); PG8_MMA(1, 1, At, B1); PG8_BAR; PG8_SCHED;
            } else {
            PG8_LDB(B0, 0, 0); PG8_SCHED; PG8_LDA(At, 0, 0); PG8_STAGE(PG8_SA(1, 1), a1 + hstep, voffA);
            PG8_WAIT_L(8); PG8_BAR; PG8_WAIT_L(0); PG8_MMA(0, 0, At, B0); PG8_BAR; PG8_SCHED;
            PG8_LDB(B1, 0, 1); PG8_STAGE(PG8_SB(0, 0), b2, voffB);
            PG8_BAR; PG8_WAIT_L(0); PG8_MMA(0, 1, At, B1); PG8_BAR;
            PG8_LDA(At, 0, 1); PG8_STAGE(PG8_SA(0, 0), a2, voffA);
            PG8_BAR; PG8_WAIT_L(0); PG8_MMA(1, 0, At, B0); PG8_BAR; PG8_SCHED;
            PG8_STAGE(PG8_SB(0, 1), b2 + hstep, voffB);
            PG8_WAIT_V(6); PG8_BAR; PG8_MMA(1, 1, At, B1); PG8_BAR;
            PG8_LDB(B0, 1, 0); PG8_SCHED; PG8_LDA(At, 1, 0); PG8_STAGE(PG8_SA(0, 1), a2 + hstep, voffA);
            PG8_WAIT_L(8); PG8_BAR; PG8_WAIT_L(0); PG8_MMA(0, 0, At, B0); PG8_BAR; PG8_SCHED;
            PG8_LDB(B1, 1, 1); PG8_STAGE(PG8_SB(1, 0), b3, voffB);
            PG8_BAR; PG8_WAIT_L(0); PG8_MMA(0, 1, At, B1); PG8_BAR;
            PG8_LDA(At, 1, 1); PG8_STAGE(PG8_SA(1, 0), a3, voffA);
            PG8_BAR; PG8_WAIT_L(0); PG8_MMA(1, 0, At, B0); PG8_BAR; PG8_SCHED;
            PG8_STAGE(PG8_SB(1, 1), b3 + hstep, voffB);
            PG8_WAIT_V(6); PG8_BAR; PG8_MMA(1, 1, At, B1); PG8_BAR;
            }
        }
        if constexpr (ALIGN_EPI) { if (wr == 0) PG8_BAR; }
        E(acc, cur, wr, wc, fr, fq);
        if (!has_next) break;
        if (nxt.seg == 0)
#pragma unroll
        for (int a = 0; a < 2; ++a)
#pragma unroll
            for (int b = 0; b < 2; ++b)
#pragma unroll
                for (int m = 0; m < 4; ++m)
#pragma unroll
                    for (int n = 0; n < 2; ++n) acc[a][b][m][n] = (f32x4){0.f, 0.f, 0.f, 0.f};
        cur = nxt; cA = nA; cB = nB; ++ui;
        if constexpr (ALIGN_EPI) { if (wr == 1) PG8_BAR; }
    }
    PG8_WAIT_V(0);
    if constexpr (!ALIGN_EPI) { if (wr == 0) PG8_BAR; }
    PG8_BAR;
#undef PG8_SA
#undef PG8_SB
#undef PG8_STAGE
#undef PG8_LDA
#undef PG8_LDB
#undef PG8_MMA
#undef PG8_WAIT_V
#undef PG8_WAIT_L
#undef PG8_BAR
#undef PG8_SCHED
}
}

#define LAS __attribute__((address_space(3)))
typedef unsigned short bf16;
typedef short bf16x8 __attribute__((ext_vector_type(8)));
typedef float f32x4 __attribute__((ext_vector_type(4)));
typedef unsigned u32x4 __attribute__((ext_vector_type(4)));
typedef unsigned u32x2 __attribute__((ext_vector_type(2)));
using pg8::cvt_pk_bf16;

constexpr int NWAVES = 8, NTHR = 512;
constexpr int DM = 2048, MP = 8192, MS = 1024, MT = 9216, TP = 2048, TS = 8;
constexpr int NIN = 11288, NPROJ = 11264, NPROJ_PAD = 11520, DFF = 5632;
constexpr int C_MQ = 0, C_MK = 1024, C_MV = 2048, C_MO = 3072, C_GQ = 4096, C_GK = 4608, C_GV = 5120, C_GR = 6144, C_GA = 7168, C_GB = 9216;
constexpr float EPS = 1e-6f;
constexpr int NCH = 16;
constexpr int LDS_BYTES = 147456;

constexpr size_t O_YP = 0, O_YS = 16777216, O_PC = 18874368, O_PN = 19922944, O_PM = 19927040, O_PS = 19927056, O_PCONV = 20451344,
                 O_SC = 20496400, O_SN = 54050832, O_SM = 54181904, O_SS = 54182416, O_SCONV = 70959632;

constexpr size_t MiB = 1u << 20;
constexpr size_t WS_GATES = 64 * 1024;
constexpr size_t WS_PART = WS_GATES + (size_t)MT * 32 * 4;
constexpr size_t WS_DN = WS_PART + (size_t)MT * 32 * 4;
constexpr size_t WS_NPREV = WS_DN + 256 * 256 * 4;
constexpr size_t WS_CHS = WS_NPREV + 256 * 256 * 2;
constexpr size_t WS_BEND = WS_CHS + 256 * 2 * 4;
constexpr size_t WS_RSTD = WS_BEND + 256 * 128 * 4;
static_assert(WS_RSTD + MT * 4 <= 4 * MiB, "small region");
constexpr size_t WS_WIN = 4 * MiB;
constexpr size_t WS_WA = WS_WIN + (size_t)NPROJ_PAD * DM * 2;
constexpr size_t WS_WB = WS_WA + (size_t)2048 * 1024 * 2;
constexpr size_t WS_WO = WS_WB + (size_t)2048 * 1024 * 2;
constexpr size_t WS_WUG = WS_WO + (size_t)2048 * 2048 * 2;
constexpr size_t WS_WD = WS_WUG + (size_t)2 * DFF * DM * 2;
constexpr size_t WS_R1 = WS_WD + (size_t)DM * DFF * 2;
static_assert(WS_R1 == 131 * MiB, "map");
constexpr size_t WS_XN = WS_R1;
constexpr size_t WS_X1W = WS_R1 + 36 * MiB;
constexpr size_t WS_X1 = WS_R1 + 72 * MiB;
constexpr size_t WS_DC = WS_R1;
constexpr size_t WS_DS = WS_R1 + 64 * MiB;
constexpr size_t WS_CT = WS_R1 + 96 * MiB;
constexpr size_t WS_ST = WS_R1 + 128 * MiB;
constexpr size_t WS_YM = WS_R1 + 144 * MiB;
constexpr size_t WS_YG = WS_YM + 18 * MiB;
constexpr size_t WS_PROJ = WS_YG + 18 * MiB;
constexpr size_t WS_U = WS_PROJ, WS_G = WS_PROJ + 99 * MiB;
constexpr size_t WS_END = WS_PROJ + 198 * MiB;
static_assert(WS_END == 509 * MiB, "map");

struct Args {
    const float* in[25]; float* out; unsigned char* ws; int ph_lo, ph_hi;
};
enum { I_XP = 0, I_XS, I_C, I_N, I_M, I_S, I_CONV, I_WIN, I_BI, I_BF, I_AUP, I_AB, I_MHW, I_GHW, I_WA, I_WB, I_WO, I_NMIX, I_NFFN, I_WUP, I_WGATE, I_CW, I_CB, I_WDOWN, I_FNW };

__device__ __forceinline__ float bf2f(unsigned short b) { return __builtin_bit_cast(float, (unsigned)b << 16); }
__device__ __forceinline__ float bflo(unsigned w) { return __builtin_bit_cast(float, w << 16); }
__device__ __forceinline__ float bfhi(unsigned w) { return __builtin_bit_cast(float, w & 0xffff0000u); }
__device__ __forceinline__ unsigned short f2bf(float f) { return (unsigned short)(cvt_pk_bf16(f, 0.f) & 0xffffu); }
__device__ __forceinline__ float logsig(float z) { return fminf(z, 0.f) - __logf(1.f + __expf(-fabsf(z))); }
__device__ __forceinline__ float sigm(float z) { return 1.f / (1.f + __expf(-z)); }
__device__ __forceinline__ float wave_sum(float v) {
#pragma unroll
    for (int o = 1; o < 64; o <<= 1) v += __shfl_xor(v, o);
    return v;
}
__device__ __forceinline__ float wave_max(float v) {
#pragma unroll
    for (int o = 1; o < 64; o <<= 1) v = fmaxf(v, __shfl_xor(v, o));
    return v;
}
__device__ __forceinline__ float sum4(f32x4 v) { return (v.x + v.y) + (v.z + v.w); }
__device__ __forceinline__ float dot4(f32x4 a, f32x4 b) { return (a.x * b.x + a.y * b.y) + (a.z * b.z + a.w * b.w); }
__device__ __forceinline__ float gelu_tanh(float v) { const float u = 0.7978845608028654f * (v + 0.044715f * v * v * v); return v * sigm(2.f * u); }

typedef f32x4 AccT[2][2][4][2];
struct EpiProj {
    static constexpr bool PERM = true;
    bf16* P; float* gates;
    __device__ __forceinline__ void operator()(AccT& acc, const pg8::Unit& u, int wr, int wc, int fr, int fq) const {
        const int row0 = u.pm * 256 + wr * 64 + fr;
        if (u.pn < 44) {
            const int col0 = u.pn * 256 + wc * 32 + 8 * fq;
#pragma unroll
            for (int ai = 0; ai < 2; ++ai)
#pragma unroll
                for (int m = 0; m < 4; ++m) { bf16* rowp = P + (size_t)(row0 + ai * 128 + m * 16) * NPROJ + col0;
#pragma unroll
                    for (int bj = 0; bj < 2; ++bj) { const f32x4 v0 = acc[ai][bj][m][0], v1 = acc[ai][bj][m][1]; u32x4 w;
                        w.x = cvt_pk_bf16(v0[0], v0[1]); w.y = cvt_pk_bf16(v0[2], v0[3]); w.z = cvt_pk_bf16(v1[0], v1[1]); w.w = cvt_pk_bf16(v1[2], v1[3]);
                        *(u32x4*)(rowp + bj * 128) = w; } }
        } else if (wc == 0) {
#pragma unroll
            for (int ai = 0; ai < 2; ++ai)
#pragma unroll
                for (int m = 0; m < 4; ++m) { float* rowp = gates + (size_t)(row0 + ai * 128 + m * 16) * 32 + 8 * fq;
                    *(f32x4*)rowp = acc[ai][0][m][0]; *(f32x4*)(rowp + 4) = acc[ai][0][m][1]; }
        }
    }
};
struct EpiBranch {
    static constexpr bool PERM = true;
    const bf16* P; bf16* O;
    __device__ __forceinline__ void operator()(AccT& acc, const pg8::Unit& u, int wr, int wc, int fr, int fq) const {
        const int row0 = u.pm * 256 + wr * 64 + fr, col0 = u.pn * 256 + wc * 32 + 8 * fq;
#pragma unroll
        for (int ai = 0; ai < 2; ++ai)
#pragma unroll
            for (int m = 0; m < 4; ++m) { const int row = row0 + ai * 128 + m * 16;
#pragma unroll
                for (int bj = 0; bj < 2; ++bj) { const int col = col0 + bj * 128;
                    const u32x4 ga = *(const u32x4*)(P + (size_t)row * NPROJ + C_GA + col), gb = *(const u32x4*)(P + (size_t)row * NPROJ + C_GB + col);
                    float fa[8] = {bflo(ga.x), bfhi(ga.x), bflo(ga.y), bfhi(ga.y), bflo(ga.z), bfhi(ga.z), bflo(ga.w), bfhi(ga.w)};
                    float fb[8] = {bflo(gb.x), bfhi(gb.x), bflo(gb.y), bfhi(gb.y), bflo(gb.z), bfhi(gb.z), bflo(gb.w), bfhi(gb.w)};
                    if (u.seg == 0) {
#pragma unroll
                        for (int i = 0; i < 8; ++i) { const float r = (1.f + __expf(-fb[i])) / (1.f + __expf(-fa[i])); acc[ai][bj][m][i >> 2][i & 3] *= r; }
                    } else {
                        float o[8];
#pragma unroll
                        for (int i = 0; i < 8; ++i) o[i] = acc[ai][bj][m][i >> 2][i & 3] * sigm(fb[i]);
                        u32x4 w; w.x = cvt_pk_bf16(o[0], o[1]); w.y = cvt_pk_bf16(o[2], o[3]); w.z = cvt_pk_bf16(o[4], o[5]); w.w = cvt_pk_bf16(o[6], o[7]);
                        *(u32x4*)(O + (size_t)row * DM + col) = w;
                    } } }
    }
};
struct EpiOut {
    static constexpr bool PERM = true;
    const float* xp; const float* xs; float* X1; bf16* X1W; const float* nw; float* part; float* tailp;
    __device__ __forceinline__ void operator()(AccT& acc, const pg8::Unit& u, int wr, int wc, int fr, int fq) const {
        const int row0 = u.pm * 256 + wr * 64 + fr, col0 = u.pn * 256 + wc * 32 + 8 * fq;
        if (u.tail >= 0) {
            float* tp = tailp + (size_t)u.tail * 65536 + (wr * 64 + fr) * 256 + wc * 32 + 8 * fq;
#pragma unroll
            for (int ai = 0; ai < 2; ++ai)
#pragma unroll
                for (int m = 0; m < 4; ++m)
#pragma unroll
                    for (int bj = 0; bj < 2; ++bj) { float* p = tp + (ai * 128 + m * 16) * 256 + bj * 128; *(f32x4*)p = acc[ai][bj][m][0]; *(f32x4*)(p + 4) = acc[ai][bj][m][1]; }
            return;
        }
#pragma unroll
        for (int ai = 0; ai < 2; ++ai)
#pragma unroll
            for (int m = 0; m < 4; ++m) { const int row = row0 + ai * 128 + m * 16;
                const float* xrow = row < MP ? xp + (size_t)row * DM : xs + (size_t)(row - MP) * DM;
                float ss = 0.f;
#pragma unroll
                for (int bj = 0; bj < 2; ++bj) { const int col = col0 + bj * 128;
                    const f32x4 v0 = acc[ai][bj][m][0] + *(const f32x4*)(xrow + col), v1 = acc[ai][bj][m][1] + *(const f32x4*)(xrow + col + 4);
                    *(f32x4*)(X1 + (size_t)row * DM + col) = v0; *(f32x4*)(X1 + (size_t)row * DM + col + 4) = v1;
                    ss += dot4(v0, v0) + dot4(v1, v1);
                    const f32x4 w0 = *(const f32x4*)(nw + col), w1 = *(const f32x4*)(nw + col + 4);
                    u32x4 w; w.x = cvt_pk_bf16(v0[0] * w0[0], v0[1] * w0[1]); w.y = cvt_pk_bf16(v0[2] * w0[2], v0[3] * w0[3]);
                    w.z = cvt_pk_bf16(v1[0] * w1[0], v1[1] * w1[1]); w.w = cvt_pk_bf16(v1[2] * w1[2], v1[3] * w1[3]);
                    *(u32x4*)(X1W + (size_t)row * DM + col) = w; }
                ss += __shfl_xor(ss, 16); ss += __shfl_xor(ss, 32);
                if (fq == 0) part[(size_t)row * 32 + u.pn * 4 + wc] = ss; }
    }
};
#define DPP_MOV(ctrl, oldv, srcv) __builtin_bit_cast(float, __builtin_amdgcn_update_dpp(__builtin_bit_cast(int, (float)(oldv)), __builtin_bit_cast(int, (float)(srcv)), (ctrl), 0xf, 0xf, false))
struct EpiUGAct {
    static constexpr bool PERM = true;
    const float* rstd; bf16* ACT; float* out; const float* cw; const float* cb; const float* cst; float* ub; LAS float* xch;
    __device__ __forceinline__ void operator()(AccT& acc, const pg8::Unit& u, int wr, int wc, int fr, int fq) const {
        const int row0 = u.pm * 256 + wr * 64 + fr, col = u.pn * 128 + wc * 32 + 8 * fq;
        const bool sample = u.pm >= 32;
#pragma unroll
        for (int ai = 0; ai < 2; ++ai)
#pragma unroll
            for (int m = 0; m < 4; ++m) { const int row = row0 + ai * 128 + m * 16;
                const float r = rstd[row];
                acc[ai][0][m][0] = acc[ai][0][m][0] * r; acc[ai][0][m][1] = acc[ai][0][m][1] * r; acc[ai][1][m][0] = acc[ai][1][m][0] * r; acc[ai][1][m][1] = acc[ai][1][m][1] * r;
                float* cs = nullptr;
                if (row < MP) { const int t = row & (TP - 1); if (t >= TP - 2) cs = out + O_PCONV + ((size_t)(row >> 11) * 2 + (t - (TP - 2))) * DFF + col; }
                else { const int rr = row - MP, t = rr & 7; if (t >= 6) cs = out + O_SCONV + ((size_t)(rr >> 3) * 2 + (t - 6)) * DFF + col; }
                if (cs) { *(f32x4*)cs = acc[ai][0][m][0]; *(f32x4*)(cs + 4) = acc[ai][0][m][1]; } }
        if (fr >= 14) {
#pragma unroll
            for (int ai = 0; ai < 2; ++ai) { LAS float* p = xch + ((((ai * 2 + wr) * 4 + wc) * 2 + (fr - 14)) * 4 + fq) * 8; *(LAS f32x4*)p = acc[ai][0][3][0]; *(LAS f32x4*)(p + 4) = acc[ai][0][3][1]; }
            if (!sample && wr == 1) { float* p = ub + ((size_t)u.pm * 6 + (fr - 14)) * DFF + col; *(f32x4*)p = acc[1][0][3][0]; *(f32x4*)(p + 4) = acc[1][0][3][1]; }
        }
        if (!sample && wr == 0 && fr < 2) { float* p = ub + ((size_t)u.pm * 6 + 2 + fr) * DFF + col; *(f32x4*)p = acc[0][0][0][0]; *(f32x4*)(p + 4) = acc[0][0][0][1];
            p += 2 * DFF; *(f32x4*)p = acc[0][1][0][0]; *(f32x4*)(p + 4) = acc[0][1][0][1]; }
        asm volatile("s_waitcnt lgkmcnt(0)" ::: "memory"); __builtin_amdgcn_s_barrier();
        const f32x4 k0a = *(const f32x4*)(cw + col), k0b = *(const f32x4*)(cw + col + 4), k1a = *(const f32x4*)(cw + DFF + col), k1b = *(const f32x4*)(cw + DFF + col + 4);
        const f32x4 k2a = *(const f32x4*)(cw + 2 * DFF + col), k2b = *(const f32x4*)(cw + 2 * DFF + col + 4), cba = *(const f32x4*)(cb + col), cbb = *(const f32x4*)(cb + col + 4);
#pragma unroll
        for (int ai = 0; ai < 2; ++ai) {
            f32x4 pe0 = {0.f, 0.f, 0.f, 0.f}, pe1 = {0.f, 0.f, 0.f, 0.f};
            if (!(ai == 0 && wr == 0) && fr >= 14) { const int sai = (wr == 1) ? ai : ai - 1, swr = wr ^ 1;
                const LAS float* p = xch + ((((sai * 2 + swr) * 4 + wc) * 2 + (fr - 14)) * 4 + fq) * 8; pe0 = *(const LAS f32x4*)p; pe1 = *(const LAS f32x4*)(p + 4); }
#pragma unroll
            for (int m = 0; m < 4; ++m) { const int row = row0 + ai * 128 + m * 16;
                const f32x4 c0 = acc[ai][0][m][0], c1 = acc[ai][0][m][1], v0 = m ? acc[ai][0][m ? m - 1 : 0][0] : pe0, v1 = m ? acc[ai][0][m ? m - 1 : 0][1] : pe1;
                float cur[8] = {c0[0], c0[1], c0[2], c0[3], c1[0], c1[1], c1[2], c1[3]}, prv[8] = {v0[0], v0[1], v0[2], v0[3], v1[0], v1[1], v1[2], v1[3]};
                float p1[8], p2[8];
#pragma unroll
                for (int i = 0; i < 8; ++i) { const float y1 = DPP_MOV(0x121, 0.f, prv[i]); p1[i] = DPP_MOV(0x111, y1, cur[i]); const float y2 = DPP_MOV(0x122, 0.f, prv[i]); p2[i] = DPP_MOV(0x112, y2, cur[i]); }
                if (sample) { const int t = fr & 7;
                    if (t < 2) { const float* st = cst + (size_t)((row - MP) >> 3) * 2 * DFF + col;
                        const f32x4 s1a = *(const f32x4*)(st + DFF), s1b = *(const f32x4*)(st + DFF + 4);
                        if (t == 0) { const f32x4 s0a = *(const f32x4*)st, s0b = *(const f32x4*)(st + 4);
#pragma unroll
                            for (int i = 0; i < 4; ++i) { p1[i] = s1a[i]; p1[4 + i] = s1b[i]; p2[i] = s0a[i]; p2[4 + i] = s0b[i]; } }
                        else {
#pragma unroll
                            for (int i = 0; i < 4; ++i) { p2[i] = s1a[i]; p2[4 + i] = s1b[i]; } } } }
                const f32x4 g0 = acc[ai][1][m][0], g1 = acc[ai][1][m][1];
                float o[8];
#pragma unroll
                for (int i = 0; i < 4; ++i) { o[i] = gelu_tanh(cba[i] + k0a[i] * p2[i] + k1a[i] * p1[i] + k2a[i] * cur[i]) * g0[i];
                    o[4 + i] = gelu_tanh(cbb[i] + k0b[i] * p2[4 + i] + k1b[i] * p1[4 + i] + k2b[i] * cur[4 + i]) * g1[i]; }
                u32x4 w; w.x = cvt_pk_bf16(o[0], o[1]); w.y = cvt_pk_bf16(o[2], o[3]); w.z = cvt_pk_bf16(o[4], o[5]); w.w = cvt_pk_bf16(o[6], o[7]);
                *(u32x4*)(ACT + (size_t)row * DFF + col) = w; }
        }
    }
};
struct EpiDown {
    static constexpr bool PERM = true;
    const float* X1; float* out; float* tailp;
    __device__ __forceinline__ void operator()(AccT& acc, const pg8::Unit& u, int wr, int wc, int fr, int fq) const {
        if (u.tail < 0) {
            const int row0 = u.pm * 256 + wr * 64 + fr, col0 = u.pn * 256 + wc * 32 + 8 * fq;
#pragma unroll
            for (int ai = 0; ai < 2; ++ai)
#pragma unroll
                for (int m = 0; m < 4; ++m) { const int row = row0 + ai * 128 + m * 16;
#pragma unroll
                    for (int bj = 0; bj < 2; ++bj) { const int col = col0 + bj * 128;
                        const f32x4 v0 = acc[ai][bj][m][0] + *(const f32x4*)(X1 + (size_t)row * DM + col), v1 = acc[ai][bj][m][1] + *(const f32x4*)(X1 + (size_t)row * DM + col + 4);
                        *(f32x4*)(out + (size_t)row * DM + col) = v0; *(f32x4*)(out + (size_t)row * DM + col + 4) = v1; } }
        } else {
            float* tp = tailp + (size_t)u.tail * 65536 + (wr * 64 + fr) * 256 + wc * 32 + 8 * fq;
#pragma unroll
            for (int ai = 0; ai < 2; ++ai)
#pragma unroll
                for (int m = 0; m < 4; ++m)
#pragma unroll
                    for (int bj = 0; bj < 2; ++bj) { float* p = tp + (ai * 128 + m * 16) * 256 + bj * 128; *(f32x4*)p = acc[ai][bj][m][0]; *(f32x4*)(p + 4) = acc[ai][bj][m][1]; }
        }
    }
};

template <class ColPtr>
__device__ __forceinline__ void transpose_item(const ColPtr& cp, int K, int srcN, bf16* WT, LAS float* scr, int kb, int nb, int lane) {
    const int k0 = 64 * kb, n0 = 64 * nb, kr = lane >> 4, n4 = (lane & 15) * 4;
    const float* src = cp(n0 + n4);
    f32x4 v[16];
#pragma unroll
    for (int i = 0; i < 16; ++i) v[i] = src ? *(const f32x4*)(src + (size_t)(k0 + 4 * i + kr) * srcN) : (f32x4){0.f, 0.f, 0.f, 0.f};
#pragma unroll
    for (int i = 0; i < 16; ++i) { LAS float* d = scr + (4 * i + kr) * 65 + n4; d[0] = v[i][0]; d[1] = v[i][1]; d[2] = v[i][2]; d[3] = v[i][3]; }
    asm volatile("s_waitcnt lgkmcnt(0)" ::: "memory");
    const int c = lane & 7;
#pragma unroll
    for (int j = 0; j < 8; ++j) { const int n = (lane >> 3) + 8 * j; const LAS float* s = scr + (8 * c) * 65 + n;
        u32x4 o; o.x = cvt_pk_bf16(s[0 * 65], s[1 * 65]); o.y = cvt_pk_bf16(s[2 * 65], s[3 * 65]); o.z = cvt_pk_bf16(s[4 * 65], s[5 * 65]); o.w = cvt_pk_bf16(s[6 * 65], s[7 * 65]);
        *(u32x4*)(WT + (size_t)(n0 + n) * K + k0 + 8 * c) = o; }
    asm volatile("s_waitcnt lgkmcnt(0)" ::: "memory");
}
struct ColWin { const float* W; __device__ __forceinline__ const float* operator()(int n) const {
    int c; if (n < 4096) c = n; else if (n < 7168) c = n + 8; else if (n < 11264) c = n + 24; else if (n < 11272) c = 4096 + (n - 11264); else if (n < 11288) c = 7176 + (n - 11272); else return nullptr;
    return W + c; } };
struct ColPlain { const float* W; __device__ __forceinline__ const float* operator()(int n) const { return W + n; } };
struct ColUG { const float* Wu; const float* Wg; __device__ __forceinline__ const float* operator()(int n) const { const int pn = n >> 8, w = n & 255; return w < 128 ? Wu + pn * 128 + w : Wg + pn * 128 + (w - 128); } };

__device__ __forceinline__ void p0_prologue(const Args& a, LAS unsigned char* lds, int gwg, int nwgs, int mode) {
    int tid_ = threadIdx.x; asm volatile("" : "+v"(tid_));
    const int tid = tid_, lane = tid & 63, wave = __builtin_amdgcn_readfirstlane(tid >> 6);
    LAS float* scr = (LAS float*)(lds + wave * 16640);
    const int gw = gwg * NWAVES + wave, NGW = nwgs * NWAVES;
    unsigned char* ws = a.ws;
    constexpr int I_WIN_ = 32 * (NPROJ_PAD / 64), I_A = 16 * 32, I_O = 32 * 32, I_UG = 32 * (2 * DFF / 64), I_D = (DFF / 64) * 32;
    constexpr int NITEMS = I_WIN_ + 2 * I_A + I_O + I_UG + I_D;
    const int it0 = mode == 0 ? 0 : I_WIN_, it1 = mode == 0 ? I_WIN_ : NITEMS;
    for (int it = it0 + gw; it < it1; it += NGW) {
        int r = it;
        if (r < I_WIN_) { ColWin cp{a.in[I_WIN]}; const int nblk = NPROJ_PAD / 64; transpose_item(cp, DM, NIN, (bf16*)(ws + WS_WIN), scr, r / nblk, r % nblk, lane); continue; } r -= I_WIN_;
        if (r < I_A) { ColPlain cp{a.in[I_WA]}; transpose_item(cp, 1024, DM, (bf16*)(ws + WS_WA), scr, r / 32, r % 32, lane); continue; } r -= I_A;
        if (r < I_A) { ColPlain cp{a.in[I_WB]}; transpose_item(cp, 1024, DM, (bf16*)(ws + WS_WB), scr, r / 32, r % 32, lane); continue; } r -= I_A;
        if (r < I_O) { ColPlain cp{a.in[I_WO]}; transpose_item(cp, DM, DM, (bf16*)(ws + WS_WO), scr, r / 32, r % 32, lane); continue; } r -= I_O;
        if (r < I_UG) { ColUG cp{a.in[I_WUP], a.in[I_WGATE]}; const int nblk = 2 * DFF / 64; transpose_item(cp, DM, DFF, (bf16*)(ws + WS_WUG), scr, r / nblk, r % nblk, lane); continue; } r -= I_UG;
        { ColPlain cp{a.in[I_WDOWN]}; transpose_item(cp, DFF, DM, (bf16*)(ws + WS_WD), scr, r / 32, r % 32, lane); }
    }
    const float* nw = a.in[I_NMIX]; bf16* XN = (bf16*)(ws + WS_XN);
    if (mode == 0)
    for (int m = gw; m < MT; m += NGW) {
        const float* xrow = m < MP ? a.in[I_XP] + (size_t)m * DM : a.in[I_XS] + (size_t)(m - MP) * DM;
        f32x4 v[8]; float s = 0.f;
#pragma unroll
        for (int j = 0; j < 8; ++j) { v[j] = *(const f32x4*)(xrow + 4 * lane + 256 * j); s += dot4(v[j], v[j]); }
        const float r = rsqrtf(wave_sum(s) * (1.f / DM) + EPS);
#pragma unroll
        for (int j = 0; j < 8; ++j) { const f32x4 w = *(const f32x4*)(nw + 4 * lane + 256 * j); u32x2 o; o.x = cvt_pk_bf16(v[j][0] * r * w[0], v[j][1] * r * w[1]); o.y = cvt_pk_bf16(v[j][2] * r * w[2], v[j][3] * r * w[3]);
            *(u32x2*)(XN + (size_t)m * DM + 4 * lane + 256 * j) = o; }
    }
}

__device__ __forceinline__ void stage_v(LAS bf16* Vs, const bf16* P, int row0, int colbase, int tid) {
#pragma unroll
    for (int i = 0; i < 8; ++i) { const int idx = tid + NTHR * i, s = idx >> 5, p = idx & 31;
        *(LAS u32x4*)(Vs + s * 272 + p * 8) = *(const u32x4*)(P + (size_t)(row0 + s) * NPROJ + colbase + 8 * p); }
}
typedef short v4i16_t __attribute__((ext_vector_type(4)));
__device__ __forceinline__ u32x2 tr64(const LAS bf16* p) { return __builtin_bit_cast(u32x2, __builtin_amdgcn_ds_read_tr16_b64_v4i16((LAS v4i16_t*)p)); }
__device__ __forceinline__ bf16x8 tr_frag(const LAS bf16* img, int RS, int c0, int ks, int lane) {
    const int g = lane >> 4, q = (lane & 15) >> 2, p = lane & 3;
    const LAS bf16* a = img + (32 * ks + 4 * g + q) * RS + c0 + 4 * p;
    const u32x2 lo = tr64(a), hi = tr64(a + 16 * RS);
    u32x4 w; w.x = lo.x; w.y = lo.y; w.z = hi.x; w.w = hi.y;
    return __builtin_bit_cast(bf16x8, w);
}
__device__ __forceinline__ float wave_iscan_add(float v, int lane) {
#pragma unroll
    for (int o = 1; o < 64; o <<= 1) { const float t = __shfl_up(v, o); if (lane >= o) v += t; }
    return v;
}
__device__ __forceinline__ float wave_iscan_max(float v, int lane) {
#pragma unroll
    for (int o = 1; o < 64; o <<= 1) { const float t = __shfl_up(v, o); if (lane >= o) v = fmaxf(v, t); }
    return v;
}

__device__ __forceinline__ void gla_logdecay(const Args& a, const float* gates, int row0, int h, LAS float* galS, LAS float* segS, int tid, float (&la)[32], float& off, float& tot) {
    const int d = tid & 127, seg = tid >> 7;
    { const int t = tid >> 2, q = tid & 3; *(LAS f32x4*)(galS + t * 16 + q * 4) = *(const f32x4*)(gates + (size_t)(row0 + t) * 32 + 8 + q * 4); }
    float up[16];
#pragma unroll
    for (int j = 0; j < 16; ++j) up[j] = a.in[I_AUP][j * 512 + h * 128 + d];
    const float ab = a.in[I_AB][h * 128 + d];
    __syncthreads();
    float ssum = 0.f;
#pragma unroll
    for (int i = 0; i < 32; ++i) { const int t = seg * 32 + i; float z = ab;
#pragma unroll
        for (int q = 0; q < 4; ++q) { const f32x4 g = *(const LAS f32x4*)(galS + t * 16 + q * 4); z += g[0] * up[4 * q] + g[1] * up[4 * q + 1] + g[2] * up[4 * q + 2] + g[3] * up[4 * q + 3]; }
        la[i] = logsig(z) * (1.f / 16.f); ssum += la[i]; }
    segS[seg * 128 + d] = ssum;
    __syncthreads();
    off = 0.f; tot = 0.f;
#pragma unroll
    for (int s = 0; s < 4; ++s) { const float v = segS[s * 128 + d]; tot += v; off += (s < seg) ? v : 0.f; }
}

template <bool ML>
__device__ __forceinline__ void chunk_state(const Args& a, LAS unsigned char* lds, int bh, int c) {
    constexpr int DK = ML ? 256 : 128, NDT = DK / 16, RSK = DK + 16;
    int tid_ = threadIdx.x; asm volatile("" : "+v"(tid_));
    const int tid = tid_, lane = tid & 63, wave = __builtin_amdgcn_readfirstlane(tid >> 6), fr = lane & 15, fq = lane >> 4;
    const int b = bh >> 2, h = bh & 3, row0 = b * TP + c * 128, item = bh * NCH + c;
    unsigned char* ws = a.ws;
    const bf16* P = (const bf16*)(ws + WS_PROJ); const float* gates = (const float*)(ws + WS_GATES);
    LAS bf16* Ks = (LAS bf16*)lds; LAS bf16* Vs = (LAS bf16*)(lds + 69632); LAS float* sc = (LAS float*)(lds + 139264);
    __syncthreads();
    stage_v(Vs, P, row0, (ML ? C_MV : C_GV) + h * 256, tid);
    if (ML) {
        if (wave == 0) {
            const int t0 = 2 * lane;
            const float lf0 = logsig(gates[(size_t)(row0 + t0) * 32 + 4 + h] + a.in[I_BF][h]), lf1 = logsig(gates[(size_t)(row0 + t0 + 1) * 32 + 4 + h] + a.in[I_BF][h]);
            const float i0 = gates[(size_t)(row0 + t0) * 32 + h] + a.in[I_BI][h], i1 = gates[(size_t)(row0 + t0 + 1) * 32 + h] + a.in[I_BI][h];
            const float pr = lf0 + lf1, S = wave_iscan_add(pr, lane), ex = S - pr;
            const float ah0 = i0 - (ex + lf0), ah1 = i1 - S;
            const float Ah = wave_max(fmaxf(ah0, ah1));
            sc[t0] = __expf(ah0 - Ah) * (1.f / 16.f); sc[t0 + 1] = __expf(ah1 - Ah) * (1.f / 16.f);
            if (lane == 63) { float* chs = (float*)(ws + WS_CHS); chs[item * 2] = Ah; chs[item * 2 + 1] = S; }
        }
        __syncthreads();
#pragma unroll
        for (int i = 0; i < 8; ++i) { const int idx = tid + NTHR * i, s = idx >> 5, dp = idx & 31; const float w = sc[s];
            const u32x4 v = *(const u32x4*)(P + (size_t)(row0 + s) * NPROJ + C_MK + h * 256 + 8 * dp);
            u32x4 o; o.x = cvt_pk_bf16(bflo(v.x) * w, bfhi(v.x) * w); o.y = cvt_pk_bf16(bflo(v.y) * w, bfhi(v.y) * w); o.z = cvt_pk_bf16(bflo(v.z) * w, bfhi(v.z) * w); o.w = cvt_pk_bf16(bflo(v.w) * w, bfhi(v.w) * w);
            *(LAS u32x4*)(Ks + s * RSK + 8 * dp) = o; }
    } else {
        float la[32], off, tot;
        LAS float* galS = (LAS float*)(lds + 36864); gla_logdecay(a, gates, row0, h, galS, galS + 2048, tid, la, off, tot);
        const int d = tid & 127, seg = tid >> 7;
        if (seg == 0) ((float*)(ws + WS_BEND))[item * 128 + d] = tot;
        float bcur = off;
#pragma unroll
        for (int i = 0; i < 32; ++i) { const int t = seg * 32 + i; bcur += la[i];
            const float kv = bf2f(P[(size_t)(row0 + t) * NPROJ + C_GK + h * 128 + d]);
            Ks[t * RSK + d] = f2bf(kv * __expf(tot - bcur)); }
    }
    __syncthreads();
    f32x4 acc[2][NDT];
#pragma unroll
    for (int e = 0; e < 2; ++e)
#pragma unroll
        for (int d = 0; d < NDT; ++d) acc[e][d] = (f32x4){0.f, 0.f, 0.f, 0.f};
#pragma unroll
    for (int ks = 0; ks < 4; ++ks) {
        bf16x8 vb[2];
#pragma unroll
        for (int e = 0; e < 2; ++e) vb[e] = tr_frag(Vs, 272, wave * 32 + e * 16, ks, lane);
#pragma unroll
        for (int d = 0; d < NDT; ++d) { const bf16x8 ka = tr_frag(Ks, RSK, d * 16, ks, lane);
#pragma unroll
            for (int e = 0; e < 2; ++e) acc[e][d] = __builtin_amdgcn_mfma_f32_16x16x32_bf16(ka, vb[e], acc[e][d], 0, 0, 0); }
    }
    float* dst = (float*)(ws + (ML ? WS_DC : WS_DS)) + (size_t)item * 256 * DK;
#pragma unroll
    for (int e = 0; e < 2; ++e)
#pragma unroll
        for (int d = 0; d < NDT; ++d) *(f32x4*)(dst + (size_t)(wave * 32 + e * 16 + fr) * DK + d * 16 + 4 * fq) = acc[e][d];
    if (ML && tid < 256) { float s = 0.f;
#pragma unroll 16
        for (int i = 0; i < 128; ++i) s += bf2f(Ks[i * RSK + tid]);
        ((float*)(ws + WS_DN))[item * 256 + tid] = s; }
}

__device__ __forceinline__ void scan_mlstm(const Args& a, int j) {
    int tid_ = threadIdx.x; asm volatile("" : "+v"(tid_));
    const int tid = tid_, bh = j >> 5, eb = j & 31;
    unsigned char* ws = a.ws;
    const float* chs = (const float*)(ws + WS_CHS);
    const int e = eb * 8 + (tid >> 6), d4 = (tid & 63) * 4;
    const float* dC = (const float*)(ws + WS_DC) + (size_t)bh * NCH * 65536 + (size_t)e * 256 + d4;
    bf16* CT = (bf16*)(ws + WS_CT) + (size_t)bh * NCH * 65536 + (size_t)e * 256 + d4;
    f32x4 Cv = {0.f, 0.f, 0.f, 0.f}; float Fs = 0.f, Mp = 0.f;
    const bool do_n = (eb == 0 && tid < 256);
    float nv = 0.f;
    f32x4 dv[NCH];
#pragma unroll
    for (int c = 0; c < NCH; ++c) dv[c] = *(const f32x4*)(dC + (size_t)c * 65536);
#pragma unroll
    for (int c = 0; c < NCH; ++c) {
        u32x2 o; o.x = cvt_pk_bf16(Cv[0], Cv[1]); o.y = cvt_pk_bf16(Cv[2], Cv[3]); *(u32x2*)(CT + (size_t)c * 65536) = o;
        if (do_n) ((bf16*)(ws + WS_NPREV))[(bh * NCH + c) * 256 + tid] = f2bf(nv);
        const float Ah = chs[(bh * NCH + c) * 2], bt = chs[(bh * NCH + c) * 2 + 1];
        const float Ac = Ah - Fs, Mn = fmaxf(Mp, Ac), f1 = __expf(Mp - Mn), f2 = __expf(Ac - Mn);
        Cv = Cv * f1 + dv[c] * f2;
        if (do_n) nv = nv * f1 + ((const float*)(ws + WS_DN))[(bh * NCH + c) * 256 + tid] * f2;
        Mp = Mn; Fs += bt;
    }
    float* oC = a.out + O_PC + (size_t)bh * 65536;
#pragma unroll
    for (int i = 0; i < 4; ++i) oC[(size_t)(d4 + i) * 256 + e] = Cv[i];
    if (do_n) a.out[O_PN + bh * 256 + tid] = nv;
    if (eb == 0 && tid == 0) a.out[O_PM + bh] = Fs + Mp;
}
__device__ __forceinline__ void scan_gla(const Args& a, int j) {
    int tid_ = threadIdx.x; asm volatile("" : "+v"(tid_));
    const int tid = tid_, bh = j >> 4, eb = j & 15;
    unsigned char* ws = a.ws;
    const float* bend = (const float*)(ws + WS_BEND);
    const int ee = eb * 16 + (tid >> 5), d4 = (tid & 31) * 4;
    const float* dS = (const float*)(ws + WS_DS) + (size_t)bh * NCH * 32768 + (size_t)ee * 128 + d4;
    bf16* ST = (bf16*)(ws + WS_ST) + (size_t)bh * NCH * 32768 + (size_t)ee * 128 + d4;
    f32x4 Sv = {0.f, 0.f, 0.f, 0.f};
    f32x4 dv[NCH];
#pragma unroll
    for (int c = 0; c < NCH; ++c) dv[c] = *(const f32x4*)(dS + (size_t)c * 32768);
#pragma unroll
    for (int c = 0; c < NCH; ++c) {
        u32x2 o; o.x = cvt_pk_bf16(Sv[0], Sv[1]); o.y = cvt_pk_bf16(Sv[2], Sv[3]); *(u32x2*)(ST + (size_t)c * 32768) = o;
        const f32x4 be = *(const f32x4*)(bend + (bh * NCH + c) * 128 + d4);
        Sv[0] = Sv[0] * __expf(be[0]) + dv[c][0]; Sv[1] = Sv[1] * __expf(be[1]) + dv[c][1]; Sv[2] = Sv[2] * __expf(be[2]) + dv[c][2]; Sv[3] = Sv[3] * __expf(be[3]) + dv[c][3];
    }
    float* oS = a.out + O_PS + (size_t)bh * 32768;
#pragma unroll
    for (int i = 0; i < 4; ++i) oS[(size_t)(d4 + i) * 256 + ee] = Sv[i];
}

template <bool ML>
__device__ __forceinline__ void chunk_out(const Args& a, LAS unsigned char* lds, int bh, int c) {
    constexpr int DK = ML ? 256 : 128, QS = DK + 8, NKK = DK / 32;
    int tid_ = threadIdx.x; asm volatile("" : "+v"(tid_));
    const int tid = tid_, lane = tid & 63, wave = __builtin_amdgcn_readfirstlane(tid >> 6), fr = lane & 15, fq = lane >> 4;
    const int b = bh >> 2, h = bh & 3, row0 = b * TP + c * 128, item = bh * NCH + c;
    unsigned char* ws = a.ws;
    const bf16* P = (const bf16*)(ws + WS_PROJ); const float* gates = (const float*)(ws + WS_GATES);
    LAS bf16* Qs = (LAS bf16*)lds; LAS bf16* Ks = Qs + 128 * QS;
    LAS float* sc = (LAS float*)(lds + 143616);
    __syncthreads();
    if (ML) {
        if (wave == 0) {
            const float* chs = (const float*)(ws + WS_CHS);
            const float Ahc = lane < NCH ? chs[(bh * NCH + lane) * 2] : 0.f, btc = lane < NCH ? chs[(bh * NCH + lane) * 2 + 1] : 0.f;
            const float fsx = wave_iscan_add(btc, lane) - btc;
            const float Mp = fmaxf(0.f, wave_max(lane < c ? Ahc - fsx : -3.0e38f)), Fs = wave_sum(lane < c ? btc : 0.f);
            const int t0 = 2 * lane;
            const float lf0 = logsig(gates[(size_t)(row0 + t0) * 32 + 4 + h] + a.in[I_BF][h]), lf1 = logsig(gates[(size_t)(row0 + t0 + 1) * 32 + 4 + h] + a.in[I_BF][h]);
            const float i0 = gates[(size_t)(row0 + t0) * 32 + h] + a.in[I_BI][h], i1 = gates[(size_t)(row0 + t0 + 1) * 32 + h] + a.in[I_BI][h];
            const float pr = lf0 + lf1, S = wave_iscan_add(pr, lane), b0 = S - lf1, b1 = S;
            const float a0 = i0 - b0 - Fs, a1 = i1 - b1 - Fs;
            const float cm = wave_iscan_max(fmaxf(a0, a1), lane); float exm = __shfl_up(cm, 1); if (lane == 0) exm = -3.0e38f;
            const float M0 = fmaxf(fmaxf(Mp, exm), a0), M1 = fmaxf(M0, a1);
            sc[t0] = a0; sc[t0 + 1] = a1; sc[128 + t0] = M0; sc[128 + t0 + 1] = M1; sc[256 + t0] = __expf(Mp - M0); sc[256 + t0 + 1] = __expf(Mp - M1);
            sc[384 + t0] = __expf(-(Fs + b0 + M0)); sc[384 + t0 + 1] = __expf(-(Fs + b1 + M1));
        }
#pragma unroll
        for (int i = 0; i < 8; ++i) { const int idx = tid + NTHR * i, t = idx >> 5, p = idx & 31;
            *(LAS u32x4*)(Qs + t * QS + p * 8) = *(const u32x4*)(P + (size_t)(row0 + t) * NPROJ + C_MQ + h * 256 + p * 8);
            *(LAS u32x4*)(Ks + t * QS + p * 8) = *(const u32x4*)(P + (size_t)(row0 + t) * NPROJ + C_MK + h * 256 + p * 8); }
    } else {
        float la[32], off, tot;
        LAS float* galS = (LAS float*)(lds + 69632); LAS float* segS = galS + 128 * 16;
        gla_logdecay(a, gates, row0, h, galS, segS, tid, la, off, tot);
        const int d = tid & 127, seg = tid >> 7;
        float bcur = off;
#pragma unroll
        for (int i = 0; i < 32; ++i) { const int t = seg * 32 + i; bcur += la[i];
            const float qv = bf2f(P[(size_t)(row0 + t) * NPROJ + C_GQ + h * 128 + d]), kv = bf2f(P[(size_t)(row0 + t) * NPROJ + C_GK + h * 128 + d]);
            Qs[t * QS + d] = f2bf(qv * 0.08838834764831845f * __expf(bcur)); Ks[t * QS + d] = f2bf(kv * __expf(-bcur)); }
    }
    __syncthreads();
    constexpr int NCP = ML ? 16 : 8;
    u32x4 cpre[NCP]; u32x4 npre = {0u, 0u, 0u, 0u};
    if (ML) { const bf16* CT = (const bf16*)(ws + WS_CT) + (size_t)item * 65536;
#pragma unroll
        for (int i = 0; i < NCP; ++i) { const int idx = tid + NTHR * i, e = idx >> 5, p = idx & 31; cpre[i] = *(const u32x4*)(CT + (size_t)e * 256 + p * 8); }
        if (tid < 32) npre = *(const u32x4*)((const bf16*)(ws + WS_NPREV) + (size_t)item * 256 + tid * 8);
    } else { const bf16* ST = (const bf16*)(ws + WS_ST) + (size_t)item * 32768;
#pragma unroll
        for (int i = 0; i < NCP; ++i) { const int idx = tid + NTHR * i, e = idx >> 4, p = idx & 15; cpre[i] = *(const u32x4*)(ST + (size_t)e * 128 + p * 8); }
    }
    bf16x8 qf[NKK];
#pragma unroll
    for (int kk = 0; kk < NKK; ++kk) qf[kk] = *(const LAS bf16x8*)(Qs + (wave * 16 + fr) * QS + kk * 32 + fq * 8);
    const int t = wave * 16 + fr;
    u32x2 pb[8]; float den = 0.f;
    {
        const float Mt = ML ? sc[128 + t] : 0.f;
#pragma unroll
        for (int st = 0; st < 8; ++st) { f32x4 s = {0.f, 0.f, 0.f, 0.f};
#pragma unroll
            for (int kk = 0; kk < NKK; ++kk) { const bf16x8 kf = *(const LAS bf16x8*)(Ks + (st * 16 + fr) * QS + kk * 32 + fq * 8); s = __builtin_amdgcn_mfma_f32_16x16x32_bf16(kf, qf[kk], s, 0, 0, 0); }
            float p[4];
            f32x4 as4 = {0.f, 0.f, 0.f, 0.f}; if (ML) as4 = *(const LAS f32x4*)(sc + st * 16 + 4 * fq);
#pragma unroll
            for (int r = 0; r < 4; ++r) { const int si = st * 16 + 4 * fq + r;
                const float e = ML ? s[r] * (1.f / 16.f) * __expf(fminf(as4[r] - Mt, 0.f)) : s[r];
                p[r] = (si <= t) ? e : 0.f;
                den += p[r]; }
            pb[st].x = cvt_pk_bf16(p[0], p[1]); pb[st].y = cvt_pk_bf16(p[2], p[3]);
            __builtin_amdgcn_sched_barrier(0); }
    }
    __syncthreads();
    LAS bf16* Cl = (LAS bf16*)lds;
    if (ML) {
#pragma unroll
        for (int i = 0; i < NCP; ++i) { const int idx = tid + NTHR * i, e = idx >> 5, p = idx & 31; *(LAS u32x4*)(Cl + e * QS + p * 8) = cpre[i]; }
        { const int e = tid >> 5, p = tid & 31; *(LAS u32x4*)(Cl + (256 + e) * QS + p * 8) = npre; }
    } else {
#pragma unroll
        for (int i = 0; i < NCP; ++i) { const int idx = tid + NTHR * i, e = idx >> 4, p = idx & 15; *(LAS u32x4*)(Cl + e * QS + p * 8) = cpre[i]; }
    }
    u32x4 vpre[8];
#pragma unroll
    for (int i = 0; i < 8; ++i) { const int idx = tid + NTHR * i, sr = idx >> 5, p = idx & 31; vpre[i] = *(const u32x4*)(P + (size_t)(row0 + sr) * NPROJ + (ML ? C_MV : C_GV) + h * 256 + 8 * p); }
    __syncthreads();
    f32x4 acc[16];
#pragma unroll
    for (int et = 0; et < 16; ++et) { acc[et] = (f32x4){0.f, 0.f, 0.f, 0.f};
#pragma unroll
        for (int kk = 0; kk < NKK; ++kk) { const bf16x8 cf = *(const LAS bf16x8*)(Cl + (et * 16 + fr) * QS + kk * 32 + fq * 8); acc[et] = __builtin_amdgcn_mfma_f32_16x16x32_bf16(cf, qf[kk], acc[et], 0, 0, 0); }
        if ((et & 1) == 1) __builtin_amdgcn_sched_barrier(0); }
    float wint = 1.f, qn = 0.f;
    if (ML) {
        f32x4 dn = {0.f, 0.f, 0.f, 0.f};
#pragma unroll
        for (int kk = 0; kk < NKK; ++kk) { const bf16x8 nf = *(const LAS bf16x8*)(Cl + (256 + fr) * QS + kk * 32 + fq * 8); dn = __builtin_amdgcn_mfma_f32_16x16x32_bf16(nf, qf[kk], dn, 0, 0, 0); }
        qn = __shfl(dn[0], fr);
        wint = sc[256 + t];
#pragma unroll
        for (int et = 0; et < 16; ++et) acc[et] = acc[et] * wint;
    }
    __syncthreads();
    LAS bf16* Vs = (LAS bf16*)lds;
#pragma unroll
    for (int i = 0; i < 8; ++i) { const int idx = tid + NTHR * i, sr = idx >> 5, p = idx & 31; *(LAS u32x4*)(Vs + sr * 272 + p * 8) = vpre[i]; }
    __syncthreads();
#pragma unroll
    for (int ks = 0; ks < 4; ++ks) {
        u32x4 pw; pw.x = pb[2 * ks].x; pw.y = pb[2 * ks].y; pw.z = pb[2 * ks + 1].x; pw.w = pb[2 * ks + 1].y;
        const bf16x8 pf = __builtin_bit_cast(bf16x8, pw);
#pragma unroll
        for (int et = 0; et < 16; ++et) { acc[et] = __builtin_amdgcn_mfma_f32_16x16x32_bf16(tr_frag(Vs, 272, et * 16, ks, lane), pf, acc[et], 0, 0, 0); if ((et & 3) == 3) __builtin_amdgcn_sched_barrier(0); }
    }
    float inv = 1.f;
    if (ML) { den += __shfl_xor(den, 16); den += __shfl_xor(den, 32); den += wint * qn; inv = 1.f / fmaxf(fabsf(den), sc[384 + t]); }
    float ss = 0.f;
#pragma unroll
    for (int et = 0; et < 16; ++et) { acc[et] = acc[et] * inv; ss += dot4(acc[et], acc[et]); }
    ss += __shfl_xor(ss, 16); ss += __shfl_xor(ss, 32);
    const float rn = rsqrtf(ss * (1.f / 256.f) + EPS);
    const float* hw = a.in[ML ? I_MHW : I_GHW] + h * 256;
    const bf16* gp = P + (size_t)(row0 + t) * NPROJ + (ML ? C_MO : C_GR) + h * 256;
    bf16* yp = (bf16*)(ws + (ML ? WS_YM : WS_YG)) + (size_t)(row0 + t) * 1024 + h * 256;
#pragma unroll
    for (int et = 0; et < 16; ++et) { const int e = et * 16 + 4 * fq;
        const u32x2 gw = *(const u32x2*)(gp + e); const f32x4 w = *(const f32x4*)(hw + e);
        const float g0 = bflo(gw.x), g1 = bfhi(gw.x), g2 = bflo(gw.y), g3 = bfhi(gw.y);
        float o0 = acc[et][0] * rn * w[0], o1 = acc[et][1] * rn * w[1], o2 = acc[et][2] * rn * w[2], o3 = acc[et][3] * rn * w[3];
        if (ML) { o0 *= sigm(g0); o1 *= sigm(g1); o2 *= sigm(g2); o3 *= sigm(g3); } else { o0 *= g0 * sigm(g0); o1 *= g1 * sigm(g1); o2 *= g2 * sigm(g2); o3 *= g3 * sigm(g3); }
        u32x2 o; o.x = cvt_pk_bf16(o0, o1); o.y = cvt_pk_bf16(o2, o3); *(u32x2*)(yp + e) = o;
        if ((et & 3) == 3) __builtin_amdgcn_sched_barrier(0); }
}

template <bool ML>
__device__ __forceinline__ void sample_item(const Args& a, LAS unsigned char* lds, int b, int h) {
    constexpr int DK = ML ? 256 : 128;
    int tid_ = threadIdx.x; asm volatile("" : "+v"(tid_));
    const int tid = tid_, lane = tid & 63, wave = __builtin_amdgcn_readfirstlane(tid >> 6);
    unsigned char* ws = a.ws;
    const bf16* P = (const bf16*)(ws + WS_PROJ); const float* gates = (const float*)(ws + WS_GATES);
    const int row0 = MP + b * 8, bh = b * 4 + h;
    LAS float* qT = (LAS float*)lds;
    LAS float* wkT = qT + 2048;
    LAS float* kT = wkT + 2048;
    LAS float* vS = kT + 2048;
    LAS float* red = vS + 2048;
    LAS float* sm = red + 16384;
    const float* C0 = a.in[ML ? I_C : I_S] + (size_t)bh * DK * 256;
    float* C1 = a.out + (ML ? O_SC : O_SS) + (size_t)bh * DK * 256;
    f32x4 nx[8];
#pragma unroll
    for (int j = 0; j < 8; ++j) nx[j] = __builtin_nontemporal_load((const f32x4*)(C0 + (size_t)(wave + 8 * j) * 256 + 4 * lane));
    __syncthreads();
    float aS[8], Mt[8], bS[8]; float m0 = 0.f, dec = 1.f;
    if (ML) {
        m0 = a.in[I_M][bh]; float bs = 0.f, M = m0;
#pragma unroll
        for (int t = 0; t < 8; ++t) { const float mi = gates[(size_t)(row0 + t) * 32 + h], mf = gates[(size_t)(row0 + t) * 32 + 4 + h];
            bs += logsig(mf + a.in[I_BF][h]); bS[t] = bs; aS[t] = mi + a.in[I_BI][h] - bs; M = fmaxf(M, aS[t]); Mt[t] = M; }
        dec = __expf(m0 - Mt[7]);
        if (tid == 0) {
#pragma unroll
            for (int t = 0; t < 8; ++t) { sm[200 + t] = aS[t]; sm[208 + t] = Mt[t]; sm[216 + t] = bS[t]; } }
        if (tid < 256) { const int d = tid;
#pragma unroll
            for (int t = 0; t < 8; ++t) { const float qv = bf2f(P[(size_t)(row0 + t) * NPROJ + C_MQ + h * 256 + d]), kv = bf2f(P[(size_t)(row0 + t) * NPROJ + C_MK + h * 256 + d]) * (1.f / 16.f);
                qT[d * 8 + t] = qv; kT[d * 8 + t] = kv; wkT[d * 8 + t] = kv * __expf(aS[t] - Mt[7]); } }
    } else {
        if (tid < 128) { const int d = tid; float up[16];
#pragma unroll
            for (int j = 0; j < 16; ++j) up[j] = a.in[I_AUP][j * 512 + h * 128 + d];
            const float ab = a.in[I_AB][h * 128 + d];
            float bc[8]; float bs = 0.f;
#pragma unroll
            for (int t = 0; t < 8; ++t) { float z = ab;
#pragma unroll
                for (int j = 0; j < 16; ++j) z += gates[(size_t)(row0 + t) * 32 + 8 + j] * up[j];
                bs += logsig(z) * (1.f / 16.f); bc[t] = bs; }
            sm[72 + d] = __expf(bs);
#pragma unroll
            for (int t = 0; t < 8; ++t) { const float qv = bf2f(P[(size_t)(row0 + t) * NPROJ + C_GQ + h * 128 + d]), kv = bf2f(P[(size_t)(row0 + t) * NPROJ + C_GK + h * 128 + d]);
                qT[d * 8 + t] = qv * 0.08838834764831845f * __expf(bc[t]); kT[d * 8 + t] = kv * __expf(-bc[t]); wkT[d * 8 + t] = kv * __expf(bs - bc[t]); } }
    }
    { const int t = tid >> 6; const u32x2 w = *(const u32x2*)(P + (size_t)(row0 + t) * NPROJ + (ML ? C_MV : C_GV) + h * 256 + 4 * lane);
      *(LAS f32x4*)(vS + t * 256 + 4 * lane) = (f32x4){bflo(w.x), bfhi(w.x), bflo(w.y), bfhi(w.y)}; }
    __syncthreads();
    float prow, qn = 0.f;
    { const int s8 = lane & 7, part = lane >> 3; float sd = 0.f;
#pragma unroll 8
      for (int i = 0; i < DK / 8; ++i) { const int d = 8 * i + part; sd += qT[d * 8 + wave] * kT[d * 8 + s8]; }
      sd += __shfl_xor(sd, 8); sd += __shfl_xor(sd, 16); sd += __shfl_xor(sd, 32);
      if (ML) prow = (s8 <= wave) ? sd * __expf(sm[200 + s8] - sm[208 + wave]) : 0.f; else prow = (s8 <= wave) ? sd : 0.f; }
    if (ML) { const float* n0 = a.in[I_N] + (size_t)bh * 256; float sd = 0.f;
#pragma unroll
      for (int i = 0; i < 4; ++i) { const int d = lane + 64 * i; sd += qT[d * 8 + wave] * n0[d]; }
      qn = wave_sum(sd); }
    f32x4 v[8], acc[8];
#pragma unroll
    for (int s = 0; s < 8; ++s) { v[s] = *(const LAS f32x4*)(vS + s * 256 + 4 * lane); acc[s] = (f32x4){0.f, 0.f, 0.f, 0.f}; }
#pragma unroll
    for (int bt = 0; bt < DK / 64; ++bt) {
        f32x4 cur[8];
#pragma unroll
        for (int j = 0; j < 8; ++j) cur[j] = nx[j];
        if (bt + 1 < DK / 64) {
#pragma unroll
            for (int j = 0; j < 8; ++j) nx[j] = __builtin_nontemporal_load((const f32x4*)(C0 + (size_t)(wave + 8 * (8 * (bt + 1) + j)) * 256 + 4 * lane)); }
#pragma unroll
        for (int j = 0; j < 8; ++j) { const int d = wave + 8 * (8 * bt + j); const f32x4 cv = cur[j];
            const f32x4 q0 = *(const LAS f32x4*)(qT + d * 8), q1 = *(const LAS f32x4*)(qT + d * 8 + 4), k0 = *(const LAS f32x4*)(wkT + d * 8), k1 = *(const LAS f32x4*)(wkT + d * 8 + 4);
            const float dd = ML ? dec : sm[72 + d];
            acc[0] += cv * q0[0]; acc[1] += cv * q0[1]; acc[2] += cv * q0[2]; acc[3] += cv * q0[3]; acc[4] += cv * q1[0]; acc[5] += cv * q1[1]; acc[6] += cv * q1[2]; acc[7] += cv * q1[3];
            f32x4 cn = cv * dd;
            cn += v[0] * k0[0]; cn += v[1] * k0[1]; cn += v[2] * k0[2]; cn += v[3] * k0[3]; cn += v[4] * k1[0]; cn += v[5] * k1[1]; cn += v[6] * k1[2]; cn += v[7] * k1[3];
            __builtin_nontemporal_store(cn, (f32x4*)(C1 + (size_t)d * 256 + 4 * lane)); }
    }
#pragma unroll
    for (int s = 0; s < 8; ++s) *(LAS f32x4*)(red + (wave * 8 + s) * 256 + 4 * lane) = acc[s];
    __syncthreads();
    const int t = wave;
    f32x4 qc = {0.f, 0.f, 0.f, 0.f};
#pragma unroll
    for (int w = 0; w < 8; ++w) qc += *(const LAS f32x4*)(red + (w * 8 + t) * 256 + 4 * lane);
    float wint = 1.f, den = 0.f, Mtt = 0.f, btt = 0.f;
    if (ML) { Mtt = sm[208 + t]; btt = sm[216 + t]; wint = __expf(m0 - Mtt); }
    f32x4 num = qc * wint;
#pragma unroll
    for (int s = 0; s < 8; ++s) { const float p = __shfl(prow, s); num += v[s] * p; den += p; }
    if (ML) { den += wint * qn; const float fl = fmaxf(fabsf(den), __expf(-(btt + Mtt))); num = num * (1.f / fl); }
    const float rn = rsqrtf(wave_sum(dot4(num, num)) * (1.f / 256.f) + EPS);
    const f32x4 w = *(const f32x4*)(a.in[ML ? I_MHW : I_GHW] + h * 256 + 4 * lane);
    const u32x2 gw = *(const u32x2*)(P + (size_t)(row0 + t) * NPROJ + (ML ? C_MO : C_GR) + h * 256 + 4 * lane);
    const float g0 = bflo(gw.x), g1 = bfhi(gw.x), g2 = bflo(gw.y), g3 = bfhi(gw.y);
    float o0 = num[0] * rn * w[0], o1 = num[1] * rn * w[1], o2 = num[2] * rn * w[2], o3 = num[3] * rn * w[3];
    if (ML) { o0 *= sigm(g0); o1 *= sigm(g1); o2 *= sigm(g2); o3 *= sigm(g3); } else { o0 *= g0 * sigm(g0); o1 *= g1 * sigm(g1); o2 *= g2 * sigm(g2); o3 *= g3 * sigm(g3); }
    u32x2 o; o.x = cvt_pk_bf16(o0, o1); o.y = cvt_pk_bf16(o2, o3);
    *(u32x2*)((bf16*)(ws + (ML ? WS_YM : WS_YG)) + (size_t)(row0 + t) * 1024 + h * 256 + 4 * lane) = o;
    if (ML) {
        if (tid < 256) { float s = dec * a.in[I_N][(size_t)bh * 256 + tid];
#pragma unroll
            for (int q = 0; q < 8; ++q) s += wkT[tid * 8 + q];
            a.out[O_SN + (size_t)bh * 256 + tid] = s; }
        if (tid == 0) a.out[O_SM + bh] = bS[7] + Mt[7];
    }
}

__device__ __forceinline__ void rstd_phase(const Args& a, int vcu, int G) {
    int tid_ = threadIdx.x; asm volatile("" : "+v"(tid_));
    const int tid = tid_, lane = tid & 63, wave = tid >> 6;
    const float* part = (const float*)(a.ws + WS_PART); float* rstd = (float*)(a.ws + WS_RSTD);
    const bool split = (G == 256); const int nplain = split ? MP : MT;
    for (int row = vcu * NTHR + tid; row < nplain; row += G * NTHR) { float s = 0.f;
#pragma unroll
        for (int i = 0; i < 8; ++i) s += sum4(*(const f32x4*)(part + (size_t)row * 32 + 4 * i));
        rstd[row] = rsqrtf(s * (1.f / DM) + EPS); }
    if (split) {
        const float* tailp = (const float*)(a.ws + WS_PROJ); const float* nw = a.in[I_NFFN]; float* X1 = (float*)(a.ws + WS_X1); bf16* X1W = (bf16*)(a.ws + WS_X1W);
        for (int rr = vcu * NWAVES + wave; rr < MS; rr += G * NWAVES) { const int m = MP + rr, pmo = rr >> 8;
            f32x4 v[8]; float ss = 0.f;
#pragma unroll
            for (int j = 0; j < 8; ++j) { v[j] = *(const f32x4*)(a.in[I_XS] + (size_t)rr * DM + 4 * lane + 256 * j);
                const float* tp = tailp + (size_t)(pmo * 8 + j) * 8 * 65536 + (rr & 255) * 256 + 4 * lane;
#pragma unroll
                for (int sl = 0; sl < 8; ++sl) v[j] += *(const f32x4*)(tp + (size_t)sl * 65536);
                ss += dot4(v[j], v[j]); }
            ss = wave_sum(ss);
            if (lane == 0) rstd[m] = rsqrtf(ss * (1.f / DM) + EPS);
#pragma unroll
            for (int j = 0; j < 8; ++j) { const f32x4 w = *(const f32x4*)(nw + 4 * lane + 256 * j);
                *(f32x4*)(X1 + (size_t)m * DM + 4 * lane + 256 * j) = v[j];
                u32x2 o; o.x = cvt_pk_bf16(v[j][0] * w[0], v[j][1] * w[1]); o.y = cvt_pk_bf16(v[j][2] * w[2], v[j][3] * w[3]);
                *(u32x2*)(X1W + (size_t)m * DM + 4 * lane + 256 * j) = o; }
        }
    }
}
__device__ __forceinline__ void act_fixup(const Args& a, int vcu, int G) {
    unsigned char* ws = a.ws; const float* ub = (const float*)(ws + WS_U); bf16* ACT = (bf16*)(ws + WS_G);
    const float* cw = a.in[I_CW]; const float* cb = a.in[I_CB];
    int tid_ = threadIdx.x; asm volatile("" : "+v"(tid_));
    for (int idx = vcu * NTHR + tid_; idx < 28 * DFF; idx += G * NTHR) {
        const int k = idx / DFF, col = idx % DFF, pm = (k / 7) * 8 + 1 + (k % 7);
        const float um2 = ub[((size_t)(pm - 1) * 6 + 0) * DFF + col], um1 = ub[((size_t)(pm - 1) * 6 + 1) * DFF + col];
        const float u0 = ub[((size_t)pm * 6 + 2) * DFF + col], u1 = ub[((size_t)pm * 6 + 3) * DFF + col], g0 = ub[((size_t)pm * 6 + 4) * DFF + col], g1 = ub[((size_t)pm * 6 + 5) * DFF + col];
        const float c0 = cw[col], c1 = cw[DFF + col], c2 = cw[2 * DFF + col], bb = cb[col];
        ACT[(size_t)(pm * 256) * DFF + col] = f2bf(gelu_tanh(bb + c0 * um2 + c1 * um1 + c2 * u0) * g0);
        ACT[(size_t)(pm * 256 + 1) * DFF + col] = f2bf(gelu_tanh(bb + c0 * um1 + c1 * u0 + c2 * u1) * g1);
    }
}
__device__ __forceinline__ void final_norm(const Args& a, int vcu, int G) {
    int tid_ = threadIdx.x; asm volatile("" : "+v"(tid_));
    const int tid = tid_, lane = tid & 63, wave = tid >> 6;
    const float* fw = a.in[I_FNW]; const float* X1 = (const float*)(a.ws + WS_X1); const float* tailp = (const float*)(a.ws + WS_U);
    const bool split = (G == 256);
    int tpm = -1, tpn = -1;
    if (split && lane < 32) { pg8::StaticOrder S; S.init(MT, DM, G, 0); pg8::Unit u; if (S.at(256 + lane, u)) { tpm = u.pm; tpn = u.pn; } }
    for (int m = vcu * NWAVES + wave; m < MT; m += G * NWAVES) {
        const int pm = m >> 8;
        float* row = a.out + (size_t)m * DM;
        f32x4 v[8]; float ss = 0.f;
#pragma unroll
        for (int j = 0; j < 8; ++j) {
            const unsigned long long mask = __ballot(tpm == pm && tpn == j);
            if (mask == 0ull) v[j] = *(const f32x4*)(row + 4 * lane + 256 * j);
            else { const int tt = __ffsll((long long)mask) - 1;
                v[j] = *(const f32x4*)(X1 + (size_t)m * DM + 4 * lane + 256 * j);
                const float* tp = tailp + (size_t)tt * 8 * 65536 + (m & 255) * 256 + 4 * lane;
#pragma unroll
                for (int sl = 0; sl < 8; ++sl) v[j] += *(const f32x4*)(tp + (size_t)sl * 65536); }
            ss += dot4(v[j], v[j]); }
        const float r = rsqrtf(wave_sum(ss) * (1.f / DM) + EPS);
#pragma unroll
        for (int j = 0; j < 8; ++j) { const f32x4 w = *(const f32x4*)(fw + 4 * lane + 256 * j);
            *(f32x4*)(row + 4 * lane + 256 * j) = (f32x4){v[j][0] * r * w[0], v[j][1] * r * w[1], v[j][2] * r * w[2], v[j][3] * r * w[3]}; }
    }
}

#define XB_TMO      128
#define XB_XCNT(j)  (256  + 64 * (j))
#define XB_XSUB(j)  (1280 + 64 * (j))
#define XB_XGEN(j)  (2304 + 64 * (j))
#define XB_TOP      3328
#define XB_TOPGEN   3392
#define XCD_BAR_WORDS 3456
#define XB_SPIN_CAP (1u << 18)

__device__ __forceinline__ unsigned xb_ld(unsigned* p)              { return __hip_atomic_load(p, __ATOMIC_RELAXED, __HIP_MEMORY_SCOPE_AGENT); }
__device__ __forceinline__ unsigned xb_add(unsigned* p, unsigned v) { return __hip_atomic_fetch_add(p, v, __ATOMIC_RELAXED, __HIP_MEMORY_SCOPE_AGENT); }
__device__ __forceinline__ unsigned xb_xcc_id() { return (unsigned)__builtin_amdgcn_s_getreg((3 << 11) | 20) & 0xFu; }
#define XB_SPIN(cond, bar) do { unsigned _sp = 0; while (cond) { __builtin_amdgcn_s_sleep(1); \
    if ((++_sp & 255u) == 0u) { if (xb_ld(&(bar)[XB_TMO])) break; if (_sp > XB_SPIN_CAP) { atomicAdd(&(bar)[XB_TMO], 1u); break; } } } } while (0)

struct XcdBarrier {
    unsigned* bar; unsigned x;
    volatile LAS unsigned* st;
};

__device__ __forceinline__ XcdBarrier xcd_barrier_post(unsigned* bar, volatile LAS unsigned* st) {
    XcdBarrier b; b.bar = bar; b.x = xb_xcc_id(); b.st = st;
    if (threadIdx.x == 0) (void)xb_add(&bar[XB_XCNT(b.x)], 1u);
    return b;
}
__device__ __forceinline__ void xcd_barrier_complete(unsigned* bar, unsigned x, unsigned& nloc, unsigned& nx) {
    const unsigned G = gridDim.x * gridDim.y * gridDim.z;
    unsigned sum, cnt, mine, sp = 0u;
    for (;;) {
        sum = 0u; cnt = 0u; mine = 0u;
#pragma unroll
        for (unsigned j = 0; j < 16; ++j) { const unsigned c = xb_ld(&bar[XB_XCNT(j)]); sum += c; cnt += (c > 0u) ? 1u : 0u; mine = (j == x) ? c : mine; }
        if (sum == G) break;
        __builtin_amdgcn_s_sleep(1);
        if ((++sp & 255u) == 0u) { if (xb_ld(&bar[XB_TMO])) break; if (sp > XB_SPIN_CAP) { atomicAdd(&bar[XB_TMO], 1u); break; } }
    }
    nloc = mine > 0u ? mine : 1u; nx = cnt > 0u ? cnt : 1u;
}

__device__ __forceinline__ void xcd_barrier(const XcdBarrier& b) {
    asm volatile("s_waitcnt vmcnt(0)" ::: "memory");
    __syncthreads();
    if (threadIdx.x == 0) {
        unsigned* bar = b.bar;
        __builtin_amdgcn_s_waitcnt(0);
        unsigned nloc = b.st[0], nx = b.st[1];
        if (nloc == 0u) { xcd_barrier_complete(bar, b.x, nloc, nx); b.st[0] = nloc; b.st[1] = nx; }
        const unsigned old = xb_add(&bar[XB_XSUB(b.x)], 1u);
        const unsigned gen = old / nloc;
        if (old + 1u == (gen + 1u) * nloc) {
            __builtin_amdgcn_fence(__ATOMIC_RELEASE, "agent");
            asm volatile("s_waitcnt vmcnt(0)" ::: "memory");
            const unsigned og = xb_add(&bar[XB_TOP], 1u);
            const unsigned tg = og / nx;
            if (og + 1u == (tg + 1u) * nx) xb_add(&bar[XB_TOPGEN], 1u);
            else XB_SPIN(xb_ld(&bar[XB_TOPGEN]) == tg, bar);
            __builtin_amdgcn_fence(__ATOMIC_ACQUIRE, "agent");
            xb_add(&bar[XB_XGEN(b.x)], 1u);
            asm volatile("s_waitcnt vmcnt(0)" ::: "memory");
        } else {
            XB_SPIN(xb_ld(&bar[XB_XGEN(b.x)]) == gen, bar);
            __builtin_amdgcn_fence(__ATOMIC_ACQUIRE, "agent");
            asm volatile("s_waitcnt vmcnt(0)" ::: "memory");
        }
    }
    __syncthreads();
}

constexpr int N_PHASES = 12;
__global__ void __launch_bounds__(NTHR) fwd_kernel(Args args) {
    extern __shared__ __attribute__((aligned(16))) unsigned char lds_raw[];
    LAS unsigned char* lds = (LAS unsigned char*)lds_raw;
    cg::grid_group grid = cg::this_grid();
    volatile LAS unsigned* bst = (volatile LAS unsigned*)(lds + LDS_BYTES - 16);
    if (threadIdx.x < 4) bst[threadIdx.x] = 0u;
    __syncthreads();
    XcdBarrier xbar = xcd_barrier_post((unsigned*)args.ws, bst);
    const int G = gridDim.x, bx = blockIdx.x;
    const int vcu = (G % 8 == 0) ? (bx % 8) * (G / 8) + bx / 8 : bx;
    const int lo = args.ph_lo, hi = args.ph_hi;
    unsigned char* ws = args.ws;
#ifndef USE_CG_SYNC
#define USE_CG_SYNC 0
#endif
#ifndef DOUBLE_MASK
#define DOUBLE_MASK 0
#endif
#define REP(k) for (int rep_ = 0; rep_ < 1 + ((DOUBLE_MASK >> (k)) & 1); ++rep_)
#ifndef DBL_P2
#define DBL_P2 0
#endif
#ifndef BIS
#define BIS 15
#endif
#ifndef PHASE_MASK
#define PHASE_MASK 0xfff
#endif
#define IN(k) (((PHASE_MASK >> (k)) & 1) && lo <= (k) && (k) < hi)
#define SEAM(k) do { if (IN(k) && IN((k) + 1)) { if (USE_CG_SYNC || lo < 0) grid.sync(); else xcd_barrier(xbar); } } while (0)
    if (IN(0)) REP(0) { p0_prologue(args, lds, vcu, G, 0); __syncthreads(); }
    SEAM(0);
    if (IN(1)) REP(1) {
        pg8::Gemm g{(const bf16*)(ws + WS_XN), (const bf16*)(ws + WS_WIN), nullptr, nullptr, MT, NPROJ_PAD, DM}; pg8::StaticOrder S; S.init(MT, NPROJ_PAD, G, bx);
        EpiProj E{(bf16*)(ws + WS_PROJ), (float*)(ws + WS_GATES)};
        pg8::gemm_phase<EpiProj, pg8::StaticOrder, true, true>(lds, g, S, E);
        { const int rem = S.nwg % G, nidle = rem ? G - rem : G, idx = rem ? bx - rem : bx;
          if (idx >= 0) p0_prologue(args, lds, idx, nidle, 1); }
        __syncthreads();
    }
    SEAM(1);
    if (IN(2)) REP(2) {
        for (int it = bx; it < 1536; it += G) {
            if (it < 512) { for (int r_ = 0; r_ < 1 + (DBL_P2 & 1); ++r_) sample_item<true>(args, lds, it >> 2, it & 3); }
            else if (it < 1024) { for (int r_ = 0; r_ < 1 + ((DBL_P2 >> 1) & 1); ++r_) sample_item<false>(args, lds, (it - 512) >> 2, (it - 512) & 3); }
            else if (it < 1280) { for (int r_ = 0; r_ < 1 + ((DBL_P2 >> 2) & 1); ++r_) chunk_state<true>(args, lds, (it - 1024) >> 4, (it - 1024) & 15); }
            else { for (int r_ = 0; r_ < 1 + ((DBL_P2 >> 3) & 1); ++r_) chunk_state<false>(args, lds, (it - 1280) >> 4, (it - 1280) & 15); }
        }
    }
    SEAM(2);
    if (IN(3)) REP(3) { for (int it = bx; it < 768; it += G) { if (it < 512) scan_mlstm(args, it); else scan_gla(args, it - 512); } }
    SEAM(3);
    if (IN(4)) REP(4) { for (int it = bx; it < 512; it += G) { if (it < 256) { if (BIS & 1) chunk_out<true>(args, lds, it >> 4, it & 15); } else { if (BIS & 2) chunk_out<false>(args, lds, (it - 256) >> 4, (it - 256) & 15); } } __syncthreads(); }
    SEAM(4);
    if (IN(5)) REP(5) {
        pg8::Gemm g{(const bf16*)(ws + WS_YM), (const bf16*)(ws + WS_WA), (const bf16*)(ws + WS_YG), (const bf16*)(ws + WS_WB), MT, DM, 1024}; pg8::TwoSegOrder S; S.S.init(MT, DM, G, bx);
        EpiBranch E{(const bf16*)(ws + WS_PROJ), (bf16*)(ws + WS_XN)};
        pg8::gemm_phase<EpiBranch, pg8::TwoSegOrder, true, true>(lds, g, S, E);
    }
    SEAM(5);
    if (IN(6)) REP(6) {
        pg8::Gemm g{(const bf16*)(ws + WS_XN), (const bf16*)(ws + WS_WO), nullptr, nullptr, MT, DM, DM}; pg8::SplitRowsOrder<1, 32> S; S.split = (G == 256); S.S.init(S.split ? MP : MT, DM, G, bx);
        EpiOut E{args.in[I_XP], args.in[I_XS], (float*)(ws + WS_X1), (bf16*)(ws + WS_X1W), args.in[I_NFFN], (float*)(ws + WS_PART), (float*)(ws + WS_PROJ)};
        pg8::gemm_phase<EpiOut, pg8::SplitRowsOrder<1, 32>, true, true>(lds, g, S, E);
    }
    SEAM(6);
    if (IN(7)) REP(7) rstd_phase(args, vcu, G);
    SEAM(7);
    if (IN(8)) REP(8) {
        pg8::Gemm g{(const bf16*)(ws + WS_X1W), (const bf16*)(ws + WS_WUG), nullptr, nullptr, MT, 2 * DFF, DM}; pg8::StaticOrder S; S.init(MT, 2 * DFF, G, bx);
        EpiUGAct E{(const float*)(ws + WS_RSTD), (bf16*)(ws + WS_G), args.out, args.in[I_CW], args.in[I_CB], args.in[I_CONV], (float*)(ws + WS_U), (LAS float*)(lds + 131072)};
        pg8::gemm_phase<EpiUGAct, pg8::StaticOrder, true, true>(lds, g, S, E);
    }
    SEAM(8);
    if (IN(9)) REP(9) act_fixup(args, vcu, G);
    SEAM(9);
    if (IN(10)) REP(10) {
        pg8::Gemm g{(const bf16*)(ws + WS_G), (const bf16*)(ws + WS_WD), nullptr, nullptr, MT, DM, DFF}; pg8::DownOrder S; S.S.init(MT, DM, G, bx); S.split = (G == 256);
        EpiDown E{(const float*)(ws + WS_X1), args.out, (float*)(ws + WS_U)};
        pg8::gemm_phase<EpiDown, pg8::DownOrder, true, true>(lds, g, S, E);
    }
    SEAM(10);
    if (IN(11)) REP(11) final_norm(args, vcu, G);
#ifdef EXTRA_SYNCS
    for (int i_ = 0; i_ < EXTRA_SYNCS; ++i_) xcd_barrier(xbar);
#endif
#undef IN
#undef SEAM
}

extern "C" void kernel_launch(void* const* d_in, const int* in_sizes, int n_in, void* d_out, int out_size, void* d_ws, size_t ws_size, hipStream_t stream) {
    static int grid = 0;
    if (grid == 0) {
        if (n_in != 25 || ws_size < WS_END) { fprintf(stderr, "kernel_launch: unexpected n_in %d / ws_size %zu (need %zu)\n", n_in, ws_size, (size_t)WS_END); grid = -1; return; }
        int dev = 0, cus = 0, per_cu = 0;
        (void)hipGetDevice(&dev); (void)hipDeviceGetAttribute(&cus, hipDeviceAttributeMultiprocessorCount, dev);
        if (hipFuncSetAttribute((const void*)fwd_kernel, hipFuncAttributeMaxDynamicSharedMemorySize, LDS_BYTES) != hipSuccess) { fprintf(stderr, "kernel_launch: hipFuncSetAttribute failed\n"); grid = -1; return; }
        if (hipOccupancyMaxActiveBlocksPerMultiprocessor(&per_cu, (const void*)fwd_kernel, NTHR, LDS_BYTES) != hipSuccess || per_cu < 1) { fprintf(stderr, "kernel_launch: occupancy query says %d\n", per_cu); per_cu = 1; }
        (void)hipGetLastError();
        grid = cus * 1;
        if (grid <= 0) grid = 256;
    }
    if (grid < 0) return;
    if (hipMemsetAsync(d_ws, 0, 65536, stream) != hipSuccess) { fprintf(stderr, "kernel_launch: memset failed\n"); return; }
    Args a{};
    for (int i = 0; i < 25; ++i) a.in[i] = (const float*)d_in[i];
    a.out = (float*)d_out; a.ws = (unsigned char*)d_ws;
    if (MK_N_LAUNCHES == 1) {
        a.ph_lo = 0; a.ph_hi = N_PHASES;
        void* kargs[] = {&a};
        hipError_t e = hipLaunchCooperativeKernel((const void*)fwd_kernel, dim3(grid), dim3(NTHR), kargs, LDS_BYTES, stream);
        if (e != hipSuccess) fprintf(stderr, "kernel_launch: cooperative launch failed: %s (grid %d)\n", hipGetErrorString(e), grid);
    } else {
        for (int p = 0; p < N_PHASES; ++p) { a.ph_lo = p; a.ph_hi = p + 1; hipLaunchKernelGGL(fwd_kernel, dim3(grid), dim3(NTHR), LDS_BYTES, stream, a); }
    }
}
```

```cpp
#include <hip/hip_runtime.h>
#include <hip/hip_cooperative_groups.h>
#include <cstdio>
#include <cstdint>
namespace cg = cooperative_groups;

#ifndef MK_N_LAUNCHES
#define MK_N_LAUNCHES 1
#endif

namespace pg8 {
#define PG8_LAS __attribute__((address_space(3)))
typedef unsigned short bf16_t;
typedef short bf16x8 __attribute__((ext_vector_type(8)));
typedef float f32x4 __attribute__((ext_vector_type(4)));
typedef unsigned u32x4 __attribute__((ext_vector_type(4)));
constexpr int BM = 256, BK = 64, HALF = 128, HTB = HALF * BK * 2  , STAGE_BYTES = 8 * HTB, NXCD = 8, WGM = 8;

__host__ __device__ __forceinline__ int lds_byte(int r, int c) { const int st = (r >> 4) * 2 + (c >> 5), rr = r & 15, cc = c & 31, ob = rr * 64 + cc * 2; return st * 1024 + (ob ^ (((ob >> 9) & 1) << 5)); }
__host__ __device__ __forceinline__ void stage_rc(int b, int& R, int& C) { const int st = b / 1024, sb = b % 1024, swz = sb ^ (((sb >> 9) & 1) << 5); R = (st >> 1) * 16 + swz / 64; C = (st & 1) * 32 + (swz % 64) / 2; }
__host__ __device__ __forceinline__ int perm32(int rho) { const int n = rho >> 4, i = rho & 15; return 8 * (i >> 2) + 4 * n + (i & 3); }

struct Unit { int pm, pn, seg, kt0, nkt, tail; };
struct Gemm { const bf16_t* A; const bf16_t* Bt; const bf16_t* A2; const bf16_t* Bt2; int M, N, K; };

struct StaticOrder {
    int nM, nN, nwg, G, c;
    __host__ __device__ void init(int M, int N, int G_, int c_) { nM = M / BM; nN = N / BM; nwg = nM * nN; G = G_; c = c_; }
    __host__ __device__ bool next(int i, Unit& u) const { return at((long)i * G + c, u); }
    __host__ __device__ bool at(long L, Unit& u) const {
        if (L >= nwg) return false;
        int wgid = (int)L; { const int q = nwg / NXCD, r = nwg % NXCD, xcd = wgid % NXCD, off = wgid / NXCD; wgid = (xcd < r ? xcd * (q + 1) : r * (q + 1) + (xcd - r) * q) + off; }
        const int nig = WGM * nN, gid = wgid / nig, fm = gid * WGM, gsz = (nM - fm) < WGM ? (nM - fm) : WGM;
        u.pm = fm + ((wgid % nig) % gsz); u.pn = (wgid % nig) / gsz; u.seg = 0; u.kt0 = 0; u.nkt = -1; u.tail = -1; return true;
    }
};
struct DownOrder {
    StaticOrder S; bool split;
    __host__ __device__ bool next(int i, Unit& u) const {
        if (!split) return S.next(i, u);
        if (i == 0) return S.at(S.c, u);
        if (i > 1) return false;
        const int tt = S.c >> 3, sl = S.c & 7;
        if (!S.at(256 + tt, u)) return false;
        u.kt0 = 11 * sl + (sl & 1); u.nkt = (sl & 1) ? 10 : 12; u.tail = tt * 8 + sl; return true;
    }
};
template <int NSEG, int KT>
struct SplitRowsOrder {
    StaticOrder S; bool split;
    __host__ __device__ bool next(int i, Unit& u) const {
        if (!split) { if (!S.next(i / NSEG, u)) return false; u.seg = i % NSEG; return true; }
        if (i < NSEG) { if (!S.at(S.c, u)) return false; u.seg = i; return true; }
        if (i >= 2 * NSEG) return false;
        const int tt = S.c >> 3, sl = S.c & 7;
        u.pm = 32 + (tt >> 3); u.pn = tt & 7; u.seg = i - NSEG; u.kt0 = (KT / 8) * sl; u.nkt = KT / 8; u.tail = tt * 8 + sl; return true;
    }
};
template <int NSEG, int KT>
struct TailOnlyOrder {
    int c;
    __host__ __device__ bool next(int i, Unit& u) const {
        if (i >= NSEG) return false;
        const int tt = c >> 3, sl = c & 7;
        u.pm = 32 + (tt >> 3); u.pn = tt & 7; u.seg = i; u.kt0 = (KT / 8) * sl; u.nkt = KT / 8; u.tail = tt * 8 + sl; return true;
    }
};
template <int NSEG>
struct MainOnlyOrder {
    StaticOrder S;
    __host__ __device__ bool next(int i, Unit& u) const { if (i >= NSEG) return false; if (!S.at(S.c, u)) return false; u.seg = i; return true; }
};
struct TwoSegOrder {
    StaticOrder S;
    __host__ __device__ bool next(int i, Unit& u) const { if (!S.next(i >> 1, u)) return false; u.seg = i & 1; return true; }
};

__device__ __forceinline__ unsigned cvt_pk_bf16(float lo, float hi) { unsigned r; asm volatile("v_cvt_pk_bf16_f32 %0, %1, %2" : "=v"(r) : "v"(lo), "v"(hi)); return r; }

template <class Epi, class Sched, bool ALIGN_EPI = false, bool SP2 = false>
__device__ __forceinline__ void gemm_phase(PG8_LAS unsigned char* lds, const Gemm g, const Sched& S, const Epi& E) {
    int tid_ = threadIdx.x; asm volatile("" : "+v"(tid_));
    const int tid = tid_, wid = __builtin_amdgcn_readfirstlane(tid >> 6), lane = tid & 63, wr = wid >> 2, wc = wid & 3, fr = lane & 15, fq = lane >> 4;
    const int K = g.K, ntf = K / BK;
    unsigned voffA[2], voffB[2];
#pragma unroll
    for (int i = 0; i < 2; ++i) { int R, C; stage_rc(tid * 16 + i * 8192, R, C); const int Rb = Epi::PERM ? ((R & ~31) + perm32(R & 31)) : R;
        voffA[i] = (unsigned)(R * K + C) * 2u; voffB[i] = (unsigned)(Rb * K + C) * 2u; }
    const size_t kstep = (size_t)(BK * 2);
    const size_t hstep = (size_t)HALF * K * 2;
    const size_t tstep = 2 * hstep;
    const unsigned ldsw = (unsigned)wid * 1024u;
    const int aoff = lds_byte(wr * 64 + fr, fq * 8), boff = lds_byte(wc * 32 + fr, fq * 8);
#define PG8_SA(b, h) (((b) * 2 + (h)) * HTB)
#define PG8_SB(b, h) ((4 + (b) * 2 + (h)) * HTB)
#define PG8_STAGE(bufoff, gbase, voff) do { _Pragma("unroll") for (int _i = 0; _i < 2; ++_i) \
        __builtin_amdgcn_global_load_lds((const unsigned*)((const char*)(gbase) + (voff)[_i]), (PG8_LAS unsigned*)(lds + (bufoff) + ldsw + _i * 8192), 16, 0, 0); } while (0)
#define PG8_LDA(dst, b, h) do { _Pragma("unroll") for (int m = 0; m < 4; ++m) _Pragma("unroll") for (int k = 0; k < 2; ++k) dst[m][k] = *(const PG8_LAS bf16x8*)(lds + PG8_SA(b, h) + aoff + m * 2048 + k * 1024); } while (0)
#define PG8_LDB(dst, b, h) do { _Pragma("unroll") for (int n = 0; n < 2; ++n) _Pragma("unroll") for (int k = 0; k < 2; ++k) dst[n][k] = *(const PG8_LAS bf16x8*)(lds + PG8_SB(b, h) + boff + n * 2048 + k * 1024); } while (0)
#define PG8_MMA(ai, bj, At, Bt) do { __builtin_amdgcn_s_setprio(1); _Pragma("unroll") for (int m = 0; m < 4; ++m) _Pragma("unroll") for (int n = 0; n < 2; ++n) _Pragma("unroll") for (int k = 0; k < 2; ++k) \
        acc[ai][bj][m][n] = __builtin_amdgcn_mfma_f32_16x16x32_bf16(Bt[n][k], At[m][k], acc[ai][bj][m][n], 0, 0, 0); __builtin_amdgcn_s_setprio(0); } while (0)
#define PG8_WAIT_V(n) asm volatile("s_waitcnt vmcnt(" #n ")" ::: "memory")
#define PG8_WAIT_L(n) asm volatile("s_waitcnt lgkmcnt(" #n ")" ::: "memory")
#define PG8_BAR __builtin_amdgcn_s_barrier()
#define PG8_SCHED __builtin_amdgcn_sched_barrier(0)
    Unit cur, nxt; int ui = 0;
    if (!S.next(0, cur)) return;
    f32x4 acc[2][2][4][2];
#pragma unroll
    for (int a = 0; a < 2; ++a)
#pragma unroll
        for (int b = 0; b < 2; ++b)
#pragma unroll
            for (int m = 0; m < 4; ++m)
#pragma unroll
                for (int n = 0; n < 2; ++n) acc[a][b][m][n] = (f32x4){0.f, 0.f, 0.f, 0.f};
    bf16x8 At[4][2], B0[2][2], B1[2][2];
    const char* cA = (const char*)(cur.seg ? g.A2 : g.A) + (size_t)cur.pm * tstep + (size_t)cur.kt0 * kstep; const char* cB = (const char*)(cur.seg ? g.Bt2 : g.Bt) + (size_t)cur.pn * tstep + (size_t)cur.kt0 * kstep;
    if constexpr (SP2) {
        PG8_STAGE(PG8_SB(0, 0), cB, voffB); PG8_STAGE(PG8_SB(0, 1), cB + hstep, voffB); PG8_STAGE(PG8_SA(0, 0), cA, voffA); PG8_STAGE(PG8_SA(0, 1), cA + hstep, voffA);
        if (wr == 1) PG8_BAR;
        PG8_WAIT_V(2); PG8_BAR;
        PG8_STAGE(PG8_SB(1, 0), cB + kstep, voffB); PG8_STAGE(PG8_SA(1, 0), cA + kstep, voffA); PG8_STAGE(PG8_SB(1, 1), cB + hstep + kstep, voffB);
        PG8_WAIT_V(6); PG8_BAR;
    } else {
        PG8_STAGE(PG8_SB(0, 0), cB, voffB); PG8_STAGE(PG8_SA(0, 0), cA, voffA); PG8_STAGE(PG8_SB(0, 1), cB + hstep, voffB); PG8_STAGE(PG8_SA(0, 1), cA + hstep, voffA);
        if (wr == 1) PG8_BAR;
        PG8_WAIT_V(4); PG8_BAR;
        PG8_STAGE(PG8_SB(1, 0), cB + kstep, voffB); PG8_STAGE(PG8_SA(1, 0), cA + kstep, voffA); PG8_STAGE(PG8_SB(1, 1), cB + hstep + kstep, voffB);
        PG8_WAIT_V(6); PG8_BAR;
    }
    for (;;) {
        const bool has_next = S.next(ui + 1, nxt);
        const char* nA = has_next ? (const char*)(nxt.seg ? g.A2 : g.A) + (size_t)nxt.pm * tstep + (size_t)nxt.kt0 * kstep : cA; const char* nB = has_next ? (const char*)(nxt.seg ? g.Bt2 : g.Bt) + (size_t)nxt.pn * tstep + (size_t)nxt.kt0 * kstep : cB;
        const int nt = cur.nkt > 0 ? cur.nkt : ntf;
        for (int t = 0; t < nt; t += 2) {
            const bool last = (t == nt - 2);
            const char* a1 = cA + (size_t)(t + 1) * kstep;
            const char* a2 = last ? nA : cA + (size_t)(t + 2) * kstep; const char* b2 = last ? nB : cB + (size_t)(t + 2) * kstep;
            const char* a3 = a2 + kstep; const char* b3 = b2 + kstep;
            if constexpr (SP2) {
            PG8_LDB(B0, 0, 0); PG8_LDB(B1, 0, 1); PG8_SCHED; PG8_LDA(At, 0, 0); PG8_STAGE(PG8_SA(1, 1), a1 + hstep, voffA);
            PG8_WAIT_V(8); PG8_WAIT_L(0); PG8_BAR; PG8_MMA(0, 0, At, B0); PG8_MMA(0, 1, At, B1); PG8_BAR; PG8_SCHED;
            PG8_LDA(At, 0, 1); PG8_STAGE(PG8_SB(0, 0), b2, voffB); PG8_STAGE(PG8_SB(0, 1), b2 + hstep, voffB); PG8_STAGE(PG8_SA(0, 0), a2, voffA);
            PG8_WAIT_V(8); PG8_WAIT_L(0); PG8_BAR; PG8_MMA(1, 0, At, B0); PG8_MMA(1, 1, At, B1); PG8_BAR; PG8_SCHED;
            PG8_LDB(B0, 1, 0); PG8_LDB(B1, 1, 1); PG8_SCHED; PG8_LDA(At, 1, 0); PG8_STAGE(PG8_SA(0, 1), a2 + hstep, voffA);
            PG8_WAIT_V(8); PG8_WAIT_L(0); PG8_BAR; PG8_MMA(0, 0, At, B0); PG8_MMA(0, 1, At, B1); PG8_BAR; PG8_SCHED;
            PG8_LDA(At, 1, 1); PG8_STAGE(PG8_SB(1, 0), b3, voffB); PG8_STAGE(PG8_SB(1, 1), b3 + hstep, voffB); PG8_STAGE(PG8_SA(1, 0), a3, voffA);
            PG8_WAIT_V(8); PG8_WAIT_L(0); PG8_BAR; PG8_MMA(1, 0, At, B0); PG8_MMA(1, 1, At, B1); PG8_BAR; PG8_SCHED;
            } else {
            PG8_LDB(B0, 0, 0); PG8_SCHED; PG8_LDA(At, 0, 0); PG8_STAGE(PG8_SA(1, 1), a1 + hstep, voffA);
            PG8_WAIT_L(8); PG8_BAR; PG8_WAIT_L(0); PG8_MMA(0, 0, At, B0); PG8_BAR; PG8_SCHED;
            PG8_LDB(B1, 0, 1); PG8_STAGE(PG8_SB(0, 0), b2, voffB);
            PG8_BAR; PG8_WAIT_L(0); PG8_MMA(0, 1, At, B1); PG8_BAR;
            PG8_LDA(At, 0, 1); PG8_STAGE(PG8_SA(0, 0), a2, voffA);
            PG8_BAR; PG8_WAIT_L(0); PG8_MMA(1, 0, At, B0); PG8_BAR; PG8_SCHED;
            PG8_STAGE(PG8_SB(0, 1), b2 + hstep, voffB);
            PG8_WAIT_V(6); PG8_BAR; PG8_MMA(1, 1, At, B1); PG8_BAR;
            PG8_LDB(B0, 1, 0); PG8_SCHED; PG8_LDA(At, 1, 0); PG8_STAGE(PG8_SA(0, 1), a2 + hstep, voffA);
            PG8_WAIT_L(8); PG8_BAR; PG8_WAIT_L(0); PG8_MMA(0, 0, At, B0); PG8_BAR; PG8_SCHED;
            PG8_LDB(B1, 1, 1); PG8_STAGE(PG8_SB(1, 0), b3, voffB);
            PG8_BAR; PG8_WAIT_L(0); PG8_MMA(0, 1, At, B1); PG8_BAR;
            PG8_LDA(At, 1, 1); PG8_STAGE(PG8_SA(1, 0), a3, voffA);
            PG8_BAR; PG8_WAIT_L(0); PG8_MMA(1, 0, At, B0); PG8_BAR; PG8_SCHED;
            PG8_STAGE(PG8_SB(1, 1), b3 + hstep, voffB);
            PG8_WAIT_V(6); PG8_BAR; PG8_MMA(1, 1, At, B1); PG8_BAR;
            }
        }
        if constexpr (ALIGN_EPI) { if (wr == 0) PG8_BAR; }
        E(acc, cur, wr, wc, fr, fq);
        if (!has_next) break;
        if (nxt.seg == 0)
#pragma unroll
        for (int a = 0; a < 2; ++a)
#pragma unroll
            for (int b = 0; b < 2; ++b)
#pragma unroll
                for (int m = 0; m < 4; ++m)
#pragma unroll
                    for (int n = 0; n < 2; ++n) acc[a][b][m][n] = (f32x4){0.f, 0.f, 0.f, 0.f};
        cur = nxt; cA = nA; cB = nB; ++ui;
        if constexpr (ALIGN_EPI) { if (wr == 1) PG8_BAR; }
    }
    PG8_WAIT_V(0);
    if constexpr (!ALIGN_EPI) { if (wr == 0) PG8_BAR; }
    PG8_BAR;
#undef PG8_SA
#undef PG8_SB
#undef PG8_STAGE
#undef PG8_LDA
#undef PG8_LDB
#undef PG8_MMA
#undef PG8_WAIT_V
#undef PG8_WAIT_L
#undef PG8_BAR
#undef PG8_SCHED
}
}

#define LAS __attribute__((address_space(3)))
typedef unsigned short bf16;
typedef short bf16x8 __attribute__((ext_vector_type(8)));
typedef float f32x4 __attribute__((ext_vector_type(4)));
typedef unsigned u32x4 __attribute__((ext_vector_type(4)));
typedef unsigned u32x2 __attribute__((ext_vector_type(2)));
using pg8::cvt_pk_bf16;

constexpr int NWAVES = 8, NTHR = 512;
constexpr int DM = 2048, MP = 8192, MS = 1024, MT = 9216, TP = 2048, TS = 8;
constexpr int NIN = 11288, NPROJ = 11264, NPROJ_PAD = 11520, DFF = 5632;
constexpr int C_MQ = 0, C_MK = 1024, C_MV = 2048, C_MO = 3072, C_GQ = 4096, C_GK = 4608, C_GV = 5120, C_GR = 6144, C_GA = 7168, C_GB = 9216;
constexpr float EPS = 1e-6f;
constexpr int NCH = 16;
constexpr int LDS_BYTES = 147456;

constexpr size_t O_YP = 0, O_YS = 16777216, O_PC = 18874368, O_PN = 19922944, O_PM = 19927040, O_PS = 19927056, O_PCONV = 20451344,
                 O_SC = 20496400, O_SN = 54050832, O_SM = 54181904, O_SS = 54182416, O_SCONV = 70959632;

constexpr size_t MiB = 1u << 20;
constexpr size_t WS_GATES = 64 * 1024;
constexpr size_t WS_PART = WS_GATES + (size_t)MT * 32 * 4;
constexpr size_t WS_DN = WS_PART + (size_t)MT * 32 * 4;
constexpr size_t WS_NPREV = WS_DN + 256 * 256 * 4;
constexpr size_t WS_CHS = WS_NPREV + 256 * 256 * 2;
constexpr size_t WS_BEND = WS_CHS + 256 * 2 * 4;
constexpr size_t WS_RSTD = WS_BEND + 256 * 128 * 4;
static_assert(WS_RSTD + MT * 4 <= 4 * MiB, "small region");
constexpr size_t WS_WIN = 4 * MiB;
constexpr size_t WS_WA = WS_WIN + (size_t)NPROJ_PAD * DM * 2;
constexpr size_t WS_WB = WS_WA + (size_t)2048 * 1024 * 2;
constexpr size_t WS_WO = WS_WB + (size_t)2048 * 1024 * 2;
constexpr size_t WS_WUG = WS_WO + (size_t)2048 * 2048 * 2;
constexpr size_t WS_WD = WS_WUG + (size_t)2 * DFF * DM * 2;
constexpr size_t WS_R1 = WS_WD + (size_t)DM * DFF * 2;
static_assert(WS_R1 == 131 * MiB, "map");
constexpr size_t WS_XN = WS_R1;
constexpr size_t WS_X1W = WS_R1 + 36 * MiB;
constexpr size_t WS_X1 = WS_R1 + 72 * MiB;
constexpr size_t WS_DC = WS_R1;
constexpr size_t WS_DS = WS_R1 + 64 * MiB;
constexpr size_t WS_CT = WS_R1 + 96 * MiB;
constexpr size_t WS_ST = WS_R1 + 128 * MiB;
constexpr size_t WS_YM = WS_R1 + 144 * MiB;
constexpr size_t WS_YG = WS_YM + 18 * MiB;
constexpr size_t WS_PROJ = WS_YG + 18 * MiB;
constexpr size_t WS_U = WS_PROJ, WS_G = WS_PROJ + 99 * MiB;
constexpr size_t WS_END = WS_PROJ + 198 * MiB;
static_assert(WS_END == 509 * MiB, "map");

struct Args {
    const float* in[25]; float* out; unsigned char* ws; int ph_lo, ph_hi;
};
enum { I_XP = 0, I_XS, I_C, I_N, I_M, I_S, I_CONV, I_WIN, I_BI, I_BF, I_AUP, I_AB, I_MHW, I_GHW, I_WA, I_WB, I_WO, I_NMIX, I_NFFN, I_WUP, I_WGATE, I_CW, I_CB, I_WDOWN, I_FNW };

__device__ __forceinline__ float bf2f(unsigned short b) { return __builtin_bit_cast(float, (unsigned)b << 16); }
__device__ __forceinline__ float bflo(unsigned w) { return __builtin_bit_cast(float, w << 16); }
__device__ __forceinline__ float bfhi(unsigned w) { return __builtin_bit_cast(float, w & 0xffff0000u); }
__device__ __forceinline__ unsigned short f2bf(float f) { return (unsigned short)(cvt_pk_bf16(f, 0.f) & 0xffffu); }
__device__ __forceinline__ float logsig(float z) { return fminf(z, 0.f) - __logf(1.f + __expf(-fabsf(z))); }
__device__ __forceinline__ float sigm(float z) { return 1.f / (1.f + __expf(-z)); }
__device__ __forceinline__ float wave_sum(float v) {
#pragma unroll
    for (int o = 1; o < 64; o <<= 1) v += __shfl_xor(v, o);
    return v;
}
__device__ __forceinline__ float wave_max(float v) {
#pragma unroll
    for (int o = 1; o < 64; o <<= 1) v = fmaxf(v, __shfl_xor(v, o));
    return v;
}
__device__ __forceinline__ float sum4(f32x4 v) { return (v.x + v.y) + (v.z + v.w); }
__device__ __forceinline__ float dot4(f32x4 a, f32x4 b) { return (a.x * b.x + a.y * b.y) + (a.z * b.z + a.w * b.w); }
__device__ __forceinline__ float gelu_tanh(float v) { const float u = 0.7978845608028654f * (v + 0.044715f * v * v * v); return v * sigm(2.f * u); }

typedef f32x4 AccT[2][2][4][2];
struct EpiProj {
    static constexpr bool PERM = true;
    bf16* P; float* gates;
    __device__ __forceinline__ void operator()(AccT& acc, const pg8::Unit& u, int wr, int wc, int fr, int fq) const {
        const int row0 = u.pm * 256 + wr * 64 + fr;
        if (u.pn < 44) {
            const int col0 = u.pn * 256 + wc * 32 + 8 * fq;
#pragma unroll
            for (int ai = 0; ai < 2; ++ai)
#pragma unroll
                for (int m = 0; m < 4; ++m) { bf16* rowp = P + (size_t)(row0 + ai * 128 + m * 16) * NPROJ + col0;
#pragma unroll
                    for (int bj = 0; bj < 2; ++bj) { const f32x4 v0 = acc[ai][bj][m][0], v1 = acc[ai][bj][m][1]; u32x4 w;
                        w.x = cvt_pk_bf16(v0[0], v0[1]); w.y = cvt_pk_bf16(v0[2], v0[3]); w.z = cvt_pk_bf16(v1[0], v1[1]); w.w = cvt_pk_bf16(v1[2], v1[3]);
                        *(u32x4*)(rowp + bj * 128) = w; } }
        } else if (wc == 0) {
#pragma unroll
            for (int ai = 0; ai < 2; ++ai)
#pragma unroll
                for (int m = 0; m < 4; ++m) { float* rowp = gates + (size_t)(row0 + ai * 128 + m * 16) * 32 + 8 * fq;
                    *(f32x4*)rowp = acc[ai][0][m][0]; *(f32x4*)(rowp + 4) = acc[ai][0][m][1]; }
        }
    }
};
struct EpiBranch {
    static constexpr bool PERM = true;
    const bf16* P; bf16* O; float* tailp;
    __device__ __forceinline__ void operator()(AccT& acc, const pg8::Unit& u, int wr, int wc, int fr, int fq) const {
        const int row0 = u.pm * 256 + wr * 64 + fr, col0 = u.pn * 256 + wc * 32 + 8 * fq;
#pragma unroll
        for (int ai = 0; ai < 2; ++ai)
#pragma unroll
            for (int m = 0; m < 4; ++m) { const int row = row0 + ai * 128 + m * 16;
#pragma unroll
                for (int bj = 0; bj < 2; ++bj) { const int col = col0 + bj * 128;
                    const u32x4 ga = *(const u32x4*)(P + (size_t)row * NPROJ + C_GA + col), gb = *(const u32x4*)(P + (size_t)row * NPROJ + C_GB + col);
                    float fa[8] = {bflo(ga.x), bfhi(ga.x), bflo(ga.y), bfhi(ga.y), bflo(ga.z), bfhi(ga.z), bflo(ga.w), bfhi(ga.w)};
                    float fb[8] = {bflo(gb.x), bfhi(gb.x), bflo(gb.y), bfhi(gb.y), bflo(gb.z), bfhi(gb.z), bflo(gb.w), bfhi(gb.w)};
                    if (u.seg == 0) {
#pragma unroll
                        for (int i = 0; i < 8; ++i) { const float r = (1.f + __expf(-fb[i])) / (1.f + __expf(-fa[i])); acc[ai][bj][m][i >> 2][i & 3] *= r; }
                    } else {
                        float o[8];
#pragma unroll
                        for (int i = 0; i < 8; ++i) o[i] = acc[ai][bj][m][i >> 2][i & 3] * sigm(fb[i]);
                        if (u.tail < 0) { u32x4 w; w.x = cvt_pk_bf16(o[0], o[1]); w.y = cvt_pk_bf16(o[2], o[3]); w.z = cvt_pk_bf16(o[4], o[5]); w.w = cvt_pk_bf16(o[6], o[7]);
                            *(u32x4*)(O + (size_t)row * DM + col) = w; }
                        else { float* p = tailp + (size_t)u.tail * 65536 + (row & 255) * 256 + (col & 255); *(f32x4*)p = (f32x4){o[0], o[1], o[2], o[3]}; *(f32x4*)(p + 4) = (f32x4){o[4], o[5], o[6], o[7]}; }
                    } } }
    }
};
struct EpiOut {
    static constexpr bool PERM = true;
    const float* xp; const float* xs; float* X1; bf16* X1W; const float* nw; float* part; float* tailp;
    __device__ __forceinline__ void operator()(AccT& acc, const pg8::Unit& u, int wr, int wc, int fr, int fq) const {
        const int row0 = u.pm * 256 + wr * 64 + fr, col0 = u.pn * 256 + wc * 32 + 8 * fq;
        if (u.tail >= 0) {
            float* tp = tailp + (size_t)u.tail * 65536 + (wr * 64 + fr) * 256 + wc * 32 + 8 * fq;
#pragma unroll
            for (int ai = 0; ai < 2; ++ai)
#pragma unroll
                for (int m = 0; m < 4; ++m)
#pragma unroll
                    for (int bj = 0; bj < 2; ++bj) { float* p = tp + (ai * 128 + m * 16) * 256 + bj * 128; *(f32x4*)p = acc[ai][bj][m][0]; *(f32x4*)(p + 4) = acc[ai][bj][m][1]; }
            return;
        }
#pragma unroll
        for (int ai = 0; ai < 2; ++ai)
#pragma unroll
            for (int m = 0; m < 4; ++m) { const int row = row0 + ai * 128 + m * 16;
                const float* xrow = row < MP ? xp + (size_t)row * DM : xs + (size_t)(row - MP) * DM;
                float ss = 0.f;
#pragma unroll
                for (int bj = 0; bj < 2; ++bj) { const int col = col0 + bj * 128;
                    const f32x4 v0 = acc[ai][bj][m][0] + *(const f32x4*)(xrow + col), v1 = acc[ai][bj][m][1] + *(const f32x4*)(xrow + col + 4);
                    *(f32x4*)(X1 + (size_t)row * DM + col) = v0; *(f32x4*)(X1 + (size_t)row * DM + col + 4) = v1;
                    ss += dot4(v0, v0) + dot4(v1, v1);
                    const f32x4 w0 = *(const f32x4*)(nw + col), w1 = *(const f32x4*)(nw + col + 4);
                    u32x4 w; w.x = cvt_pk_bf16(v0[0] * w0[0], v0[1] * w0[1]); w.y = cvt_pk_bf16(v0[2] * w0[2], v0[3] * w0[3]);
                    w.z = cvt_pk_bf16(v1[0] * w1[0], v1[1] * w1[1]); w.w = cvt_pk_bf16(v1[2] * w1[2], v1[3] * w1[3]);
                    *(u32x4*)(X1W + (size_t)row * DM + col) = w; }
                ss += __shfl_xor(ss, 16); ss += __shfl_xor(ss, 32);
                if (fq == 0) part[(size_t)row * 32 + u.pn * 4 + wc] = ss; }
    }
};
#define DPP_MOV(ctrl, oldv, srcv) __builtin_bit_cast(float, __builtin_amdgcn_update_dpp(__builtin_bit_cast(int, (float)(oldv)), __builtin_bit_cast(int, (float)(srcv)), (ctrl), 0xf, 0xf, false))
struct EpiUGAct {
    static constexpr bool PERM = true;
    const float* rstd; bf16* ACT; float* out; const float* cw; const float* cb; const float* cst; float* ub; LAS float* xch;
    __device__ __forceinline__ void operator()(AccT& acc, const pg8::Unit& u, int wr, int wc, int fr, int fq) const {
        const int row0 = u.pm * 256 + wr * 64 + fr, col = u.pn * 128 + wc * 32 + 8 * fq;
        const bool sample = u.pm >= 32;
#pragma unroll
        for (int ai = 0; ai < 2; ++ai)
#pragma unroll
            for (int m = 0; m < 4; ++m) { const int row = row0 + ai * 128 + m * 16;
                const float r = rstd[row];
                acc[ai][0][m][0] = acc[ai][0][m][0] * r; acc[ai][0][m][1] = acc[ai][0][m][1] * r; acc[ai][1][m][0] = acc[ai][1][m][0] * r; acc[ai][1][m][1] = acc[ai][1][m][1] * r;
                float* cs = nullptr;
                if (row < MP) { const int t = row & (TP - 1); if (t >= TP - 2) cs = out + O_PCONV + ((size_t)(row >> 11) * 2 + (t - (TP - 2))) * DFF + col; }
                else { const int rr = row - MP, t = rr & 7; if (t >= 6) cs = out + O_SCONV + ((size_t)(rr >> 3) * 2 + (t - 6)) * DFF + col; }
                if (cs) { *(f32x4*)cs = acc[ai][0][m][0]; *(f32x4*)(cs + 4) = acc[ai][0][m][1]; } }
        if (fr >= 14) {
#pragma unroll
            for (int ai = 0; ai < 2; ++ai) { LAS float* p = xch + ((((ai * 2 + wr) * 4 + wc) * 2 + (fr - 14)) * 4 + fq) * 8; *(LAS f32x4*)p = acc[ai][0][3][0]; *(LAS f32x4*)(p + 4) = acc[ai][0][3][1]; }
            if (!sample && wr == 1) { float* p = ub + ((size_t)u.pm * 6 + (fr - 14)) * DFF + col; *(f32x4*)p = acc[1][0][3][0]; *(f32x4*)(p + 4) = acc[1][0][3][1]; }
        }
        if (!sample && wr == 0 && fr < 2) { float* p = ub + ((size_t)u.pm * 6 + 2 + fr) * DFF + col; *(f32x4*)p = acc[0][0][0][0]; *(f32x4*)(p + 4) = acc[0][0][0][1];
            p += 2 * DFF; *(f32x4*)p = acc[0][1][0][0]; *(f32x4*)(p + 4) = acc[0][1][0][1]; }
        asm volatile("s_waitcnt lgkmcnt(0)" ::: "memory"); __builtin_amdgcn_s_barrier();
        const f32x4 k0a = *(const f32x4*)(cw + col), k0b = *(const f32x4*)(cw + col + 4), k1a = *(const f32x4*)(cw + DFF + col), k1b = *(const f32x4*)(cw + DFF + col + 4);
        const f32x4 k2a = *(const f32x4*)(cw + 2 * DFF + col), k2b = *(const f32x4*)(cw + 2 * DFF + col + 4), cba = *(const f32x4*)(cb + col), cbb = *(const f32x4*)(cb + col + 4);
#pragma unroll
        for (int ai = 0; ai < 2; ++ai) {
            f32x4 pe0 = {0.f, 0.f, 0.f, 0.f}, pe1 = {0.f, 0.f, 0.f, 0.f};
            if (!(ai == 0 && wr == 0) && fr >= 14) { const int sai = (wr == 1) ? ai : ai - 1, swr = wr ^ 1;
                const LAS float* p = xch + ((((sai * 2 + swr) * 4 + wc) * 2 + (fr - 14)) * 4 + fq) * 8; pe0 = *(const LAS f32x4*)p; pe1 = *(const LAS f32x4*)(p + 4); }
#pragma unroll
            for (int m = 0; m < 4; ++m) { const int row = row0 + ai * 128 + m * 16;
                const f32x4 c0 = acc[ai][0][m][0], c1 = acc[ai][0][m][1], v0 = m ? acc[ai][0][m ? m - 1 : 0][0] : pe0, v1 = m ? acc[ai][0][m ? m - 1 : 0][1] : pe1;
                float cur[8] = {c0[0], c0[1], c0[2], c0[3], c1[0], c1[1], c1[2], c1[3]}, prv[8] = {v0[0], v0[1], v0[2], v0[3], v1[0], v1[1], v1[2], v1[3]};
                float p1[8], p2[8];
#pragma unroll
                for (int i = 0; i < 8; ++i) { const float y1 = DPP_MOV(0x121, 0.f, prv[i]); p1[i] = DPP_MOV(0x111, y1, cur[i]); const float y2 = DPP_MOV(0x122, 0.f, prv[i]); p2[i] = DPP_MOV(0x112, y2, cur[i]); }
                if (sample) { const int t = fr & 7;
                    if (t < 2) { const float* st = cst + (size_t)((row - MP) >> 3) * 2 * DFF + col;
                        const f32x4 s1a = *(const f32x4*)(st + DFF), s1b = *(const f32x4*)(st + DFF + 4);
                        if (t == 0) { const f32x4 s0a = *(const f32x4*)st, s0b = *(const f32x4*)(st + 4);
#pragma unroll
                            for (int i = 0; i < 4; ++i) { p1[i] = s1a[i]; p1[4 + i] = s1b[i]; p2[i] = s0a[i]; p2[4 + i] = s0b[i]; } }
                        else {
#pragma unroll
                            for (int i = 0; i < 4; ++i) { p2[i] = s1a[i]; p2[4 + i] = s1b[i]; } } } }
                const f32x4 g0 = acc[ai][1][m][0], g1 = acc[ai][1][m][1];
                float o[8];
#pragma unroll
                for (int i = 0; i < 4; ++i) { o[i] = gelu_tanh(cba[i] + k0a[i] * p2[i] + k1a[i] * p1[i] + k2a[i] * cur[i]) * g0[i];
                    o[4 + i] = gelu_tanh(cbb[i] + k0b[i] * p2[4 + i] + k1b[i] * p1[4 + i] + k2b[i] * cur[4 + i]) * g1[i]; }
                u32x4 w; w.x = cvt_pk_bf16(o[0], o[1]); w.y = cvt_pk_bf16(o[2], o[3]); w.z = cvt_pk_bf16(o[4], o[5]); w.w = cvt_pk_bf16(o[6], o[7]);
                *(u32x4*)(ACT + (size_t)row * DFF + col) = w; }
        }
    }
};
struct EpiDown {
    static constexpr bool PERM = true;
    const float* X1; float* out; float* tailp;
    __device__ __forceinline__ void operator()(AccT& acc, const pg8::Unit& u, int wr, int wc, int fr, int fq) const {
        if (u.tail < 0) {
            const int row0 = u.pm * 256 + wr * 64 + fr, col0 = u.pn * 256 + wc * 32 + 8 * fq;
#pragma unroll
            for (int ai = 0; ai < 2; ++ai)
#pragma unroll
                for (int m = 0; m < 4; ++m) { const int row = row0 + ai * 128 + m * 16;
#pragma unroll
                    for (int bj = 0; bj < 2; ++bj) { const int col = col0 + bj * 128;
                        const f32x4 v0 = acc[ai][bj][m][0] + *(const f32x4*)(X1 + (size_t)row * DM + col), v1 = acc[ai][bj][m][1] + *(const f32x4*)(X1 + (size_t)row * DM + col + 4);
                        *(f32x4*)(out + (size_t)row * DM + col) = v0; *(f32x4*)(out + (size_t)row * DM + col + 4) = v1; } }
        } else {
            float* tp = tailp + (size_t)u.tail * 65536 + (wr * 64 + fr) * 256 + wc * 32 + 8 * fq;
#pragma unroll
            for (int ai = 0; ai < 2; ++ai)
#pragma unroll
                for (int m = 0; m < 4; ++m)
#pragma unroll
                    for (int bj = 0; bj < 2; ++bj) { float* p = tp + (ai * 128 + m * 16) * 256 + bj * 128; *(f32x4*)p = acc[ai][bj][m][0]; *(f32x4*)(p + 4) = acc[ai][bj][m][1]; }
        }
    }
};

template <class ColPtr>
__device__ __forceinline__ void transpose_item(const ColPtr& cp, int K, int srcN, bf16* WT, LAS float* scr, int kb, int nb, int lane) {
    const int k0 = 64 * kb, n0 = 64 * nb, kr = lane >> 4, n4 = (lane & 15) * 4;
    const float* src = cp(n0 + n4);
    f32x4 v[16];
#pragma unroll
    for (int i = 0; i < 16; ++i) v[i] = src ? *(const f32x4*)(src + (size_t)(k0 + 4 * i + kr) * srcN) : (f32x4){0.f, 0.f, 0.f, 0.f};
#pragma unroll
    for (int i = 0; i < 16; ++i) { LAS float* d = scr + (4 * i + kr) * 65 + n4; d[0] = v[i][0]; d[1] = v[i][1]; d[2] = v[i][2]; d[3] = v[i][3]; }
    asm volatile("s_waitcnt lgkmcnt(0)" ::: "memory");
    const int c = lane & 7;
#pragma unroll
    for (int j = 0; j < 8; ++j) { const int n = (lane >> 3) + 8 * j; const LAS float* s = scr + (8 * c) * 65 + n;
        u32x4 o; o.x = cvt_pk_bf16(s[0 * 65], s[1 * 65]); o.y = cvt_pk_bf16(s[2 * 65], s[3 * 65]); o.z = cvt_pk_bf16(s[4 * 65], s[5 * 65]); o.w = cvt_pk_bf16(s[6 * 65], s[7 * 65]);
        *(u32x4*)(WT + (size_t)(n0 + n) * K + k0 + 8 * c) = o; }
    asm volatile("s_waitcnt lgkmcnt(0)" ::: "memory");
}
struct ColWin { const float* W; __device__ __forceinline__ const float* operator()(int n) const {
    int c; if (n < 4096) c = n; else if (n < 7168) c = n + 8; else if (n < 11264) c = n + 24; else if (n < 11272) c = 4096 + (n - 11264); else if (n < 11288) c = 7176 + (n - 11272); else return nullptr;
    return W + c; } };
struct ColPlain { const float* W; __device__ __forceinline__ const float* operator()(int n) const { return W + n; } };
struct ColUG { const float* Wu; const float* Wg; __device__ __forceinline__ const float* operator()(int n) const { const int pn = n >> 8, w = n & 255; return w < 128 ? Wu + pn * 128 + w : Wg + pn * 128 + (w - 128); } };

__device__ __forceinline__ void p0_prologue(const Args& a, LAS unsigned char* lds, int gwg, int nwgs, int mode) {
    int tid_ = threadIdx.x; asm volatile("" : "+v"(tid_));
    const int tid = tid_, lane = tid & 63, wave = __builtin_amdgcn_readfirstlane(tid >> 6);
    LAS float* scr = (LAS float*)(lds + wave * 16640);
    const int gw = gwg * NWAVES + wave, NGW = nwgs * NWAVES;
    unsigned char* ws = a.ws;
    constexpr int I_WIN_ = 32 * (NPROJ_PAD / 64), I_A = 16 * 32, I_O = 32 * 32, I_UG = 32 * (2 * DFF / 64), I_D = (DFF / 64) * 32;
    constexpr int NITEMS = I_WIN_ + 2 * I_A + I_O + I_UG + I_D;
    const int it0 = mode == 0 ? 0 : I_WIN_, it1 = mode == 0 ? I_WIN_ : NITEMS;
    for (int it = it0 + gw; it < it1; it += NGW) {
        int r = it;
        if (r < I_WIN_) { ColWin cp{a.in[I_WIN]}; const int nblk = NPROJ_PAD / 64; transpose_item(cp, DM, NIN, (bf16*)(ws + WS_WIN), scr, r / nblk, r % nblk, lane); continue; } r -= I_WIN_;
        if (r < I_A) { ColPlain cp{a.in[I_WA]}; transpose_item(cp, 1024, DM, (bf16*)(ws + WS_WA), scr, r / 32, r % 32, lane); continue; } r -= I_A;
        if (r < I_A) { ColPlain cp{a.in[I_WB]}; transpose_item(cp, 1024, DM, (bf16*)(ws + WS_WB), scr, r / 32, r % 32, lane); continue; } r -= I_A;
        if (r < I_O) { ColPlain cp{a.in[I_WO]}; transpose_item(cp, DM, DM, (bf16*)(ws + WS_WO), scr, r / 32, r % 32, lane); continue; } r -= I_O;
        if (r < I_UG) { ColUG cp{a.in[I_WUP], a.in[I_WGATE]}; const int nblk = 2 * DFF / 64; transpose_item(cp, DM, DFF, (bf16*)(ws + WS_WUG), scr, r / nblk, r % nblk, lane); continue; } r -= I_UG;
        { ColPlain cp{a.in[I_WDOWN]}; transpose_item(cp, DFF, DM, (bf16*)(ws + WS_WD), scr, r / 32, r % 32, lane); }
    }
    const float* nw = a.in[I_NMIX]; bf16* XN = (bf16*)(ws + WS_XN);
    if (mode == 0)
    for (int m = gw; m < MT; m += NGW) {
        const float* xrow = m < MP ? a.in[I_XP] + (size_t)m * DM : a.in[I_XS] + (size_t)(m - MP) * DM;
        f32x4 v[8]; float s = 0.f;
#pragma unroll
        for (int j = 0; j < 8; ++j) { v[j] = *(const f32x4*)(xrow + 4 * lane + 256 * j); s += dot4(v[j], v[j]); }
        const float r = rsqrtf(wave_sum(s) * (1.f / DM) + EPS);
#pragma unroll
        for (int j = 0; j < 8; ++j) { const f32x4 w = *(const f32x4*)(nw + 4 * lane + 256 * j); u32x2 o; o.x = cvt_pk_bf16(v[j][0] * r * w[0], v[j][1] * r * w[1]); o.y = cvt_pk_bf16(v[j][2] * r * w[2], v[j][3] * r * w[3]);
            *(u32x2*)(XN + (size_t)m * DM + 4 * lane + 256 * j) = o; }
    }
}

__device__ __forceinline__ void stage_v(LAS bf16* Vs, const bf16* P, int row0, int colbase, int tid) {
#pragma unroll
    for (int i = 0; i < 8; ++i) { const int idx = tid + NTHR * i, s = idx >> 5, p = idx & 31;
        *(LAS u32x4*)(Vs + s * 272 + p * 8) = *(const u32x4*)(P + (size_t)(row0 + s) * NPROJ + colbase + 8 * p); }
}
typedef short v4i16_t __attribute__((ext_vector_type(4)));
__device__ __forceinline__ u32x2 tr64(const LAS bf16* p) { return __builtin_bit_cast(u32x2, __builtin_amdgcn_ds_read_tr16_b64_v4i16((LAS v4i16_t*)p)); }
__device__ __forceinline__ bf16x8 tr_frag(const LAS bf16* img, int RS, int c0, int ks, int lane) {
    const int g = lane >> 4, q = (lane & 15) >> 2, p = lane & 3;
    const LAS bf16* a = img + (32 * ks + 4 * g + q) * RS + c0 + 4 * p;
    const u32x2 lo = tr64(a), hi = tr64(a + 16 * RS);
    u32x4 w; w.x = lo.x; w.y = lo.y; w.z = hi.x; w.w = hi.y;
    return __builtin_bit_cast(bf16x8, w);
}
__device__ __forceinline__ float wave_iscan_add(float v, int lane) {
#pragma unroll
    for (int o = 1; o < 64; o <<= 1) { const float t = __shfl_up(v, o); if (lane >= o) v += t; }
    return v;
}
__device__ __forceinline__ float wave_iscan_max(float v, int lane) {
#pragma unroll
    for (int o = 1; o < 64; o <<= 1) { const float t = __shfl_up(v, o); if (lane >= o) v = fmaxf(v, t); }
    return v;
}

__device__ __forceinline__ void gla_logdecay(const Args& a, const float* gates, int row0, int h, LAS float* galS, LAS float* segS, int tid, float (&la)[32], float& off, float& tot) {
    const int d = tid & 127, seg = tid >> 7;
    { const int t = tid >> 2, q = tid & 3; *(LAS f32x4*)(galS + t * 16 + q * 4) = *(const f32x4*)(gates + (size_t)(row0 + t) * 32 + 8 + q * 4); }
    float up[16];
#pragma unroll
    for (int j = 0; j < 16; ++j) up[j] = a.in[I_AUP][j * 512 + h * 128 + d];
    const float ab = a.in[I_AB][h * 128 + d];
    __syncthreads();
    float ssum = 0.f;
#pragma unroll
    for (int i = 0; i < 32; ++i) { const int t = seg * 32 + i; float z = ab;
#pragma unroll
        for (int q = 0; q < 4; ++q) { const f32x4 g = *(const LAS f32x4*)(galS + t * 16 + q * 4); z += g[0] * up[4 * q] + g[1] * up[4 * q + 1] + g[2] * up[4 * q + 2] + g[3] * up[4 * q + 3]; }
        la[i] = logsig(z) * (1.f / 16.f); ssum += la[i]; }
    segS[seg * 128 + d] = ssum;
    __syncthreads();
    off = 0.f; tot = 0.f;
#pragma unroll
    for (int s = 0; s < 4; ++s) { const float v = segS[s * 128 + d]; tot += v; off += (s < seg) ? v : 0.f; }
}

template <bool ML>
__device__ __forceinline__ void chunk_state(const Args& a, LAS unsigned char* lds, int bh, int c) {
    constexpr int DK = ML ? 256 : 128, NDT = DK / 16, RSK = DK + 16;
    int tid_ = threadIdx.x; asm volatile("" : "+v"(tid_));
    const int tid = tid_, lane = tid & 63, wave = __builtin_amdgcn_readfirstlane(tid >> 6), fr = lane & 15, fq = lane >> 4;
    const int b = bh >> 2, h = bh & 3, row0 = b * TP + c * 128, item = bh * NCH + c;
    unsigned char* ws = a.ws;
    const bf16* P = (const bf16*)(ws + WS_PROJ); const float* gates = (const float*)(ws + WS_GATES);
    LAS bf16* Ks = (LAS bf16*)lds; LAS bf16* Vs = (LAS bf16*)(lds + 69632); LAS float* sc = (LAS float*)(lds + 139264);
    __syncthreads();
    stage_v(Vs, P, row0, (ML ? C_MV : C_GV) + h * 256, tid);
    if (ML) {
        if (wave == 0) {
            const int t0 = 2 * lane;
            const float lf0 = logsig(gates[(size_t)(row0 + t0) * 32 + 4 + h] + a.in[I_BF][h]), lf1 = logsig(gates[(size_t)(row0 + t0 + 1) * 32 + 4 + h] + a.in[I_BF][h]);
            const float i0 = gates[(size_t)(row0 + t0) * 32 + h] + a.in[I_BI][h], i1 = gates[(size_t)(row0 + t0 + 1) * 32 + h] + a.in[I_BI][h];
            const float pr = lf0 + lf1, S = wave_iscan_add(pr, lane), ex = S - pr;
            const float ah0 = i0 - (ex + lf0), ah1 = i1 - S;
            const float Ah = wave_max(fmaxf(ah0, ah1));
            sc[t0] = __expf(ah0 - Ah) * (1.f / 16.f); sc[t0 + 1] = __expf(ah1 - Ah) * (1.f / 16.f);
            if (lane == 63) { float* chs = (float*)(ws + WS_CHS); chs[item * 2] = Ah; chs[item * 2 + 1] = S; }
        }
        __syncthreads();
#pragma unroll
        for (int i = 0; i < 8; ++i) { const int idx = tid + NTHR * i, s = idx >> 5, dp = idx & 31; const float w = sc[s];
            const u32x4 v = *(const u32x4*)(P + (size_t)(row0 + s) * NPROJ + C_MK + h * 256 + 8 * dp);
            u32x4 o; o.x = cvt_pk_bf16(bflo(v.x) * w, bfhi(v.x) * w); o.y = cvt_pk_bf16(bflo(v.y) * w, bfhi(v.y) * w); o.z = cvt_pk_bf16(bflo(v.z) * w, bfhi(v.z) * w); o.w = cvt_pk_bf16(bflo(v.w) * w, bfhi(v.w) * w);
            *(LAS u32x4*)(Ks + s * RSK + 8 * dp) = o; }
    } else {
        float la[32], off, tot;
        LAS float* galS = (LAS float*)(lds + 36864); gla_logdecay(a, gates, row0, h, galS, galS + 2048, tid, la, off, tot);
        const int d = tid & 127, seg = tid >> 7;
        if (seg == 0) ((float*)(ws + WS_BEND))[item * 128 + d] = tot;
        float bcur = off;
#pragma unroll
        for (int i = 0; i < 32; ++i) { const int t = seg * 32 + i; bcur += la[i];
            const float kv = bf2f(P[(size_t)(row0 + t) * NPROJ + C_GK + h * 128 + d]);
            Ks[t * RSK + d] = f2bf(kv * __expf(tot - bcur)); }
    }
    __syncthreads();
    f32x4 acc[2][NDT];
#pragma unroll
    for (int e = 0; e < 2; ++e)
#pragma unroll
        for (int d = 0; d < NDT; ++d) acc[e][d] = (f32x4){0.f, 0.f, 0.f, 0.f};
#pragma unroll
    for (int ks = 0; ks < 4; ++ks) {
        bf16x8 vb[2];
#pragma unroll
        for (int e = 0; e < 2; ++e) vb[e] = tr_frag(Vs, 272, wave * 32 + e * 16, ks, lane);
#pragma unroll
        for (int d = 0; d < NDT; ++d) { const bf16x8 ka = tr_frag(Ks, RSK, d * 16, ks, lane);
#pragma unroll
            for (int e = 0; e < 2; ++e) acc[e][d] = __builtin_amdgcn_mfma_f32_16x16x32_bf16(ka, vb[e], acc[e][d], 0, 0, 0); }
    }
    float* dst = (float*)(ws + (ML ? WS_DC : WS_DS)) + (size_t)item * 256 * DK;
#pragma unroll
    for (int e = 0; e < 2; ++e)
#pragma unroll
        for (int d = 0; d < NDT; ++d) *(f32x4*)(dst + (size_t)(wave * 32 + e * 16 + fr) * DK + d * 16 + 4 * fq) = acc[e][d];
    if (ML && tid < 256) { float s = 0.f;
#pragma unroll 16
        for (int i = 0; i < 128; ++i) s += bf2f(Ks[i * RSK + tid]);
        ((float*)(ws + WS_DN))[item * 256 + tid] = s; }
}

__device__ __forceinline__ void scan_mlstm(const Args& a, int j) {
    int tid_ = threadIdx.x; asm volatile("" : "+v"(tid_));
    const int tid = tid_, bh = j >> 5, eb = j & 31;
    unsigned char* ws = a.ws;
    const float* chs = (const float*)(ws + WS_CHS);
    const int e = eb * 8 + (tid >> 6), d4 = (tid & 63) * 4;
    const float* dC = (const float*)(ws + WS_DC) + (size_t)bh * NCH * 65536 + (size_t)e * 256 + d4;
    bf16* CT = (bf16*)(ws + WS_CT) + (size_t)bh * NCH * 65536 + (size_t)e * 256 + d4;
    f32x4 Cv = {0.f, 0.f, 0.f, 0.f}; float Fs = 0.f, Mp = 0.f;
    const bool do_n = (eb == 0 && tid < 256);
    float nv = 0.f;
    f32x4 dv[NCH];
#pragma unroll
    for (int c = 0; c < NCH; ++c) dv[c] = *(const f32x4*)(dC + (size_t)c * 65536);
#pragma unroll
    for (int c = 0; c < NCH; ++c) {
        u32x2 o; o.x = cvt_pk_bf16(Cv[0], Cv[1]); o.y = cvt_pk_bf16(Cv[2], Cv[3]); *(u32x2*)(CT + (size_t)c * 65536) = o;
        if (do_n) ((bf16*)(ws + WS_NPREV))[(bh * NCH + c) * 256 + tid] = f2bf(nv);
        const float Ah = chs[(bh * NCH + c) * 2], bt = chs[(bh * NCH + c) * 2 + 1];
        const float Ac = Ah - Fs, Mn = fmaxf(Mp, Ac), f1 = __expf(Mp - Mn), f2 = __expf(Ac - Mn);
        Cv = Cv * f1 + dv[c] * f2;
        if (do_n) nv = nv * f1 + ((const float*)(ws + WS_DN))[(bh * NCH + c) * 256 + tid] * f2;
        Mp = Mn; Fs += bt;
    }
    float* oC = a.out + O_PC + (size_t)bh * 65536;
#pragma unroll
    for (int i = 0; i < 4; ++i) oC[(size_t)(d4 + i) * 256 + e] = Cv[i];
    if (do_n) a.out[O_PN + bh * 256 + tid] = nv;
    if (eb == 0 && tid == 0) a.out[O_PM + bh] = Fs + Mp;
}
__device__ __forceinline__ void scan_gla(const Args& a, int j) {
    int tid_ = threadIdx.x; asm volatile("" : "+v"(tid_));
    const int tid = tid_, bh = j >> 4, eb = j & 15;
    unsigned char* ws = a.ws;
    const float* bend = (const float*)(ws + WS_BEND);
    const int ee = eb * 16 + (tid >> 5), d4 = (tid & 31) * 4;
    const float* dS = (const float*)(ws + WS_DS) + (size_t)bh * NCH * 32768 + (size_t)ee * 128 + d4;
    bf16* ST = (bf16*)(ws + WS_ST) + (size_t)bh * NCH * 32768 + (size_t)ee * 128 + d4;
    f32x4 Sv = {0.f, 0.f, 0.f, 0.f};
    f32x4 dv[NCH];
#pragma unroll
    for (int c = 0; c < NCH; ++c) dv[c] = *(const f32x4*)(dS + (size_t)c * 32768);
#pragma unroll
    for (int c = 0; c < NCH; ++c) {
        u32x2 o; o.x = cvt_pk_bf16(Sv[0], Sv[1]); o.y = cvt_pk_bf16(Sv[2], Sv[3]); *(u32x2*)(ST + (size_t)c * 32768) = o;
        const f32x4 be = *(const f32x4*)(bend + (bh * NCH + c) * 128 + d4);
        Sv[0] = Sv[0] * __expf(be[0]) + dv[c][0]; Sv[1] = Sv[1] * __expf(be[1]) + dv[c][1]; Sv[2] = Sv[2] * __expf(be[2]) + dv[c][2]; Sv[3] = Sv[3] * __expf(be[3]) + dv[c][3];
    }
    float* oS = a.out + O_PS + (size_t)bh * 32768;
#pragma unroll
    for (int i = 0; i < 4; ++i) oS[(size_t)(d4 + i) * 256 + ee] = Sv[i];
}

template <bool ML>
__device__ __forceinline__ void chunk_out(const Args& a, LAS unsigned char* lds, int bh, int c) {
    constexpr int DK = ML ? 256 : 128, QS = DK + 8, NKK = DK / 32;
    int tid_ = threadIdx.x; asm volatile("" : "+v"(tid_));
    const int tid = tid_, lane = tid & 63, wave = __builtin_amdgcn_readfirstlane(tid >> 6), fr = lane & 15, fq = lane >> 4;
    const int b = bh >> 2, h = bh & 3, row0 = b * TP + c * 128, item = bh * NCH + c;
    unsigned char* ws = a.ws;
    const bf16* P = (const bf16*)(ws + WS_PROJ); const float* gates = (const float*)(ws + WS_GATES);
    LAS bf16* Qs = (LAS bf16*)lds; LAS bf16* Ks = Qs + 128 * QS;
    LAS float* sc = (LAS float*)(lds + 143616);
    __syncthreads();
    if (ML) {
        if (wave == 0) {
            const float* chs = (const float*)(ws + WS_CHS);
            const float Ahc = lane < NCH ? chs[(bh * NCH + lane) * 2] : 0.f, btc = lane < NCH ? chs[(bh * NCH + lane) * 2 + 1] : 0.f;
            const float fsx = wave_iscan_add(btc, lane) - btc;
            const float Mp = fmaxf(0.f, wave_max(lane < c ? Ahc - fsx : -3.0e38f)), Fs = wave_sum(lane < c ? btc : 0.f);
            const int t0 = 2 * lane;
            const float lf0 = logsig(gates[(size_t)(row0 + t0) * 32 + 4 + h] + a.in[I_BF][h]), lf1 = logsig(gates[(size_t)(row0 + t0 + 1) * 32 + 4 + h] + a.in[I_BF][h]);
            const float i0 = gates[(size_t)(row0 + t0) * 32 + h] + a.in[I_BI][h], i1 = gates[(size_t)(row0 + t0 + 1) * 32 + h] + a.in[I_BI][h];
            const float pr = lf0 + lf1, S = wave_iscan_add(pr, lane), b0 = S - lf1, b1 = S;
            const float a0 = i0 - b0 - Fs, a1 = i1 - b1 - Fs;
            const float cm = wave_iscan_max(fmaxf(a0, a1), lane); float exm = __shfl_up(cm, 1); if (lane == 0) exm = -3.0e38f;
            const float M0 = fmaxf(fmaxf(Mp, exm), a0), M1 = fmaxf(M0, a1);
            sc[t0] = a0; sc[t0 + 1] = a1; sc[128 + t0] = M0; sc[128 + t0 + 1] = M1; sc[256 + t0] = __expf(Mp - M0); sc[256 + t0 + 1] = __expf(Mp - M1);
            sc[384 + t0] = __expf(-(Fs + b0 + M0)); sc[384 + t0 + 1] = __expf(-(Fs + b1 + M1));
        }
#pragma unroll
        for (int i = 0; i < 8; ++i) { const int idx = tid + NTHR * i, t = idx >> 5, p = idx & 31;
            *(LAS u32x4*)(Qs + t * QS + p * 8) = *(const u32x4*)(P + (size_t)(row0 + t) * NPROJ + C_MQ + h * 256 + p * 8);
            *(LAS u32x4*)(Ks + t * QS + p * 8) = *(const u32x4*)(P + (size_t)(row0 + t) * NPROJ + C_MK + h * 256 + p * 8); }
    } else {
        float la[32], off, tot;
        LAS float* galS = (LAS float*)(lds + 69632); LAS float* segS = galS + 128 * 16;
        gla_logdecay(a, gates, row0, h, galS, segS, tid, la, off, tot);
        const int d = tid & 127, seg = tid >> 7;
        float bcur = off;
#pragma unroll
        for (int i = 0; i < 32; ++i) { const int t = seg * 32 + i; bcur += la[i];
            const float qv = bf2f(P[(size_t)(row0 + t) * NPROJ + C_GQ + h * 128 + d]), kv = bf2f(P[(size_t)(row0 + t) * NPROJ + C_GK + h * 128 + d]);
            Qs[t * QS + d] = f2bf(qv * 0.08838834764831845f * __expf(bcur)); Ks[t * QS + d] = f2bf(kv * __expf(-bcur)); }
    }
    __syncthreads();
    constexpr int NCP = ML ? 16 : 8;
    u32x4 cpre[NCP]; u32x4 npre = {0u, 0u, 0u, 0u};
    if (ML) { const bf16* CT = (const bf16*)(ws + WS_CT) + (size_t)item * 65536;
#pragma unroll
        for (int i = 0; i < NCP; ++i) { const int idx = tid + NTHR * i, e = idx >> 5, p = idx & 31; cpre[i] = *(const u32x4*)(CT + (size_t)e * 256 + p * 8); }
        if (tid < 32) npre = *(const u32x4*)((const bf16*)(ws + WS_NPREV) + (size_t)item * 256 + tid * 8);
    } else { const bf16* ST = (const bf16*)(ws + WS_ST) + (size_t)item * 32768;
#pragma unroll
        for (int i = 0; i < NCP; ++i) { const int idx = tid + NTHR * i, e = idx >> 4, p = idx & 15; cpre[i] = *(const u32x4*)(ST + (size_t)e * 128 + p * 8); }
    }
    bf16x8 qf[NKK];
#pragma unroll
    for (int kk = 0; kk < NKK; ++kk) qf[kk] = *(const LAS bf16x8*)(Qs + (wave * 16 + fr) * QS + kk * 32 + fq * 8);
    const int t = wave * 16 + fr;
    u32x2 pb[8]; float den = 0.f;
    {
        const float Mt = ML ? sc[128 + t] : 0.f;
#pragma unroll
        for (int st = 0; st < 8; ++st) { f32x4 s = {0.f, 0.f, 0.f, 0.f};
#pragma unroll
            for (int kk = 0; kk < NKK; ++kk) { const bf16x8 kf = *(const LAS bf16x8*)(Ks + (st * 16 + fr) * QS + kk * 32 + fq * 8); s = __builtin_amdgcn_mfma_f32_16x16x32_bf16(kf, qf[kk], s, 0, 0, 0); }
            float p[4];
            f32x4 as4 = {0.f, 0.f, 0.f, 0.f}; if (ML) as4 = *(const LAS f32x4*)(sc + st * 16 + 4 * fq);
#pragma unroll
            for (int r = 0; r < 4; ++r) { const int si = st * 16 + 4 * fq + r;
                const float e = ML ? s[r] * (1.f / 16.f) * __expf(fminf(as4[r] - Mt, 0.f)) : s[r];
                p[r] = (si <= t) ? e : 0.f;
                den += p[r]; }
            pb[st].x = cvt_pk_bf16(p[0], p[1]); pb[st].y = cvt_pk_bf16(p[2], p[3]);
            __builtin_amdgcn_sched_barrier(0); }
    }
    __syncthreads();
    LAS bf16* Cl = (LAS bf16*)lds;
    if (ML) {
#pragma unroll
        for (int i = 0; i < NCP; ++i) { const int idx = tid + NTHR * i, e = idx >> 5, p = idx & 31; *(LAS u32x4*)(Cl + e * QS + p * 8) = cpre[i]; }
        { const int e = tid >> 5, p = tid & 31; *(LAS u32x4*)(Cl + (256 + e) * QS + p * 8) = npre; }
    } else {
#pragma unroll
        for (int i = 0; i < NCP; ++i) { const int idx = tid + NTHR * i, e = idx >> 4, p = idx & 15; *(LAS u32x4*)(Cl + e * QS + p * 8) = cpre[i]; }
    }
    u32x4 vpre[8];
#pragma unroll
    for (int i = 0; i < 8; ++i) { const int idx = tid + NTHR * i, sr = idx >> 5, p = idx & 31; vpre[i] = *(const u32x4*)(P + (size_t)(row0 + sr) * NPROJ + (ML ? C_MV : C_GV) + h * 256 + 8 * p); }
    __syncthreads();
    f32x4 acc[16];
#pragma unroll
    for (int et = 0; et < 16; ++et) { acc[et] = (f32x4){0.f, 0.f, 0.f, 0.f};
#pragma unroll
        for (int kk = 0; kk < NKK; ++kk) { const bf16x8 cf = *(const LAS bf16x8*)(Cl + (et * 16 + fr) * QS + kk * 32 + fq * 8); acc[et] = __builtin_amdgcn_mfma_f32_16x16x32_bf16(cf, qf[kk], acc[et], 0, 0, 0); }
        if ((et & 1) == 1) __builtin_amdgcn_sched_barrier(0); }
    float wint = 1.f, qn = 0.f;
    if (ML) {
        f32x4 dn = {0.f, 0.f, 0.f, 0.f};
#pragma unroll
        for (int kk = 0; kk < NKK; ++kk) { const bf16x8 nf = *(const LAS bf16x8*)(Cl + (256 + fr) * QS + kk * 32 + fq * 8); dn = __builtin_amdgcn_mfma_f32_16x16x32_bf16(nf, qf[kk], dn, 0, 0, 0); }
        qn = __shfl(dn[0], fr);
        wint = sc[256 + t];
#pragma unroll
        for (int et = 0; et < 16; ++et) acc[et] = acc[et] * wint;
    }
    __syncthreads();
    LAS bf16* Vs = (LAS bf16*)lds;
#pragma unroll
    for (int i = 0; i < 8; ++i) { const int idx = tid + NTHR * i, sr = idx >> 5, p = idx & 31; *(LAS u32x4*)(Vs + sr * 272 + p * 8) = vpre[i]; }
    __syncthreads();
#pragma unroll
    for (int ks = 0; ks < 4; ++ks) {
        u32x4 pw; pw.x = pb[2 * ks].x; pw.y = pb[2 * ks].y; pw.z = pb[2 * ks + 1].x; pw.w = pb[2 * ks + 1].y;
        const bf16x8 pf = __builtin_bit_cast(bf16x8, pw);
#pragma unroll
        for (int et = 0; et < 16; ++et) { acc[et] = __builtin_amdgcn_mfma_f32_16x16x32_bf16(tr_frag(Vs, 272, et * 16, ks, lane), pf, acc[et], 0, 0, 0); if ((et & 3) == 3) __builtin_amdgcn_sched_barrier(0); }
    }
    float inv = 1.f;
    if (ML) { den += __shfl_xor(den, 16); den += __shfl_xor(den, 32); den += wint * qn; inv = 1.f / fmaxf(fabsf(den), sc[384 + t]); }
    float ss = 0.f;
#pragma unroll
    for (int et = 0; et < 16; ++et) { acc[et] = acc[et] * inv; ss += dot4(acc[et], acc[et]); }
    ss += __shfl_xor(ss, 16); ss += __shfl_xor(ss, 32);
    const float rn = rsqrtf(ss * (1.f / 256.f) + EPS);
    const float* hw = a.in[ML ? I_MHW : I_GHW] + h * 256;
    const bf16* gp = P + (size_t)(row0 + t) * NPROJ + (ML ? C_MO : C_GR) + h * 256;
    bf16* yp = (bf16*)(ws + (ML ? WS_YM : WS_YG)) + (size_t)(row0 + t) * 1024 + h * 256;
#pragma unroll
    for (int et = 0; et < 16; ++et) { const int e = et * 16 + 4 * fq;
        const u32x2 gw = *(const u32x2*)(gp + e); const f32x4 w = *(const f32x4*)(hw + e);
        const float g0 = bflo(gw.x), g1 = bfhi(gw.x), g2 = bflo(gw.y), g3 = bfhi(gw.y);
        float o0 = acc[et][0] * rn * w[0], o1 = acc[et][1] * rn * w[1], o2 = acc[et][2] * rn * w[2], o3 = acc[et][3] * rn * w[3];
        if (ML) { o0 *= sigm(g0); o1 *= sigm(g1); o2 *= sigm(g2); o3 *= sigm(g3); } else { o0 *= g0 * sigm(g0); o1 *= g1 * sigm(g1); o2 *= g2 * sigm(g2); o3 *= g3 * sigm(g3); }
        u32x2 o; o.x = cvt_pk_bf16(o0, o1); o.y = cvt_pk_bf16(o2, o3); *(u32x2*)(yp + e) = o;
        if ((et & 3) == 3) __builtin_amdgcn_sched_barrier(0); }
}

template <bool ML>
__device__ __forceinline__ void sample_item(const Args& a, LAS unsigned char* lds, int b, int h) {
    constexpr int DK = ML ? 256 : 128;
    int tid_ = threadIdx.x; asm volatile("" : "+v"(tid_));
    const int tid = tid_, lane = tid & 63, wave = __builtin_amdgcn_readfirstlane(tid >> 6);
    unsigned char* ws = a.ws;
    const bf16* P = (const bf16*)(ws + WS_PROJ); const float* gates = (const float*)(ws + WS_GATES);
    const int row0 = MP + b * 8, bh = b * 4 + h;
    LAS float* qT = (LAS float*)lds;
    LAS float* wkT = qT + 2048;
    LAS float* kT = wkT + 2048;
    LAS float* vS = kT + 2048;
    LAS float* red = vS + 2048;
    LAS float* sm = red + 16384;
    const float* C0 = a.in[ML ? I_C : I_S] + (size_t)bh * DK * 256;
    float* C1 = a.out + (ML ? O_SC : O_SS) + (size_t)bh * DK * 256;
    f32x4 nx[8];
#pragma unroll
    for (int j = 0; j < 8; ++j) nx[j] = __builtin_nontemporal_load((const f32x4*)(C0 + (size_t)(wave + 8 * j) * 256 + 4 * lane));
    __syncthreads();
    float aS[8], Mt[8], bS[8]; float m0 = 0.f, dec = 1.f;
    if (ML) {
        m0 = a.in[I_M][bh]; float bs = 0.f, M = m0;
#pragma unroll
        for (int t = 0; t < 8; ++t) { const float mi = gates[(size_t)(row0 + t) * 32 + h], mf = gates[(size_t)(row0 + t) * 32 + 4 + h];
            bs += logsig(mf + a.in[I_BF][h]); bS[t] = bs; aS[t] = mi + a.in[I_BI][h] - bs; M = fmaxf(M, aS[t]); Mt[t] = M; }
        dec = __expf(m0 - Mt[7]);
        if (tid == 0) {
#pragma unroll
            for (int t = 0; t < 8; ++t) { sm[200 + t] = aS[t]; sm[208 + t] = Mt[t]; sm[216 + t] = bS[t]; } }
        if (tid < 256) { const int d = tid;
#pragma unroll
            for (int t = 0; t < 8; ++t) { const float qv = bf2f(P[(size_t)(row0 + t) * NPROJ + C_MQ + h * 256 + d]), kv = bf2f(P[(size_t)(row0 + t) * NPROJ + C_MK + h * 256 + d]) * (1.f / 16.f);
                qT[d * 8 + t] = qv; kT[d * 8 + t] = kv; wkT[d * 8 + t] = kv * __expf(aS[t] - Mt[7]); } }
    } else {
        if (tid < 128) { const int d = tid; float up[16];
#pragma unroll
            for (int j = 0; j < 16; ++j) up[j] = a.in[I_AUP][j * 512 + h * 128 + d];
            const float ab = a.in[I_AB][h * 128 + d];
            float bc[8]; float bs = 0.f;
#pragma unroll
            for (int t = 0; t < 8; ++t) { float z = ab;
#pragma unroll
                for (int j = 0; j < 16; ++j) z += gates[(size_t)(row0 + t) * 32 + 8 + j] * up[j];
                bs += logsig(z) * (1.f / 16.f); bc[t] = bs; }
            sm[72 + d] = __expf(bs);
#pragma unroll
            for (int t = 0; t < 8; ++t) { const float qv = bf2f(P[(size_t)(row0 + t) * NPROJ + C_GQ + h * 128 + d]), kv = bf2f(P[(size_t)(row0 + t) * NPROJ + C_GK + h * 128 + d]);
                qT[d * 8 + t] = qv * 0.08838834764831845f * __expf(bc[t]); kT[d * 8 + t] = kv * __expf(-bc[t]); wkT[d * 8 + t] = kv * __expf(bs - bc[t]); } }
    }
    { const int t = tid >> 6; const u32x2 w = *(const u32x2*)(P + (size_t)(row0 + t) * NPROJ + (ML ? C_MV : C_GV) + h * 256 + 4 * lane);
      *(LAS f32x4*)(vS + t * 256 + 4 * lane) = (f32x4){bflo(w.x), bfhi(w.x), bflo(w.y), bfhi(w.y)}; }
    __syncthreads();
    float prow, qn = 0.f;
    { const int s8 = lane & 7, part = lane >> 3; float sd = 0.f;
#pragma unroll 8
      for (int i = 0; i < DK / 8; ++i) { const int d = 8 * i + part; sd += qT[d * 8 + wave] * kT[d * 8 + s8]; }
      sd += __shfl_xor(sd, 8); sd += __shfl_xor(sd, 16); sd += __shfl_xor(sd, 32);
      if (ML) prow = (s8 <= wave) ? sd * __expf(sm[200 + s8] - sm[208 + wave]) : 0.f; else prow = (s8 <= wave) ? sd : 0.f; }
    if (ML) { const float* n0 = a.in[I_N] + (size_t)bh * 256; float sd = 0.f;
#pragma unroll
      for (int i = 0; i < 4; ++i) { const int d = lane + 64 * i; sd += qT[d * 8 + wave] * n0[d]; }
      qn = wave_sum(sd); }
    f32x4 v[8], acc[8];
#pragma unroll
    for (int s = 0; s < 8; ++s) { v[s] = *(const LAS f32x4*)(vS + s * 256 + 4 * lane); acc[s] = (f32x4){0.f, 0.f, 0.f, 0.f}; }
#pragma unroll
    for (int bt = 0; bt < DK / 64; ++bt) {
        f32x4 cur[8];
#pragma unroll
        for (int j = 0; j < 8; ++j) cur[j] = nx[j];
        if (bt + 1 < DK / 64) {
#pragma unroll
            for (int j = 0; j < 8; ++j) nx[j] = __builtin_nontemporal_load((const f32x4*)(C0 + (size_t)(wave + 8 * (8 * (bt + 1) + j)) * 256 + 4 * lane)); }
#pragma unroll
        for (int j = 0; j < 8; ++j) { const int d = wave + 8 * (8 * bt + j); const f32x4 cv = cur[j];
            const f32x4 q0 = *(const LAS f32x4*)(qT + d * 8), q1 = *(const LAS f32x4*)(qT + d * 8 + 4), k0 = *(const LAS f32x4*)(wkT + d * 8), k1 = *(const LAS f32x4*)(wkT + d * 8 + 4);
            const float dd = ML ? dec : sm[72 + d];
            acc[0] += cv * q0[0]; acc[1] += cv * q0[1]; acc[2] += cv * q0[2]; acc[3] += cv * q0[3]; acc[4] += cv * q1[0]; acc[5] += cv * q1[1]; acc[6] += cv * q1[2]; acc[7] += cv * q1[3];
            f32x4 cn = cv * dd;
            cn += v[0] * k0[0]; cn += v[1] * k0[1]; cn += v[2] * k0[2]; cn += v[3] * k0[3]; cn += v[4] * k1[0]; cn += v[5] * k1[1]; cn += v[6] * k1[2]; cn += v[7] * k1[3];
            __builtin_nontemporal_store(cn, (f32x4*)(C1 + (size_t)d * 256 + 4 * lane)); }
    }
#pragma unroll
    for (int s = 0; s < 8; ++s) *(LAS f32x4*)(red + (wave * 8 + s) * 256 + 4 * lane) = acc[s];
    __syncthreads();
    const int t = wave;
    f32x4 qc = {0.f, 0.f, 0.f, 0.f};
#pragma unroll
    for (int w = 0; w < 8; ++w) qc += *(const LAS f32x4*)(red + (w * 8 + t) * 256 + 4 * lane);
    float wint = 1.f, den = 0.f, Mtt = 0.f, btt = 0.f;
    if (ML) { Mtt = sm[208 + t]; btt = sm[216 + t]; wint = __expf(m0 - Mtt); }
    f32x4 num = qc * wint;
#pragma unroll
    for (int s = 0; s < 8; ++s) { const float p = __shfl(prow, s); num += v[s] * p; den += p; }
    if (ML) { den += wint * qn; const float fl = fmaxf(fabsf(den), __expf(-(btt + Mtt))); num = num * (1.f / fl); }
    const float rn = rsqrtf(wave_sum(dot4(num, num)) * (1.f / 256.f) + EPS);
    const f32x4 w = *(const f32x4*)(a.in[ML ? I_MHW : I_GHW] + h * 256 + 4 * lane);
    const u32x2 gw = *(const u32x2*)(P + (size_t)(row0 + t) * NPROJ + (ML ? C_MO : C_GR) + h * 256 + 4 * lane);
    const float g0 = bflo(gw.x), g1 = bfhi(gw.x), g2 = bflo(gw.y), g3 = bfhi(gw.y);
    float o0 = num[0] * rn * w[0], o1 = num[1] * rn * w[1], o2 = num[2] * rn * w[2], o3 = num[3] * rn * w[3];
    if (ML) { o0 *= sigm(g0); o1 *= sigm(g1); o2 *= sigm(g2); o3 *= sigm(g3); } else { o0 *= g0 * sigm(g0); o1 *= g1 * sigm(g1); o2 *= g2 * sigm(g2); o3 *= g3 * sigm(g3); }
    u32x2 o; o.x = cvt_pk_bf16(o0, o1); o.y = cvt_pk_bf16(o2, o3);
    *(u32x2*)((bf16*)(ws + (ML ? WS_YM : WS_YG)) + (size_t)(row0 + t) * 1024 + h * 256 + 4 * lane) = o;
    if (ML) {
        if (tid < 256) { float s = dec * a.in[I_N][(size_t)bh * 256 + tid];
#pragma unroll
            for (int q = 0; q < 8; ++q) s += wkT[tid * 8 + q];
            a.out[O_SN + (size_t)bh * 256 + tid] = s; }
        if (tid == 0) a.out[O_SM + bh] = bS[7] + Mt[7];
    }
}

__device__ __forceinline__ void merge_reduce(const Args& a, int vcu, int G) {
    int tid_ = threadIdx.x; asm volatile("" : "+v"(tid_));
    const int tid = tid_, lane = tid & 63, wave = tid >> 6;
    const float* tailp = a.out + O_YP; bf16* O = (bf16*)(a.ws + WS_XN);
    for (int rr = vcu * NWAVES + wave; rr < MS; rr += G * NWAVES) { const int m = MP + rr, pmo = rr >> 8;
#pragma unroll
        for (int j = 0; j < 8; ++j) { const float* tp = tailp + (size_t)(pmo * 8 + j) * 8 * 65536 + (rr & 255) * 256 + 4 * lane;
            f32x4 v = *(const f32x4*)tp;
#pragma unroll
            for (int sl = 1; sl < 8; ++sl) v += *(const f32x4*)(tp + (size_t)sl * 65536);
            u32x2 o; o.x = cvt_pk_bf16(v[0], v[1]); o.y = cvt_pk_bf16(v[2], v[3]); *(u32x2*)(O + (size_t)m * DM + 4 * lane + 256 * j) = o; }
    }
}
__device__ __forceinline__ void rstd_phase(const Args& a, int vcu, int G) {
    int tid_ = threadIdx.x; asm volatile("" : "+v"(tid_));
    const int tid = tid_, lane = tid & 63, wave = tid >> 6;
    const float* part = (const float*)(a.ws + WS_PART); float* rstd = (float*)(a.ws + WS_RSTD);
    const bool split = (G == 256); const int nplain = split ? MP : MT;
    for (int row = vcu * NTHR + tid; row < nplain; row += G * NTHR) { float s = 0.f;
#pragma unroll
        for (int i = 0; i < 8; ++i) s += sum4(*(const f32x4*)(part + (size_t)row * 32 + 4 * i));
        rstd[row] = rsqrtf(s * (1.f / DM) + EPS); }
    if (split) {
        const float* tailp = (const float*)(a.ws + WS_PROJ); const float* nw = a.in[I_NFFN]; float* X1 = (float*)(a.ws + WS_X1); bf16* X1W = (bf16*)(a.ws + WS_X1W);
        for (int rr = vcu * NWAVES + wave; rr < MS; rr += G * NWAVES) { const int m = MP + rr, pmo = rr >> 8;
            f32x4 v[8]; float ss = 0.f;
#pragma unroll
            for (int j = 0; j < 8; ++j) { v[j] = *(const f32x4*)(a.in[I_XS] + (size_t)rr * DM + 4 * lane + 256 * j);
                const float* tp = tailp + (size_t)(pmo * 8 + j) * 8 * 65536 + (rr & 255) * 256 + 4 * lane;
#pragma unroll
                for (int sl = 0; sl < 8; ++sl) v[j] += *(const f32x4*)(tp + (size_t)sl * 65536);
                ss += dot4(v[j], v[j]); }
            ss = wave_sum(ss);
            if (lane == 0) rstd[m] = rsqrtf(ss * (1.f / DM) + EPS);
#pragma unroll
            for (int j = 0; j < 8; ++j) { const f32x4 w = *(const f32x4*)(nw + 4 * lane + 256 * j);
                *(f32x4*)(X1 + (size_t)m * DM + 4 * lane + 256 * j) = v[j];
                u32x2 o; o.x = cvt_pk_bf16(v[j][0] * w[0], v[j][1] * w[1]); o.y = cvt_pk_bf16(v[j][2] * w[2], v[j][3] * w[3]);
                *(u32x2*)(X1W + (size_t)m * DM + 4 * lane + 256 * j) = o; }
        }
    }
}
__device__ __forceinline__ void act_fixup(const Args& a, int vcu, int G) {
    unsigned char* ws = a.ws; const float* ub = (const float*)(ws + WS_U); bf16* ACT = (bf16*)(ws + WS_G);
    const float* cw = a.in[I_CW]; const float* cb = a.in[I_CB];
    int tid_ = threadIdx.x; asm volatile("" : "+v"(tid_));
    for (int idx = vcu * NTHR + tid_; idx < 28 * DFF; idx += G * NTHR) {
        const int k = idx / DFF, col = idx % DFF, pm = (k / 7) * 8 + 1 + (k % 7);
        const float um2 = ub[((size_t)(pm - 1) * 6 + 0) * DFF + col], um1 = ub[((size_t)(pm - 1) * 6 + 1) * DFF + col];
        const float u0 = ub[((size_t)pm * 6 + 2) * DFF + col], u1 = ub[((size_t)pm * 6 + 3) * DFF + col], g0 = ub[((size_t)pm * 6 + 4) * DFF + col], g1 = ub[((size_t)pm * 6 + 5) * DFF + col];
        const float c0 = cw[col], c1 = cw[DFF + col], c2 = cw[2 * DFF + col], bb = cb[col];
        ACT[(size_t)(pm * 256) * DFF + col] = f2bf(gelu_tanh(bb + c0 * um2 + c1 * um1 + c2 * u0) * g0);
        ACT[(size_t)(pm * 256 + 1) * DFF + col] = f2bf(gelu_tanh(bb + c0 * um1 + c1 * u0 + c2 * u1) * g1);
    }
}
__device__ __forceinline__ void final_norm(const Args& a, int vcu, int G) {
    int tid_ = threadIdx.x; asm volatile("" : "+v"(tid_));
    const int tid = tid_, lane = tid & 63, wave = tid >> 6;
    const float* fw = a.in[I_FNW]; const float* X1 = (const float*)(a.ws + WS_X1); const float* tailp = (const float*)(a.ws + WS_U);
    const bool split = (G == 256);
    int tpm = -1, tpn = -1;
    if (split && lane < 32) { pg8::StaticOrder S; S.init(MT, DM, G, 0); pg8::Unit u; if (S.at(256 + lane, u)) { tpm = u.pm; tpn = u.pn; } }
    for (int m = vcu * NWAVES + wave; m < MT; m += G * NWAVES) {
        const int pm = m >> 8;
        float* row = a.out + (size_t)m * DM;
        f32x4 v[8]; float ss = 0.f;
#pragma unroll
        for (int j = 0; j < 8; ++j) {
            const unsigned long long mask = __ballot(tpm == pm && tpn == j);
            if (mask == 0ull) v[j] = *(const f32x4*)(row + 4 * lane + 256 * j);
            else { const int tt = __ffsll((long long)mask) - 1;
                v[j] = *(const f32x4*)(X1 + (size_t)m * DM + 4 * lane + 256 * j);
                const float* tp = tailp + (size_t)tt * 8 * 65536 + (m & 255) * 256 + 4 * lane;
#pragma unroll
                for (int sl = 0; sl < 8; ++sl) v[j] += *(const f32x4*)(tp + (size_t)sl * 65536); }
            ss += dot4(v[j], v[j]); }
        const float r = rsqrtf(wave_sum(ss) * (1.f / DM) + EPS);
#pragma unroll
        for (int j = 0; j < 8; ++j) { const f32x4 w = *(const f32x4*)(fw + 4 * lane + 256 * j);
            *(f32x4*)(row + 4 * lane + 256 * j) = (f32x4){v[j][0] * r * w[0], v[j][1] * r * w[1], v[j][2] * r * w[2], v[j][3] * r * w[3]}; }
    }
}

#define XB_TMO      128
#define XB_XCNT(j)  (256  + 64 * (j))
#define XB_XSUB(j)  (1280 + 64 * (j))
#define XB_XGEN(j)  (2304 + 64 * (j))
#define XB_TOP      3328
#define XB_TOPGEN   3392
#define XCD_BAR_WORDS 3456
#define XB_SPIN_CAP (1u << 18)

__device__ __forceinline__ unsigned xb_ld(unsigned* p)              { return __hip_atomic_load(p, __ATOMIC_RELAXED, __HIP_MEMORY_SCOPE_AGENT); }
__device__ __forceinline__ unsigned xb_add(unsigned* p, unsigned v) { return __hip_atomic_fetch_add(p, v, __ATOMIC_RELAXED, __HIP_MEMORY_SCOPE_AGENT); }
__device__ __forceinline__ unsigned xb_xcc_id() { return (unsigned)__builtin_amdgcn_s_getreg((3 << 11) | 20) & 0xFu; }
#define XB_SPIN(cond, bar) do { unsigned _sp = 0; while (cond) { __builtin_amdgcn_s_sleep(1); \
    if ((++_sp & 255u) == 0u) { if (xb_ld(&(bar)[XB_TMO])) break; if (_sp > XB_SPIN_CAP) { atomicAdd(&(bar)[XB_TMO], 1u); break; } } } } while (0)

struct XcdBarrier {
    unsigned* bar; unsigned x;
    volatile LAS unsigned* st;
};

__device__ __forceinline__ XcdBarrier xcd_barrier_post(unsigned* bar, volatile LAS unsigned* st) {
    XcdBarrier b; b.bar = bar; b.x = xb_xcc_id(); b.st = st;
    if (threadIdx.x == 0) (void)xb_add(&bar[XB_XCNT(b.x)], 1u);
    return b;
}
__device__ __forceinline__ void xcd_barrier_complete(unsigned* bar, unsigned x, unsigned& nloc, unsigned& nx) {
    const unsigned G = gridDim.x * gridDim.y * gridDim.z;
    unsigned sum, cnt, mine, sp = 0u;
    for (;;) {
        sum = 0u; cnt = 0u; mine = 0u;
#pragma unroll
        for (unsigned j = 0; j < 16; ++j) { const unsigned c = xb_ld(&bar[XB_XCNT(j)]); sum += c; cnt += (c > 0u) ? 1u : 0u; mine = (j == x) ? c : mine; }
        if (sum == G) break;
        __builtin_amdgcn_s_sleep(1);
        if ((++sp & 255u) == 0u) { if (xb_ld(&bar[XB_TMO])) break; if (sp > XB_SPIN_CAP) { atomicAdd(&bar[XB_TMO], 1u); break; } }
    }
    nloc = mine > 0u ? mine : 1u; nx = cnt > 0u ? cnt : 1u;
}

__device__ __forceinline__ void xcd_barrier(const XcdBarrier& b) {
    asm volatile("s_waitcnt vmcnt(0)" ::: "memory");
    __syncthreads();
    if (threadIdx.x == 0) {
        unsigned* bar = b.bar;
        __builtin_amdgcn_s_waitcnt(0);
        unsigned nloc = b.st[0], nx = b.st[1];
        if (nloc == 0u) { xcd_barrier_complete(bar, b.x, nloc, nx); b.st[0] = nloc; b.st[1] = nx; }
        const unsigned old = xb_add(&bar[XB_XSUB(b.x)], 1u);
        const unsigned gen = old / nloc;
        if (old + 1u == (gen + 1u) * nloc) {
            __builtin_amdgcn_fence(__ATOMIC_RELEASE, "agent");
            asm volatile("s_waitcnt vmcnt(0)" ::: "memory");
            const unsigned og = xb_add(&bar[XB_TOP], 1u);
            const unsigned tg = og / nx;
            if (og + 1u == (tg + 1u) * nx) xb_add(&bar[XB_TOPGEN], 1u);
            else XB_SPIN(xb_ld(&bar[XB_TOPGEN]) == tg, bar);
            __builtin_amdgcn_fence(__ATOMIC_ACQUIRE, "agent");
            xb_add(&bar[XB_XGEN(b.x)], 1u);
            asm volatile("s_waitcnt vmcnt(0)" ::: "memory");
        } else {
            XB_SPIN(xb_ld(&bar[XB_XGEN(b.x)]) == gen, bar);
            __builtin_amdgcn_fence(__ATOMIC_ACQUIRE, "agent");
            asm volatile("s_waitcnt vmcnt(0)" ::: "memory");
        }
    }
    __syncthreads();
}

constexpr int N_PHASES = 12;
__global__ void __launch_bounds__(NTHR) fwd_kernel(Args args) {
    extern __shared__ __attribute__((aligned(16))) unsigned char lds_raw[];
    LAS unsigned char* lds = (LAS unsigned char*)lds_raw;
    cg::grid_group grid = cg::this_grid();
    volatile LAS unsigned* bst = (volatile LAS unsigned*)(lds + LDS_BYTES - 16);
    if (threadIdx.x < 4) bst[threadIdx.x] = 0u;
    __syncthreads();
    XcdBarrier xbar = xcd_barrier_post((unsigned*)args.ws, bst);
    const int G = gridDim.x, bx = blockIdx.x;
    const int vcu = (G % 8 == 0) ? (bx % 8) * (G / 8) + bx / 8 : bx;
    const int lo = args.ph_lo, hi = args.ph_hi;
    unsigned char* ws = args.ws;
#ifndef USE_CG_SYNC
#define USE_CG_SYNC 0
#endif
#ifndef DOUBLE_MASK
#define DOUBLE_MASK 0
#endif
#define REP(k) for (int rep_ = 0; rep_ < 1 + ((DOUBLE_MASK >> (k)) & 1); ++rep_)
#ifndef DBL_P2
#define DBL_P2 0
#endif
#ifndef BIS
#define BIS 15
#endif
#ifndef PHASE_MASK
#define PHASE_MASK 0xfff
#endif
#define IN(k) (((PHASE_MASK >> (k)) & 1) && lo <= (k) && (k) < hi)
#define SEAM(k) do { if (IN(k) && IN((k) + 1)) { if (USE_CG_SYNC || lo < 0) grid.sync(); else xcd_barrier(xbar); } } while (0)
    if (IN(0)) REP(0) { p0_prologue(args, lds, vcu, G, 0); __syncthreads(); }
    SEAM(0);
    if (IN(1)) REP(1) {
        pg8::Gemm g{(const bf16*)(ws + WS_XN), (const bf16*)(ws + WS_WIN), nullptr, nullptr, MT, NPROJ_PAD, DM}; pg8::StaticOrder S; S.init(MT, NPROJ_PAD, G, bx);
        EpiProj E{(bf16*)(ws + WS_PROJ), (float*)(ws + WS_GATES)};
        pg8::gemm_phase<EpiProj, pg8::StaticOrder, true, true>(lds, g, S, E);
        { const int rem = S.nwg % G, nidle = rem ? G - rem : G, idx = rem ? bx - rem : bx;
          if (idx >= 0) p0_prologue(args, lds, idx, nidle, 1); }
        __syncthreads();
    }
    SEAM(1);
    if (IN(2)) REP(2) {
        for (int it = bx; it < 1536; it += G) {
            if (it < 512) { for (int r_ = 0; r_ < 1 + (DBL_P2 & 1); ++r_) sample_item<true>(args, lds, it >> 2, it & 3); }
            else if (it < 1024) { for (int r_ = 0; r_ < 1 + ((DBL_P2 >> 1) & 1); ++r_) sample_item<false>(args, lds, (it - 512) >> 2, (it - 512) & 3); }
            else if (it < 1280) { for (int r_ = 0; r_ < 1 + ((DBL_P2 >> 2) & 1); ++r_) chunk_state<true>(args, lds, (it - 1024) >> 4, (it - 1024) & 15); }
            else { for (int r_ = 0; r_ < 1 + ((DBL_P2 >> 3) & 1); ++r_) chunk_state<false>(args, lds, (it - 1280) >> 4, (it - 1280) & 15); }
        }
    }
    SEAM(2);
    if (IN(3)) REP(3) { for (int it = bx; it < 768; it += G) { if (it < 512) scan_mlstm(args, it); else scan_gla(args, it - 512); }
        if (G == 256) {
            pg8::Gemm g{(const bf16*)(ws + WS_YM), (const bf16*)(ws + WS_WA), (const bf16*)(ws + WS_YG), (const bf16*)(ws + WS_WB), MT, DM, 1024}; pg8::TailOnlyOrder<2, 16> S; S.c = bx;
            EpiBranch E{(const bf16*)(ws + WS_PROJ), (bf16*)(ws + WS_XN), args.out + O_YP};
            pg8::gemm_phase<EpiBranch, pg8::TailOnlyOrder<2, 16>, true, true>(lds, g, S, E);
        }
    }
    SEAM(3);
    if (IN(4)) REP(4) { for (int it = bx; it < 512; it += G) { if (it < 256) { if (BIS & 1) chunk_out<true>(args, lds, it >> 4, it & 15); } else { if (BIS & 2) chunk_out<false>(args, lds, (it - 256) >> 4, (it - 256) & 15); } } __syncthreads(); if (G == 256) merge_reduce(args, vcu, G); }
    SEAM(4);
    if (IN(5)) REP(5) {
        pg8::Gemm g{(const bf16*)(ws + WS_YM), (const bf16*)(ws + WS_WA), (const bf16*)(ws + WS_YG), (const bf16*)(ws + WS_WB), MT, DM, 1024}; EpiBranch E{(const bf16*)(ws + WS_PROJ), (bf16*)(ws + WS_XN), nullptr};
        if (G == 256) { pg8::MainOnlyOrder<2> S; S.S.init(MP, DM, G, bx); pg8::gemm_phase<EpiBranch, pg8::MainOnlyOrder<2>, true, true>(lds, g, S, E); }
        else { pg8::TwoSegOrder S; S.S.init(MT, DM, G, bx); pg8::gemm_phase<EpiBranch, pg8::TwoSegOrder, true, true>(lds, g, S, E); }
    }
    SEAM(5);
    if (IN(6)) REP(6) {
        pg8::Gemm g{(const bf16*)(ws + WS_XN), (const bf16*)(ws + WS_WO), nullptr, nullptr, MT, DM, DM}; pg8::SplitRowsOrder<1, 32> S; S.split = (G == 256); S.S.init(S.split ? MP : MT, DM, G, bx);
        EpiOut E{args.in[I_XP], args.in[I_XS], (float*)(ws + WS_X1), (bf16*)(ws + WS_X1W), args.in[I_NFFN], (float*)(ws + WS_PART), (float*)(ws + WS_PROJ)};
        pg8::gemm_phase<EpiOut, pg8::SplitRowsOrder<1, 32>, true, true>(lds, g, S, E);
    }
    SEAM(6);
    if (IN(7)) REP(7) rstd_phase(args, vcu, G);
    SEAM(7);
    if (IN(8)) REP(8) {
        pg8::Gemm g{(const bf16*)(ws + WS_X1W), (const bf16*)(ws + WS_WUG), nullptr, nullptr, MT, 2 * DFF, DM}; pg8::StaticOrder S; S.init(MT, 2 * DFF, G, bx);
        EpiUGAct E{(const float*)(ws + WS_RSTD), (bf16*)(ws + WS_G), args.out, args.in[I_CW], args.in[I_CB], args.in[I_CONV], (float*)(ws + WS_U), (LAS float*)(lds + 131072)};
        pg8::gemm_phase<EpiUGAct, pg8::StaticOrder, true, true>(lds, g, S, E);
    }
    SEAM(8);
    if (IN(9)) REP(9) act_fixup(args, vcu, G);
    SEAM(9);
    if (IN(10)) REP(10) {
        pg8::Gemm g{(const bf16*)(ws + WS_G), (const bf16*)(ws + WS_WD), nullptr, nullptr, MT, DM, DFF}; pg8::DownOrder S; S.S.init(MT, DM, G, bx); S.split = (G == 256);
        EpiDown E{(const float*)(ws + WS_X1), args.out, (float*)(ws + WS_U)};
        pg8::gemm_phase<EpiDown, pg8::DownOrder, true, true>(lds, g, S, E);
    }
    SEAM(10);
    if (IN(11)) REP(11) final_norm(args, vcu, G);
#ifdef EXTRA_SYNCS
    for (int i_ = 0; i_ < EXTRA_SYNCS; ++i_) xcd_barrier(xbar);
#endif
#undef IN
#undef SEAM
}

extern "C" void kernel_launch(void* const* d_in, const int* in_sizes, int n_in, void* d_out, int out_size, void* d_ws, size_t ws_size, hipStream_t stream) {
    static int grid = 0;
    if (grid == 0) {
        if (n_in != 25 || ws_size < WS_END) { fprintf(stderr, "kernel_launch: unexpected n_in %d / ws_size %zu (need %zu)\n", n_in, ws_size, (size_t)WS_END); grid = -1; return; }
        int dev = 0, cus = 0, per_cu = 0;
        (void)hipGetDevice(&dev); (void)hipDeviceGetAttribute(&cus, hipDeviceAttributeMultiprocessorCount, dev);
        if (hipFuncSetAttribute((const void*)fwd_kernel, hipFuncAttributeMaxDynamicSharedMemorySize, LDS_BYTES) != hipSuccess) { fprintf(stderr, "kernel_launch: hipFuncSetAttribute failed\n"); grid = -1; return; }
        if (hipOccupancyMaxActiveBlocksPerMultiprocessor(&per_cu, (const void*)fwd_kernel, NTHR, LDS_BYTES) != hipSuccess || per_cu < 1) { fprintf(stderr, "kernel_launch: occupancy query says %d\n", per_cu); per_cu = 1; }
        (void)hipGetLastError();
        grid = cus * 1;
        if (grid <= 0) grid = 256;
    }
    if (grid < 0) return;
    if (hipMemsetAsync(d_ws, 0, 65536, stream) != hipSuccess) { fprintf(stderr, "kernel_launch: memset failed\n"); return; }
    Args a{};
    for (int i = 0; i < 25; ++i) a.in[i] = (const float*)d_in[i];
    a.out = (float*)d_out; a.ws = (unsigned char*)d_ws;
    if (MK_N_LAUNCHES == 1) {
        a.ph_lo = 0; a.ph_hi = N_PHASES;
        void* kargs[] = {&a};
        hipError_t e = hipLaunchCooperativeKernel((const void*)fwd_kernel, dim3(grid), dim3(NTHR), kargs, LDS_BYTES, stream);
        if (e != hipSuccess) fprintf(stderr, "kernel_launch: cooperative launch failed: %s (grid %d)\n", hipGetErrorString(e), grid);
    } else {
        for (int p = 0; p < N_PHASES; ++p) { a.ph_lo = p; a.ph_hi = p + 1; hipLaunchKernelGGL(fwd_kernel, dim3(grid), dim3(NTHR), LDS_BYTES, stream, a); }
    }
}
```

```cpp
#include <hip/hip_runtime.h>
#include <hip/hip_cooperative_groups.h>
#include <cstdio>
#include <cstdint>
namespace cg = cooperative_groups;

#ifndef MK_N_LAUNCHES
#define MK_N_LAUNCHES 1
#endif

namespace pg8 {
#define PG8_LAS __attribute__((address_space(3)))
typedef unsigned short bf16_t;
typedef short bf16x8 __attribute__((ext_vector_type(8)));
typedef float f32x4 __attribute__((ext_vector_type(4)));
typedef unsigned u32x4 __attribute__((ext_vector_type(4)));
constexpr int BM = 256, BK = 64, HALF = 128, HTB = HALF * BK * 2  , STAGE_BYTES = 8 * HTB, NXCD = 8, WGM = 8;

__host__ __device__ __forceinline__ int lds_byte(int r, int c) { const int st = (r >> 4) * 2 + (c >> 5), rr = r & 15, cc = c & 31, ob = rr * 64 + cc * 2; return st * 1024 + (ob ^ (((ob >> 9) & 1) << 5)); }
__host__ __device__ __forceinline__ void stage_rc(int b, int& R, int& C) { const int st = b / 1024, sb = b % 1024, swz = sb ^ (((sb >> 9) & 1) << 5); R = (st >> 1) * 16 + swz / 64; C = (st & 1) * 32 + (swz % 64) / 2; }
__host__ __device__ __forceinline__ int perm32(int rho) { const int n = rho >> 4, i = rho & 15; return 8 * (i >> 2) + 4 * n + (i & 3); }

struct Unit { int pm, pn, seg, kt0, nkt, tail; };
struct Gemm { const bf16_t* A; const bf16_t* Bt; const bf16_t* A2; const bf16_t* Bt2; int M, N, K; };

struct StaticOrder {
    int nM, nN, nwg, G, c;
    __host__ __device__ void init(int M, int N, int G_, int c_) { nM = M / BM; nN = N / BM; nwg = nM * nN; G = G_; c = c_; }
    __host__ __device__ bool next(int i, Unit& u) const { return at((long)i * G + c, u); }
    __host__ __device__ bool at(long L, Unit& u) const {
        if (L >= nwg) return false;
        int wgid = (int)L; { const int q = nwg / NXCD, r = nwg % NXCD, xcd = wgid % NXCD, off = wgid / NXCD; wgid = (xcd < r ? xcd * (q + 1) : r * (q + 1) + (xcd - r) * q) + off; }
        const int nig = WGM * nN, gid = wgid / nig, fm = gid * WGM, gsz = (nM - fm) < WGM ? (nM - fm) : WGM;
        u.pm = fm + ((wgid % nig) % gsz); u.pn = (wgid % nig) / gsz; u.seg = 0; u.kt0 = 0; u.nkt = -1; u.tail = -1; return true;
    }
};
struct DownOrder {
    StaticOrder S; bool split;
    __host__ __device__ bool next(int i, Unit& u) const {
        if (!split) return S.next(i, u);
        if (i == 0) return S.at(S.c, u);
        if (i > 1) return false;
        const int tt = S.c >> 3, sl = S.c & 7;
        if (!S.at(256 + tt, u)) return false;
        u.kt0 = 11 * sl + (sl & 1); u.nkt = (sl & 1) ? 10 : 12; u.tail = tt * 8 + sl; return true;
    }
};
template <int NSEG, int KT>
struct SplitRowsOrder {
    StaticOrder S; bool split;
    __host__ __device__ bool next(int i, Unit& u) const {
        if (!split) { if (!S.next(i / NSEG, u)) return false; u.seg = i % NSEG; return true; }
        if (i < NSEG) { if (!S.at(S.c, u)) return false; u.seg = i; return true; }
        if (i >= 2 * NSEG) return false;
        const int tt = S.c >> 3, sl = S.c & 7;
        u.pm = 32 + (tt >> 3); u.pn = tt & 7; u.seg = i - NSEG; u.kt0 = (KT / 8) * sl; u.nkt = KT / 8; u.tail = tt * 8 + sl; return true;
    }
};
template <int NSEG, int KT>
struct TailOnlyOrder {
    int c;
    __host__ __device__ bool next(int i, Unit& u) const {
        if (i >= NSEG) return false;
        const int tt = c >> 3, sl = c & 7;
        u.pm = 32 + (tt >> 3); u.pn = tt & 7; u.seg = i; u.kt0 = (KT / 8) * sl; u.nkt = KT / 8; u.tail = tt * 8 + sl; return true;
    }
};
template <int NSEG>
struct MainOnlyOrder {
    StaticOrder S;
    __host__ __device__ bool next(int i, Unit& u) const { if (i >= NSEG) return false; if (!S.at(S.c, u)) return false; u.seg = i; return true; }
};
struct TwoSegOrder {
    StaticOrder S;
    __host__ __device__ bool next(int i, Unit& u) const { if (!S.next(i >> 1, u)) return false; u.seg = i & 1; return true; }
};

__device__ __forceinline__ unsigned cvt_pk_bf16(float lo, float hi) { unsigned r; asm volatile("v_cvt_pk_bf16_f32 %0, %1, %2" : "=v"(r) : "v"(lo), "v"(hi)); return r; }

template <class Epi, class Sched, bool ALIGN_EPI = false, bool SP2 = false>
__device__ __forceinline__ void gemm_phase(PG8_LAS unsigned char* lds, const Gemm g, const Sched& S, const Epi& E) {
    int tid_ = threadIdx.x; asm volatile("" : "+v"(tid_));
    const int tid = tid_, wid = __builtin_amdgcn_readfirstlane(tid >> 6), lane = tid & 63, wr = wid >> 2, wc = wid & 3, fr = lane & 15, fq = lane >> 4;
    const int K = g.K, ntf = K / BK;
    unsigned voffA[2], voffB[2];
#pragma unroll
    for (int i = 0; i < 2; ++i) { int R, C; stage_rc(tid * 16 + i * 8192, R, C); const int Rb = Epi::PERM ? ((R & ~31) + perm32(R & 31)) : R;
        voffA[i] = (unsigned)(R * K + C) * 2u; voffB[i] = (unsigned)(Rb * K + C) * 2u; }
    const size_t kstep = (size_t)(BK * 2);
    const size_t hstep = (size_t)HALF * K * 2;
    const size_t tstep = 2 * hstep;
    const unsigned ldsw = (unsigned)wid * 1024u;
    const int aoff = lds_byte(wr * 64 + fr, fq * 8), boff = lds_byte(wc * 32 + fr, fq * 8);
#define PG8_SA(b, h) (((b) * 2 + (h)) * HTB)
#define PG8_SB(b, h) ((4 + (b) * 2 + (h)) * HTB)
#define PG8_STAGE(bufoff, gbase, voff) do { _Pragma("unroll") for (int _i = 0; _i < 2; ++_i) \
        __builtin_amdgcn_global_load_lds((const unsigned*)((const char*)(gbase) + (voff)[_i]), (PG8_LAS unsigned*)(lds + (bufoff) + ldsw + _i * 8192), 16, 0, 0); } while (0)
#define PG8_LDA(dst, b, h) do { _Pragma("unroll") for (int m = 0; m < 4; ++m) _Pragma("unroll") for (int k = 0; k < 2; ++k) dst[m][k] = *(const PG8_LAS bf16x8*)(lds + PG8_SA(b, h) + aoff + m * 2048 + k * 1024); } while (0)
#define PG8_LDB(dst, b, h) do { _Pragma("unroll") for (int n = 0; n < 2; ++n) _Pragma("unroll") for (int k = 0; k < 2; ++k) dst[n][k] = *(const PG8_LAS bf16x8*)(lds + PG8_SB(b, h) + boff + n * 2048 + k * 1024); } while (0)
#define PG8_MMA(ai, bj, At, Bt) do { __builtin_amdgcn_s_setprio(1); _Pragma("unroll") for (int m = 0; m < 4; ++m) _Pragma("unroll") for (int n = 0; n < 2; ++n) _Pragma("unroll") for (int k = 0; k < 2; ++k) \
        acc[ai][bj][m][n] = __builtin_amdgcn_mfma_f32_16x16x32_bf16(Bt[n][k], At[m][k], acc[ai][bj][m][n], 0, 0, 0); __builtin_amdgcn_s_setprio(0); } while (0)
#define PG8_WAIT_V(n) asm volatile("s_waitcnt vmcnt(" #n ")" ::: "memory")
#define PG8_WAIT_L(n) asm volatile("s_waitcnt lgkmcnt(" #n ")" ::: "memory")
#define PG8_BAR __builtin_amdgcn_s_barrier()
#define PG8_SCHED __builtin_amdgcn_sched_barrier(0)
    Unit cur, nxt; int ui = 0;
    if (!S.next(0, cur)) return;
    f32x4 acc[2][2][4][2];
#pragma unroll
    for (int a = 0; a < 2; ++a)
#pragma unroll
        for (int b = 0; b < 2; ++b)
#pragma unroll
            for (int m = 0; m < 4; ++m)
#pragma unroll
                for (int n = 0; n < 2; ++n) acc[a][b][m][n] = (f32x4){0.f, 0.f, 0.f, 0.f};
    bf16x8 At[4][2], B0[2][2], B1[2][2];
    const char* cA = (const char*)(cur.seg ? g.A2 : g.A) + (size_t)cur.pm * tstep + (size_t)cur.kt0 * kstep; const char* cB = (const char*)(cur.seg ? g.Bt2 : g.Bt) + (size_t)cur.pn * tstep + (size_t)cur.kt0 * kstep;
    if constexpr (SP2) {
        PG8_STAGE(PG8_SB(0, 0), cB, voffB); PG8_STAGE(PG8_SB(0, 1), cB + hstep, voffB); PG8_STAGE(PG8_SA(0, 0), cA, voffA); PG8_STAGE(PG8_SA(0, 1), cA + hstep, voffA);
        if (wr == 1) PG8_BAR;
        PG8_WAIT_V(2); PG8_BAR;
        PG8_STAGE(PG8_SB(1, 0), cB + kstep, voffB); PG8_STAGE(PG8_SA(1, 0), cA + kstep, voffA); PG8_STAGE(PG8_SB(1, 1), cB + hstep + kstep, voffB);
        PG8_WAIT_V(6); PG8_BAR;
    } else {
        PG8_STAGE(PG8_SB(0, 0), cB, voffB); PG8_STAGE(PG8_SA(0, 0), cA, voffA); PG8_STAGE(PG8_SB(0, 1), cB + hstep, voffB); PG8_STAGE(PG8_SA(0, 1), cA + hstep, voffA);
        if (wr == 1) PG8_BAR;
        PG8_WAIT_V(4); PG8_BAR;
        PG8_STAGE(PG8_SB(1, 0), cB + kstep, voffB); PG8_STAGE(PG8_SA(1, 0), cA + kstep, voffA); PG8_STAGE(PG8_SB(1, 1), cB + hstep + kstep, voffB);
        PG8_WAIT_V(6); PG8_BAR;
    }
    for (;;) {
        const bool has_next = S.next(ui + 1, nxt);
        const char* nA = has_next ? (const char*)(nxt.seg ? g.A2 : g.A) + (size_t)nxt.pm * tstep + (size_t)nxt.kt0 * kstep : cA; const char* nB = has_next ? (const char*)(nxt.seg ? g.Bt2 : g.Bt) + (size_t)nxt.pn * tstep + (size_t)nxt.kt0 * kstep : cB;
        const int nt = cur.nkt > 0 ? cur.nkt : ntf;
        for (int t = 0; t < nt; t += 2) {
            const bool last = (t == nt - 2);
            const char* a1 = cA + (size_t)(t + 1) * kstep;
            const char* a2 = last ? nA : cA + (size_t)(t + 2) * kstep; const char* b2 = last ? nB : cB + (size_t)(t + 2) * kstep;
            const char* a3 = a2 + kstep; const char* b3 = b2 + kstep;
            if constexpr (SP2) {
            PG8_LDB(B0, 0, 0); PG8_LDB(B1, 0, 1); PG8_SCHED; PG8_LDA(At, 0, 0); PG8_STAGE(PG8_SA(1, 1), a1 + hstep, voffA);
            PG8_WAIT_V(8); PG8_WAIT_L(0); PG8_BAR; PG8_MMA(0, 0, At, B0); PG8_MMA(0, 1, At, B1); PG8_BAR; PG8_SCHED;
            PG8_LDA(At, 0, 1); PG8_STAGE(PG8_SB(0, 0), b2, voffB); PG8_STAGE(PG8_SB(0, 1), b2 + hstep, voffB); PG8_STAGE(PG8_SA(0, 0), a2, voffA);
            PG8_WAIT_V(8); PG8_WAIT_L(0); PG8_BAR; PG8_MMA(1, 0, At, B0); PG8_MMA(1, 1, At, B1); PG8_BAR; PG8_SCHED;
            PG8_LDB(B0, 1, 0); PG8_LDB(B1, 1, 1); PG8_SCHED; PG8_LDA(At, 1, 0); PG8_STAGE(PG8_SA(0, 1), a2 + hstep, voffA);
            PG8_WAIT_V(8); PG8_WAIT_L(0); PG8_BAR; PG8_MMA(0, 0, At, B0); PG8_MMA(0, 1, At, B1); PG8_BAR; PG8_SCHED;
            PG8_LDA(At, 1, 1); PG8_STAGE(PG8_SB(1, 0), b3, voffB); PG8_STAGE(PG8_SB(1, 1), b3 + hstep, voffB); PG8_STAGE(PG8_SA(1, 0), a3, voffA);
            PG8_WAIT_V(8); PG8_WAIT_L(0); PG8_BAR; PG8_MMA(1, 0, At, B0); PG8_MMA(1, 1, At, B1); PG8_BAR; PG8_SCHED;
            } else {
            PG8_LDB(B0, 0, 0); PG8_SCHED; PG8_LDA(At, 0, 0); PG8_STAGE(PG8_SA(1, 1), a1 + hstep, voffA);
            PG8_WAIT_L(8); PG8_BAR; PG8_WAIT_L(0); PG8_MMA(0, 0, At, B0); PG8_BAR; PG8_SCHED;
            PG8_LDB(B1, 0, 1); PG8_STAGE(PG8_SB(0, 0), b2, voffB);
            PG8_BAR; PG8_WAIT_L(0); PG8_MMA(0, 1, At, B1); PG8_BAR;
            PG8_LDA(At, 0, 1); PG8_STAGE(PG8_SA(0, 0), a2, voffA);
            PG8_BAR; PG8_WAIT_L(0); PG8_MMA(1, 0, At, B0); PG8_BAR; PG8_SCHED;
            PG8_STAGE(PG8_SB(0, 1), b2 + hstep, voffB);
            PG8_WAIT_V(6); PG8_BAR; PG8_MMA(1, 1, At, B1); PG8_BAR;
            PG8_LDB(B0, 1, 0); PG8_SCHED; PG8_LDA(At, 1, 0); PG8_STAGE(PG8_SA(0, 1), a2 + hstep, voffA);
            PG8_WAIT_L(8); PG8_BAR; PG8_WAIT_L(0); PG8_MMA(0, 0, At, B0); PG8_BAR; PG8_SCHED;
            PG8_LDB(B1, 1, 1); PG8_STAGE(PG8_SB(1, 0), b3, voffB);
            PG8_BAR; PG8_WAIT_L(0); PG8_MMA(0, 1, At, B1); PG8_BAR;
            PG8_LDA(At, 1, 1); PG8_STAGE(PG8_SA(1, 0), a3, voffA);
            PG8_BAR; PG8_WAIT_L(0); PG8_MMA(1, 0, At, B0); PG8_BAR; PG8_SCHED;
            PG8_STAGE(PG8_SB(1, 1), b3 + hstep, voffB);
            PG8_WAIT_V(6); PG8_BAR; PG8_MMA(1, 1, At, B1); PG8_BAR;
            }
        }
        if constexpr (ALIGN_EPI) { if (wr == 0) PG8_BAR; }
        E(acc, cur, wr, wc, fr, fq);
        if (!has_next) break;
        if (nxt.seg == 0)
#pragma unroll
        for (int a = 0; a < 2; ++a)
#pragma unroll
            for (int b = 0; b < 2; ++b)
#pragma unroll
                for (int m = 0; m < 4; ++m)
#pragma unroll
                    for (int n = 0; n < 2; ++n) acc[a][b][m][n] = (f32x4){0.f, 0.f, 0.f, 0.f};
        cur = nxt; cA = nA; cB = nB; ++ui;
        if constexpr (ALIGN_EPI) { if (wr == 1) PG8_BAR; }
    }
    PG8_WAIT_V(0);
    if constexpr (!ALIGN_EPI) { if (wr == 0) PG8_BAR; }
    PG8_BAR;
#undef PG8_SA
#undef PG8_SB
#undef PG8_STAGE
#undef PG8_LDA
#undef PG8_LDB
#undef PG8_MMA
#undef PG8_WAIT_V
#undef PG8_WAIT_L
#undef PG8_BAR
#undef PG8_SCHED
}
}

#define LAS __attribute__((address_space(3)))
typedef unsigned short bf16;
typedef short bf16x8 __attribute__((ext_vector_type(8)));
typedef float f32x4 __attribute__((ext_vector_type(4)));
typedef unsigned u32x4 __attribute__((ext_vector_type(4)));
typedef unsigned u32x2 __attribute__((ext_vector_type(2)));
using pg8::cvt_pk_bf16;

constexpr int NWAVES = 8, NTHR = 512;
constexpr int DM = 2048, MP = 8192, MS = 1024, MT = 9216, TP = 2048, TS = 8;
constexpr int NIN = 11288, NPROJ = 11264, NPROJ_PAD = 11520, DFF = 5632;
constexpr int C_MQ = 0, C_MK = 1024, C_MV = 2048, C_MO = 3072, C_GQ = 4096, C_GK = 4608, C_GV = 5120, C_GR = 6144, C_GA = 7168, C_GB = 9216;
constexpr float EPS = 1e-6f;
constexpr int NCH = 16;
constexpr int LDS_BYTES = 147456;

constexpr size_t O_YP = 0, O_YS = 16777216, O_PC = 18874368, O_PN = 19922944, O_PM = 19927040, O_PS = 19927056, O_PCONV = 20451344,
                 O_SC = 20496400, O_SN = 54050832, O_SM = 54181904, O_SS = 54182416, O_SCONV = 70959632;

constexpr size_t MiB = 1u << 20;
constexpr size_t WS_GATES = 64 * 1024;
constexpr size_t WS_PART = WS_GATES + (size_t)MT * 32 * 4;
constexpr size_t WS_DN = WS_PART + (size_t)MT * 32 * 4;
constexpr size_t WS_NPREV = WS_DN + 256 * 256 * 4;
constexpr size_t WS_CHS = WS_NPREV + 256 * 256 * 2;
constexpr size_t WS_BEND = WS_CHS + 256 * 2 * 4;
constexpr size_t WS_RSTD = WS_BEND + 256 * 128 * 4;
static_assert(WS_RSTD + MT * 4 <= 4 * MiB, "small region");
constexpr size_t WS_WIN = 4 * MiB;
constexpr size_t WS_WA = WS_WIN + (size_t)NPROJ_PAD * DM * 2;
constexpr size_t WS_WB = WS_WA + (size_t)2048 * 1024 * 2;
constexpr size_t WS_WO = WS_WB + (size_t)2048 * 1024 * 2;
constexpr size_t WS_WUG = WS_WO + (size_t)2048 * 2048 * 2;
constexpr size_t WS_WD = WS_WUG + (size_t)2 * DFF * DM * 2;
constexpr size_t WS_R1 = WS_WD + (size_t)DM * DFF * 2;
static_assert(WS_R1 == 131 * MiB, "map");
constexpr size_t WS_XN = WS_R1;
constexpr size_t WS_X1W = WS_R1 + 36 * MiB;
constexpr size_t WS_X1 = WS_R1 + 72 * MiB;
constexpr size_t WS_DC = WS_R1;
constexpr size_t WS_DS = WS_R1 + 64 * MiB;
constexpr size_t WS_CT = WS_R1 + 96 * MiB;
constexpr size_t WS_ST = WS_R1 + 128 * MiB;
constexpr size_t WS_YM = WS_R1 + 144 * MiB;
constexpr size_t WS_YG = WS_YM + 18 * MiB;
constexpr size_t WS_PROJ = WS_YG + 18 * MiB;
constexpr size_t WS_U = WS_PROJ, WS_G = WS_PROJ + 99 * MiB;
constexpr size_t WS_END = WS_PROJ + 198 * MiB;
static_assert(WS_END == 509 * MiB, "map");

struct Args {
    const float* in[25]; float* out; unsigned char* ws; int ph_lo, ph_hi;
};
enum { I_XP = 0, I_XS, I_C, I_N, I_M, I_S, I_CONV, I_WIN, I_BI, I_BF, I_AUP, I_AB, I_MHW, I_GHW, I_WA, I_WB, I_WO, I_NMIX, I_NFFN, I_WUP, I_WGATE, I_CW, I_CB, I_WDOWN, I_FNW };

__device__ __forceinline__ float bf2f(unsigned short b) { return __builtin_bit_cast(float, (unsigned)b << 16); }
__device__ __forceinline__ float bflo(unsigned w) { return __builtin_bit_cast(float, w << 16); }
__device__ __forceinline__ float bfhi(unsigned w) { return __builtin_bit_cast(float, w & 0xffff0000u); }
__device__ __forceinline__ unsigned short f2bf(float f) { return (unsigned short)(cvt_pk_bf16(f, 0.f) & 0xffffu); }
__device__ __forceinline__ float logsig(float z) { return fminf(z, 0.f) - __logf(1.f + __expf(-fabsf(z))); }
__device__ __forceinline__ float sigm(float z) { return 1.f / (1.f + __expf(-z)); }
__device__ __forceinline__ float wave_sum(float v) {
#pragma unroll
    for (int o = 1; o < 64; o <<= 1) v += __shfl_xor(v, o);
    return v;
}
__device__ __forceinline__ float wave_max(float v) {
#pragma unroll
    for (int o = 1; o < 64; o <<= 1) v = fmaxf(v, __shfl_xor(v, o));
    return v;
}
__device__ __forceinline__ float sum4(f32x4 v) { return (v.x + v.y) + (v.z + v.w); }
__device__ __forceinline__ float dot4(f32x4 a, f32x4 b) { return (a.x * b.x + a.y * b.y) + (a.z * b.z + a.w * b.w); }
__device__ __forceinline__ float gelu_tanh(float v) { const float u = 0.7978845608028654f * (v + 0.044715f * v * v * v); return v * sigm(2.f * u); }

typedef f32x4 AccT[2][2][4][2];
struct EpiProj {
    static constexpr bool PERM = true;
    bf16* P; float* gates;
    __device__ __forceinline__ void operator()(AccT& acc, const pg8::Unit& u, int wr, int wc, int fr, int fq) const {
        const int row0 = u.pm * 256 + wr * 64 + fr;
        if (u.pn < 28) {
            const int col0 = u.pn * 256 + wc * 32 + 8 * fq;
#pragma unroll
            for (int ai = 0; ai < 2; ++ai)
#pragma unroll
                for (int m = 0; m < 4; ++m) { bf16* rowp = P + (size_t)(row0 + ai * 128 + m * 16) * NPROJ + col0;
#pragma unroll
                    for (int bj = 0; bj < 2; ++bj) { const f32x4 v0 = acc[ai][bj][m][0], v1 = acc[ai][bj][m][1]; u32x4 w;
                        w.x = cvt_pk_bf16(v0[0], v0[1]); w.y = cvt_pk_bf16(v0[2], v0[3]); w.z = cvt_pk_bf16(v1[0], v1[1]); w.w = cvt_pk_bf16(v1[2], v1[3]);
                        *(u32x4*)(rowp + bj * 128) = w; } }
        } else if (u.pn >= 28 && u.pn < 44) {
            const int n0 = (u.pn - 28) * 128 + wc * 32 + 8 * fq;
#pragma unroll
            for (int ai = 0; ai < 2; ++ai)
#pragma unroll
                for (int m = 0; m < 4; ++m) { bf16* rowp = P + (size_t)(row0 + ai * 128 + m * 16) * NPROJ;
                    float R[8], sb[8];
#pragma unroll
                    for (int i = 0; i < 8; ++i) { const float ga = acc[ai][0][m][i >> 2][i & 3], gb = acc[ai][1][m][i >> 2][i & 3];
                        const float ea = __expf(fminf(-ga, 40.f)), eb = __expf(fminf(-gb, 40.f)); sb[i] = __builtin_amdgcn_rcpf(1.f + eb); R[i] = (1.f + eb) * __builtin_amdgcn_rcpf(1.f + ea); }
                    u32x4 w; w.x = cvt_pk_bf16(R[0], R[1]); w.y = cvt_pk_bf16(R[2], R[3]); w.z = cvt_pk_bf16(R[4], R[5]); w.w = cvt_pk_bf16(R[6], R[7]);
                    *(u32x4*)(rowp + C_GA + n0) = w;
                    w.x = cvt_pk_bf16(sb[0], sb[1]); w.y = cvt_pk_bf16(sb[2], sb[3]); w.z = cvt_pk_bf16(sb[4], sb[5]); w.w = cvt_pk_bf16(sb[6], sb[7]);
                    *(u32x4*)(rowp + C_GB + n0) = w; }
        } else if (wc == 0) {
#pragma unroll
            for (int ai = 0; ai < 2; ++ai)
#pragma unroll
                for (int m = 0; m < 4; ++m) { float* rowp = gates + (size_t)(row0 + ai * 128 + m * 16) * 32 + 8 * fq;
                    *(f32x4*)rowp = acc[ai][0][m][0]; *(f32x4*)(rowp + 4) = acc[ai][0][m][1]; }
        }
    }
};
struct EpiBranch {
    static constexpr bool PERM = true;
    const bf16* P; bf16* O; float* tailp;
    __device__ __forceinline__ void operator()(AccT& acc, const pg8::Unit& u, int wr, int wc, int fr, int fq) const {
        const int row0 = u.pm * 256 + wr * 64 + fr, col0 = u.pn * 256 + wc * 32 + 8 * fq;
#pragma unroll
        for (int ai = 0; ai < 2; ++ai)
#pragma unroll
            for (int m = 0; m < 4; ++m) { const int row = row0 + ai * 128 + m * 16;
#pragma unroll
                for (int bj = 0; bj < 2; ++bj) { const int col = col0 + bj * 128;
                    const u32x4 gw = *(const u32x4*)(P + (size_t)row * NPROJ + (u.seg == 0 ? C_GA : C_GB) + col);
                    float fg[8] = {bflo(gw.x), bfhi(gw.x), bflo(gw.y), bfhi(gw.y), bflo(gw.z), bfhi(gw.z), bflo(gw.w), bfhi(gw.w)};
                    if (u.seg == 0) {
#pragma unroll
                        for (int i = 0; i < 8; ++i) acc[ai][bj][m][i >> 2][i & 3] *= fg[i];
                    } else {
                        float o[8];
#pragma unroll
                        for (int i = 0; i < 8; ++i) o[i] = acc[ai][bj][m][i >> 2][i & 3] * fg[i];
                        if (u.tail < 0) { u32x4 w; w.x = cvt_pk_bf16(o[0], o[1]); w.y = cvt_pk_bf16(o[2], o[3]); w.z = cvt_pk_bf16(o[4], o[5]); w.w = cvt_pk_bf16(o[6], o[7]);
                            *(u32x4*)(O + (size_t)row * DM + col) = w; }
                        else { float* p = tailp + (size_t)u.tail * 65536 + (row & 255) * 256 + (col & 255); *(f32x4*)p = (f32x4){o[0], o[1], o[2], o[3]}; *(f32x4*)(p + 4) = (f32x4){o[4], o[5], o[6], o[7]}; }
                    } } }
    }
};
struct EpiOut {
    static constexpr bool PERM = true;
    const float* xp; const float* xs; float* X1; bf16* X1W; const float* nw; float* part; float* tailp;
    __device__ __forceinline__ void operator()(AccT& acc, const pg8::Unit& u, int wr, int wc, int fr, int fq) const {
        const int row0 = u.pm * 256 + wr * 64 + fr, col0 = u.pn * 256 + wc * 32 + 8 * fq;
        if (u.tail >= 0) {
            float* tp = tailp + (size_t)u.tail * 65536 + (wr * 64 + fr) * 256 + wc * 32 + 8 * fq;
#pragma unroll
            for (int ai = 0; ai < 2; ++ai)
#pragma unroll
                for (int m = 0; m < 4; ++m)
#pragma unroll
                    for (int bj = 0; bj < 2; ++bj) { float* p = tp + (ai * 128 + m * 16) * 256 + bj * 128; *(f32x4*)p = acc[ai][bj][m][0]; *(f32x4*)(p + 4) = acc[ai][bj][m][1]; }
            return;
        }
#pragma unroll
        for (int ai = 0; ai < 2; ++ai)
#pragma unroll
            for (int m = 0; m < 4; ++m) { const int row = row0 + ai * 128 + m * 16;
                const float* xrow = row < MP ? xp + (size_t)row * DM : xs + (size_t)(row - MP) * DM;
                float ss = 0.f;
#pragma unroll
                for (int bj = 0; bj < 2; ++bj) { const int col = col0 + bj * 128;
                    const f32x4 v0 = acc[ai][bj][m][0] + *(const f32x4*)(xrow + col), v1 = acc[ai][bj][m][1] + *(const f32x4*)(xrow + col + 4);
                    *(f32x4*)(X1 + (size_t)row * DM + col) = v0; *(f32x4*)(X1 + (size_t)row * DM + col + 4) = v1;
                    ss += dot4(v0, v0) + dot4(v1, v1);
                    const f32x4 w0 = *(const f32x4*)(nw + col), w1 = *(const f32x4*)(nw + col + 4);
                    u32x4 w; w.x = cvt_pk_bf16(v0[0] * w0[0], v0[1] * w0[1]); w.y = cvt_pk_bf16(v0[2] * w0[2], v0[3] * w0[3]);
                    w.z = cvt_pk_bf16(v1[0] * w1[0], v1[1] * w1[1]); w.w = cvt_pk_bf16(v1[2] * w1[2], v1[3] * w1[3]);
                    *(u32x4*)(X1W + (size_t)row * DM + col) = w; }
                ss += __shfl_xor(ss, 16); ss += __shfl_xor(ss, 32);
                if (fq == 0) part[(size_t)row * 32 + u.pn * 4 + wc] = ss; }
    }
};
#define DPP_MOV(ctrl, oldv, srcv) __builtin_bit_cast(float, __builtin_amdgcn_update_dpp(__builtin_bit_cast(int, (float)(oldv)), __builtin_bit_cast(int, (float)(srcv)), (ctrl), 0xf, 0xf, false))
struct EpiUGAct {
    static constexpr bool PERM = true;
    const float* rstd; bf16* ACT; float* out; const float* cw; const float* cb; const float* cst; float* ub; LAS float* xch;
    __device__ __forceinline__ void operator()(AccT& acc, const pg8::Unit& u, int wr, int wc, int fr, int fq) const {
        const int row0 = u.pm * 256 + wr * 64 + fr, col = u.pn * 128 + wc * 32 + 8 * fq;
        const bool sample = u.pm >= 32;
#pragma unroll
        for (int ai = 0; ai < 2; ++ai)
#pragma unroll
            for (int m = 0; m < 4; ++m) { const int row = row0 + ai * 128 + m * 16;
                const float r = rstd[row];
                acc[ai][0][m][0] = acc[ai][0][m][0] * r; acc[ai][0][m][1] = acc[ai][0][m][1] * r; acc[ai][1][m][0] = acc[ai][1][m][0] * r; acc[ai][1][m][1] = acc[ai][1][m][1] * r;
                float* cs = nullptr;
                if (row < MP) { const int t = row & (TP - 1); if (t >= TP - 2) cs = out + O_PCONV + ((size_t)(row >> 11) * 2 + (t - (TP - 2))) * DFF + col; }
                else { const int rr = row - MP, t = rr & 7; if (t >= 6) cs = out + O_SCONV + ((size_t)(rr >> 3) * 2 + (t - 6)) * DFF + col; }
                if (cs) { *(f32x4*)cs = acc[ai][0][m][0]; *(f32x4*)(cs + 4) = acc[ai][0][m][1]; } }
        if (fr >= 14) {
#pragma unroll
            for (int ai = 0; ai < 2; ++ai) { LAS float* p = xch + ((((ai * 2 + wr) * 4 + wc) * 2 + (fr - 14)) * 4 + fq) * 8; *(LAS f32x4*)p = acc[ai][0][3][0]; *(LAS f32x4*)(p + 4) = acc[ai][0][3][1]; }
            if (!sample && wr == 1) { float* p = ub + ((size_t)u.pm * 6 + (fr - 14)) * DFF + col; *(f32x4*)p = acc[1][0][3][0]; *(f32x4*)(p + 4) = acc[1][0][3][1]; }
        }
        if (!sample && wr == 0 && fr < 2) { float* p = ub + ((size_t)u.pm * 6 + 2 + fr) * DFF + col; *(f32x4*)p = acc[0][0][0][0]; *(f32x4*)(p + 4) = acc[0][0][0][1];
            p += 2 * DFF; *(f32x4*)p = acc[0][1][0][0]; *(f32x4*)(p + 4) = acc[0][1][0][1]; }
        asm volatile("s_waitcnt lgkmcnt(0)" ::: "memory"); __builtin_amdgcn_s_barrier();
        const f32x4 k0a = *(const f32x4*)(cw + col), k0b = *(const f32x4*)(cw + col + 4), k1a = *(const f32x4*)(cw + DFF + col), k1b = *(const f32x4*)(cw + DFF + col + 4);
        const f32x4 k2a = *(const f32x4*)(cw + 2 * DFF + col), k2b = *(const f32x4*)(cw + 2 * DFF + col + 4), cba = *(const f32x4*)(cb + col), cbb = *(const f32x4*)(cb + col + 4);
#pragma unroll
        for (int ai = 0; ai < 2; ++ai) {
            f32x4 pe0 = {0.f, 0.f, 0.f, 0.f}, pe1 = {0.f, 0.f, 0.f, 0.f};
            if (!(ai == 0 && wr == 0) && fr >= 14) { const int sai = (wr == 1) ? ai : ai - 1, swr = wr ^ 1;
                const LAS float* p = xch + ((((sai * 2 + swr) * 4 + wc) * 2 + (fr - 14)) * 4 + fq) * 8; pe0 = *(const LAS f32x4*)p; pe1 = *(const LAS f32x4*)(p + 4); }
#pragma unroll
            for (int m = 0; m < 4; ++m) { const int row = row0 + ai * 128 + m * 16;
                const f32x4 c0 = acc[ai][0][m][0], c1 = acc[ai][0][m][1], v0 = m ? acc[ai][0][m ? m - 1 : 0][0] : pe0, v1 = m ? acc[ai][0][m ? m - 1 : 0][1] : pe1;
                float cur[8] = {c0[0], c0[1], c0[2], c0[3], c1[0], c1[1], c1[2], c1[3]}, prv[8] = {v0[0], v0[1], v0[2], v0[3], v1[0], v1[1], v1[2], v1[3]};
                float p1[8], p2[8];
#pragma unroll
                for (int i = 0; i < 8; ++i) { const float y1 = DPP_MOV(0x121, 0.f, prv[i]); p1[i] = DPP_MOV(0x111, y1, cur[i]); const float y2 = DPP_MOV(0x122, 0.f, prv[i]); p2[i] = DPP_MOV(0x112, y2, cur[i]); }
                if (sample) { const int t = fr & 7;
                    if (t < 2) { const float* st = cst + (size_t)((row - MP) >> 3) * 2 * DFF + col;
                        const f32x4 s1a = *(const f32x4*)(st + DFF), s1b = *(const f32x4*)(st + DFF + 4);
                        if (t == 0) { const f32x4 s0a = *(const f32x4*)st, s0b = *(const f32x4*)(st + 4);
#pragma unroll
                            for (int i = 0; i < 4; ++i) { p1[i] = s1a[i]; p1[4 + i] = s1b[i]; p2[i] = s0a[i]; p2[4 + i] = s0b[i]; } }
                        else {
#pragma unroll
                            for (int i = 0; i < 4; ++i) { p2[i] = s1a[i]; p2[4 + i] = s1b[i]; } } } }
                const f32x4 g0 = acc[ai][1][m][0], g1 = acc[ai][1][m][1];
                float o[8];
#pragma unroll
                for (int i = 0; i < 4; ++i) { o[i] = gelu_tanh(cba[i] + k0a[i] * p2[i] + k1a[i] * p1[i] + k2a[i] * cur[i]) * g0[i];
                    o[4 + i] = gelu_tanh(cbb[i] + k0b[i] * p2[4 + i] + k1b[i] * p1[4 + i] + k2b[i] * cur[4 + i]) * g1[i]; }
                u32x4 w; w.x = cvt_pk_bf16(o[0], o[1]); w.y = cvt_pk_bf16(o[2], o[3]); w.z = cvt_pk_bf16(o[4], o[5]); w.w = cvt_pk_bf16(o[6], o[7]);
                *(u32x4*)(ACT + (size_t)row * DFF + col) = w; }
        }
    }
};
struct EpiDown {
    static constexpr bool PERM = true;
    const float* X1; float* out; float* tailp;
    __device__ __forceinline__ void operator()(AccT& acc, const pg8::Unit& u, int wr, int wc, int fr, int fq) const {
        if (u.tail < 0) {
            const int row0 = u.pm * 256 + wr * 64 + fr, col0 = u.pn * 256 + wc * 32 + 8 * fq;
#pragma unroll
            for (int ai = 0; ai < 2; ++ai)
#pragma unroll
                for (int m = 0; m < 4; ++m) { const int row = row0 + ai * 128 + m * 16;
#pragma unroll
                    for (int bj = 0; bj < 2; ++bj) { const int col = col0 + bj * 128;
                        const f32x4 v0 = acc[ai][bj][m][0] + *(const f32x4*)(X1 + (size_t)row * DM + col), v1 = acc[ai][bj][m][1] + *(const f32x4*)(X1 + (size_t)row * DM + col + 4);
                        *(f32x4*)(out + (size_t)row * DM + col) = v0; *(f32x4*)(out + (size_t)row * DM + col + 4) = v1; } }
        } else {
            float* tp = tailp + (size_t)u.tail * 65536 + (wr * 64 + fr) * 256 + wc * 32 + 8 * fq;
#pragma unroll
            for (int ai = 0; ai < 2; ++ai)
#pragma unroll
                for (int m = 0; m < 4; ++m)
#pragma unroll
                    for (int bj = 0; bj < 2; ++bj) { float* p = tp + (ai * 128 + m * 16) * 256 + bj * 128; *(f32x4*)p = acc[ai][bj][m][0]; *(f32x4*)(p + 4) = acc[ai][bj][m][1]; }
        }
    }
};

template <class ColPtr>
__device__ __forceinline__ void transpose_item(const ColPtr& cp, int K, int srcN, bf16* WT, LAS float* scr, int kb, int nb, int lane) {
    const int k0 = 64 * kb, n0 = 64 * nb, kr = lane >> 4, n4 = (lane & 15) * 4;
    const float* src = cp(n0 + n4);
    f32x4 v[16];
#pragma unroll
    for (int i = 0; i < 16; ++i) v[i] = src ? *(const f32x4*)(src + (size_t)(k0 + 4 * i + kr) * srcN) : (f32x4){0.f, 0.f, 0.f, 0.f};
#pragma unroll
    for (int i = 0; i < 16; ++i) { LAS float* d = scr + (4 * i + kr) * 65 + n4; d[0] = v[i][0]; d[1] = v[i][1]; d[2] = v[i][2]; d[3] = v[i][3]; }
    asm volatile("s_waitcnt lgkmcnt(0)" ::: "memory");
    const int c = lane & 7;
#pragma unroll
    for (int j = 0; j < 8; ++j) { const int n = (lane >> 3) + 8 * j; const LAS float* s = scr + (8 * c) * 65 + n;
        u32x4 o; o.x = cvt_pk_bf16(s[0 * 65], s[1 * 65]); o.y = cvt_pk_bf16(s[2 * 65], s[3 * 65]); o.z = cvt_pk_bf16(s[4 * 65], s[5 * 65]); o.w = cvt_pk_bf16(s[6 * 65], s[7 * 65]);
        *(u32x4*)(WT + (size_t)(n0 + n) * K + k0 + 8 * c) = o; }
    asm volatile("s_waitcnt lgkmcnt(0)" ::: "memory");
}
struct ColWin { const float* W; __device__ __forceinline__ const float* operator()(int n) const {
    int c; if (n < 4096) c = n; else if (n < 7168) c = n + 8; else if (n < 11264) { const int l = n - 7168, q = l >> 8, w = l & 255; c = 7192 + (w < 128 ? 128 * q + w : 2048 + 128 * q + (w - 128)); } else if (n < 11272) c = 4096 + (n - 11264); else if (n < 11288) c = 7176 + (n - 11272); else return nullptr;
    return W + c; } };
struct ColPlain { const float* W; __device__ __forceinline__ const float* operator()(int n) const { return W + n; } };
struct ColUG { const float* Wu; const float* Wg; __device__ __forceinline__ const float* operator()(int n) const { const int pn = n >> 8, w = n & 255; return w < 128 ? Wu + pn * 128 + w : Wg + pn * 128 + (w - 128); } };

__device__ __forceinline__ void p0_prologue(const Args& a, LAS unsigned char* lds, int gwg, int nwgs, int mode) {
    int tid_ = threadIdx.x; asm volatile("" : "+v"(tid_));
    const int tid = tid_, lane = tid & 63, wave = __builtin_amdgcn_readfirstlane(tid >> 6);
    LAS float* scr = (LAS float*)(lds + wave * 16640);
    const int gw = gwg * NWAVES + wave, NGW = nwgs * NWAVES;
    unsigned char* ws = a.ws;
    constexpr int I_WIN_ = 32 * (NPROJ_PAD / 64), I_A = 16 * 32, I_O = 32 * 32, I_UG = 32 * (2 * DFF / 64), I_D = (DFF / 64) * 32;
    constexpr int NITEMS = I_WIN_ + 2 * I_A + I_O + I_UG + I_D;
    const int it0 = mode == 0 ? 0 : I_WIN_, it1 = mode == 0 ? I_WIN_ : NITEMS;
    for (int it = it0 + gw; it < it1; it += NGW) {
        int r = it;
        if (r < I_WIN_) { ColWin cp{a.in[I_WIN]}; const int nblk = NPROJ_PAD / 64; transpose_item(cp, DM, NIN, (bf16*)(ws + WS_WIN), scr, r / nblk, r % nblk, lane); continue; } r -= I_WIN_;
        if (r < I_A) { ColPlain cp{a.in[I_WA]}; transpose_item(cp, 1024, DM, (bf16*)(ws + WS_WA), scr, r / 32, r % 32, lane); continue; } r -= I_A;
        if (r < I_A) { ColPlain cp{a.in[I_WB]}; transpose_item(cp, 1024, DM, (bf16*)(ws + WS_WB), scr, r / 32, r % 32, lane); continue; } r -= I_A;
        if (r < I_O) { ColPlain cp{a.in[I_WO]}; transpose_item(cp, DM, DM, (bf16*)(ws + WS_WO), scr, r / 32, r % 32, lane); continue; } r -= I_O;
        if (r < I_UG) { ColUG cp{a.in[I_WUP], a.in[I_WGATE]}; const int nblk = 2 * DFF / 64; transpose_item(cp, DM, DFF, (bf16*)(ws + WS_WUG), scr, r / nblk, r % nblk, lane); continue; } r -= I_UG;
        { ColPlain cp{a.in[I_WDOWN]}; transpose_item(cp, DFF, DM, (bf16*)(ws + WS_WD), scr, r / 32, r % 32, lane); }
    }
    const float* nw = a.in[I_NMIX]; bf16* XN = (bf16*)(ws + WS_XN);
    if (mode == 0)
    for (int m = gw; m < MT; m += NGW) {
        const float* xrow = m < MP ? a.in[I_XP] + (size_t)m * DM : a.in[I_XS] + (size_t)(m - MP) * DM;
        f32x4 v[8]; float s = 0.f;
#pragma unroll
        for (int j = 0; j < 8; ++j) { v[j] = *(const f32x4*)(xrow + 4 * lane + 256 * j); s += dot4(v[j], v[j]); }
        const float r = rsqrtf(wave_sum(s) * (1.f / DM) + EPS);
#pragma unroll
        for (int j = 0; j < 8; ++j) { const f32x4 w = *(const f32x4*)(nw + 4 * lane + 256 * j); u32x2 o; o.x = cvt_pk_bf16(v[j][0] * r * w[0], v[j][1] * r * w[1]); o.y = cvt_pk_bf16(v[j][2] * r * w[2], v[j][3] * r * w[3]);
            *(u32x2*)(XN + (size_t)m * DM + 4 * lane + 256 * j) = o; }
    }
}

__device__ __forceinline__ void stage_v(LAS bf16* Vs, const bf16* P, int row0, int colbase, int tid) {
#pragma unroll
    for (int i = 0; i < 8; ++i) { const int idx = tid + NTHR * i, s = idx >> 5, p = idx & 31;
        *(LAS u32x4*)(Vs + s * 272 + p * 8) = *(const u32x4*)(P + (size_t)(row0 + s) * NPROJ + colbase + 8 * p); }
}
typedef short v4i16_t __attribute__((ext_vector_type(4)));
__device__ __forceinline__ u32x2 tr64(const LAS bf16* p) { return __builtin_bit_cast(u32x2, __builtin_amdgcn_ds_read_tr16_b64_v4i16((LAS v4i16_t*)p)); }
__device__ __forceinline__ bf16x8 tr_frag(const LAS bf16* img, int RS, int c0, int ks, int lane) {
    const int g = lane >> 4, q = (lane & 15) >> 2, p = lane & 3;
    const LAS bf16* a = img + (32 * ks + 4 * g + q) * RS + c0 + 4 * p;
    const u32x2 lo = tr64(a), hi = tr64(a + 16 * RS);
    u32x4 w; w.x = lo.x; w.y = lo.y; w.z = hi.x; w.w = hi.y;
    return __builtin_bit_cast(bf16x8, w);
}
__device__ __forceinline__ float wave_iscan_add(float v, int lane) {
#pragma unroll
    for (int o = 1; o < 64; o <<= 1) { const float t = __shfl_up(v, o); if (lane >= o) v += t; }
    return v;
}
__device__ __forceinline__ float wave_iscan_max(float v, int lane) {
#pragma unroll
    for (int o = 1; o < 64; o <<= 1) { const float t = __shfl_up(v, o); if (lane >= o) v = fmaxf(v, t); }
    return v;
}

__device__ __forceinline__ void gla_logdecay(const Args& a, const float* gates, int row0, int h, LAS float* galS, LAS float* segS, int tid, float (&la)[32], float& off, float& tot) {
    const int d = tid & 127, seg = tid >> 7;
    { const int t = tid >> 2, q = tid & 3; *(LAS f32x4*)(galS + t * 16 + q * 4) = *(const f32x4*)(gates + (size_t)(row0 + t) * 32 + 8 + q * 4); }
    float up[16];
#pragma unroll
    for (int j = 0; j < 16; ++j) up[j] = a.in[I_AUP][j * 512 + h * 128 + d];
    const float ab = a.in[I_AB][h * 128 + d];
    __syncthreads();
    float ssum = 0.f;
#pragma unroll
    for (int i = 0; i < 32; ++i) { const int t = seg * 32 + i; float z = ab;
#pragma unroll
        for (int q = 0; q < 4; ++q) { const f32x4 g = *(const LAS f32x4*)(galS + t * 16 + q * 4); z += g[0] * up[4 * q] + g[1] * up[4 * q + 1] + g[2] * up[4 * q + 2] + g[3] * up[4 * q + 3]; }
        la[i] = logsig(z) * (1.f / 16.f); ssum += la[i]; }
    segS[seg * 128 + d] = ssum;
    __syncthreads();
    off = 0.f; tot = 0.f;
#pragma unroll
    for (int s = 0; s < 4; ++s) { const float v = segS[s * 128 + d]; tot += v; off += (s < seg) ? v : 0.f; }
}

template <bool ML>
__device__ __forceinline__ void chunk_state(const Args& a, LAS unsigned char* lds, int bh, int c) {
    constexpr int DK = ML ? 256 : 128, NDT = DK / 16, RSK = DK + 16;
    int tid_ = threadIdx.x; asm volatile("" : "+v"(tid_));
    const int tid = tid_, lane = tid & 63, wave = __builtin_amdgcn_readfirstlane(tid >> 6), fr = lane & 15, fq = lane >> 4;
    const int b = bh >> 2, h = bh & 3, row0 = b * TP + c * 128, item = bh * NCH + c;
    unsigned char* ws = a.ws;
    const bf16* P = (const bf16*)(ws + WS_PROJ); const float* gates = (const float*)(ws + WS_GATES);
    LAS bf16* Ks = (LAS bf16*)lds; LAS bf16* Vs = (LAS bf16*)(lds + 69632); LAS float* sc = (LAS float*)(lds + 139264);
    __syncthreads();
    stage_v(Vs, P, row0, (ML ? C_MV : C_GV) + h * 256, tid);
    if (ML) {
        if (wave == 0) {
            const int t0 = 2 * lane;
            const float lf0 = logsig(gates[(size_t)(row0 + t0) * 32 + 4 + h] + a.in[I_BF][h]), lf1 = logsig(gates[(size_t)(row0 + t0 + 1) * 32 + 4 + h] + a.in[I_BF][h]);
            const float i0 = gates[(size_t)(row0 + t0) * 32 + h] + a.in[I_BI][h], i1 = gates[(size_t)(row0 + t0 + 1) * 32 + h] + a.in[I_BI][h];
            const float pr = lf0 + lf1, S = wave_iscan_add(pr, lane), ex = S - pr;
            const float ah0 = i0 - (ex + lf0), ah1 = i1 - S;
            const float Ah = wave_max(fmaxf(ah0, ah1));
            sc[t0] = __expf(ah0 - Ah) * (1.f / 16.f); sc[t0 + 1] = __expf(ah1 - Ah) * (1.f / 16.f);
            if (lane == 63) { float* chs = (float*)(ws + WS_CHS); chs[item * 2] = Ah; chs[item * 2 + 1] = S; }
        }
        __syncthreads();
#pragma unroll
        for (int i = 0; i < 8; ++i) { const int idx = tid + NTHR * i, s = idx >> 5, dp = idx & 31; const float w = sc[s];
            const u32x4 v = *(const u32x4*)(P + (size_t)(row0 + s) * NPROJ + C_MK + h * 256 + 8 * dp);
            u32x4 o; o.x = cvt_pk_bf16(bflo(v.x) * w, bfhi(v.x) * w); o.y = cvt_pk_bf16(bflo(v.y) * w, bfhi(v.y) * w); o.z = cvt_pk_bf16(bflo(v.z) * w, bfhi(v.z) * w); o.w = cvt_pk_bf16(bflo(v.w) * w, bfhi(v.w) * w);
            *(LAS u32x4*)(Ks + s * RSK + 8 * dp) = o; }
    } else {
        float la[32], off, tot;
        LAS float* galS = (LAS float*)(lds + 36864); gla_logdecay(a, gates, row0, h, galS, galS + 2048, tid, la, off, tot);
        const int d = tid & 127, seg = tid >> 7;
        if (seg == 0) ((float*)(ws + WS_BEND))[item * 128 + d] = tot;
        float bcur = off;
#pragma unroll
        for (int i = 0; i < 32; ++i) { const int t = seg * 32 + i; bcur += la[i];
            const float kv = bf2f(P[(size_t)(row0 + t) * NPROJ + C_GK + h * 128 + d]);
            Ks[t * RSK + d] = f2bf(kv * __expf(tot - bcur)); }
    }
    __syncthreads();
    f32x4 acc[2][NDT];
#pragma unroll
    for (int e = 0; e < 2; ++e)
#pragma unroll
        for (int d = 0; d < NDT; ++d) acc[e][d] = (f32x4){0.f, 0.f, 0.f, 0.f};
#pragma unroll
    for (int ks = 0; ks < 4; ++ks) {
        bf16x8 vb[2];
#pragma unroll
        for (int e = 0; e < 2; ++e) vb[e] = tr_frag(Vs, 272, wave * 32 + e * 16, ks, lane);
#pragma unroll
        for (int d = 0; d < NDT; ++d) { const bf16x8 ka = tr_frag(Ks, RSK, d * 16, ks, lane);
#pragma unroll
            for (int e = 0; e < 2; ++e) acc[e][d] = __builtin_amdgcn_mfma_f32_16x16x32_bf16(ka, vb[e], acc[e][d], 0, 0, 0); }
    }
    float* dst = (float*)(ws + (ML ? WS_DC : WS_DS)) + (size_t)item * 256 * DK;
#pragma unroll
    for (int e = 0; e < 2; ++e)
#pragma unroll
        for (int d = 0; d < NDT; ++d) *(f32x4*)(dst + (size_t)(wave * 32 + e * 16 + fr) * DK + d * 16 + 4 * fq) = acc[e][d];
    if (ML && tid < 256) { float s = 0.f;
#pragma unroll 16
        for (int i = 0; i < 128; ++i) s += bf2f(Ks[i * RSK + tid]);
        ((float*)(ws + WS_DN))[item * 256 + tid] = s; }
}

__device__ __forceinline__ void scan_mlstm(const Args& a, int j) {
    int tid_ = threadIdx.x; asm volatile("" : "+v"(tid_));
    const int tid = tid_, bh = j >> 5, eb = j & 31;
    unsigned char* ws = a.ws;
    const float* chs = (const float*)(ws + WS_CHS);
    const int e = eb * 8 + (tid >> 6), d4 = (tid & 63) * 4;
    const float* dC = (const float*)(ws + WS_DC) + (size_t)bh * NCH * 65536 + (size_t)e * 256 + d4;
    bf16* CT = (bf16*)(ws + WS_CT) + (size_t)bh * NCH * 65536 + (size_t)e * 256 + d4;
    f32x4 Cv = {0.f, 0.f, 0.f, 0.f}; float Fs = 0.f, Mp = 0.f;
    const bool do_n = (eb == 0 && tid < 256);
    float nv = 0.f;
    f32x4 dv[NCH];
#pragma unroll
    for (int c = 0; c < NCH; ++c) dv[c] = *(const f32x4*)(dC + (size_t)c * 65536);
#pragma unroll
    for (int c = 0; c < NCH; ++c) {
        u32x2 o; o.x = cvt_pk_bf16(Cv[0], Cv[1]); o.y = cvt_pk_bf16(Cv[2], Cv[3]); *(u32x2*)(CT + (size_t)c * 65536) = o;
        if (do_n) ((bf16*)(ws + WS_NPREV))[(bh * NCH + c) * 256 + tid] = f2bf(nv);
        const float Ah = chs[(bh * NCH + c) * 2], bt = chs[(bh * NCH + c) * 2 + 1];
        const float Ac = Ah - Fs, Mn = fmaxf(Mp, Ac), f1 = __expf(Mp - Mn), f2 = __expf(Ac - Mn);
        Cv = Cv * f1 + dv[c] * f2;
        if (do_n) nv = nv * f1 + ((const float*)(ws + WS_DN))[(bh * NCH + c) * 256 + tid] * f2;
        Mp = Mn; Fs += bt;
    }
    float* oC = a.out + O_PC + (size_t)bh * 65536;
#pragma unroll
    for (int i = 0; i < 4; ++i) oC[(size_t)(d4 + i) * 256 + e] = Cv[i];
    if (do_n) a.out[O_PN + bh * 256 + tid] = nv;
    if (eb == 0 && tid == 0) a.out[O_PM + bh] = Fs + Mp;
}
__device__ __forceinline__ void scan_gla(const Args& a, int j) {
    int tid_ = threadIdx.x; asm volatile("" : "+v"(tid_));
    const int tid = tid_, bh = j >> 4, eb = j & 15;
    unsigned char* ws = a.ws;
    const float* bend = (const float*)(ws + WS_BEND);
    const int ee = eb * 16 + (tid >> 5), d4 = (tid & 31) * 4;
    const float* dS = (const float*)(ws + WS_DS) + (size_t)bh * NCH * 32768 + (size_t)ee * 128 + d4;
    bf16* ST = (bf16*)(ws + WS_ST) + (size_t)bh * NCH * 32768 + (size_t)ee * 128 + d4;
    f32x4 Sv = {0.f, 0.f, 0.f, 0.f};
    f32x4 dv[NCH];
#pragma unroll
    for (int c = 0; c < NCH; ++c) dv[c] = *(const f32x4*)(dS + (size_t)c * 32768);
#pragma unroll
    for (int c = 0; c < NCH; ++c) {
        u32x2 o; o.x = cvt_pk_bf16(Sv[0], Sv[1]); o.y = cvt_pk_bf16(Sv[2], Sv[3]); *(u32x2*)(ST + (size_t)c * 32768) = o;
        const f32x4 be = *(const f32x4*)(bend + (bh * NCH + c) * 128 + d4);
        Sv[0] = Sv[0] * __expf(be[0]) + dv[c][0]; Sv[1] = Sv[1] * __expf(be[1]) + dv[c][1]; Sv[2] = Sv[2] * __expf(be[2]) + dv[c][2]; Sv[3] = Sv[3] * __expf(be[3]) + dv[c][3];
    }
    float* oS = a.out + O_PS + (size_t)bh * 32768;
#pragma unroll
    for (int i = 0; i < 4; ++i) oS[(size_t)(d4 + i) * 256 + ee] = Sv[i];
}

template <bool ML>
__device__ __forceinline__ void chunk_out(const Args& a, LAS unsigned char* lds, int bh, int c) {
    constexpr int DK = ML ? 256 : 128, QS = DK + 8, NKK = DK / 32;
    int tid_ = threadIdx.x; asm volatile("" : "+v"(tid_));
    const int tid = tid_, lane = tid & 63, wave = __builtin_amdgcn_readfirstlane(tid >> 6), fr = lane & 15, fq = lane >> 4;
    const int b = bh >> 2, h = bh & 3, row0 = b * TP + c * 128, item = bh * NCH + c;
    unsigned char* ws = a.ws;
    const bf16* P = (const bf16*)(ws + WS_PROJ); const float* gates = (const float*)(ws + WS_GATES);
    LAS bf16* Qs = (LAS bf16*)lds; LAS bf16* Ks = Qs + 128 * QS;
    LAS float* sc = (LAS float*)(lds + 143616);
    __syncthreads();
    if (ML) {
        if (wave == 0) {
            const float* chs = (const float*)(ws + WS_CHS);
            const float Ahc = lane < NCH ? chs[(bh * NCH + lane) * 2] : 0.f, btc = lane < NCH ? chs[(bh * NCH + lane) * 2 + 1] : 0.f;
            const float fsx = wave_iscan_add(btc, lane) - btc;
            const float Mp = fmaxf(0.f, wave_max(lane < c ? Ahc - fsx : -3.0e38f)), Fs = wave_sum(lane < c ? btc : 0.f);
            const int t0 = 2 * lane;
            const float lf0 = logsig(gates[(size_t)(row0 + t0) * 32 + 4 + h] + a.in[I_BF][h]), lf1 = logsig(gates[(size_t)(row0 + t0 + 1) * 32 + 4 + h] + a.in[I_BF][h]);
            const float i0 = gates[(size_t)(row0 + t0) * 32 + h] + a.in[I_BI][h], i1 = gates[(size_t)(row0 + t0 + 1) * 32 + h] + a.in[I_BI][h];
            const float pr = lf0 + lf1, S = wave_iscan_add(pr, lane), b0 = S - lf1, b1 = S;
            const float a0 = i0 - b0 - Fs, a1 = i1 - b1 - Fs;
            const float cm = wave_iscan_max(fmaxf(a0, a1), lane); float exm = __shfl_up(cm, 1); if (lane == 0) exm = -3.0e38f;
            const float M0 = fmaxf(fmaxf(Mp, exm), a0), M1 = fmaxf(M0, a1);
            sc[t0] = a0; sc[t0 + 1] = a1; sc[128 + t0] = M0; sc[128 + t0 + 1] = M1; sc[256 + t0] = __expf(Mp - M0); sc[256 + t0 + 1] = __expf(Mp - M1);
            sc[384 + t0] = __expf(-(Fs + b0 + M0)); sc[384 + t0 + 1] = __expf(-(Fs + b1 + M1));
        }
#pragma unroll
        for (int i = 0; i < 8; ++i) { const int idx = tid + NTHR * i, t = idx >> 5, p = idx & 31;
            *(LAS u32x4*)(Qs + t * QS + p * 8) = *(const u32x4*)(P + (size_t)(row0 + t) * NPROJ + C_MQ + h * 256 + p * 8);
            *(LAS u32x4*)(Ks + t * QS + p * 8) = *(const u32x4*)(P + (size_t)(row0 + t) * NPROJ + C_MK + h * 256 + p * 8); }
    } else {
        float la[32], off, tot;
        LAS float* galS = (LAS float*)(lds + 69632); LAS float* segS = galS + 128 * 16;
        gla_logdecay(a, gates, row0, h, galS, segS, tid, la, off, tot);
        const int d = tid & 127, seg = tid >> 7;
        float bcur = off;
#pragma unroll
        for (int i = 0; i < 32; ++i) { const int t = seg * 32 + i; bcur += la[i];
            const float qv = bf2f(P[(size_t)(row0 + t) * NPROJ + C_GQ + h * 128 + d]), kv = bf2f(P[(size_t)(row0 + t) * NPROJ + C_GK + h * 128 + d]);
            Qs[t * QS + d] = f2bf(qv * 0.08838834764831845f * __expf(bcur)); Ks[t * QS + d] = f2bf(kv * __expf(-bcur)); }
    }
    __syncthreads();
    constexpr int NCP = ML ? 16 : 8;
    u32x4 cpre[NCP]; u32x4 npre = {0u, 0u, 0u, 0u};
    if (ML) { const bf16* CT = (const bf16*)(ws + WS_CT) + (size_t)item * 65536;
#pragma unroll
        for (int i = 0; i < NCP; ++i) { const int idx = tid + NTHR * i, e = idx >> 5, p = idx & 31; cpre[i] = *(const u32x4*)(CT + (size_t)e * 256 + p * 8); }
        if (tid < 32) npre = *(const u32x4*)((const bf16*)(ws + WS_NPREV) + (size_t)item * 256 + tid * 8);
    } else { const bf16* ST = (const bf16*)(ws + WS_ST) + (size_t)item * 32768;
#pragma unroll
        for (int i = 0; i < NCP; ++i) { const int idx = tid + NTHR * i, e = idx >> 4, p = idx & 15; cpre[i] = *(const u32x4*)(ST + (size_t)e * 128 + p * 8); }
    }
    bf16x8 qf[NKK];
#pragma unroll
    for (int kk = 0; kk < NKK; ++kk) qf[kk] = *(const LAS bf16x8*)(Qs + (wave * 16 + fr) * QS + kk * 32 + fq * 8);
    const int t = wave * 16 + fr;
    u32x2 pb[8]; float den = 0.f;
    {
        const float Mt = ML ? sc[128 + t] : 0.f;
#pragma unroll
        for (int st = 0; st < 8; ++st) { f32x4 s = {0.f, 0.f, 0.f, 0.f};
#pragma unroll
            for (int kk = 0; kk < NKK; ++kk) { const bf16x8 kf = *(const LAS bf16x8*)(Ks + (st * 16 + fr) * QS + kk * 32 + fq * 8); s = __builtin_amdgcn_mfma_f32_16x16x32_bf16(kf, qf[kk], s, 0, 0, 0); }
            float p[4];
            f32x4 as4 = {0.f, 0.f, 0.f, 0.f}; if (ML) as4 = *(const LAS f32x4*)(sc + st * 16 + 4 * fq);
#pragma unroll
            for (int r = 0; r < 4; ++r) { const int si = st * 16 + 4 * fq + r;
                const float e = ML ? s[r] * (1.f / 16.f) * __expf(fminf(as4[r] - Mt, 0.f)) : s[r];
                p[r] = (si <= t) ? e : 0.f;
                den += p[r]; }
            pb[st].x = cvt_pk_bf16(p[0], p[1]); pb[st].y = cvt_pk_bf16(p[2], p[3]);
            __builtin_amdgcn_sched_barrier(0); }
    }
    __syncthreads();
    LAS bf16* Cl = (LAS bf16*)lds;
    if (ML) {
#pragma unroll
        for (int i = 0; i < NCP; ++i) { const int idx = tid + NTHR * i, e = idx >> 5, p = idx & 31; *(LAS u32x4*)(Cl + e * QS + p * 8) = cpre[i]; }
        { const int e = tid >> 5, p = tid & 31; *(LAS u32x4*)(Cl + (256 + e) * QS + p * 8) = npre; }
    } else {
#pragma unroll
        for (int i = 0; i < NCP; ++i) { const int idx = tid + NTHR * i, e = idx >> 4, p = idx & 15; *(LAS u32x4*)(Cl + e * QS + p * 8) = cpre[i]; }
    }
    u32x4 vpre[8];
#pragma unroll
    for (int i = 0; i < 8; ++i) { const int idx = tid + NTHR * i, sr = idx >> 5, p = idx & 31; vpre[i] = *(const u32x4*)(P + (size_t)(row0 + sr) * NPROJ + (ML ? C_MV : C_GV) + h * 256 + 8 * p); }
    __syncthreads();
    f32x4 acc[16];
#pragma unroll
    for (int et = 0; et < 16; ++et) { acc[et] = (f32x4){0.f, 0.f, 0.f, 0.f};
#pragma unroll
        for (int kk = 0; kk < NKK; ++kk) { const bf16x8 cf = *(const LAS bf16x8*)(Cl + (et * 16 + fr) * QS + kk * 32 + fq * 8); acc[et] = __builtin_amdgcn_mfma_f32_16x16x32_bf16(cf, qf[kk], acc[et], 0, 0, 0); }
        if ((et & 1) == 1) __builtin_amdgcn_sched_barrier(0); }
    float wint = 1.f, qn = 0.f;
    if (ML) {
        f32x4 dn = {0.f, 0.f, 0.f, 0.f};
#pragma unroll
        for (int kk = 0; kk < NKK; ++kk) { const bf16x8 nf = *(const LAS bf16x8*)(Cl + (256 + fr) * QS + kk * 32 + fq * 8); dn = __builtin_amdgcn_mfma_f32_16x16x32_bf16(nf, qf[kk], dn, 0, 0, 0); }
        qn = __shfl(dn[0], fr);
        wint = sc[256 + t];
#pragma unroll
        for (int et = 0; et < 16; ++et) acc[et] = acc[et] * wint;
    }
    __syncthreads();
    LAS bf16* Vs = (LAS bf16*)lds;
#pragma unroll
    for (int i = 0; i < 8; ++i) { const int idx = tid + NTHR * i, sr = idx >> 5, p = idx & 31; *(LAS u32x4*)(Vs + sr * 272 + p * 8) = vpre[i]; }
    __syncthreads();
#pragma unroll
    for (int ks = 0; ks < 4; ++ks) {
        u32x4 pw; pw.x = pb[2 * ks].x; pw.y = pb[2 * ks].y; pw.z = pb[2 * ks + 1].x; pw.w = pb[2 * ks + 1].y;
        const bf16x8 pf = __builtin_bit_cast(bf16x8, pw);
#pragma unroll
        for (int et = 0; et < 16; ++et) { acc[et] = __builtin_amdgcn_mfma_f32_16x16x32_bf16(tr_frag(Vs, 272, et * 16, ks, lane), pf, acc[et], 0, 0, 0); if ((et & 3) == 3) __builtin_amdgcn_sched_barrier(0); }
    }
    float inv = 1.f;
    if (ML) { den += __shfl_xor(den, 16); den += __shfl_xor(den, 32); den += wint * qn; inv = 1.f / fmaxf(fabsf(den), sc[384 + t]); }
    float ss = 0.f;
#pragma unroll
    for (int et = 0; et < 16; ++et) { acc[et] = acc[et] * inv; ss += dot4(acc[et], acc[et]); }
    ss += __shfl_xor(ss, 16); ss += __shfl_xor(ss, 32);
    const float rn = rsqrtf(ss * (1.f / 256.f) + EPS);
    const float* hw = a.in[ML ? I_MHW : I_GHW] + h * 256;
    const bf16* gp = P + (size_t)(row0 + t) * NPROJ + (ML ? C_MO : C_GR) + h * 256;
    bf16* yp = (bf16*)(ws + (ML ? WS_YM : WS_YG)) + (size_t)(row0 + t) * 1024 + h * 256;
#pragma unroll
    for (int et = 0; et < 16; ++et) { const int e = et * 16 + 4 * fq;
        const u32x2 gw = *(const u32x2*)(gp + e); const f32x4 w = *(const f32x4*)(hw + e);
        const float g0 = bflo(gw.x), g1 = bfhi(gw.x), g2 = bflo(gw.y), g3 = bfhi(gw.y);
        float o0 = acc[et][0] * rn * w[0], o1 = acc[et][1] * rn * w[1], o2 = acc[et][2] * rn * w[2], o3 = acc[et][3] * rn * w[3];
        if (ML) { o0 *= sigm(g0); o1 *= sigm(g1); o2 *= sigm(g2); o3 *= sigm(g3); } else { o0 *= g0 * sigm(g0); o1 *= g1 * sigm(g1); o2 *= g2 * sigm(g2); o3 *= g3 * sigm(g3); }
        u32x2 o; o.x = cvt_pk_bf16(o0, o1); o.y = cvt_pk_bf16(o2, o3); *(u32x2*)(yp + e) = o;
        if ((et & 3) == 3) __builtin_amdgcn_sched_barrier(0); }
}

template <bool ML>
__device__ __forceinline__ void sample_item(const Args& a, LAS unsigned char* lds, int b, int h) {
    constexpr int DK = ML ? 256 : 128;
    int tid_ = threadIdx.x; asm volatile("" : "+v"(tid_));
    const int tid = tid_, lane = tid & 63, wave = __builtin_amdgcn_readfirstlane(tid >> 6);
    unsigned char* ws = a.ws;
    const bf16* P = (const bf16*)(ws + WS_PROJ); const float* gates = (const float*)(ws + WS_GATES);
    const int row0 = MP + b * 8, bh = b * 4 + h;
    LAS float* qT = (LAS float*)lds;
    LAS float* wkT = qT + 2048;
    LAS float* kT = wkT + 2048;
    LAS float* vS = kT + 2048;
    LAS float* red = vS + 2048;
    LAS float* sm = red + 16384;
    const float* C0 = a.in[ML ? I_C : I_S] + (size_t)bh * DK * 256;
    float* C1 = a.out + (ML ? O_SC : O_SS) + (size_t)bh * DK * 256;
    f32x4 nx[8];
#pragma unroll
    for (int j = 0; j < 8; ++j) nx[j] = __builtin_nontemporal_load((const f32x4*)(C0 + (size_t)(wave + 8 * j) * 256 + 4 * lane));
    __syncthreads();
    float aS[8], Mt[8], bS[8]; float m0 = 0.f, dec = 1.f;
    if (ML) {
        m0 = a.in[I_M][bh]; float bs = 0.f, M = m0;
#pragma unroll
        for (int t = 0; t < 8; ++t) { const float mi = gates[(size_t)(row0 + t) * 32 + h], mf = gates[(size_t)(row0 + t) * 32 + 4 + h];
            bs += logsig(mf + a.in[I_BF][h]); bS[t] = bs; aS[t] = mi + a.in[I_BI][h] - bs; M = fmaxf(M, aS[t]); Mt[t] = M; }
        dec = __expf(m0 - Mt[7]);
        if (tid == 0) {
#pragma unroll
            for (int t = 0; t < 8; ++t) { sm[200 + t] = aS[t]; sm[208 + t] = Mt[t]; sm[216 + t] = bS[t]; } }
        if (tid < 256) { const int d = tid;
#pragma unroll
            for (int t = 0; t < 8; ++t) { const float qv = bf2f(P[(size_t)(row0 + t) * NPROJ + C_MQ + h * 256 + d]), kv = bf2f(P[(size_t)(row0 + t) * NPROJ + C_MK + h * 256 + d]) * (1.f / 16.f);
                qT[d * 8 + t] = qv; kT[d * 8 + t] = kv; wkT[d * 8 + t] = kv * __expf(aS[t] - Mt[7]); } }
    } else {
        if (tid < 128) { const int d = tid; float up[16];
#pragma unroll
            for (int j = 0; j < 16; ++j) up[j] = a.in[I_AUP][j * 512 + h * 128 + d];
            const float ab = a.in[I_AB][h * 128 + d];
            float bc[8]; float bs = 0.f;
#pragma unroll
            for (int t = 0; t < 8; ++t) { float z = ab;
#pragma unroll
                for (int j = 0; j < 16; ++j) z += gates[(size_t)(row0 + t) * 32 + 8 + j] * up[j];
                bs += logsig(z) * (1.f / 16.f); bc[t] = bs; }
            sm[72 + d] = __expf(bs);
#pragma unroll
            for (int t = 0; t < 8; ++t) { const float qv = bf2f(P[(size_t)(row0 + t) * NPROJ + C_GQ + h * 128 + d]), kv = bf2f(P[(size_t)(row0 + t) * NPROJ + C_GK + h * 128 + d]);
                qT[d * 8 + t] = qv * 0.08838834764831845f * __expf(bc[t]); kT[d * 8 + t] = kv * __expf(-bc[t]); wkT[d * 8 + t] = kv * __expf(bs - bc[t]); } }
    }
    { const int t = tid >> 6; const u32x2 w = *(const u32x2*)(P + (size_t)(row0 + t) * NPROJ + (ML ? C_MV : C_GV) + h * 256 + 4 * lane);
      *(LAS f32x4*)(vS + t * 256 + 4 * lane) = (f32x4){bflo(w.x), bfhi(w.x), bflo(w.y), bfhi(w.y)}; }
    __syncthreads();
    float prow, qn = 0.f;
    { const int s8 = lane & 7, part = lane >> 3; float sd = 0.f;
#pragma unroll 8
      for (int i = 0; i < DK / 8; ++i) { const int d = 8 * i + part; sd += qT[d * 8 + wave] * kT[d * 8 + s8]; }
      sd += __shfl_xor(sd, 8); sd += __shfl_xor(sd, 16); sd += __shfl_xor(sd, 32);
      if (ML) prow = (s8 <= wave) ? sd * __expf(sm[200 + s8] - sm[208 + wave]) : 0.f; else prow = (s8 <= wave) ? sd : 0.f; }
    if (ML) { const float* n0 = a.in[I_N] + (size_t)bh * 256; float sd = 0.f;
#pragma unroll
      for (int i = 0; i < 4; ++i) { const int d = lane + 64 * i; sd += qT[d * 8 + wave] * n0[d]; }
      qn = wave_sum(sd); }
    f32x4 v[8], acc[8];
#pragma unroll
    for (int s = 0; s < 8; ++s) { v[s] = *(const LAS f32x4*)(vS + s * 256 + 4 * lane); acc[s] = (f32x4){0.f, 0.f, 0.f, 0.f}; }
#pragma unroll
    for (int bt = 0; bt < DK / 64; ++bt) {
        f32x4 cur[8];
#pragma unroll
        for (int j = 0; j < 8; ++j) cur[j] = nx[j];
        if (bt + 1 < DK / 64) {
#pragma unroll
            for (int j = 0; j < 8; ++j) nx[j] = __builtin_nontemporal_load((const f32x4*)(C0 + (size_t)(wave + 8 * (8 * (bt + 1) + j)) * 256 + 4 * lane)); }
#pragma unroll
        for (int j = 0; j < 8; ++j) { const int d = wave + 8 * (8 * bt + j); const f32x4 cv = cur[j];
            const f32x4 q0 = *(const LAS f32x4*)(qT + d * 8), q1 = *(const LAS f32x4*)(qT + d * 8 + 4), k0 = *(const LAS f32x4*)(wkT + d * 8), k1 = *(const LAS f32x4*)(wkT + d * 8 + 4);
            const float dd = ML ? dec : sm[72 + d];
            acc[0] += cv * q0[0]; acc[1] += cv * q0[1]; acc[2] += cv * q0[2]; acc[3] += cv * q0[3]; acc[4] += cv * q1[0]; acc[5] += cv * q1[1]; acc[6] += cv * q1[2]; acc[7] += cv * q1[3];
            f32x4 cn = cv * dd;
            cn += v[0] * k0[0]; cn += v[1] * k0[1]; cn += v[2] * k0[2]; cn += v[3] * k0[3]; cn += v[4] * k1[0]; cn += v[5] * k1[1]; cn += v[6] * k1[2]; cn += v[7] * k1[3];
            __builtin_nontemporal_store(cn, (f32x4*)(C1 + (size_t)d * 256 + 4 * lane)); }
    }
#pragma unroll
    for (int s = 0; s < 8; ++s) *(LAS f32x4*)(red + (wave * 8 + s) * 256 + 4 * lane) = acc[s];
    __syncthreads();
    const int t = wave;
    f32x4 qc = {0.f, 0.f, 0.f, 0.f};
#pragma unroll
    for (int w = 0; w < 8; ++w) qc += *(const LAS f32x4*)(red + (w * 8 + t) * 256 + 4 * lane);
    float wint = 1.f, den = 0.f, Mtt = 0.f, btt = 0.f;
    if (ML) { Mtt = sm[208 + t]; btt = sm[216 + t]; wint = __expf(m0 - Mtt); }
    f32x4 num = qc * wint;
#pragma unroll
    for (int s = 0; s < 8; ++s) { const float p = __shfl(prow, s); num += v[s] * p; den += p; }
    if (ML) { den += wint * qn; const float fl = fmaxf(fabsf(den), __expf(-(btt + Mtt))); num = num * (1.f / fl); }
    const float rn = rsqrtf(wave_sum(dot4(num, num)) * (1.f / 256.f) + EPS);
    const f32x4 w = *(const f32x4*)(a.in[ML ? I_MHW : I_GHW] + h * 256 + 4 * lane);
    const u32x2 gw = *(const u32x2*)(P + (size_t)(row0 + t) * NPROJ + (ML ? C_MO : C_GR) + h * 256 + 4 * lane);
    const float g0 = bflo(gw.x), g1 = bfhi(gw.x), g2 = bflo(gw.y), g3 = bfhi(gw.y);
    float o0 = num[0] * rn * w[0], o1 = num[1] * rn * w[1], o2 = num[2] * rn * w[2], o3 = num[3] * rn * w[3];
    if (ML) { o0 *= sigm(g0); o1 *= sigm(g1); o2 *= sigm(g2); o3 *= sigm(g3); } else { o0 *= g0 * sigm(g0); o1 *= g1 * sigm(g1); o2 *= g2 * sigm(g2); o3 *= g3 * sigm(g3); }
    u32x2 o; o.x = cvt_pk_bf16(o0, o1); o.y = cvt_pk_bf16(o2, o3);
    *(u32x2*)((bf16*)(ws + (ML ? WS_YM : WS_YG)) + (size_t)(row0 + t) * 1024 + h * 256 + 4 * lane) = o;
    if (ML) {
        if (tid < 256) { float s = dec * a.in[I_N][(size_t)bh * 256 + tid];
#pragma unroll
            for (int q = 0; q < 8; ++q) s += wkT[tid * 8 + q];
            a.out[O_SN + (size_t)bh * 256 + tid] = s; }
        if (tid == 0) a.out[O_SM + bh] = bS[7] + Mt[7];
    }
}

__device__ __forceinline__ void merge_reduce(const Args& a, int vcu, int G) {
    int tid_ = threadIdx.x; asm volatile("" : "+v"(tid_));
    const int tid = tid_, lane = tid & 63, wave = tid >> 6;
    const float* tailp = a.out + O_YP; bf16* O = (bf16*)(a.ws + WS_XN);
    for (int rr = vcu * NWAVES + wave; rr < MS; rr += G * NWAVES) { const int m = MP + rr, pmo = rr >> 8;
#pragma unroll
        for (int j = 0; j < 8; ++j) { const float* tp = tailp + (size_t)(pmo * 8 + j) * 8 * 65536 + (rr & 255) * 256 + 4 * lane;
            f32x4 v = *(const f32x4*)tp;
#pragma unroll
            for (int sl = 1; sl < 8; ++sl) v += *(const f32x4*)(tp + (size_t)sl * 65536);
            u32x2 o; o.x = cvt_pk_bf16(v[0], v[1]); o.y = cvt_pk_bf16(v[2], v[3]); *(u32x2*)(O + (size_t)m * DM + 4 * lane + 256 * j) = o; }
    }
}
__device__ __forceinline__ void rstd_phase(const Args& a, int vcu, int G) {
    int tid_ = threadIdx.x; asm volatile("" : "+v"(tid_));
    const int tid = tid_, lane = tid & 63, wave = tid >> 6;
    const float* part = (const float*)(a.ws + WS_PART); float* rstd = (float*)(a.ws + WS_RSTD);
    const bool split = (G == 256); const int nplain = split ? MP : MT;
    for (int row = vcu * NTHR + tid; row < nplain; row += G * NTHR) { float s = 0.f;
#pragma unroll
        for (int i = 0; i < 8; ++i) s += sum4(*(const f32x4*)(part + (size_t)row * 32 + 4 * i));
        rstd[row] = rsqrtf(s * (1.f / DM) + EPS); }
    if (split) {
        const float* tailp = (const float*)(a.ws + WS_PROJ); const float* nw = a.in[I_NFFN]; float* X1 = (float*)(a.ws + WS_X1); bf16* X1W = (bf16*)(a.ws + WS_X1W);
        for (int rr = vcu * NWAVES + wave; rr < MS; rr += G * NWAVES) { const int m = MP + rr, pmo = rr >> 8;
            f32x4 v[8]; float ss = 0.f;
#pragma unroll
            for (int j = 0; j < 8; ++j) { v[j] = *(const f32x4*)(a.in[I_XS] + (size_t)rr * DM + 4 * lane + 256 * j);
                const float* tp = tailp + (size_t)(pmo * 8 + j) * 8 * 65536 + (rr & 255) * 256 + 4 * lane;
#pragma unroll
                for (int sl = 0; sl < 8; ++sl) v[j] += *(const f32x4*)(tp + (size_t)sl * 65536);
                ss += dot4(v[j], v[j]); }
            ss = wave_sum(ss);
            if (lane == 0) rstd[m] = rsqrtf(ss * (1.f / DM) + EPS);
#pragma unroll
            for (int j = 0; j < 8; ++j) { const f32x4 w = *(const f32x4*)(nw + 4 * lane + 256 * j);
                *(f32x4*)(X1 + (size_t)m * DM + 4 * lane + 256 * j) = v[j];
                u32x2 o; o.x = cvt_pk_bf16(v[j][0] * w[0], v[j][1] * w[1]); o.y = cvt_pk_bf16(v[j][2] * w[2], v[j][3] * w[3]);
                *(u32x2*)(X1W + (size_t)m * DM + 4 * lane + 256 * j) = o; }
        }
    }
}
__device__ __forceinline__ void act_fixup(const Args& a, int vcu, int G) {
    unsigned char* ws = a.ws; const float* ub = (const float*)(ws + WS_U); bf16* ACT = (bf16*)(ws + WS_G);
    const float* cw = a.in[I_CW]; const float* cb = a.in[I_CB];
    int tid_ = threadIdx.x; asm volatile("" : "+v"(tid_));
    for (int idx = vcu * NTHR + tid_; idx < 28 * DFF; idx += G * NTHR) {
        const int k = idx / DFF, col = idx % DFF, pm = (k / 7) * 8 + 1 + (k % 7);
        const float um2 = ub[((size_t)(pm - 1) * 6 + 0) * DFF + col], um1 = ub[((size_t)(pm - 1) * 6 + 1) * DFF + col];
        const float u0 = ub[((size_t)pm * 6 + 2) * DFF + col], u1 = ub[((size_t)pm * 6 + 3) * DFF + col], g0 = ub[((size_t)pm * 6 + 4) * DFF + col], g1 = ub[((size_t)pm * 6 + 5) * DFF + col];
        const float c0 = cw[col], c1 = cw[DFF + col], c2 = cw[2 * DFF + col], bb = cb[col];
        ACT[(size_t)(pm * 256) * DFF + col] = f2bf(gelu_tanh(bb + c0 * um2 + c1 * um1 + c2 * u0) * g0);
        ACT[(size_t)(pm * 256 + 1) * DFF + col] = f2bf(gelu_tanh(bb + c0 * um1 + c1 * u0 + c2 * u1) * g1);
    }
}
__device__ __forceinline__ void final_norm(const Args& a, int vcu, int G) {
    int tid_ = threadIdx.x; asm volatile("" : "+v"(tid_));
    const int tid = tid_, lane = tid & 63, wave = tid >> 6;
    const float* fw = a.in[I_FNW]; const float* X1 = (const float*)(a.ws + WS_X1); const float* tailp = (const float*)(a.ws + WS_U);
    const bool split = (G == 256);
    int tpm = -1, tpn = -1;
    if (split && lane < 32) { pg8::StaticOrder S; S.init(MT, DM, G, 0); pg8::Unit u; if (S.at(256 + lane, u)) { tpm = u.pm; tpn = u.pn; } }
    for (int m = vcu * NWAVES + wave; m < MT; m += G * NWAVES) {
        const int pm = m >> 8;
        float* row = a.out + (size_t)m * DM;
        f32x4 v[8]; float ss = 0.f;
#pragma unroll
        for (int j = 0; j < 8; ++j) {
            const unsigned long long mask = __ballot(tpm == pm && tpn == j);
            if (mask == 0ull) v[j] = *(const f32x4*)(row + 4 * lane + 256 * j);
            else { const int tt = __ffsll((long long)mask) - 1;
                v[j] = *(const f32x4*)(X1 + (size_t)m * DM + 4 * lane + 256 * j);
                const float* tp = tailp + (size_t)tt * 8 * 65536 + (m & 255) * 256 + 4 * lane;
#pragma unroll
                for (int sl = 0; sl < 8; ++sl) v[j] += *(const f32x4*)(tp + (size_t)sl * 65536); }
            ss += dot4(v[j], v[j]); }
        const float r = rsqrtf(wave_sum(ss) * (1.f / DM) + EPS);
#pragma unroll
        for (int j = 0; j < 8; ++j) { const f32x4 w = *(const f32x4*)(fw + 4 * lane + 256 * j);
            *(f32x4*)(row + 4 * lane + 256 * j) = (f32x4){v[j][0] * r * w[0], v[j][1] * r * w[1], v[j][2] * r * w[2], v[j][3] * r * w[3]}; }
    }
}

#define XB_TMO      128
#define XB_XCNT(j)  (256  + 64 * (j))
#define XB_XSUB(j)  (1280 + 64 * (j))
#define XB_XGEN(j)  (2304 + 64 * (j))
#define XB_TOP      3328
#define XB_TOPGEN   3392
#define XCD_BAR_WORDS 3456
#define XB_SPIN_CAP (1u << 18)

__device__ __forceinline__ unsigned xb_ld(unsigned* p)              { return __hip_atomic_load(p, __ATOMIC_RELAXED, __HIP_MEMORY_SCOPE_AGENT); }
__device__ __forceinline__ unsigned xb_add(unsigned* p, unsigned v) { return __hip_atomic_fetch_add(p, v, __ATOMIC_RELAXED, __HIP_MEMORY_SCOPE_AGENT); }
__device__ __forceinline__ unsigned xb_xcc_id() { return (unsigned)__builtin_amdgcn_s_getreg((3 << 11) | 20) & 0xFu; }
#define XB_SPIN(cond, bar) do { unsigned _sp = 0; while (cond) { __builtin_amdgcn_s_sleep(1); \
    if ((++_sp & 255u) == 0u) { if (xb_ld(&(bar)[XB_TMO])) break; if (_sp > XB_SPIN_CAP) { atomicAdd(&(bar)[XB_TMO], 1u); break; } } } } while (0)

struct XcdBarrier {
    unsigned* bar; unsigned x;
    volatile LAS unsigned* st;
};

__device__ __forceinline__ XcdBarrier xcd_barrier_post(unsigned* bar, volatile LAS unsigned* st) {
    XcdBarrier b; b.bar = bar; b.x = xb_xcc_id(); b.st = st;
    if (threadIdx.x == 0) (void)xb_add(&bar[XB_XCNT(b.x)], 1u);
    return b;
}
__device__ __forceinline__ void xcd_barrier_complete(unsigned* bar, unsigned x, unsigned& nloc, unsigned& nx) {
    const unsigned G = gridDim.x * gridDim.y * gridDim.z;
    unsigned sum, cnt, mine, sp = 0u;
    for (;;) {
        sum = 0u; cnt = 0u; mine = 0u;
#pragma unroll
        for (unsigned j = 0; j < 16; ++j) { const unsigned c = xb_ld(&bar[XB_XCNT(j)]); sum += c; cnt += (c > 0u) ? 1u : 0u; mine = (j == x) ? c : mine; }
        if (sum == G) break;
        __builtin_amdgcn_s_sleep(1);
        if ((++sp & 255u) == 0u) { if (xb_ld(&bar[XB_TMO])) break; if (sp > XB_SPIN_CAP) { atomicAdd(&bar[XB_TMO], 1u); break; } }
    }
    nloc = mine > 0u ? mine : 1u; nx = cnt > 0u ? cnt : 1u;
}

__device__ __forceinline__ void xcd_barrier(const XcdBarrier& b) {
    asm volatile("s_waitcnt vmcnt(0)" ::: "memory");
    __syncthreads();
    if (threadIdx.x == 0) {
        unsigned* bar = b.bar;
        __builtin_amdgcn_s_waitcnt(0);
        unsigned nloc = b.st[0], nx = b.st[1];
        if (nloc == 0u) { xcd_barrier_complete(bar, b.x, nloc, nx); b.st[0] = nloc; b.st[1] = nx; }
        const unsigned old = xb_add(&bar[XB_XSUB(b.x)], 1u);
        const unsigned gen = old / nloc;
        if (old + 1u == (gen + 1u) * nloc) {
            __builtin_amdgcn_fence(__ATOMIC_RELEASE, "agent");
            asm volatile("s_waitcnt vmcnt(0)" ::: "memory");
            const unsigned og = xb_add(&bar[XB_TOP], 1u);
            const unsigned tg = og / nx;
            if (og + 1u == (tg + 1u) * nx) xb_add(&bar[XB_TOPGEN], 1u);
            else XB_SPIN(xb_ld(&bar[XB_TOPGEN]) == tg, bar);
            __builtin_amdgcn_fence(__ATOMIC_ACQUIRE, "agent");
            xb_add(&bar[XB_XGEN(b.x)], 1u);
            asm volatile("s_waitcnt vmcnt(0)" ::: "memory");
        } else {
            XB_SPIN(xb_ld(&bar[XB_XGEN(b.x)]) == gen, bar);
            __builtin_amdgcn_fence(__ATOMIC_ACQUIRE, "agent");
            asm volatile("s_waitcnt vmcnt(0)" ::: "memory");
        }
    }
    __syncthreads();
}

constexpr int N_PHASES = 12;
__global__ void __launch_bounds__(NTHR) fwd_kernel(Args args) {
    extern __shared__ __attribute__((aligned(16))) unsigned char lds_raw[];
    LAS unsigned char* lds = (LAS unsigned char*)lds_raw;
    cg::grid_group grid = cg::this_grid();
    volatile LAS unsigned* bst = (volatile LAS unsigned*)(lds + LDS_BYTES - 16);
    if (threadIdx.x < 4) bst[threadIdx.x] = 0u;
    __syncthreads();
    XcdBarrier xbar = xcd_barrier_post((unsigned*)args.ws, bst);
    const int G = gridDim.x, bx = blockIdx.x;
    const int vcu = (G % 8 == 0) ? (bx % 8) * (G / 8) + bx / 8 : bx;
    const int lo = args.ph_lo, hi = args.ph_hi;
    unsigned char* ws = args.ws;
#ifndef USE_CG_SYNC
#define USE_CG_SYNC 0
#endif
#ifndef DOUBLE_MASK
#define DOUBLE_MASK 0
#endif
#define REP(k) for (int rep_ = 0; rep_ < 1 + ((DOUBLE_MASK >> (k)) & 1); ++rep_)
#ifndef DBL_P2
#define DBL_P2 0
#endif
#ifndef BIS
#define BIS 15
#endif
#ifndef PHASE_MASK
#define PHASE_MASK 0xfff
#endif
#define IN(k) (((PHASE_MASK >> (k)) & 1) && lo <= (k) && (k) < hi)
#define SEAM(k) do { if (IN(k) && IN((k) + 1)) { if (USE_CG_SYNC || lo < 0) grid.sync(); else xcd_barrier(xbar); } } while (0)
    if (IN(0)) REP(0) { p0_prologue(args, lds, vcu, G, 0); __syncthreads(); }
    SEAM(0);
    if (IN(1)) REP(1) {
        pg8::Gemm g{(const bf16*)(ws + WS_XN), (const bf16*)(ws + WS_WIN), nullptr, nullptr, MT, NPROJ_PAD, DM}; pg8::StaticOrder S; S.init(MT, NPROJ_PAD, G, bx);
        EpiProj E{(bf16*)(ws + WS_PROJ), (float*)(ws + WS_GATES)};
        pg8::gemm_phase<EpiProj, pg8::StaticOrder, true, true>(lds, g, S, E);
        { const int rem = S.nwg % G, nidle = rem ? G - rem : G, idx = rem ? bx - rem : bx;
          if (idx >= 0) p0_prologue(args, lds, idx, nidle, 1); }
        __syncthreads();
    }
    SEAM(1);
    if (IN(2)) REP(2) {
        for (int it = bx; it < 1536; it += G) {
            if (it < 512) { for (int r_ = 0; r_ < 1 + (DBL_P2 & 1); ++r_) sample_item<true>(args, lds, it >> 2, it & 3); }
            else if (it < 1024) { for (int r_ = 0; r_ < 1 + ((DBL_P2 >> 1) & 1); ++r_) sample_item<false>(args, lds, (it - 512) >> 2, (it - 512) & 3); }
            else if (it < 1280) { for (int r_ = 0; r_ < 1 + ((DBL_P2 >> 2) & 1); ++r_) chunk_state<true>(args, lds, (it - 1024) >> 4, (it - 1024) & 15); }
            else { for (int r_ = 0; r_ < 1 + ((DBL_P2 >> 3) & 1); ++r_) chunk_state<false>(args, lds, (it - 1280) >> 4, (it - 1280) & 15); }
        }
    }
    SEAM(2);
    if (IN(3)) REP(3) { for (int it = bx; it < 768; it += G) { if (it < 512) scan_mlstm(args, it); else scan_gla(args, it - 512); }
        if (G == 256) {
            pg8::Gemm g{(const bf16*)(ws + WS_YM), (const bf16*)(ws + WS_WA), (const bf16*)(ws + WS_YG), (const bf16*)(ws + WS_WB), MT, DM, 1024}; pg8::TailOnlyOrder<2, 16> S; S.c = bx;
            EpiBranch E{(const bf16*)(ws + WS_PROJ), (bf16*)(ws + WS_XN), args.out + O_YP};
            pg8::gemm_phase<EpiBranch, pg8::TailOnlyOrder<2, 16>, true, true>(lds, g, S, E);
        }
    }
    SEAM(3);
    if (IN(4)) REP(4) { for (int it = bx; it < 512; it += G) { if (it < 256) { if (BIS & 1) chunk_out<true>(args, lds, it >> 4, it & 15); } else { if (BIS & 2) chunk_out<false>(args, lds, (it - 256) >> 4, (it - 256) & 15); } } __syncthreads(); if (G == 256) merge_reduce(args, vcu, G); }
    SEAM(4);
    if (IN(5)) REP(5) {
        pg8::Gemm g{(const bf16*)(ws + WS_YM), (const bf16*)(ws + WS_WA), (const bf16*)(ws + WS_YG), (const bf16*)(ws + WS_WB), MT, DM, 1024}; EpiBranch E{(const bf16*)(ws + WS_PROJ), (bf16*)(ws + WS_XN), nullptr};
        if (G == 256) { pg8::MainOnlyOrder<2> S; S.S.init(MP, DM, G, bx); pg8::gemm_phase<EpiBranch, pg8::MainOnlyOrder<2>, true, true>(lds, g, S, E); }
        else { pg8::TwoSegOrder S; S.S.init(MT, DM, G, bx); pg8::gemm_phase<EpiBranch, pg8::TwoSegOrder, true, true>(lds, g, S, E); }
    }
    SEAM(5);
    if (IN(6)) REP(6) {
        pg8::Gemm g{(const bf16*)(ws + WS_XN), (const bf16*)(ws + WS_WO), nullptr, nullptr, MT, DM, DM}; pg8::SplitRowsOrder<1, 32> S; S.split = (G == 256); S.S.init(S.split ? MP : MT, DM, G, bx);
        EpiOut E{args.in[I_XP], args.in[I_XS], (float*)(ws + WS_X1), (bf16*)(ws + WS_X1W), args.in[I_NFFN], (float*)(ws + WS_PART), (float*)(ws + WS_PROJ)};
        pg8::gemm_phase<EpiOut, pg8::SplitRowsOrder<1, 32>, true, true>(lds, g, S, E);
    }
    SEAM(6);
    if (IN(7)) REP(7) rstd_phase(args, vcu, G);
    SEAM(7);
    if (IN(8)) REP(8) {
        pg8::Gemm g{(const bf16*)(ws + WS_X1W), (const bf16*)(ws + WS_WUG), nullptr, nullptr, MT, 2 * DFF, DM}; pg8::StaticOrder S; S.init(MT, 2 * DFF, G, bx);
        EpiUGAct E{(const float*)(ws + WS_RSTD), (bf16*)(ws + WS_G), args.out, args.in[I_CW], args.in[I_CB], args.in[I_CONV], (float*)(ws + WS_U), (LAS float*)(lds + 131072)};
        pg8::gemm_phase<EpiUGAct, pg8::StaticOrder, true, true>(lds, g, S, E);
    }
    SEAM(8);
    if (IN(9)) REP(9) act_fixup(args, vcu, G);
    SEAM(9);
    if (IN(10)) REP(10) {
        pg8::Gemm g{(const bf16*)(ws + WS_G), (const bf16*)(ws + WS_WD), nullptr, nullptr, MT, DM, DFF}; pg8::DownOrder S; S.S.init(MT, DM, G, bx); S.split = (G == 256);
        EpiDown E{(const float*)(ws + WS_X1), args.out, (float*)(ws + WS_U)};
        pg8::gemm_phase<EpiDown, pg8::DownOrder, true, true>(lds, g, S, E);
    }
    SEAM(10);
    if (IN(11)) REP(11) final_norm(args, vcu, G);
#ifdef EXTRA_SYNCS
    for (int i_ = 0; i_ < EXTRA_SYNCS; ++i_) xcd_barrier(xbar);
#endif
#undef IN
#undef SEAM
}

extern "C" void kernel_launch(void* const* d_in, const int* in_sizes, int n_in, void* d_out, int out_size, void* d_ws, size_t ws_size, hipStream_t stream) {
    static int grid = 0;
    if (grid == 0) {
        if (n_in != 25 || ws_size < WS_END) { fprintf(stderr, "kernel_launch: unexpected n_in %d / ws_size %zu (need %zu)\n", n_in, ws_size, (size_t)WS_END); grid = -1; return; }
        int dev = 0, cus = 0, per_cu = 0;
        (void)hipGetDevice(&dev); (void)hipDeviceGetAttribute(&cus, hipDeviceAttributeMultiprocessorCount, dev);
        if (hipFuncSetAttribute((const void*)fwd_kernel, hipFuncAttributeMaxDynamicSharedMemorySize, LDS_BYTES) != hipSuccess) { fprintf(stderr, "kernel_launch: hipFuncSetAttribute failed\n"); grid = -1; return; }
        if (hipOccupancyMaxActiveBlocksPerMultiprocessor(&per_cu, (const void*)fwd_kernel, NTHR, LDS_BYTES) != hipSuccess || per_cu < 1) { fprintf(stderr, "kernel_launch: occupancy query says %d\n", per_cu); per_cu = 1; }
        (void)hipGetLastError();
        grid = cus * 1;
        if (grid <= 0) grid = 256;
    }
    if (grid < 0) return;
    if (hipMemsetAsync(d_ws, 0, 65536, stream) != hipSuccess) { fprintf(stderr, "kernel_launch: memset failed\n"); return; }
    Args a{};
    for (int i = 0; i < 25; ++i) a.in[i] = (const float*)d_in[i];
    a.out = (float*)d_out; a.ws = (unsigned char*)d_ws;
    if (MK_N_LAUNCHES == 1) {
        a.ph_lo = 0; a.ph_hi = N_PHASES;
        void* kargs[] = {&a};
        hipError_t e = hipLaunchCooperativeKernel((const void*)fwd_kernel, dim3(grid), dim3(NTHR), kargs, LDS_BYTES, stream);
        if (e != hipSuccess) fprintf(stderr, "kernel_launch: cooperative launch failed: %s (grid %d)\n", hipGetErrorString(e), grid);
    } else {
        for (int p = 0; p < N_PHASES; ++p) { a.ph_lo = p; a.ph_hi = p + 1; hipLaunchKernelGGL(fwd_kernel, dim3(grid), dim3(NTHR), LDS_BYTES, stream, a); }
    }
}
```

```cpp
#include <hip/hip_runtime.h>
#include <hip/hip_cooperative_groups.h>
#include <cstdio>
#include <cstdint>
namespace cg = cooperative_groups;

#ifndef MK_N_LAUNCHES
#define MK_N_LAUNCHES 1
#endif

namespace pg8 {
#define PG8_LAS __attribute__((address_space(3)))
typedef unsigned short bf16_t;
typedef short bf16x8 __attribute__((ext_vector_type(8)));
typedef float f32x4 __attribute__((ext_vector_type(4)));
typedef unsigned u32x4 __attribute__((ext_vector_type(4)));
constexpr int BM = 256, BK = 64, HALF = 128, HTB = HALF * BK * 2  , STAGE_BYTES = 8 * HTB, NXCD = 8, WGM = 8;

__host__ __device__ __forceinline__ int lds_byte(int r, int c) { const int st = (r >> 4) * 2 + (c >> 5), rr = r & 15, cc = c & 31, ob = rr * 64 + cc * 2; return st * 1024 + (ob ^ (((ob >> 9) & 1) << 5)); }
__host__ __device__ __forceinline__ void stage_rc(int b, int& R, int& C) { const int st = b / 1024, sb = b % 1024, swz = sb ^ (((sb >> 9) & 1) << 5); R = (st >> 1) * 16 + swz / 64; C = (st & 1) * 32 + (swz % 64) / 2; }
__host__ __device__ __forceinline__ int perm32(int rho) { const int n = rho >> 4, i = rho & 15; return 8 * (i >> 2) + 4 * n + (i & 3); }

struct Unit { int pm, pn, seg, kt0, nkt, tail; };
struct Gemm { const bf16_t* A; const bf16_t* Bt; const bf16_t* A2; const bf16_t* Bt2; int M, N, K; };

struct StaticOrder {
    int nM, nN, nwg, G, c;
    __host__ __device__ void init(int M, int N, int G_, int c_) { nM = M / BM; nN = N / BM; nwg = nM * nN; G = G_; c = c_; }
    __host__ __device__ bool next(int i, Unit& u) const { return at((long)i * G + c, u); }
    __host__ __device__ bool at(long L, Unit& u) const {
        if (L >= nwg) return false;
        int wgid = (int)L; { const int q = nwg / NXCD, r = nwg % NXCD, xcd = wgid % NXCD, off = wgid / NXCD; wgid = (xcd < r ? xcd * (q + 1) : r * (q + 1) + (xcd - r) * q) + off; }
        const int nig = WGM * nN, gid = wgid / nig, fm = gid * WGM, gsz = (nM - fm) < WGM ? (nM - fm) : WGM;
        u.pm = fm + ((wgid % nig) % gsz); u.pn = (wgid % nig) / gsz; u.seg = 0; u.kt0 = 0; u.nkt = -1; u.tail = -1; return true;
    }
};
struct DownOrder {
    StaticOrder S; bool split;
    __host__ __device__ bool next(int i, Unit& u) const {
        if (!split) return S.next(i, u);
        if (i == 0) return S.at(S.c, u);
        if (i > 1) return false;
        const int tt = S.c >> 3, sl = S.c & 7;
        if (!S.at(256 + tt, u)) return false;
        u.kt0 = 11 * sl + (sl & 1); u.nkt = (sl & 1) ? 10 : 12; u.tail = tt * 8 + sl; return true;
    }
};
template <int NSEG, int KT>
struct SplitRowsOrder {
    StaticOrder S; bool split;
    __host__ __device__ bool next(int i, Unit& u) const {
        if (!split) { if (!S.next(i / NSEG, u)) return false; u.seg = i % NSEG; return true; }
        if (i < NSEG) { if (!S.at(S.c, u)) return false; u.seg = i; return true; }
        if (i >= 2 * NSEG) return false;
        const int tt = S.c >> 3, sl = S.c & 7;
        u.pm = 32 + (tt >> 3); u.pn = tt & 7; u.seg = i - NSEG; u.kt0 = (KT / 8) * sl; u.nkt = KT / 8; u.tail = tt * 8 + sl; return true;
    }
};
template <int NSEG, int KT>
struct TailOnlyOrder {
    int c;
    __host__ __device__ bool next(int i, Unit& u) const {
        if (i >= NSEG) return false;
        const int tt = c >> 3, sl = c & 7;
        u.pm = 32 + (tt >> 3); u.pn = tt & 7; u.seg = i; u.kt0 = (KT / 8) * sl; u.nkt = KT / 8; u.tail = tt * 8 + sl; return true;
    }
};
template <int NSEG>
struct MainOnlyOrder {
    StaticOrder S;
    __host__ __device__ bool next(int i, Unit& u) const { if (i >= NSEG) return false; if (!S.at(S.c, u)) return false; u.seg = i; return true; }
};
struct TwoSegOrder {
    StaticOrder S;
    __host__ __device__ bool next(int i, Unit& u) const { if (!S.next(i >> 1, u)) return false; u.seg = i & 1; return true; }
};

__device__ __forceinline__ unsigned cvt_pk_bf16(float lo, float hi) { unsigned r; asm volatile("v_cvt_pk_bf16_f32 %0, %1, %2" : "=v"(r) : "v"(lo), "v"(hi)); return r; }

template <class Epi, class Sched, bool ALIGN_EPI = false, bool SP2 = false>
__device__ __forceinline__ void gemm_phase(PG8_LAS unsigned char* lds, const Gemm g, const Sched& S, const Epi& E) {
    int tid_ = threadIdx.x; asm volatile("" : "+v"(tid_));
    const int tid = tid_, wid = __builtin_amdgcn_readfirstlane(tid >> 6), lane = tid & 63, wr = wid >> 2, wc = wid & 3, fr = lane & 15, fq = lane >> 4;
    const int K = g.K, ntf = K / BK;
    unsigned voffA[2], voffB[2];
#pragma unroll
    for (int i = 0; i < 2; ++i) { int R, C; stage_rc(tid * 16 + i * 8192, R, C); const int Rb = Epi::PERM ? ((R & ~31) + perm32(R & 31)) : R;
        voffA[i] = (unsigned)(R * K + C) * 2u; voffB[i] = (unsigned)(Rb * K + C) * 2u; }
    const size_t kstep = (size_t)(BK * 2);
    const size_t hstep = (size_t)HALF * K * 2;
    const size_t tstep = 2 * hstep;
    const unsigned ldsw = (unsigned)wid * 1024u;
    const int aoff = lds_byte(wr * 64 + fr, fq * 8), boff = lds_byte(wc * 32 + fr, fq * 8);
#define PG8_SA(b, h) (((b) * 2 + (h)) * HTB)
#define PG8_SB(b, h) ((4 + (b) * 2 + (h)) * HTB)
#define PG8_STAGE(bufoff, gbase, voff) do { _Pragma("unroll") for (int _i = 0; _i < 2; ++_i) \
        __builtin_amdgcn_global_load_lds((const unsigned*)((const char*)(gbase) + (voff)[_i]), (PG8_LAS unsigned*)(lds + (bufoff) + ldsw + _i * 8192), 16, 0, 0); } while (0)
#define PG8_LDA(dst, b, h) do { _Pragma("unroll") for (int m = 0; m < 4; ++m) _Pragma("unroll") for (int k = 0; k < 2; ++k) dst[m][k] = *(const PG8_LAS bf16x8*)(lds + PG8_SA(b, h) + aoff + m * 2048 + k * 1024); } while (0)
#define PG8_LDB(dst, b, h) do { _Pragma("unroll") for (int n = 0; n < 2; ++n) _Pragma("unroll") for (int k = 0; k < 2; ++k) dst[n][k] = *(const PG8_LAS bf16x8*)(lds + PG8_SB(b, h) + boff + n * 2048 + k * 1024); } while (0)
#define PG8_MMA(ai, bj, At, Bt) do { __builtin_amdgcn_s_setprio(1); _Pragma("unroll") for (int m = 0; m < 4; ++m) _Pragma("unroll") for (int n = 0; n < 2; ++n) _Pragma("unroll") for (int k = 0; k < 2; ++k) \
        acc[ai][bj][m][n] = __builtin_amdgcn_mfma_f32_16x16x32_bf16(Bt[n][k], At[m][k], acc[ai][bj][m][n], 0, 0, 0); __builtin_amdgcn_s_setprio(0); } while (0)
#define PG8_WAIT_V(n) asm volatile("s_waitcnt vmcnt(" #n ")" ::: "memory")
#define PG8_WAIT_L(n) asm volatile("s_waitcnt lgkmcnt(" #n ")" ::: "memory")
#define PG8_BAR __builtin_amdgcn_s_barrier()
#define PG8_SCHED __builtin_amdgcn_sched_barrier(0)
    Unit cur, nxt; int ui = 0;
    if (!S.next(0, cur)) return;
    f32x4 acc[2][2][4][2];
#pragma unroll
    for (int a = 0; a < 2; ++a)
#pragma unroll
        for (int b = 0; b < 2; ++b)
#pragma unroll
            for (int m = 0; m < 4; ++m)
#pragma unroll
                for (int n = 0; n < 2; ++n) acc[a][b][m][n] = (f32x4){0.f, 0.f, 0.f, 0.f};
    bf16x8 At[4][2], B0[2][2], B1[2][2];
    const char* cA = (const char*)(cur.seg ? g.A2 : g.A) + (size_t)cur.pm * tstep + (size_t)cur.kt0 * kstep; const char* cB = (const char*)(cur.seg ? g.Bt2 : g.Bt) + (size_t)cur.pn * tstep + (size_t)cur.kt0 * kstep;
    if constexpr (SP2) {
        PG8_STAGE(PG8_SB(0, 0), cB, voffB); PG8_STAGE(PG8_SB(0, 1), cB + hstep, voffB); PG8_STAGE(PG8_SA(0, 0), cA, voffA); PG8_STAGE(PG8_SA(0, 1), cA + hstep, voffA);
        if (wr == 1) PG8_BAR;
        PG8_WAIT_V(2); PG8_BAR;
        PG8_STAGE(PG8_SB(1, 0), cB + kstep, voffB); PG8_STAGE(PG8_SA(1, 0), cA + kstep, voffA); PG8_STAGE(PG8_SB(1, 1), cB + hstep + kstep, voffB);
        PG8_WAIT_V(6); PG8_BAR;
    } else {
        PG8_STAGE(PG8_SB(0, 0), cB, voffB); PG8_STAGE(PG8_SA(0, 0), cA, voffA); PG8_STAGE(PG8_SB(0, 1), cB + hstep, voffB); PG8_STAGE(PG8_SA(0, 1), cA + hstep, voffA);
        if (wr == 1) PG8_BAR;
        PG8_WAIT_V(4); PG8_BAR;
        PG8_STAGE(PG8_SB(1, 0), cB + kstep, voffB); PG8_STAGE(PG8_SA(1, 0), cA + kstep, voffA); PG8_STAGE(PG8_SB(1, 1), cB + hstep + kstep, voffB);
        PG8_WAIT_V(6); PG8_BAR;
    }
    for (;;) {
        const bool has_next = S.next(ui + 1, nxt);
        const char* nA = has_next ? (const char*)(nxt.seg ? g.A2 : g.A) + (size_t)nxt.pm * tstep + (size_t)nxt.kt0 * kstep : cA; const char* nB = has_next ? (const char*)(nxt.seg ? g.Bt2 : g.Bt) + (size_t)nxt.pn * tstep + (size_t)nxt.kt0 * kstep : cB;
        const int nt = cur.nkt > 0 ? cur.nkt : ntf;
        for (int t = 0; t < nt; t += 2) {
            const bool last = (t == nt - 2);
            const char* a1 = cA + (size_t)(t + 1) * kstep;
            const char* a2 = last ? nA : cA + (size_t)(t + 2) * kstep; const char* b2 = last ? nB : cB + (size_t)(t + 2) * kstep;
            const char* a3 = a2 + kstep; const char* b3 = b2 + kstep;
            if constexpr (SP2) {
            PG8_LDB(B0, 0, 0); PG8_LDB(B1, 0, 1); PG8_SCHED; PG8_LDA(At, 0, 0); PG8_STAGE(PG8_SA(1, 1), a1 + hstep, voffA);
            PG8_WAIT_V(8); PG8_WAIT_L(0); PG8_BAR; PG8_MMA(0, 0, At, B0); PG8_MMA(0, 1, At, B1); PG8_BAR; PG8_SCHED;
            PG8_LDA(At, 0, 1); PG8_STAGE(PG8_SB(0, 0), b2, voffB); PG8_STAGE(PG8_SB(0, 1), b2 + hstep, voffB); PG8_STAGE(PG8_SA(0, 0), a2, voffA);
            PG8_WAIT_V(8); PG8_WAIT_L(0); PG8_BAR; PG8_MMA(1, 0, At, B0); PG8_MMA(1, 1, At, B1); PG8_BAR; PG8_SCHED;
            PG8_LDB(B0, 1, 0); PG8_LDB(B1, 1, 1); PG8_SCHED; PG8_LDA(At, 1, 0); PG8_STAGE(PG8_SA(0, 1), a2 + hstep, voffA);
            PG8_WAIT_V(8); PG8_WAIT_L(0); PG8_BAR; PG8_MMA(0, 0, At, B0); PG8_MMA(0, 1, At, B1); PG8_BAR; PG8_SCHED;
            PG8_LDA(At, 1, 1); PG8_STAGE(PG8_SB(1, 0), b3, voffB); PG8_STAGE(PG8_SB(1, 1), b3 + hstep, voffB); PG8_STAGE(PG8_SA(1, 0), a3, voffA);
            PG8_WAIT_V(8); PG8_WAIT_L(0); PG8_BAR; PG8_MMA(1, 0, At, B0); PG8_MMA(1, 1, At, B1); PG8_BAR; PG8_SCHED;
            } else {
            PG8_LDB(B0, 0, 0); PG8_SCHED; PG8_LDA(At, 0, 0); PG8_STAGE(PG8_SA(1, 1), a1 + hstep, voffA);
            PG8_WAIT_L(8); PG8_BAR; PG8_WAIT_L(0); PG8_MMA(0, 0, At, B0); PG8_BAR; PG8_SCHED;
            PG8_LDB(B1, 0, 1); PG8_STAGE(PG8_SB(0, 0), b2, voffB);
            PG8_BAR; PG8_WAIT_L(0); PG8_MMA(0, 1, At, B1); PG8_BAR;
            PG8_LDA(At, 0, 1); PG8_STAGE(PG8_SA(0, 0), a2, voffA);
            PG8_BAR; PG8_WAIT_L(0); PG8_MMA(1, 0, At, B0); PG8_BAR; PG8_SCHED;
            PG8_STAGE(PG8_SB(0, 1), b2 + hstep, voffB);
            PG8_WAIT_V(6); PG8_BAR; PG8_MMA(1, 1, At, B1); PG8_BAR;
            PG8_LDB(B0, 1, 0); PG8_SCHED; PG8_LDA(At, 1, 0); PG8_STAGE(PG8_SA(0, 1), a2 + hstep, voffA);
            PG8_WAIT_L(8); PG8_BAR; PG8_WAIT_L(0); PG8_MMA(0, 0, At, B0); PG8_BAR; PG8_SCHED;
            PG8_LDB(B1, 1, 1); PG8_STAGE(PG8_SB(1, 0), b3, voffB);
            PG8_BAR; PG8_WAIT_L(0); PG8_MMA(0, 1, At, B1); PG8_BAR;
            PG8_LDA(At, 1, 1); PG8_STAGE(PG8_SA(1, 0), a3, voffA);
            PG8_BAR; PG8_WAIT_L(0); PG8_MMA(1, 0, At, B0); PG8_BAR; PG8_SCHED;
            PG8_STAGE(PG8_SB(1, 1), b3 + hstep, voffB);
            PG8_WAIT_V(6); PG8_BAR; PG8_MMA(1, 1, At, B1); PG8_BAR;
            }
        }
        if constexpr (ALIGN_EPI) { if (wr == 0) PG8_BAR; }
        E(acc, cur, wr, wc, fr, fq);
        if (!has_next) break;
        if (nxt.seg == 0)
#pragma unroll
        for (int a = 0; a < 2; ++a)
#pragma unroll
            for (int b = 0; b < 2; ++b)
#pragma unroll
                for (int m = 0; m < 4; ++m)
#pragma unroll
                    for (int n = 0; n < 2; ++n) acc[a][b][m][n] = (f32x4){0.f, 0.f, 0.f, 0.f};
        cur = nxt; cA = nA; cB = nB; ++ui;
        if constexpr (ALIGN_EPI) { if (wr == 1) PG8_BAR; }
    }
    PG8_WAIT_V(0);
    if constexpr (!ALIGN_EPI) { if (wr == 0) PG8_BAR; }
    PG8_BAR;
#undef PG8_SA
#undef PG8_SB
#undef PG8_STAGE
#undef PG8_LDA
#undef PG8_LDB
#undef PG8_MMA
#undef PG8_WAIT_V
#undef PG8_WAIT_L
#undef PG8_BAR
#undef PG8_SCHED
}
}

#define LAS __attribute__((address_space(3)))
typedef unsigned short bf16;
typedef short bf16x8 __attribute__((ext_vector_type(8)));
typedef float f32x4 __attribute__((ext_vector_type(4)));
typedef unsigned u32x4 __attribute__((ext_vector_type(4)));
typedef unsigned u32x2 __attribute__((ext_vector_type(2)));
using pg8::cvt_pk_bf16;

constexpr int NWAVES = 8, NTHR = 512;
constexpr int DM = 2048, MP = 8192, MS = 1024, MT = 9216, TP = 2048, TS = 8;
constexpr int NIN = 11288, NPROJ = 11264, NPROJ_PAD = 11520, DFF = 5632;
constexpr int C_MQ = 0, C_MK = 1024, C_MV = 2048, C_MO = 3072, C_GQ = 4096, C_GK = 4608, C_GV = 5120, C_GR = 6144, C_GA = 7168, C_GB = 9216;
constexpr float EPS = 1e-6f;
constexpr int NCH = 16;
constexpr int LDS_BYTES = 147456;

constexpr size_t O_YP = 0, O_YS = 16777216, O_PC = 18874368, O_PN = 19922944, O_PM = 19927040, O_PS = 19927056, O_PCONV = 20451344,
                 O_SC = 20496400, O_SN = 54050832, O_SM = 54181904, O_SS = 54182416, O_SCONV = 70959632;

constexpr size_t MiB = 1u << 20;
constexpr size_t WS_GATES = 64 * 1024;
constexpr size_t WS_PART = WS_GATES + (size_t)MT * 32 * 4;
constexpr size_t WS_DN = WS_PART + (size_t)MT * 32 * 4;
constexpr size_t WS_NPREV = WS_DN + 256 * 256 * 4;
constexpr size_t WS_CHS = WS_NPREV + 256 * 256 * 2;
constexpr size_t WS_BEND = WS_CHS + 256 * 2 * 4;
constexpr size_t WS_RSTD = WS_BEND + 256 * 128 * 4;
static_assert(WS_RSTD + MT * 4 <= 4 * MiB, "small region");
constexpr size_t WS_WIN = 4 * MiB;
constexpr size_t WS_WA = WS_WIN + (size_t)NPROJ_PAD * DM * 2;
constexpr size_t WS_WB = WS_WA + (size_t)2048 * 1024 * 2;
constexpr size_t WS_WO = WS_WB + (size_t)2048 * 1024 * 2;
constexpr size_t WS_WUG = WS_WO + (size_t)2048 * 2048 * 2;
constexpr size_t WS_WD = WS_WUG + (size_t)2 * DFF * DM * 2;
constexpr size_t WS_R1 = WS_WD + (size_t)DM * DFF * 2;
static_assert(WS_R1 == 131 * MiB, "map");
constexpr size_t WS_XN = WS_R1;
constexpr size_t WS_X1W = WS_R1 + 36 * MiB;
constexpr size_t WS_X1 = WS_R1 + 72 * MiB;
constexpr size_t WS_DC = WS_R1;
constexpr size_t WS_DS = WS_R1 + 64 * MiB;
constexpr size_t WS_CT = WS_R1 + 96 * MiB;
constexpr size_t WS_ST = WS_R1 + 128 * MiB;
constexpr size_t WS_YM = WS_R1 + 144 * MiB;
constexpr size_t WS_YG = WS_YM + 18 * MiB;
constexpr size_t WS_PROJ = WS_YG + 18 * MiB;
constexpr size_t WS_U = WS_PROJ, WS_G = WS_PROJ + 99 * MiB;
constexpr size_t WS_END = WS_PROJ + 198 * MiB;
static_assert(WS_END == 509 * MiB, "map");

struct Args {
    const float* in[25]; float* out; unsigned char* ws; int ph_lo, ph_hi;
};
enum { I_XP = 0, I_XS, I_C, I_N, I_M, I_S, I_CONV, I_WIN, I_BI, I_BF, I_AUP, I_AB, I_MHW, I_GHW, I_WA, I_WB, I_WO, I_NMIX, I_NFFN, I_WUP, I_WGATE, I_CW, I_CB, I_WDOWN, I_FNW };

__device__ __forceinline__ float bf2f(unsigned short b) { return __builtin_bit_cast(float, (unsigned)b << 16); }
__device__ __forceinline__ float bflo(unsigned w) { return __builtin_bit_cast(float, w << 16); }
__device__ __forceinline__ float bfhi(unsigned w) { return __builtin_bit_cast(float, w & 0xffff0000u); }
__device__ __forceinline__ unsigned short f2bf(float f) { return (unsigned short)(cvt_pk_bf16(f, 0.f) & 0xffffu); }
__device__ __forceinline__ float logsig(float z) { return fminf(z, 0.f) - __logf(1.f + __expf(-fabsf(z))); }
__device__ __forceinline__ float sigm(float z) { return 1.f / (1.f + __expf(-z)); }
__device__ __forceinline__ float wave_sum(float v) {
#pragma unroll
    for (int o = 1; o < 64; o <<= 1) v += __shfl_xor(v, o);
    return v;
}
__device__ __forceinline__ float wave_max(float v) {
#pragma unroll
    for (int o = 1; o < 64; o <<= 1) v = fmaxf(v, __shfl_xor(v, o));
    return v;
}
__device__ __forceinline__ float sum4(f32x4 v) { return (v.x + v.y) + (v.z + v.w); }
__device__ __forceinline__ float dot4(f32x4 a, f32x4 b) { return (a.x * b.x + a.y * b.y) + (a.z * b.z + a.w * b.w); }
__device__ __forceinline__ float gelu_tanh(float v) { const float u = 0.7978845608028654f * (v + 0.044715f * v * v * v); return v * sigm(2.f * u); }

typedef f32x4 AccT[2][2][4][2];
struct EpiProj {
    static constexpr bool PERM = true;
    bf16* P; float* gates;
    __device__ __forceinline__ void operator()(AccT& acc, const pg8::Unit& u, int wr, int wc, int fr, int fq) const {
        const int row0 = u.pm * 256 + wr * 64 + fr;
        if (u.pn < 28) {
            const int col0 = u.pn * 256 + wc * 32 + 8 * fq;
#pragma unroll
            for (int ai = 0; ai < 2; ++ai)
#pragma unroll
                for (int m = 0; m < 4; ++m) { bf16* rowp = P + (size_t)(row0 + ai * 128 + m * 16) * NPROJ + col0;
#pragma unroll
                    for (int bj = 0; bj < 2; ++bj) { const f32x4 v0 = acc[ai][bj][m][0], v1 = acc[ai][bj][m][1]; u32x4 w;
                        w.x = cvt_pk_bf16(v0[0], v0[1]); w.y = cvt_pk_bf16(v0[2], v0[3]); w.z = cvt_pk_bf16(v1[0], v1[1]); w.w = cvt_pk_bf16(v1[2], v1[3]);
                        *(u32x4*)(rowp + bj * 128) = w; } }
        } else if (u.pn >= 28 && u.pn < 44) {
            const int n0 = (u.pn - 28) * 128 + wc * 32 + 8 * fq;
#pragma unroll
            for (int ai = 0; ai < 2; ++ai)
#pragma unroll
                for (int m = 0; m < 4; ++m) { bf16* rowp = P + (size_t)(row0 + ai * 128 + m * 16) * NPROJ;
                    float R[8], sb[8];
#pragma unroll
                    for (int i = 0; i < 8; ++i) { const float ga = acc[ai][0][m][i >> 2][i & 3], gb = acc[ai][1][m][i >> 2][i & 3];
                        const float ea = __expf(fminf(-ga, 40.f)), eb = __expf(fminf(-gb, 40.f)); sb[i] = __builtin_amdgcn_rcpf(1.f + eb); R[i] = (1.f + eb) * __builtin_amdgcn_rcpf(1.f + ea); }
                    u32x4 w; w.x = cvt_pk_bf16(R[0], R[1]); w.y = cvt_pk_bf16(R[2], R[3]); w.z = cvt_pk_bf16(R[4], R[5]); w.w = cvt_pk_bf16(R[6], R[7]);
                    *(u32x4*)(rowp + C_GA + n0) = w;
                    w.x = cvt_pk_bf16(sb[0], sb[1]); w.y = cvt_pk_bf16(sb[2], sb[3]); w.z = cvt_pk_bf16(sb[4], sb[5]); w.w = cvt_pk_bf16(sb[6], sb[7]);
                    *(u32x4*)(rowp + C_GB + n0) = w; }
        } else if (wc == 0) {
#pragma unroll
            for (int ai = 0; ai < 2; ++ai)
#pragma unroll
                for (int m = 0; m < 4; ++m) { float* rowp = gates + (size_t)(row0 + ai * 128 + m * 16) * 32 + 8 * fq;
                    *(f32x4*)rowp = acc[ai][0][m][0]; *(f32x4*)(rowp + 4) = acc[ai][0][m][1]; }
        }
    }
};
struct EpiBranch {
    static constexpr bool PERM = true;
    const bf16* P; bf16* O; float* tailp;
    __device__ __forceinline__ void operator()(AccT& acc, const pg8::Unit& u, int wr, int wc, int fr, int fq) const {
        const int row0 = u.pm * 256 + wr * 64 + fr, col0 = u.pn * 256 + wc * 32 + 8 * fq;
#pragma unroll
        for (int ai = 0; ai < 2; ++ai)
#pragma unroll
            for (int m = 0; m < 4; ++m) { const int row = row0 + ai * 128 + m * 16;
#pragma unroll
                for (int bj = 0; bj < 2; ++bj) { const int col = col0 + bj * 128;
                    const u32x4 gw = *(const u32x4*)(P + (size_t)row * NPROJ + (u.seg == 0 ? C_GA : C_GB) + col);
                    float fg[8] = {bflo(gw.x), bfhi(gw.x), bflo(gw.y), bfhi(gw.y), bflo(gw.z), bfhi(gw.z), bflo(gw.w), bfhi(gw.w)};
                    if (u.seg == 0) {
#pragma unroll
                        for (int i = 0; i < 8; ++i) acc[ai][bj][m][i >> 2][i & 3] *= fg[i];
                    } else {
                        float o[8];
#pragma unroll
                        for (int i = 0; i < 8; ++i) o[i] = acc[ai][bj][m][i >> 2][i & 3] * fg[i];
                        if (u.tail < 0) { u32x4 w; w.x = cvt_pk_bf16(o[0], o[1]); w.y = cvt_pk_bf16(o[2], o[3]); w.z = cvt_pk_bf16(o[4], o[5]); w.w = cvt_pk_bf16(o[6], o[7]);
                            *(u32x4*)(O + (size_t)row * DM + col) = w; }
                        else { float* p = tailp + (size_t)u.tail * 65536 + (row & 255) * 256 + (col & 255); *(f32x4*)p = (f32x4){o[0], o[1], o[2], o[3]}; *(f32x4*)(p + 4) = (f32x4){o[4], o[5], o[6], o[7]}; }
                    } } }
    }
};
struct EpiOut {
    static constexpr bool PERM = true;
    const float* xp; const float* xs; float* X1; bf16* X1W; const float* nw; float* part; float* tailp;
    __device__ __forceinline__ void operator()(AccT& acc, const pg8::Unit& u, int wr, int wc, int fr, int fq) const {
        const int row0 = u.pm * 256 + wr * 64 + fr, col0 = u.pn * 256 + wc * 32 + 8 * fq;
        if (u.tail >= 0) {
            float* tp = tailp + (size_t)u.tail * 65536 + (wr * 64 + fr) * 256 + wc * 32 + 8 * fq;
#pragma unroll
            for (int ai = 0; ai < 2; ++ai)
#pragma unroll
                for (int m = 0; m < 4; ++m)
#pragma unroll
                    for (int bj = 0; bj < 2; ++bj) { float* p = tp + (ai * 128 + m * 16) * 256 + bj * 128; *(f32x4*)p = acc[ai][bj][m][0]; *(f32x4*)(p + 4) = acc[ai][bj][m][1]; }
            return;
        }
#pragma unroll
        for (int ai = 0; ai < 2; ++ai)
#pragma unroll
            for (int m = 0; m < 4; ++m) { const int row = row0 + ai * 128 + m * 16;
                const float* xrow = row < MP ? xp + (size_t)row * DM : xs + (size_t)(row - MP) * DM;
                float ss = 0.f;
#pragma unroll
                for (int bj = 0; bj < 2; ++bj) { const int col = col0 + bj * 128;
                    const f32x4 v0 = acc[ai][bj][m][0] + *(const f32x4*)(xrow + col), v1 = acc[ai][bj][m][1] + *(const f32x4*)(xrow + col + 4);
                    *(f32x4*)(X1 + (size_t)row * DM + col) = v0; *(f32x4*)(X1 + (size_t)row * DM + col + 4) = v1;
                    ss += dot4(v0, v0) + dot4(v1, v1);
                    const f32x4 w0 = *(const f32x4*)(nw + col), w1 = *(const f32x4*)(nw + col + 4);
                    u32x4 w; w.x = cvt_pk_bf16(v0[0] * w0[0], v0[1] * w0[1]); w.y = cvt_pk_bf16(v0[2] * w0[2], v0[3] * w0[3]);
                    w.z = cvt_pk_bf16(v1[0] * w1[0], v1[1] * w1[1]); w.w = cvt_pk_bf16(v1[2] * w1[2], v1[3] * w1[3]);
                    *(u32x4*)(X1W + (size_t)row * DM + col) = w; }
                ss += __shfl_xor(ss, 16); ss += __shfl_xor(ss, 32);
                if (fq == 0) part[(size_t)row * 32 + u.pn * 4 + wc] = ss; }
    }
};
#define DPP_MOV(ctrl, oldv, srcv) __builtin_bit_cast(float, __builtin_amdgcn_update_dpp(__builtin_bit_cast(int, (float)(oldv)), __builtin_bit_cast(int, (float)(srcv)), (ctrl), 0xf, 0xf, false))
struct EpiUGAct {
    static constexpr bool PERM = true;
    const float* rstd; bf16* ACT; float* out; const float* cw; const float* cb; const float* cst; float* ub; LAS float* xch;
    __device__ __forceinline__ void operator()(AccT& acc, const pg8::Unit& u, int wr, int wc, int fr, int fq) const {
        const int row0 = u.pm * 256 + wr * 64 + fr, col = u.pn * 128 + wc * 32 + 8 * fq;
        const bool sample = u.pm >= 32;
#pragma unroll
        for (int ai = 0; ai < 2; ++ai)
#pragma unroll
            for (int m = 0; m < 4; ++m) { const int row = row0 + ai * 128 + m * 16;
                const float r = rstd[row];
                acc[ai][0][m][0] = acc[ai][0][m][0] * r; acc[ai][0][m][1] = acc[ai][0][m][1] * r; acc[ai][1][m][0] = acc[ai][1][m][0] * r; acc[ai][1][m][1] = acc[ai][1][m][1] * r;
                float* cs = nullptr;
                if (row < MP) { const int t = row & (TP - 1); if (t >= TP - 2) cs = out + O_PCONV + ((size_t)(row >> 11) * 2 + (t - (TP - 2))) * DFF + col; }
                else { const int rr = row - MP, t = rr & 7; if (t >= 6) cs = out + O_SCONV + ((size_t)(rr >> 3) * 2 + (t - 6)) * DFF + col; }
                if (cs) { *(f32x4*)cs = acc[ai][0][m][0]; *(f32x4*)(cs + 4) = acc[ai][0][m][1]; } }
        if (fr >= 14) {
#pragma unroll
            for (int ai = 0; ai < 2; ++ai) { LAS float* p = xch + ((((ai * 2 + wr) * 4 + wc) * 2 + (fr - 14)) * 4 + fq) * 8; *(LAS f32x4*)p = acc[ai][0][3][0]; *(LAS f32x4*)(p + 4) = acc[ai][0][3][1]; }
            if (!sample && wr == 1) { float* p = ub + ((size_t)u.pm * 6 + (fr - 14)) * DFF + col; *(f32x4*)p = acc[1][0][3][0]; *(f32x4*)(p + 4) = acc[1][0][3][1]; }
        }
        if (!sample && wr == 0 && fr < 2) { float* p = ub + ((size_t)u.pm * 6 + 2 + fr) * DFF + col; *(f32x4*)p = acc[0][0][0][0]; *(f32x4*)(p + 4) = acc[0][0][0][1];
            p += 2 * DFF; *(f32x4*)p = acc[0][1][0][0]; *(f32x4*)(p + 4) = acc[0][1][0][1]; }
        asm volatile("s_waitcnt lgkmcnt(0)" ::: "memory"); __builtin_amdgcn_s_barrier();
        const f32x4 k0a = *(const f32x4*)(cw + col), k0b = *(const f32x4*)(cw + col + 4), k1a = *(const f32x4*)(cw + DFF + col), k1b = *(const f32x4*)(cw + DFF + col + 4);
        const f32x4 k2a = *(const f32x4*)(cw + 2 * DFF + col), k2b = *(const f32x4*)(cw + 2 * DFF + col + 4), cba = *(const f32x4*)(cb + col), cbb = *(const f32x4*)(cb + col + 4);
#pragma unroll
        for (int ai = 0; ai < 2; ++ai) {
            f32x4 pe0 = {0.f, 0.f, 0.f, 0.f}, pe1 = {0.f, 0.f, 0.f, 0.f};
            if (!(ai == 0 && wr == 0) && fr >= 14) { const int sai = (wr == 1) ? ai : ai - 1, swr = wr ^ 1;
                const LAS float* p = xch + ((((sai * 2 + swr) * 4 + wc) * 2 + (fr - 14)) * 4 + fq) * 8; pe0 = *(const LAS f32x4*)p; pe1 = *(const LAS f32x4*)(p + 4); }
#pragma unroll
            for (int m = 0; m < 4; ++m) { const int row = row0 + ai * 128 + m * 16;
                const f32x4 c0 = acc[ai][0][m][0], c1 = acc[ai][0][m][1], v0 = m ? acc[ai][0][m ? m - 1 : 0][0] : pe0, v1 = m ? acc[ai][0][m ? m - 1 : 0][1] : pe1;
                float cur[8] = {c0[0], c0[1], c0[2], c0[3], c1[0], c1[1], c1[2], c1[3]}, prv[8] = {v0[0], v0[1], v0[2], v0[3], v1[0], v1[1], v1[2], v1[3]};
                float p1[8], p2[8];
#pragma unroll
                for (int i = 0; i < 8; ++i) { const float y1 = DPP_MOV(0x121, 0.f, prv[i]); p1[i] = DPP_MOV(0x111, y1, cur[i]); const float y2 = DPP_MOV(0x122, 0.f, prv[i]); p2[i] = DPP_MOV(0x112, y2, cur[i]); }
                if (sample) { const int t = fr & 7;
                    if (t < 2) { const float* st = cst + (size_t)((row - MP) >> 3) * 2 * DFF + col;
                        const f32x4 s1a = *(const f32x4*)(st + DFF), s1b = *(const f32x4*)(st + DFF + 4);
                        if (t == 0) { const f32x4 s0a = *(const f32x4*)st, s0b = *(const f32x4*)(st + 4);
#pragma unroll
                            for (int i = 0; i < 4; ++i) { p1[i] = s1a[i]; p1[4 + i] = s1b[i]; p2[i] = s0a[i]; p2[4 + i] = s0b[i]; } }
                        else {
#pragma unroll
                            for (int i = 0; i < 4; ++i) { p2[i] = s1a[i]; p2[4 + i] = s1b[i]; } } } }
                const f32x4 g0 = acc[ai][1][m][0], g1 = acc[ai][1][m][1];
                float o[8];
#pragma unroll
                for (int i = 0; i < 4; ++i) { o[i] = gelu_tanh(cba[i] + k0a[i] * p2[i] + k1a[i] * p1[i] + k2a[i] * cur[i]) * g0[i];
                    o[4 + i] = gelu_tanh(cbb[i] + k0b[i] * p2[4 + i] + k1b[i] * p1[4 + i] + k2b[i] * cur[4 + i]) * g1[i]; }
                u32x4 w; w.x = cvt_pk_bf16(o[0], o[1]); w.y = cvt_pk_bf16(o[2], o[3]); w.z = cvt_pk_bf16(o[4], o[5]); w.w = cvt_pk_bf16(o[6], o[7]);
                *(u32x4*)(ACT + (size_t)row * DFF + col) = w; }
        }
    }
};
struct EpiDown {
    static constexpr bool PERM = true;
    const float* X1; float* out; float* tailp;
    __device__ __forceinline__ void operator()(AccT& acc, const pg8::Unit& u, int wr, int wc, int fr, int fq) const {
        if (u.tail < 0) {
            const int row0 = u.pm * 256 + wr * 64 + fr, col0 = u.pn * 256 + wc * 32 + 8 * fq;
#pragma unroll
            for (int ai = 0; ai < 2; ++ai)
#pragma unroll
                for (int m = 0; m < 4; ++m) { const int row = row0 + ai * 128 + m * 16;
#pragma unroll
                    for (int bj = 0; bj < 2; ++bj) { const int col = col0 + bj * 128;
                        const f32x4 v0 = acc[ai][bj][m][0] + *(const f32x4*)(X1 + (size_t)row * DM + col), v1 = acc[ai][bj][m][1] + *(const f32x4*)(X1 + (size_t)row * DM + col + 4);
                        *(f32x4*)(out + (size_t)row * DM + col) = v0; *(f32x4*)(out + (size_t)row * DM + col + 4) = v1; } }
        } else {
            float* tp = tailp + (size_t)u.tail * 65536 + (wr * 64 + fr) * 256 + wc * 32 + 8 * fq;
#pragma unroll
            for (int ai = 0; ai < 2; ++ai)
#pragma unroll
                for (int m = 0; m < 4; ++m)
#pragma unroll
                    for (int bj = 0; bj < 2; ++bj) { float* p = tp + (ai * 128 + m * 16) * 256 + bj * 128; *(f32x4*)p = acc[ai][bj][m][0]; *(f32x4*)(p + 4) = acc[ai][bj][m][1]; }
        }
    }
};

template <class ColPtr>
__device__ __forceinline__ void transpose_item(const ColPtr& cp, int K, int srcN, bf16* WT, LAS float* scr, int kb, int nb, int lane) {
    const int k0 = 64 * kb, n0 = 64 * nb, kr = lane >> 4, n4 = (lane & 15) * 4;
    const float* src = cp(n0 + n4);
    f32x4 v[16];
#pragma unroll
    for (int i = 0; i < 16; ++i) v[i] = src ? *(const f32x4*)(src + (size_t)(k0 + 4 * i + kr) * srcN) : (f32x4){0.f, 0.f, 0.f, 0.f};
#pragma unroll
    for (int i = 0; i < 16; ++i) { LAS float* d = scr + (4 * i + kr) * 65 + n4; d[0] = v[i][0]; d[1] = v[i][1]; d[2] = v[i][2]; d[3] = v[i][3]; }
    asm volatile("s_waitcnt lgkmcnt(0)" ::: "memory");
    const int c = lane & 7;
#pragma unroll
    for (int j = 0; j < 8; ++j) { const int n = (lane >> 3) + 8 * j; const LAS float* s = scr + (8 * c) * 65 + n;
        u32x4 o; o.x = cvt_pk_bf16(s[0 * 65], s[1 * 65]); o.y = cvt_pk_bf16(s[2 * 65], s[3 * 65]); o.z = cvt_pk_bf16(s[4 * 65], s[5 * 65]); o.w = cvt_pk_bf16(s[6 * 65], s[7 * 65]);
        *(u32x4*)(WT + (size_t)(n0 + n) * K + k0 + 8 * c) = o; }
    asm volatile("s_waitcnt lgkmcnt(0)" ::: "memory");
}
struct ColWin { const float* W; __device__ __forceinline__ const float* operator()(int n) const {
    int c; if (n < 4096) c = n; else if (n < 7168) c = n + 8; else if (n < 11264) { const int l = n - 7168, q = l >> 8, w = l & 255; c = 7192 + (w < 128 ? 128 * q + w : 2048 + 128 * q + (w - 128)); } else if (n < 11272) c = 4096 + (n - 11264); else if (n < 11288) c = 7176 + (n - 11272); else return nullptr;
    return W + c; } };
struct ColPlain { const float* W; __device__ __forceinline__ const float* operator()(int n) const { return W + n; } };
struct ColUG { const float* Wu; const float* Wg; __device__ __forceinline__ const float* operator()(int n) const { const int pn = n >> 8, w = n & 255; return w < 128 ? Wu + pn * 128 + w : Wg + pn * 128 + (w - 128); } };

__device__ __forceinline__ void p0_prologue(const Args& a, LAS unsigned char* lds, int gwg, int nwgs, int mode) {
    int tid_ = threadIdx.x; asm volatile("" : "+v"(tid_));
    const int tid = tid_, lane = tid & 63, wave = __builtin_amdgcn_readfirstlane(tid >> 6);
    LAS float* scr = (LAS float*)(lds + wave * 16640);
    const int gw = gwg * NWAVES + wave, NGW = nwgs * NWAVES;
    unsigned char* ws = a.ws;
    constexpr int I_WIN_ = 32 * (NPROJ_PAD / 64), I_A = 16 * 32, I_O = 32 * 32, I_UG = 32 * (2 * DFF / 64), I_D = (DFF / 64) * 32;
    constexpr int NITEMS = I_WIN_ + 2 * I_A + I_O + I_UG + I_D;
    const int it0 = mode == 0 ? 0 : I_WIN_, it1 = mode == 0 ? I_WIN_ : NITEMS;
    for (int it = it0 + gw; it < it1; it += NGW) {
        int r = it;
        if (r < I_WIN_) { ColWin cp{a.in[I_WIN]}; const int nblk = NPROJ_PAD / 64; transpose_item(cp, DM, NIN, (bf16*)(ws + WS_WIN), scr, r / nblk, r % nblk, lane); continue; } r -= I_WIN_;
        if (r < I_A) { ColPlain cp{a.in[I_WA]}; transpose_item(cp, 1024, DM, (bf16*)(ws + WS_WA), scr, r / 32, r % 32, lane); continue; } r -= I_A;
        if (r < I_A) { ColPlain cp{a.in[I_WB]}; transpose_item(cp, 1024, DM, (bf16*)(ws + WS_WB), scr, r / 32, r % 32, lane); continue; } r -= I_A;
        if (r < I_O) { ColPlain cp{a.in[I_WO]}; transpose_item(cp, DM, DM, (bf16*)(ws + WS_WO), scr, r / 32, r % 32, lane); continue; } r -= I_O;
        if (r < I_UG) { ColUG cp{a.in[I_WUP], a.in[I_WGATE]}; const int nblk = 2 * DFF / 64; transpose_item(cp, DM, DFF, (bf16*)(ws + WS_WUG), scr, r / nblk, r % nblk, lane); continue; } r -= I_UG;
        { ColPlain cp{a.in[I_WDOWN]}; transpose_item(cp, DFF, DM, (bf16*)(ws + WS_WD), scr, r / 32, r % 32, lane); }
    }
    const float* nw = a.in[I_NMIX]; bf16* XN = (bf16*)(ws + WS_XN);
    if (mode == 0)
    for (int m = gw; m < MT; m += NGW) {
        const float* xrow = m < MP ? a.in[I_XP] + (size_t)m * DM : a.in[I_XS] + (size_t)(m - MP) * DM;
        f32x4 v[8]; float s = 0.f;
#pragma unroll
        for (int j = 0; j < 8; ++j) { v[j] = *(const f32x4*)(xrow + 4 * lane + 256 * j); s += dot4(v[j], v[j]); }
        const float r = rsqrtf(wave_sum(s) * (1.f / DM) + EPS);
#pragma unroll
        for (int j = 0; j < 8; ++j) { const f32x4 w = *(const f32x4*)(nw + 4 * lane + 256 * j); u32x2 o; o.x = cvt_pk_bf16(v[j][0] * r * w[0], v[j][1] * r * w[1]); o.y = cvt_pk_bf16(v[j][2] * r * w[2], v[j][3] * r * w[3]);
            *(u32x2*)(XN + (size_t)m * DM + 4 * lane + 256 * j) = o; }
    }
}

__device__ __forceinline__ void stage_v(LAS bf16* Vs, const bf16* P, int row0, int colbase, int tid) {
#pragma unroll
    for (int i = 0; i < 8; ++i) { const int idx = tid + NTHR * i, s = idx >> 5, p = idx & 31;
        *(LAS u32x4*)(Vs + s * 272 + p * 8) = *(const u32x4*)(P + (size_t)(row0 + s) * NPROJ + colbase + 8 * p); }
}
typedef short v4i16_t __attribute__((ext_vector_type(4)));
__device__ __forceinline__ u32x2 tr64(const LAS bf16* p) { return __builtin_bit_cast(u32x2, __builtin_amdgcn_ds_read_tr16_b64_v4i16((LAS v4i16_t*)p)); }
__device__ __forceinline__ bf16x8 tr_frag(const LAS bf16* img, int RS, int c0, int ks, int lane) {
    const int g = lane >> 4, q = (lane & 15) >> 2, p = lane & 3;
    const LAS bf16* a = img + (32 * ks + 4 * g + q) * RS + c0 + 4 * p;
    const u32x2 lo = tr64(a), hi = tr64(a + 16 * RS);
    u32x4 w; w.x = lo.x; w.y = lo.y; w.z = hi.x; w.w = hi.y;
    return __builtin_bit_cast(bf16x8, w);
}
__device__ __forceinline__ float wave_iscan_add(float v, int lane) {
#pragma unroll
    for (int o = 1; o < 64; o <<= 1) { const float t = __shfl_up(v, o); if (lane >= o) v += t; }
    return v;
}
__device__ __forceinline__ float wave_iscan_max(float v, int lane) {
#pragma unroll
    for (int o = 1; o < 64; o <<= 1) { const float t = __shfl_up(v, o); if (lane >= o) v = fmaxf(v, t); }
    return v;
}

__device__ __forceinline__ void gla_logdecay(const Args& a, const float* gates, int row0, int h, LAS float* galS, LAS float* segS, int tid, float (&la)[32], float& off, float& tot) {
    const int d = tid & 127, seg = tid >> 7;
    { const int t = tid >> 2, q = tid & 3; *(LAS f32x4*)(galS + t * 16 + q * 4) = *(const f32x4*)(gates + (size_t)(row0 + t) * 32 + 8 + q * 4); }
    float up[16];
#pragma unroll
    for (int j = 0; j < 16; ++j) up[j] = a.in[I_AUP][j * 512 + h * 128 + d];
    const float ab = a.in[I_AB][h * 128 + d];
    __syncthreads();
    float ssum = 0.f;
#pragma unroll
    for (int i = 0; i < 32; ++i) { const int t = seg * 32 + i; float z = ab;
#pragma unroll
        for (int q = 0; q < 4; ++q) { const f32x4 g = *(const LAS f32x4*)(galS + t * 16 + q * 4); z += g[0] * up[4 * q] + g[1] * up[4 * q + 1] + g[2] * up[4 * q + 2] + g[3] * up[4 * q + 3]; }
        la[i] = logsig(z) * (1.f / 16.f); ssum += la[i]; }
    segS[seg * 128 + d] = ssum;
    __syncthreads();
    off = 0.f; tot = 0.f;
#pragma unroll
    for (int s = 0; s < 4; ++s) { const float v = segS[s * 128 + d]; tot += v; off += (s < seg) ? v : 0.f; }
}

template <bool ML>
__device__ __forceinline__ void chunk_state(const Args& a, LAS unsigned char* lds, int bh, int c) {
    constexpr int DK = ML ? 256 : 128, NDT = DK / 16, RSK = DK + 16;
    int tid_ = threadIdx.x; asm volatile("" : "+v"(tid_));
    const int tid = tid_, lane = tid & 63, wave = __builtin_amdgcn_readfirstlane(tid >> 6), fr = lane & 15, fq = lane >> 4;
    const int b = bh >> 2, h = bh & 3, row0 = b * TP + c * 128, item = bh * NCH + c;
    unsigned char* ws = a.ws;
    const bf16* P = (const bf16*)(ws + WS_PROJ); const float* gates = (const float*)(ws + WS_GATES);
    LAS bf16* Ks = (LAS bf16*)lds; LAS bf16* Vs = (LAS bf16*)(lds + 69632); LAS float* sc = (LAS float*)(lds + 139264);
    __syncthreads();
    stage_v(Vs, P, row0, (ML ? C_MV : C_GV) + h * 256, tid);
    u32x4 kpre[8];
    if (ML) {
#pragma unroll
        for (int i = 0; i < 8; ++i) { const int idx = tid + NTHR * i, sr = idx >> 5, dp = idx & 31; kpre[i] = *(const u32x4*)(P + (size_t)(row0 + sr) * NPROJ + C_MK + h * 256 + 8 * dp); }
    }
    if (ML) {
        if (wave == 0) {
            const int t0 = 2 * lane;
            const float lf0 = logsig(gates[(size_t)(row0 + t0) * 32 + 4 + h] + a.in[I_BF][h]), lf1 = logsig(gates[(size_t)(row0 + t0 + 1) * 32 + 4 + h] + a.in[I_BF][h]);
            const float i0 = gates[(size_t)(row0 + t0) * 32 + h] + a.in[I_BI][h], i1 = gates[(size_t)(row0 + t0 + 1) * 32 + h] + a.in[I_BI][h];
            const float pr = lf0 + lf1, S = wave_iscan_add(pr, lane), ex = S - pr;
            const float ah0 = i0 - (ex + lf0), ah1 = i1 - S;
            const float Ah = wave_max(fmaxf(ah0, ah1));
            sc[t0] = __expf(ah0 - Ah) * (1.f / 16.f); sc[t0 + 1] = __expf(ah1 - Ah) * (1.f / 16.f);
            if (lane == 63) { float* chs = (float*)(ws + WS_CHS); chs[item * 2] = Ah; chs[item * 2 + 1] = S; }
        }
        __syncthreads();
#pragma unroll
        for (int i = 0; i < 8; ++i) { const int idx = tid + NTHR * i, s = idx >> 5, dp = idx & 31; const float w = sc[s];
            const u32x4 v = kpre[i];
            u32x4 o; o.x = cvt_pk_bf16(bflo(v.x) * w, bfhi(v.x) * w); o.y = cvt_pk_bf16(bflo(v.y) * w, bfhi(v.y) * w); o.z = cvt_pk_bf16(bflo(v.z) * w, bfhi(v.z) * w); o.w = cvt_pk_bf16(bflo(v.w) * w, bfhi(v.w) * w);
            *(LAS u32x4*)(Ks + s * RSK + 8 * dp) = o; }
    } else {
        float la[32], off, tot;
        const int d = tid & 127, seg = tid >> 7;
        unsigned short kraw[32];
#pragma unroll
        for (int i = 0; i < 32; ++i) kraw[i] = P[(size_t)(row0 + seg * 32 + i) * NPROJ + C_GK + h * 128 + d];
        LAS float* galS = (LAS float*)(lds + 36864); gla_logdecay(a, gates, row0, h, galS, galS + 2048, tid, la, off, tot);
        if (seg == 0) ((float*)(ws + WS_BEND))[item * 128 + d] = tot;
        float bcur = off;
#pragma unroll
        for (int i = 0; i < 32; ++i) { const int t = seg * 32 + i; bcur += la[i];
            const float kv = bf2f(kraw[i]);
            Ks[t * RSK + d] = f2bf(kv * __expf(tot - bcur)); }
    }
    __syncthreads();
    f32x4 acc[2][NDT];
#pragma unroll
    for (int e = 0; e < 2; ++e)
#pragma unroll
        for (int d = 0; d < NDT; ++d) acc[e][d] = (f32x4){0.f, 0.f, 0.f, 0.f};
#pragma unroll
    for (int ks = 0; ks < 4; ++ks) {
        bf16x8 vb[2];
#pragma unroll
        for (int e = 0; e < 2; ++e) vb[e] = tr_frag(Vs, 272, wave * 32 + e * 16, ks, lane);
#pragma unroll
        for (int d = 0; d < NDT; ++d) { const bf16x8 ka = tr_frag(Ks, RSK, d * 16, ks, lane);
#pragma unroll
            for (int e = 0; e < 2; ++e) acc[e][d] = __builtin_amdgcn_mfma_f32_16x16x32_bf16(ka, vb[e], acc[e][d], 0, 0, 0); }
    }
    float* dst = (float*)(ws + (ML ? WS_DC : WS_DS)) + (size_t)item * 256 * DK;
#pragma unroll
    for (int e = 0; e < 2; ++e)
#pragma unroll
        for (int d = 0; d < NDT; ++d) *(f32x4*)(dst + (size_t)(wave * 32 + e * 16 + fr) * DK + d * 16 + 4 * fq) = acc[e][d];
    if (ML && tid < 256) { float s = 0.f;
#pragma unroll 16
        for (int i = 0; i < 128; ++i) s += bf2f(Ks[i * RSK + tid]);
        ((float*)(ws + WS_DN))[item * 256 + tid] = s; }
}

__device__ __forceinline__ void scan_mlstm(const Args& a, int j) {
    int tid_ = threadIdx.x; asm volatile("" : "+v"(tid_));
    const int tid = tid_, bh = j >> 5, eb = j & 31;
    unsigned char* ws = a.ws;
    const float* chs = (const float*)(ws + WS_CHS);
    const int e = eb * 8 + (tid >> 6), d4 = (tid & 63) * 4;
    const float* dC = (const float*)(ws + WS_DC) + (size_t)bh * NCH * 65536 + (size_t)e * 256 + d4;
    bf16* CT = (bf16*)(ws + WS_CT) + (size_t)bh * NCH * 65536 + (size_t)e * 256 + d4;
    f32x4 Cv = {0.f, 0.f, 0.f, 0.f}; float Fs = 0.f, Mp = 0.f;
    const bool do_n = (eb == 0 && tid < 256);
    float nv = 0.f;
    f32x4 dv[NCH];
#pragma unroll
    for (int c = 0; c < NCH; ++c) dv[c] = *(const f32x4*)(dC + (size_t)c * 65536);
#pragma unroll
    for (int c = 0; c < NCH; ++c) {
        u32x2 o; o.x = cvt_pk_bf16(Cv[0], Cv[1]); o.y = cvt_pk_bf16(Cv[2], Cv[3]); *(u32x2*)(CT + (size_t)c * 65536) = o;
        if (do_n) ((bf16*)(ws + WS_NPREV))[(bh * NCH + c) * 256 + tid] = f2bf(nv);
        const float Ah = chs[(bh * NCH + c) * 2], bt = chs[(bh * NCH + c) * 2 + 1];
        const float Ac = Ah - Fs, Mn = fmaxf(Mp, Ac), f1 = __expf(Mp - Mn), f2 = __expf(Ac - Mn);
        Cv = Cv * f1 + dv[c] * f2;
        if (do_n) nv = nv * f1 + ((const float*)(ws + WS_DN))[(bh * NCH + c) * 256 + tid] * f2;
        Mp = Mn; Fs += bt;
    }
    float* oC = a.out + O_PC + (size_t)bh * 65536;
#pragma unroll
    for (int i = 0; i < 4; ++i) oC[(size_t)(d4 + i) * 256 + e] = Cv[i];
    if (do_n) a.out[O_PN + bh * 256 + tid] = nv;
    if (eb == 0 && tid == 0) a.out[O_PM + bh] = Fs + Mp;
}
__device__ __forceinline__ void scan_gla(const Args& a, int j) {
    int tid_ = threadIdx.x; asm volatile("" : "+v"(tid_));
    const int tid = tid_, bh = j >> 4, eb = j & 15;
    unsigned char* ws = a.ws;
    const float* bend = (const float*)(ws + WS_BEND);
    const int ee = eb * 16 + (tid >> 5), d4 = (tid & 31) * 4;
    const float* dS = (const float*)(ws + WS_DS) + (size_t)bh * NCH * 32768 + (size_t)ee * 128 + d4;
    bf16* ST = (bf16*)(ws + WS_ST) + (size_t)bh * NCH * 32768 + (size_t)ee * 128 + d4;
    f32x4 Sv = {0.f, 0.f, 0.f, 0.f};
    f32x4 dv[NCH];
#pragma unroll
    for (int c = 0; c < NCH; ++c) dv[c] = *(const f32x4*)(dS + (size_t)c * 32768);
#pragma unroll
    for (int c = 0; c < NCH; ++c) {
        u32x2 o; o.x = cvt_pk_bf16(Sv[0], Sv[1]); o.y = cvt_pk_bf16(Sv[2], Sv[3]); *(u32x2*)(ST + (size_t)c * 32768) = o;
        const f32x4 be = *(const f32x4*)(bend + (bh * NCH + c) * 128 + d4);
        Sv[0] = Sv[0] * __expf(be[0]) + dv[c][0]; Sv[1] = Sv[1] * __expf(be[1]) + dv[c][1]; Sv[2] = Sv[2] * __expf(be[2]) + dv[c][2]; Sv[3] = Sv[3] * __expf(be[3]) + dv[c][3];
    }
    float* oS = a.out + O_PS + (size_t)bh * 32768;
#pragma unroll
    for (int i = 0; i < 4; ++i) oS[(size_t)(d4 + i) * 256 + ee] = Sv[i];
}

template <bool ML>
__device__ __forceinline__ void chunk_out(const Args& a, LAS unsigned char* lds, int bh, int c) {
    constexpr int DK = ML ? 256 : 128, QS = DK + 8, NKK = DK / 32;
    int tid_ = threadIdx.x; asm volatile("" : "+v"(tid_));
    const int tid = tid_, lane = tid & 63, wave = __builtin_amdgcn_readfirstlane(tid >> 6), fr = lane & 15, fq = lane >> 4;
    const int b = bh >> 2, h = bh & 3, row0 = b * TP + c * 128, item = bh * NCH + c;
    unsigned char* ws = a.ws;
    const bf16* P = (const bf16*)(ws + WS_PROJ); const float* gates = (const float*)(ws + WS_GATES);
    LAS bf16* Qs = (LAS bf16*)lds; LAS bf16* Ks = Qs + 128 * QS;
    LAS float* sc = (LAS float*)(lds + 143616);
    __syncthreads();
    if (ML) {
        if (wave == 0) {
            const float* chs = (const float*)(ws + WS_CHS);
            const float Ahc = lane < NCH ? chs[(bh * NCH + lane) * 2] : 0.f, btc = lane < NCH ? chs[(bh * NCH + lane) * 2 + 1] : 0.f;
            const float fsx = wave_iscan_add(btc, lane) - btc;
            const float Mp = fmaxf(0.f, wave_max(lane < c ? Ahc - fsx : -3.0e38f)), Fs = wave_sum(lane < c ? btc : 0.f);
            const int t0 = 2 * lane;
            const float lf0 = logsig(gates[(size_t)(row0 + t0) * 32 + 4 + h] + a.in[I_BF][h]), lf1 = logsig(gates[(size_t)(row0 + t0 + 1) * 32 + 4 + h] + a.in[I_BF][h]);
            const float i0 = gates[(size_t)(row0 + t0) * 32 + h] + a.in[I_BI][h], i1 = gates[(size_t)(row0 + t0 + 1) * 32 + h] + a.in[I_BI][h];
            const float pr = lf0 + lf1, S = wave_iscan_add(pr, lane), b0 = S - lf1, b1 = S;
            const float a0 = i0 - b0 - Fs, a1 = i1 - b1 - Fs;
            const float cm = wave_iscan_max(fmaxf(a0, a1), lane); float exm = __shfl_up(cm, 1); if (lane == 0) exm = -3.0e38f;
            const float M0 = fmaxf(fmaxf(Mp, exm), a0), M1 = fmaxf(M0, a1);
            sc[t0] = a0; sc[t0 + 1] = a1; sc[128 + t0] = M0; sc[128 + t0 + 1] = M1; sc[256 + t0] = __expf(Mp - M0); sc[256 + t0 + 1] = __expf(Mp - M1);
            sc[384 + t0] = __expf(-(Fs + b0 + M0)); sc[384 + t0 + 1] = __expf(-(Fs + b1 + M1));
        }
#pragma unroll
        for (int i = 0; i < 8; ++i) { const int idx = tid + NTHR * i, t = idx >> 5, p = idx & 31;
            *(LAS u32x4*)(Qs + t * QS + p * 8) = *(const u32x4*)(P + (size_t)(row0 + t) * NPROJ + C_MQ + h * 256 + p * 8);
            *(LAS u32x4*)(Ks + t * QS + p * 8) = *(const u32x4*)(P + (size_t)(row0 + t) * NPROJ + C_MK + h * 256 + p * 8); }
    } else {
        float la[32], off, tot;
        const int d = tid & 127, seg = tid >> 7;
        unsigned short qraw[32], kraw[32];
#pragma unroll
        for (int i = 0; i < 32; ++i) { qraw[i] = P[(size_t)(row0 + seg * 32 + i) * NPROJ + C_GQ + h * 128 + d]; kraw[i] = P[(size_t)(row0 + seg * 32 + i) * NPROJ + C_GK + h * 128 + d]; }
        LAS float* galS = (LAS float*)(lds + 69632); LAS float* segS = galS + 128 * 16;
        gla_logdecay(a, gates, row0, h, galS, segS, tid, la, off, tot);
        float bcur = off;
#pragma unroll
        for (int i = 0; i < 32; ++i) { const int t = seg * 32 + i; bcur += la[i];
            const float qv = bf2f(qraw[i]), kv = bf2f(kraw[i]);
            Qs[t * QS + d] = f2bf(qv * 0.08838834764831845f * __expf(bcur)); Ks[t * QS + d] = f2bf(kv * __expf(-bcur)); }
    }
    __syncthreads();
    constexpr int NCP = ML ? 16 : 8;
    u32x4 cpre[NCP]; u32x4 npre = {0u, 0u, 0u, 0u};
    if (ML) { const bf16* CT = (const bf16*)(ws + WS_CT) + (size_t)item * 65536;
#pragma unroll
        for (int i = 0; i < NCP; ++i) { const int idx = tid + NTHR * i, e = idx >> 5, p = idx & 31; cpre[i] = *(const u32x4*)(CT + (size_t)e * 256 + p * 8); }
        if (tid < 32) npre = *(const u32x4*)((const bf16*)(ws + WS_NPREV) + (size_t)item * 256 + tid * 8);
    } else { const bf16* ST = (const bf16*)(ws + WS_ST) + (size_t)item * 32768;
#pragma unroll
        for (int i = 0; i < NCP; ++i) { const int idx = tid + NTHR * i, e = idx >> 4, p = idx & 15; cpre[i] = *(const u32x4*)(ST + (size_t)e * 128 + p * 8); }
    }
    bf16x8 qf[NKK];
#pragma unroll
    for (int kk = 0; kk < NKK; ++kk) qf[kk] = *(const LAS bf16x8*)(Qs + (wave * 16 + fr) * QS + kk * 32 + fq * 8);
    const int t = wave * 16 + fr;
    u32x2 pb[8]; float den = 0.f;
    {
        const float Mt = ML ? sc[128 + t] : 0.f;
#pragma unroll
        for (int st = 0; st < 8; ++st) { f32x4 s = {0.f, 0.f, 0.f, 0.f};
#pragma unroll
            for (int kk = 0; kk < NKK; ++kk) { const bf16x8 kf = *(const LAS bf16x8*)(Ks + (st * 16 + fr) * QS + kk * 32 + fq * 8); s = __builtin_amdgcn_mfma_f32_16x16x32_bf16(kf, qf[kk], s, 0, 0, 0); }
            float p[4];
            f32x4 as4 = {0.f, 0.f, 0.f, 0.f}; if (ML) as4 = *(const LAS f32x4*)(sc + st * 16 + 4 * fq);
#pragma unroll
            for (int r = 0; r < 4; ++r) { const int si = st * 16 + 4 * fq + r;
                const float e = ML ? s[r] * (1.f / 16.f) * __expf(fminf(as4[r] - Mt, 0.f)) : s[r];
                p[r] = (si <= t) ? e : 0.f;
                den += p[r]; }
            pb[st].x = cvt_pk_bf16(p[0], p[1]); pb[st].y = cvt_pk_bf16(p[2], p[3]);
            __builtin_amdgcn_sched_barrier(0); }
    }
    __syncthreads();
    LAS bf16* Cl = (LAS bf16*)lds;
    if (ML) {
#pragma unroll
        for (int i = 0; i < NCP; ++i) { const int idx = tid + NTHR * i, e = idx >> 5, p = idx & 31; *(LAS u32x4*)(Cl + e * QS + p * 8) = cpre[i]; }
        { const int e = tid >> 5, p = tid & 31; *(LAS u32x4*)(Cl + (256 + e) * QS + p * 8) = npre; }
    } else {
#pragma unroll
        for (int i = 0; i < NCP; ++i) { const int idx = tid + NTHR * i, e = idx >> 4, p = idx & 15; *(LAS u32x4*)(Cl + e * QS + p * 8) = cpre[i]; }
    }
    u32x4 vpre[8];
#pragma unroll
    for (int i = 0; i < 8; ++i) { const int idx = tid + NTHR * i, sr = idx >> 5, p = idx & 31; vpre[i] = *(const u32x4*)(P + (size_t)(row0 + sr) * NPROJ + (ML ? C_MV : C_GV) + h * 256 + 8 * p); }
    __syncthreads();
    f32x4 acc[16];
#pragma unroll
    for (int et = 0; et < 16; ++et) { acc[et] = (f32x4){0.f, 0.f, 0.f, 0.f};
#pragma unroll
        for (int kk = 0; kk < NKK; ++kk) { const bf16x8 cf = *(const LAS bf16x8*)(Cl + (et * 16 + fr) * QS + kk * 32 + fq * 8); acc[et] = __builtin_amdgcn_mfma_f32_16x16x32_bf16(cf, qf[kk], acc[et], 0, 0, 0); }
        if ((et & 1) == 1) __builtin_amdgcn_sched_barrier(0); }
    float wint = 1.f, qn = 0.f;
    if (ML) {
        f32x4 dn = {0.f, 0.f, 0.f, 0.f};
#pragma unroll
        for (int kk = 0; kk < NKK; ++kk) { const bf16x8 nf = *(const LAS bf16x8*)(Cl + (256 + fr) * QS + kk * 32 + fq * 8); dn = __builtin_amdgcn_mfma_f32_16x16x32_bf16(nf, qf[kk], dn, 0, 0, 0); }
        qn = __shfl(dn[0], fr);
        wint = sc[256 + t];
#pragma unroll
        for (int et = 0; et < 16; ++et) acc[et] = acc[et] * wint;
    }
    __syncthreads();
    LAS bf16* Vs = (LAS bf16*)lds;
#pragma unroll
    for (int i = 0; i < 8; ++i) { const int idx = tid + NTHR * i, sr = idx >> 5, p = idx & 31; *(LAS u32x4*)(Vs + sr * 272 + p * 8) = vpre[i]; }
    __syncthreads();
#pragma unroll
    for (int ks = 0; ks < 4; ++ks) {
        u32x4 pw; pw.x = pb[2 * ks].x; pw.y = pb[2 * ks].y; pw.z = pb[2 * ks + 1].x; pw.w = pb[2 * ks + 1].y;
        const bf16x8 pf = __builtin_bit_cast(bf16x8, pw);
#pragma unroll
        for (int et = 0; et < 16; ++et) { acc[et] = __builtin_amdgcn_mfma_f32_16x16x32_bf16(tr_frag(Vs, 272, et * 16, ks, lane), pf, acc[et], 0, 0, 0); if ((et & 3) == 3) __builtin_amdgcn_sched_barrier(0); }
    }
    float inv = 1.f;
    if (ML) { den += __shfl_xor(den, 16); den += __shfl_xor(den, 32); den += wint * qn; inv = 1.f / fmaxf(fabsf(den), sc[384 + t]); }
    float ss = 0.f;
#pragma unroll
    for (int et = 0; et < 16; ++et) { acc[et] = acc[et] * inv; ss += dot4(acc[et], acc[et]); }
    ss += __shfl_xor(ss, 16); ss += __shfl_xor(ss, 32);
    const float rn = rsqrtf(ss * (1.f / 256.f) + EPS);
    const float* hw = a.in[ML ? I_MHW : I_GHW] + h * 256;
    const bf16* gp = P + (size_t)(row0 + t) * NPROJ + (ML ? C_MO : C_GR) + h * 256;
    bf16* yp = (bf16*)(ws + (ML ? WS_YM : WS_YG)) + (size_t)(row0 + t) * 1024 + h * 256;
#pragma unroll
    for (int et = 0; et < 16; ++et) { const int e = et * 16 + 4 * fq;
        const u32x2 gw = *(const u32x2*)(gp + e); const f32x4 w = *(const f32x4*)(hw + e);
        const float g0 = bflo(gw.x), g1 = bfhi(gw.x), g2 = bflo(gw.y), g3 = bfhi(gw.y);
        float o0 = acc[et][0] * rn * w[0], o1 = acc[et][1] * rn * w[1], o2 = acc[et][2] * rn * w[2], o3 = acc[et][3] * rn * w[3];
        if (ML) { o0 *= sigm(g0); o1 *= sigm(g1); o2 *= sigm(g2); o3 *= sigm(g3); } else { o0 *= g0 * sigm(g0); o1 *= g1 * sigm(g1); o2 *= g2 * sigm(g2); o3 *= g3 * sigm(g3); }
        u32x2 o; o.x = cvt_pk_bf16(o0, o1); o.y = cvt_pk_bf16(o2, o3); *(u32x2*)(yp + e) = o;
        if ((et & 3) == 3) __builtin_amdgcn_sched_barrier(0); }
}

template <bool ML>
__device__ __forceinline__ void sample_item(const Args& a, LAS unsigned char* lds, int b, int h) {
    constexpr int DK = ML ? 256 : 128;
    int tid_ = threadIdx.x; asm volatile("" : "+v"(tid_));
    const int tid = tid_, lane = tid & 63, wave = __builtin_amdgcn_readfirstlane(tid >> 6);
    unsigned char* ws = a.ws;
    const bf16* P = (const bf16*)(ws + WS_PROJ); const float* gates = (const float*)(ws + WS_GATES);
    const int row0 = MP + b * 8, bh = b * 4 + h;
    LAS float* qT = (LAS float*)lds;
    LAS float* wkT = qT + 2048;
    LAS float* kT = wkT + 2048;
    LAS float* vS = kT + 2048;
    LAS float* red = vS + 2048;
    LAS float* sm = red + 16384;
    const float* C0 = a.in[ML ? I_C : I_S] + (size_t)bh * DK * 256;
    float* C1 = a.out + (ML ? O_SC : O_SS) + (size_t)bh * DK * 256;
    f32x4 nx[8];
#pragma unroll
    for (int j = 0; j < 8; ++j) nx[j] = __builtin_nontemporal_load((const f32x4*)(C0 + (size_t)(wave + 8 * j) * 256 + 4 * lane));
    __syncthreads();
    float aS[8], Mt[8], bS[8]; float m0 = 0.f, dec = 1.f;
    if (ML) {
        m0 = a.in[I_M][bh]; float bs = 0.f, M = m0;
#pragma unroll
        for (int t = 0; t < 8; ++t) { const float mi = gates[(size_t)(row0 + t) * 32 + h], mf = gates[(size_t)(row0 + t) * 32 + 4 + h];
            bs += logsig(mf + a.in[I_BF][h]); bS[t] = bs; aS[t] = mi + a.in[I_BI][h] - bs; M = fmaxf(M, aS[t]); Mt[t] = M; }
        dec = __expf(m0 - Mt[7]);
        if (tid == 0) {
#pragma unroll
            for (int t = 0; t < 8; ++t) { sm[200 + t] = aS[t]; sm[208 + t] = Mt[t]; sm[216 + t] = bS[t]; } }
        if (tid < 256) { const int d = tid;
#pragma unroll
            for (int t = 0; t < 8; ++t) { const float qv = bf2f(P[(size_t)(row0 + t) * NPROJ + C_MQ + h * 256 + d]), kv = bf2f(P[(size_t)(row0 + t) * NPROJ + C_MK + h * 256 + d]) * (1.f / 16.f);
                qT[d * 8 + t] = qv; kT[d * 8 + t] = kv; wkT[d * 8 + t] = kv * __expf(aS[t] - Mt[7]); } }
    } else {
        if (tid < 128) { const int d = tid; float up[16];
#pragma unroll
            for (int j = 0; j < 16; ++j) up[j] = a.in[I_AUP][j * 512 + h * 128 + d];
            const float ab = a.in[I_AB][h * 128 + d];
            float bc[8]; float bs = 0.f;
#pragma unroll
            for (int t = 0; t < 8; ++t) { float z = ab;
#pragma unroll
                for (int j = 0; j < 16; ++j) z += gates[(size_t)(row0 + t) * 32 + 8 + j] * up[j];
                bs += logsig(z) * (1.f / 16.f); bc[t] = bs; }
            sm[72 + d] = __expf(bs);
#pragma unroll
            for (int t = 0; t < 8; ++t) { const float qv = bf2f(P[(size_t)(row0 + t) * NPROJ + C_GQ + h * 128 + d]), kv = bf2f(P[(size_t)(row0 + t) * NPROJ + C_GK + h * 128 + d]);
                qT[d * 8 + t] = qv * 0.08838834764831845f * __expf(bc[t]); kT[d * 8 + t] = kv * __expf(-bc[t]); wkT[d * 8 + t] = kv * __expf(bs - bc[t]); } }
    }
    { const int t = tid >> 6; const u32x2 w = *(const u32x2*)(P + (size_t)(row0 + t) * NPROJ + (ML ? C_MV : C_GV) + h * 256 + 4 * lane);
      *(LAS f32x4*)(vS + t * 256 + 4 * lane) = (f32x4){bflo(w.x), bfhi(w.x), bflo(w.y), bfhi(w.y)}; }
    __syncthreads();
    float prow, qn = 0.f;
    { const int s8 = lane & 7, part = lane >> 3; float sd = 0.f;
#pragma unroll 8
      for (int i = 0; i < DK / 8; ++i) { const int d = 8 * i + part; sd += qT[d * 8 + wave] * kT[d * 8 + s8]; }
      sd += __shfl_xor(sd, 8); sd += __shfl_xor(sd, 16); sd += __shfl_xor(sd, 32);
      if (ML) prow = (s8 <= wave) ? sd * __expf(sm[200 + s8] - sm[208 + wave]) : 0.f; else prow = (s8 <= wave) ? sd : 0.f; }
    if (ML) { const float* n0 = a.in[I_N] + (size_t)bh * 256; float sd = 0.f;
#pragma unroll
      for (int i = 0; i < 4; ++i) { const int d = lane + 64 * i; sd += qT[d * 8 + wave] * n0[d]; }
      qn = wave_sum(sd); }
    f32x4 v[8], acc[8];
#pragma unroll
    for (int s = 0; s < 8; ++s) { v[s] = *(const LAS f32x4*)(vS + s * 256 + 4 * lane); acc[s] = (f32x4){0.f, 0.f, 0.f, 0.f}; }
#pragma unroll
    for (int bt = 0; bt < DK / 64; ++bt) {
        f32x4 cur[8];
#pragma unroll
        for (int j = 0; j < 8; ++j) cur[j] = nx[j];
        if (bt + 1 < DK / 64) {
#pragma unroll
            for (int j = 0; j < 8; ++j) nx[j] = __builtin_nontemporal_load((const f32x4*)(C0 + (size_t)(wave + 8 * (8 * (bt + 1) + j)) * 256 + 4 * lane)); }
#pragma unroll
        for (int j = 0; j < 8; ++j) { const int d = wave + 8 * (8 * bt + j); const f32x4 cv = cur[j];
            const f32x4 q0 = *(const LAS f32x4*)(qT + d * 8), q1 = *(const LAS f32x4*)(qT + d * 8 + 4), k0 = *(const LAS f32x4*)(wkT + d * 8), k1 = *(const LAS f32x4*)(wkT + d * 8 + 4);
            const float dd = ML ? dec : sm[72 + d];
            acc[0] += cv * q0[0]; acc[1] += cv * q0[1]; acc[2] += cv * q0[2]; acc[3] += cv * q0[3]; acc[4] += cv * q1[0]; acc[5] += cv * q1[1]; acc[6] += cv * q1[2]; acc[7] += cv * q1[3];
            f32x4 cn = cv * dd;
            cn += v[0] * k0[0]; cn += v[1] * k0[1]; cn += v[2] * k0[2]; cn += v[3] * k0[3]; cn += v[4] * k1[0]; cn += v[5] * k1[1]; cn += v[6] * k1[2]; cn += v[7] * k1[3];
            __builtin_nontemporal_store(cn, (f32x4*)(C1 + (size_t)d * 256 + 4 * lane)); }
    }
#pragma unroll
    for (int s = 0; s < 8; ++s) *(LAS f32x4*)(red + (wave * 8 + s) * 256 + 4 * lane) = acc[s];
    __syncthreads();
    const int t = wave;
    f32x4 qc = {0.f, 0.f, 0.f, 0.f};
#pragma unroll
    for (int w = 0; w < 8; ++w) qc += *(const LAS f32x4*)(red + (w * 8 + t) * 256 + 4 * lane);
    float wint = 1.f, den = 0.f, Mtt = 0.f, btt = 0.f;
    if (ML) { Mtt = sm[208 + t]; btt = sm[216 + t]; wint = __expf(m0 - Mtt); }
    f32x4 num = qc * wint;
#pragma unroll
    for (int s = 0; s < 8; ++s) { const float p = __shfl(prow, s); num += v[s] * p; den += p; }
    if (ML) { den += wint * qn; const float fl = fmaxf(fabsf(den), __expf(-(btt + Mtt))); num = num * (1.f / fl); }
    const float rn = rsqrtf(wave_sum(dot4(num, num)) * (1.f / 256.f) + EPS);
    const f32x4 w = *(const f32x4*)(a.in[ML ? I_MHW : I_GHW] + h * 256 + 4 * lane);
    const u32x2 gw = *(const u32x2*)(P + (size_t)(row0 + t) * NPROJ + (ML ? C_MO : C_GR) + h * 256 + 4 * lane);
    const float g0 = bflo(gw.x), g1 = bfhi(gw.x), g2 = bflo(gw.y), g3 = bfhi(gw.y);
    float o0 = num[0] * rn * w[0], o1 = num[1] * rn * w[1], o2 = num[2] * rn * w[2], o3 = num[3] * rn * w[3];
    if (ML) { o0 *= sigm(g0); o1 *= sigm(g1); o2 *= sigm(g2); o3 *= sigm(g3); } else { o0 *= g0 * sigm(g0); o1 *= g1 * sigm(g1); o2 *= g2 * sigm(g2); o3 *= g3 * sigm(g3); }
    u32x2 o; o.x = cvt_pk_bf16(o0, o1); o.y = cvt_pk_bf16(o2, o3);
    *(u32x2*)((bf16*)(ws + (ML ? WS_YM : WS_YG)) + (size_t)(row0 + t) * 1024 + h * 256 + 4 * lane) = o;
    if (ML) {
        if (tid < 256) { float s = dec * a.in[I_N][(size_t)bh * 256 + tid];
#pragma unroll
            for (int q = 0; q < 8; ++q) s += wkT[tid * 8 + q];
            a.out[O_SN + (size_t)bh * 256 + tid] = s; }
        if (tid == 0) a.out[O_SM + bh] = bS[7] + Mt[7];
    }
}

__device__ __forceinline__ void merge_reduce(const Args& a, int vcu, int G) {
    int tid_ = threadIdx.x; asm volatile("" : "+v"(tid_));
    const int tid = tid_, lane = tid & 63, wave = tid >> 6;
    const float* tailp = a.out + O_YP; bf16* O = (bf16*)(a.ws + WS_XN);
    for (int rr = vcu * NWAVES + wave; rr < MS; rr += G * NWAVES) { const int m = MP + rr, pmo = rr >> 8;
#pragma unroll
        for (int j = 0; j < 8; ++j) { const float* tp = tailp + (size_t)(pmo * 8 + j) * 8 * 65536 + (rr & 255) * 256 + 4 * lane;
            f32x4 v = *(const f32x4*)tp;
#pragma unroll
            for (int sl = 1; sl < 8; ++sl) v += *(const f32x4*)(tp + (size_t)sl * 65536);
            u32x2 o; o.x = cvt_pk_bf16(v[0], v[1]); o.y = cvt_pk_bf16(v[2], v[3]); *(u32x2*)(O + (size_t)m * DM + 4 * lane + 256 * j) = o; }
    }
}
__device__ __forceinline__ void rstd_phase(const Args& a, int vcu, int G) {
    int tid_ = threadIdx.x; asm volatile("" : "+v"(tid_));
    const int tid = tid_, lane = tid & 63, wave = tid >> 6;
    const float* part = (const float*)(a.ws + WS_PART); float* rstd = (float*)(a.ws + WS_RSTD);
    const bool split = (G == 256); const int nplain = split ? MP : MT;
    for (int row = vcu * NTHR + tid; row < nplain; row += G * NTHR) { float s = 0.f;
#pragma unroll
        for (int i = 0; i < 8; ++i) s += sum4(*(const f32x4*)(part + (size_t)row * 32 + 4 * i));
        rstd[row] = rsqrtf(s * (1.f / DM) + EPS); }
    if (split) {
        const float* tailp = (const float*)(a.ws + WS_PROJ); const float* nw = a.in[I_NFFN]; float* X1 = (float*)(a.ws + WS_X1); bf16* X1W = (bf16*)(a.ws + WS_X1W);
        for (int rr = vcu * NWAVES + wave; rr < MS; rr += G * NWAVES) { const int m = MP + rr, pmo = rr >> 8;
            f32x4 v[8]; float ss = 0.f;
#pragma unroll
            for (int j = 0; j < 8; ++j) { v[j] = *(const f32x4*)(a.in[I_XS] + (size_t)rr * DM + 4 * lane + 256 * j);
                const float* tp = tailp + (size_t)(pmo * 8 + j) * 8 * 65536 + (rr & 255) * 256 + 4 * lane;
#pragma unroll
                for (int sl = 0; sl < 8; ++sl) v[j] += *(const f32x4*)(tp + (size_t)sl * 65536);
                ss += dot4(v[j], v[j]); }
            ss = wave_sum(ss);
            if (lane == 0) rstd[m] = rsqrtf(ss * (1.f / DM) + EPS);
#pragma unroll
            for (int j = 0; j < 8; ++j) { const f32x4 w = *(const f32x4*)(nw + 4 * lane + 256 * j);
                *(f32x4*)(X1 + (size_t)m * DM + 4 * lane + 256 * j) = v[j];
                u32x2 o; o.x = cvt_pk_bf16(v[j][0] * w[0], v[j][1] * w[1]); o.y = cvt_pk_bf16(v[j][2] * w[2], v[j][3] * w[3]);
                *(u32x2*)(X1W + (size_t)m * DM + 4 * lane + 256 * j) = o; }
        }
    }
}
__device__ __forceinline__ void act_fixup(const Args& a, int vcu, int G) {
    unsigned char* ws = a.ws; const float* ub = (const float*)(ws + WS_U); bf16* ACT = (bf16*)(ws + WS_G);
    const float* cw = a.in[I_CW]; const float* cb = a.in[I_CB];
    int tid_ = threadIdx.x; asm volatile("" : "+v"(tid_));
    for (int idx = vcu * NTHR + tid_; idx < 28 * DFF; idx += G * NTHR) {
        const int k = idx / DFF, col = idx % DFF, pm = (k / 7) * 8 + 1 + (k % 7);
        const float um2 = ub[((size_t)(pm - 1) * 6 + 0) * DFF + col], um1 = ub[((size_t)(pm - 1) * 6 + 1) * DFF + col];
        const float u0 = ub[((size_t)pm * 6 + 2) * DFF + col], u1 = ub[((size_t)pm * 6 + 3) * DFF + col], g0 = ub[((size_t)pm * 6 + 4) * DFF + col], g1 = ub[((size_t)pm * 6 + 5) * DFF + col];
        const float c0 = cw[col], c1 = cw[DFF + col], c2 = cw[2 * DFF + col], bb = cb[col];
        ACT[(size_t)(pm * 256) * DFF + col] = f2bf(gelu_tanh(bb + c0 * um2 + c1 * um1 + c2 * u0) * g0);
        ACT[(size_t)(pm * 256 + 1) * DFF + col] = f2bf(gelu_tanh(bb + c0 * um1 + c1 * u0 + c2 * u1) * g1);
    }
}
__device__ __forceinline__ void final_norm(const Args& a, int vcu, int G) {
    int tid_ = threadIdx.x; asm volatile("" : "+v"(tid_));
    const int tid = tid_, lane = tid & 63, wave = tid >> 6;
    const float* fw = a.in[I_FNW]; const float* X1 = (const float*)(a.ws + WS_X1); const float* tailp = (const float*)(a.ws + WS_U);
    const bool split = (G == 256);
    int tpm = -1, tpn = -1;
    if (split && lane < 32) { pg8::StaticOrder S; S.init(MT, DM, G, 0); pg8::Unit u; if (S.at(256 + lane, u)) { tpm = u.pm; tpn = u.pn; } }
    for (int m = vcu * NWAVES + wave; m < MT; m += G * NWAVES) {
        const int pm = m >> 8;
        float* row = a.out + (size_t)m * DM;
        f32x4 v[8]; float ss = 0.f;
#pragma unroll
        for (int j = 0; j < 8; ++j) {
            const unsigned long long mask = __ballot(tpm == pm && tpn == j);
            if (mask == 0ull) v[j] = *(const f32x4*)(row + 4 * lane + 256 * j);
            else { const int tt = __ffsll((long long)mask) - 1;
                v[j] = *(const f32x4*)(X1 + (size_t)m * DM + 4 * lane + 256 * j);
                const float* tp = tailp + (size_t)tt * 8 * 65536 + (m & 255) * 256 + 4 * lane;
#pragma unroll
                for (int sl = 0; sl < 8; ++sl) v[j] += *(const f32x4*)(tp + (size_t)sl * 65536); }
            ss += dot4(v[j], v[j]); }
        const float r = rsqrtf(wave_sum(ss) * (1.f / DM) + EPS);
#pragma unroll
        for (int j = 0; j < 8; ++j) { const f32x4 w = *(const f32x4*)(fw + 4 * lane + 256 * j);
            *(f32x4*)(row + 4 * lane + 256 * j) = (f32x4){v[j][0] * r * w[0], v[j][1] * r * w[1], v[j][2] * r * w[2], v[j][3] * r * w[3]}; }
    }
}

#define XB_TMO      128
#define XB_XCNT(j)  (256  + 64 * (j))
#define XB_XSUB(j)  (1280 + 64 * (j))
#define XB_XGEN(j)  (2304 + 64 * (j))
#define XB_TOP      3328
#define XB_TOPGEN   3392
#define XCD_BAR_WORDS 3456
#define XB_SPIN_CAP (1u << 18)

__device__ __forceinline__ unsigned xb_ld(unsigned* p)              { return __hip_atomic_load(p, __ATOMIC_RELAXED, __HIP_MEMORY_SCOPE_AGENT); }
__device__ __forceinline__ unsigned xb_add(unsigned* p, unsigned v) { return __hip_atomic_fetch_add(p, v, __ATOMIC_RELAXED, __HIP_MEMORY_SCOPE_AGENT); }
__device__ __forceinline__ unsigned xb_xcc_id() { return (unsigned)__builtin_amdgcn_s_getreg((3 << 11) | 20) & 0xFu; }
#define XB_SPIN(cond, bar) do { unsigned _sp = 0; while (cond) { __builtin_amdgcn_s_sleep(1); \
    if ((++_sp & 255u) == 0u) { if (xb_ld(&(bar)[XB_TMO])) break; if (_sp > XB_SPIN_CAP) { atomicAdd(&(bar)[XB_TMO], 1u); break; } } } } while (0)

struct XcdBarrier {
    unsigned* bar; unsigned x;
    volatile LAS unsigned* st;
};

__device__ __forceinline__ XcdBarrier xcd_barrier_post(unsigned* bar, volatile LAS unsigned* st) {
    XcdBarrier b; b.bar = bar; b.x = xb_xcc_id(); b.st = st;
    if (threadIdx.x == 0) (void)xb_add(&bar[XB_XCNT(b.x)], 1u);
    return b;
}
__device__ __forceinline__ void xcd_barrier_complete(unsigned* bar, unsigned x, unsigned& nloc, unsigned& nx) {
    const unsigned G = gridDim.x * gridDim.y * gridDim.z;
    unsigned sum, cnt, mine, sp = 0u;
    for (;;) {
        sum = 0u; cnt = 0u; mine = 0u;
#pragma unroll
        for (unsigned j = 0; j < 16; ++j) { const unsigned c = xb_ld(&bar[XB_XCNT(j)]); sum += c; cnt += (c > 0u) ? 1u : 0u; mine = (j == x) ? c : mine; }
        if (sum == G) break;
        __builtin_amdgcn_s_sleep(1);
        if ((++sp & 255u) == 0u) { if (xb_ld(&bar[XB_TMO])) break; if (sp > XB_SPIN_CAP) { atomicAdd(&bar[XB_TMO], 1u); break; } }
    }
    nloc = mine > 0u ? mine : 1u; nx = cnt > 0u ? cnt : 1u;
}

__device__ __forceinline__ void xcd_barrier(const XcdBarrier& b) {
    asm volatile("s_waitcnt vmcnt(0)" ::: "memory");
    __syncthreads();
    if (threadIdx.x == 0) {
        unsigned* bar = b.bar;
        __builtin_amdgcn_s_waitcnt(0);
        unsigned nloc = b.st[0], nx = b.st[1];
        if (nloc == 0u) { xcd_barrier_complete(bar, b.x, nloc, nx); b.st[0] = nloc; b.st[1] = nx; }
        const unsigned old = xb_add(&bar[XB_XSUB(b.x)], 1u);
        const unsigned gen = old / nloc;
        if (old + 1u == (gen + 1u) * nloc) {
            __builtin_amdgcn_fence(__ATOMIC_RELEASE, "agent");
            asm volatile("s_waitcnt vmcnt(0)" ::: "memory");
            const unsigned og = xb_add(&bar[XB_TOP], 1u);
            const unsigned tg = og / nx;
            if (og + 1u == (tg + 1u) * nx) xb_add(&bar[XB_TOPGEN], 1u);
            else XB_SPIN(xb_ld(&bar[XB_TOPGEN]) == tg, bar);
            __builtin_amdgcn_fence(__ATOMIC_ACQUIRE, "agent");
            xb_add(&bar[XB_XGEN(b.x)], 1u);
            asm volatile("s_waitcnt vmcnt(0)" ::: "memory");
        } else {
            XB_SPIN(xb_ld(&bar[XB_XGEN(b.x)]) == gen, bar);
            __builtin_amdgcn_fence(__ATOMIC_ACQUIRE, "agent");
            asm volatile("s_waitcnt vmcnt(0)" ::: "memory");
        }
    }
    __syncthreads();
}

constexpr int N_PHASES = 12;
__global__ void __launch_bounds__(NTHR) fwd_kernel(Args args) {
    extern __shared__ __attribute__((aligned(16))) unsigned char lds_raw[];
    LAS unsigned char* lds = (LAS unsigned char*)lds_raw;
    cg::grid_group grid = cg::this_grid();
    volatile LAS unsigned* bst = (volatile LAS unsigned*)(lds + LDS_BYTES - 16);
    if (threadIdx.x < 4) bst[threadIdx.x] = 0u;
    __syncthreads();
    XcdBarrier xbar = xcd_barrier_post((unsigned*)args.ws, bst);
    const int G = gridDim.x, bx = blockIdx.x;
    const int vcu = (G % 8 == 0) ? (bx % 8) * (G / 8) + bx / 8 : bx;
    const int lo = args.ph_lo, hi = args.ph_hi;
    unsigned char* ws = args.ws;
#ifndef USE_CG_SYNC
#define USE_CG_SYNC 0
#endif
#ifndef DOUBLE_MASK
#define DOUBLE_MASK 0
#endif
#define REP(k) for (int rep_ = 0; rep_ < 1 + ((DOUBLE_MASK >> (k)) & 1); ++rep_)
#ifndef DBL_P2
#define DBL_P2 0
#endif
#ifndef BIS
#define BIS 15
#endif
#ifndef PHASE_MASK
#define PHASE_MASK 0xfff
#endif
#define IN(k) (((PHASE_MASK >> (k)) & 1) && lo <= (k) && (k) < hi)
#define SEAM(k) do { if (IN(k) && IN((k) + 1)) { if (USE_CG_SYNC || lo < 0) grid.sync(); else xcd_barrier(xbar); } } while (0)
    if (IN(0)) REP(0) { p0_prologue(args, lds, vcu, G, 0); __syncthreads(); }
    SEAM(0);
    if (IN(1)) REP(1) {
        pg8::Gemm g{(const bf16*)(ws + WS_XN), (const bf16*)(ws + WS_WIN), nullptr, nullptr, MT, NPROJ_PAD, DM}; pg8::StaticOrder S; S.init(MT, NPROJ_PAD, G, bx);
        EpiProj E{(bf16*)(ws + WS_PROJ), (float*)(ws + WS_GATES)};
        pg8::gemm_phase<EpiProj, pg8::StaticOrder, true, true>(lds, g, S, E);
        { const int rem = S.nwg % G, nidle = rem ? G - rem : G, idx = rem ? bx - rem : bx;
          if (idx >= 0) p0_prologue(args, lds, idx, nidle, 1); }
        __syncthreads();
    }
    SEAM(1);
    if (IN(2)) REP(2) {
        for (int it = bx; it < 1536; it += G) {
            if (it < 512) { for (int r_ = 0; r_ < 1 + (DBL_P2 & 1); ++r_) sample_item<true>(args, lds, it >> 2, it & 3); }
            else if (it < 1024) { for (int r_ = 0; r_ < 1 + ((DBL_P2 >> 1) & 1); ++r_) sample_item<false>(args, lds, (it - 512) >> 2, (it - 512) & 3); }
            else if (it < 1280) { for (int r_ = 0; r_ < 1 + ((DBL_P2 >> 2) & 1); ++r_) chunk_state<true>(args, lds, (it - 1024) >> 4, (it - 1024) & 15); }
            else { for (int r_ = 0; r_ < 1 + ((DBL_P2 >> 3) & 1); ++r_) chunk_state<false>(args, lds, (it - 1280) >> 4, (it - 1280) & 15); }
        }
    }
    SEAM(2);
    if (IN(3)) REP(3) { for (int it = bx; it < 768; it += G) { if (it < 512) scan_mlstm(args, it); else scan_gla(args, it - 512); }
        if (G == 256) {
            pg8::Gemm g{(const bf16*)(ws + WS_YM), (const bf16*)(ws + WS_WA), (const bf16*)(ws + WS_YG), (const bf16*)(ws + WS_WB), MT, DM, 1024}; pg8::TailOnlyOrder<2, 16> S; S.c = bx;
            EpiBranch E{(const bf16*)(ws + WS_PROJ), (bf16*)(ws + WS_XN), args.out + O_YP};
            pg8::gemm_phase<EpiBranch, pg8::TailOnlyOrder<2, 16>, true, true>(lds, g, S, E);
        }
    }
    SEAM(3);
    if (IN(4)) REP(4) { for (int it = bx; it < 512; it += G) { if (it < 256) { if (BIS & 1) chunk_out<true>(args, lds, it >> 4, it & 15); } else { if (BIS & 2) chunk_out<false>(args, lds, (it - 256) >> 4, (it - 256) & 15); } } __syncthreads(); if (G == 256) merge_reduce(args, vcu, G); }
    SEAM(4);
    if (IN(5)) REP(5) {
        pg8::Gemm g{(const bf16*)(ws + WS_YM), (const bf16*)(ws + WS_WA), (const bf16*)(ws + WS_YG), (const bf16*)(ws + WS_WB), MT, DM, 1024}; EpiBranch E{(const bf16*)(ws + WS_PROJ), (bf16*)(ws + WS_XN), nullptr};
        if (G == 256) { pg8::MainOnlyOrder<2> S; S.S.init(MP, DM, G, bx); pg8::gemm_phase<EpiBranch, pg8::MainOnlyOrder<2>, true, true>(lds, g, S, E); }
        else { pg8::TwoSegOrder S; S.S.init(MT, DM, G, bx); pg8::gemm_phase<EpiBranch, pg8::TwoSegOrder, true, true>(lds, g, S, E); }
    }
    SEAM(5);
    if (IN(6)) REP(6) {
        pg8::Gemm g{(const bf16*)(ws + WS_XN), (const bf16*)(ws + WS_WO), nullptr, nullptr, MT, DM, DM}; pg8::SplitRowsOrder<1, 32> S; S.split = (G == 256); S.S.init(S.split ? MP : MT, DM, G, bx);
        EpiOut E{args.in[I_XP], args.in[I_XS], (float*)(ws + WS_X1), (bf16*)(ws + WS_X1W), args.in[I_NFFN], (float*)(ws + WS_PART), (float*)(ws + WS_PROJ)};
        pg8::gemm_phase<EpiOut, pg8::SplitRowsOrder<1, 32>, true, true>(lds, g, S, E);
    }
    SEAM(6);
    if (IN(7)) REP(7) rstd_phase(args, vcu, G);
    SEAM(7);
    if (IN(8)) REP(8) {
        pg8::Gemm g{(const bf16*)(ws + WS_X1W), (const bf16*)(ws + WS_WUG), nullptr, nullptr, MT, 2 * DFF, DM}; pg8::StaticOrder S; S.init(MT, 2 * DFF, G, bx);
        EpiUGAct E{(const float*)(ws + WS_RSTD), (bf16*)(ws + WS_G), args.out, args.in[I_CW], args.in[I_CB], args.in[I_CONV], (float*)(ws + WS_U), (LAS float*)(lds + 131072)};
        pg8::gemm_phase<EpiUGAct, pg8::StaticOrder, true, true>(lds, g, S, E);
    }
    SEAM(8);
    if (IN(9)) REP(9) act_fixup(args, vcu, G);
    SEAM(9);
    if (IN(10)) REP(10) {
        pg8::Gemm g{(const bf16*)(ws + WS_G), (const bf16*)(ws + WS_WD), nullptr, nullptr, MT, DM, DFF}; pg8::DownOrder S; S.S.init(MT, DM, G, bx); S.split = (G == 256);
        EpiDown E{(const float*)(ws + WS_X1), args.out, (float*)(ws + WS_U)};
        pg8::gemm_phase<EpiDown, pg8::DownOrder, true, true>(lds, g, S, E);
    }
    SEAM(10);
    if (IN(11)) REP(11) final_norm(args, vcu, G);
#ifdef EXTRA_SYNCS
    for (int i_ = 0; i_ < EXTRA_SYNCS; ++i_) xcd_barrier(xbar);
#endif
#undef IN
#undef SEAM
}

extern "C" void kernel_launch(void* const* d_in, const int* in_sizes, int n_in, void* d_out, int out_size, void* d_ws, size_t ws_size, hipStream_t stream) {
    static int grid = 0;
    if (grid == 0) {
        if (n_in != 25 || ws_size < WS_END) { fprintf(stderr, "kernel_launch: unexpected n_in %d / ws_size %zu (need %zu)\n", n_in, ws_size, (size_t)WS_END); grid = -1; return; }
        int dev = 0, cus = 0, per_cu = 0;
        (void)hipGetDevice(&dev); (void)hipDeviceGetAttribute(&cus, hipDeviceAttributeMultiprocessorCount, dev);
        if (hipFuncSetAttribute((const void*)fwd_kernel, hipFuncAttributeMaxDynamicSharedMemorySize, LDS_BYTES) != hipSuccess) { fprintf(stderr, "kernel_launch: hipFuncSetAttribute failed\n"); grid = -1; return; }
        if (hipOccupancyMaxActiveBlocksPerMultiprocessor(&per_cu, (const void*)fwd_kernel, NTHR, LDS_BYTES) != hipSuccess || per_cu < 1) { fprintf(stderr, "kernel_launch: occupancy query says %d\n", per_cu); per_cu = 1; }
        (void)hipGetLastError();
        grid = cus * 1;
        if (grid <= 0) grid = 256;
    }
    if (grid < 0) return;
    if (hipMemsetAsync(d_ws, 0, 65536, stream) != hipSuccess) { fprintf(stderr, "kernel_launch: memset failed\n"); return; }
    Args a{};
    for (int i = 0; i < 25; ++i) a.in[i] = (const float*)d_in[i];
    a.out = (float*)d_out; a.ws = (unsigned char*)d_ws;
    if (MK_N_LAUNCHES == 1) {
        a.ph_lo = 0; a.ph_hi = N_PHASES;
        void* kargs[] = {&a};
        hipError_t e = hipLaunchCooperativeKernel((const void*)fwd_kernel, dim3(grid), dim3(NTHR), kargs, LDS_BYTES, stream);
        if (e != hipSuccess) fprintf(stderr, "kernel_launch: cooperative launch failed: %s (grid %d)\n", hipGetErrorString(e), grid);
    } else {
        for (int p = 0; p < N_PHASES; ++p) { a.ph_lo = p; a.ph_hi = p + 1; hipLaunchKernelGGL(fwd_kernel, dim3(grid), dim3(NTHR), LDS_BYTES, stream, a); }
    }
}
```

```cpp
#include <hip/hip_runtime.h>
#include <hip/hip_cooperative_groups.h>
#include <cstdio>
#include <cstdint>
namespace cg = cooperative_groups;

#ifndef MK_N_LAUNCHES
#define MK_N_LAUNCHES 1
#endif

namespace pg8 {
#define PG8_LAS __attribute__((address_space(3)))
typedef unsigned short bf16_t;
typedef short bf16x8 __attribute__((ext_vector_type(8)));
typedef float f32x4 __attribute__((ext_vector_type(4)));
typedef unsigned u32x4 __attribute__((ext_vector_type(4)));
constexpr int BM = 256, BK = 64, HALF = 128, HTB = HALF * BK * 2  , STAGE_BYTES = 8 * HTB, NXCD = 8, WGM = 8;

__host__ __device__ __forceinline__ int lds_byte(int r, int c) { const int st = (r >> 4) * 2 + (c >> 5), rr = r & 15, cc = c & 31, ob = rr * 64 + cc * 2; return st * 1024 + (ob ^ (((ob >> 9) & 1) << 5)); }
__host__ __device__ __forceinline__ void stage_rc(int b, int& R, int& C) { const int st = b / 1024, sb = b % 1024, swz = sb ^ (((sb >> 9) & 1) << 5); R = (st >> 1) * 16 + swz / 64; C = (st & 1) * 32 + (swz % 64) / 2; }
__host__ __device__ __forceinline__ int perm32(int rho) { const int n = rho >> 4, i = rho & 15; return 8 * (i >> 2) + 4 * n + (i & 3); }

struct Unit { int pm, pn, seg, kt0, nkt, tail; };
struct Gemm { const bf16_t* A; const bf16_t* Bt; const bf16_t* A2; const bf16_t* Bt2; int M, N, K; };

struct StaticOrder {
    int nM, nN, nwg, G, c;
    __host__ __device__ void init(int M, int N, int G_, int c_) { nM = M / BM; nN = N / BM; nwg = nM * nN; G = G_; c = c_; }
    __host__ __device__ bool next(int i, Unit& u) const { return at((long)i * G + c, u); }
    __host__ __device__ bool at(long L, Unit& u) const {
        if (L >= nwg) return false;
        int wgid = (int)L; { const int q = nwg / NXCD, r = nwg % NXCD, xcd = wgid % NXCD, off = wgid / NXCD; wgid = (xcd < r ? xcd * (q + 1) : r * (q + 1) + (xcd - r) * q) + off; }
        const int nig = WGM * nN, gid = wgid / nig, fm = gid * WGM, gsz = (nM - fm) < WGM ? (nM - fm) : WGM;
        u.pm = fm + ((wgid % nig) % gsz); u.pn = (wgid % nig) / gsz; u.seg = 0; u.kt0 = 0; u.nkt = -1; u.tail = -1; return true;
    }
};
struct DownOrder {
    StaticOrder S; bool split;
    __host__ __device__ bool next(int i, Unit& u) const {
        if (!split) return S.next(i, u);
        if (i == 0) return S.at(S.c, u);
        if (i > 1) return false;
        const int tt = S.c >> 3, sl = S.c & 7;
        if (!S.at(256 + tt, u)) return false;
        u.kt0 = 11 * sl + (sl & 1); u.nkt = (sl & 1) ? 10 : 12; u.tail = tt * 8 + sl; return true;
    }
};
template <int NSEG, int KT>
struct SplitRowsOrder {
    StaticOrder S; bool split;
    __host__ __device__ bool next(int i, Unit& u) const {
        if (!split) { if (!S.next(i / NSEG, u)) return false; u.seg = i % NSEG; return true; }
        if (i < NSEG) { if (!S.at(S.c, u)) return false; u.seg = i; return true; }
        if (i >= 2 * NSEG) return false;
        const int tt = S.c >> 3, sl = S.c & 7;
        u.pm = 32 + (tt >> 3); u.pn = tt & 7; u.seg = i - NSEG; u.kt0 = (KT / 8) * sl; u.nkt = KT / 8; u.tail = tt * 8 + sl; return true;
    }
};
template <int NSEG, int KT>
struct TailOnlyOrder {
    int c;
    __host__ __device__ bool next(int i, Unit& u) const {
        if (i >= NSEG) return false;
        const int tt = c >> 3, sl = c & 7;
        u.pm = 32 + (tt >> 3); u.pn = tt & 7; u.seg = i; u.kt0 = (KT / 8) * sl; u.nkt = KT / 8; u.tail = tt * 8 + sl; return true;
    }
};
template <int NSEG>
struct MainOnlyOrder {
    StaticOrder S;
    __host__ __device__ bool next(int i, Unit& u) const { if (i >= NSEG) return false; if (!S.at(S.c, u)) return false; u.seg = i; return true; }
};
struct TwoSegOrder {
    StaticOrder S;
    __host__ __device__ bool next(int i, Unit& u) const { if (!S.next(i >> 1, u)) return false; u.seg = i & 1; return true; }
};

__device__ __forceinline__ unsigned cvt_pk_bf16(float lo, float hi) { unsigned r; asm volatile("v_cvt_pk_bf16_f32 %0, %1, %2" : "=v"(r) : "v"(lo), "v"(hi)); return r; }

template <class Epi, class Sched, bool ALIGN_EPI = false, bool SP2 = false>
__device__ __forceinline__ void gemm_phase(PG8_LAS unsigned char* lds, const Gemm g, const Sched& S, const Epi& E) {
    int tid_ = threadIdx.x; asm volatile("" : "+v"(tid_));
    const int tid = tid_, wid = __builtin_amdgcn_readfirstlane(tid >> 6), lane = tid & 63, wr = wid >> 2, wc = wid & 3, fr = lane & 15, fq = lane >> 4;
    const int K = g.K, ntf = K / BK;
    unsigned voffA[2], voffB[2];
#pragma unroll
    for (int i = 0; i < 2; ++i) { int R, C; stage_rc(tid * 16 + i * 8192, R, C); const int Rb = Epi::PERM ? ((R & ~31) + perm32(R & 31)) : R;
        voffA[i] = (unsigned)(R * K + C) * 2u; voffB[i] = (unsigned)(Rb * K + C) * 2u; }
    const size_t kstep = (size_t)(BK * 2);
    const size_t hstep = (size_t)HALF * K * 2;
    const size_t tstep = 2 * hstep;
    const unsigned ldsw = (unsigned)wid * 1024u;
    const int aoff = lds_byte(wr * 64 + fr, fq * 8), boff = lds_byte(wc * 32 + fr, fq * 8);
#define PG8_SA(b, h) (((b) * 2 + (h)) * HTB)
#define PG8_SB(b, h) ((4 + (b) * 2 + (h)) * HTB)
#define PG8_STAGE(bufoff, gbase, voff) do { _Pragma("unroll") for (int _i = 0; _i < 2; ++_i) \
        __builtin_amdgcn_global_load_lds((const unsigned*)((const char*)(gbase) + (voff)[_i]), (PG8_LAS unsigned*)(lds + (bufoff) + ldsw + _i * 8192), 16, 0, 0); } while (0)
#define PG8_LDA(dst, b, h) do { _Pragma("unroll") for (int m = 0; m < 4; ++m) _Pragma("unroll") for (int k = 0; k < 2; ++k) dst[m][k] = *(const PG8_LAS bf16x8*)(lds + PG8_SA(b, h) + aoff + m * 2048 + k * 1024); } while (0)
#define PG8_LDB(dst, b, h) do { _Pragma("unroll") for (int n = 0; n < 2; ++n) _Pragma("unroll") for (int k = 0; k < 2; ++k) dst[n][k] = *(const PG8_LAS bf16x8*)(lds + PG8_SB(b, h) + boff + n * 2048 + k * 1024); } while (0)
#define PG8_MMA(ai, bj, At, Bt) do { __builtin_amdgcn_s_setprio(1); _Pragma("unroll") for (int m = 0; m < 4; ++m) _Pragma("unroll") for (int n = 0; n < 2; ++n) _Pragma("unroll") for (int k = 0; k < 2; ++k) \
        acc[ai][bj][m][n] = __builtin_amdgcn_mfma_f32_16x16x32_bf16(Bt[n][k], At[m][k], acc[ai][bj][m][n], 0, 0, 0); __builtin_amdgcn_s_setprio(0); } while (0)
#define PG8_WAIT_V(n) asm volatile("s_waitcnt vmcnt(" #n ")" ::: "memory")
#define PG8_WAIT_L(n) asm volatile("s_waitcnt lgkmcnt(" #n ")" ::: "memory")
#define PG8_BAR __builtin_amdgcn_s_barrier()
#define PG8_SCHED __builtin_amdgcn_sched_barrier(0)
    Unit cur, nxt; int ui = 0;
    if (!S.next(0, cur)) return;
    f32x4 acc[2][2][4][2];
#pragma unroll
    for (int a = 0; a < 2; ++a)
#pragma unroll
        for (int b = 0; b < 2; ++b)
#pragma unroll
            for (int m = 0; m < 4; ++m)
#pragma unroll
                for (int n = 0; n < 2; ++n) acc[a][b][m][n] = (f32x4){0.f, 0.f, 0.f, 0.f};
    bf16x8 At[4][2], B0[2][2], B1[2][2];
    const char* cA = (const char*)(cur.seg ? g.A2 : g.A) + (size_t)cur.pm * tstep + (size_t)cur.kt0 * kstep; const char* cB = (const char*)(cur.seg ? g.Bt2 : g.Bt) + (size_t)cur.pn * tstep + (size_t)cur.kt0 * kstep;
    if constexpr (SP2) {
        PG8_STAGE(PG8_SB(0, 0), cB, voffB); PG8_STAGE(PG8_SB(0, 1), cB + hstep, voffB); PG8_STAGE(PG8_SA(0, 0), cA, voffA); PG8_STAGE(PG8_SA(0, 1), cA + hstep, voffA);
        if (wr == 1) PG8_BAR;
        PG8_WAIT_V(2); PG8_BAR;
        PG8_STAGE(PG8_SB(1, 0), cB + kstep, voffB); PG8_STAGE(PG8_SA(1, 0), cA + kstep, voffA); PG8_STAGE(PG8_SB(1, 1), cB + hstep + kstep, voffB);
        PG8_WAIT_V(6); PG8_BAR;
    } else {
        PG8_STAGE(PG8_SB(0, 0), cB, voffB); PG8_STAGE(PG8_SA(0, 0), cA, voffA); PG8_STAGE(PG8_SB(0, 1), cB + hstep, voffB); PG8_STAGE(PG8_SA(0, 1), cA + hstep, voffA);
        if (wr == 1) PG8_BAR;
        PG8_WAIT_V(4); PG8_BAR;
        PG8_STAGE(PG8_SB(1, 0), cB + kstep, voffB); PG8_STAGE(PG8_SA(1, 0), cA + kstep, voffA); PG8_STAGE(PG8_SB(1, 1), cB + hstep + kstep, voffB);
        PG8_WAIT_V(6); PG8_BAR;
    }
    for (;;) {
        const bool has_next = S.next(ui + 1, nxt);
        const char* nA = has_next ? (const char*)(nxt.seg ? g.A2 : g.A) + (size_t)nxt.pm * tstep + (size_t)nxt.kt0 * kstep : cA; const char* nB = has_next ? (const char*)(nxt.seg ? g.Bt2 : g.Bt) + (size_t)nxt.pn * tstep + (size_t)nxt.kt0 * kstep : cB;
        const int nt = cur.nkt > 0 ? cur.nkt : ntf;
        for (int t = 0; t < nt; t += 2) {
            const bool last = (t == nt - 2);
            const char* a1 = cA + (size_t)(t + 1) * kstep;
            const char* a2 = last ? nA : cA + (size_t)(t + 2) * kstep; const char* b2 = last ? nB : cB + (size_t)(t + 2) * kstep;
            const char* a3 = a2 + kstep; const char* b3 = b2 + kstep;
            if constexpr (SP2) {
            PG8_LDB(B0, 0, 0); PG8_LDB(B1, 0, 1); PG8_SCHED; PG8_LDA(At, 0, 0); PG8_STAGE(PG8_SA(1, 1), a1 + hstep, voffA);
            PG8_WAIT_V(8); PG8_WAIT_L(0); PG8_BAR; PG8_MMA(0, 0, At, B0); PG8_MMA(0, 1, At, B1); PG8_BAR; PG8_SCHED;
            PG8_LDA(At, 0, 1); PG8_STAGE(PG8_SB(0, 0), b2, voffB); PG8_STAGE(PG8_SB(0, 1), b2 + hstep, voffB); PG8_STAGE(PG8_SA(0, 0), a2, voffA);
            PG8_WAIT_V(8); PG8_WAIT_L(0); PG8_BAR; PG8_MMA(1, 0, At, B0); PG8_MMA(1, 1, At, B1); PG8_BAR; PG8_SCHED;
            PG8_LDB(B0, 1, 0); PG8_LDB(B1, 1, 1); PG8_SCHED; PG8_LDA(At, 1, 0); PG8_STAGE(PG8_SA(0, 1), a2 + hstep, voffA);
            PG8_WAIT_V(8); PG8_WAIT_L(0); PG8_BAR; PG8_MMA(0, 0, At, B0); PG8_MMA(0, 1, At, B1); PG8_BAR; PG8_SCHED;
            PG8_LDA(At, 1, 1); PG8_STAGE(PG8_SB(1, 0), b3, voffB); PG8_STAGE(PG8_SB(1, 1), b3 + hstep, voffB); PG8_STAGE(PG8_SA(1, 0), a3, voffA);
            PG8_WAIT_V(8); PG8_WAIT_L(0); PG8_BAR; PG8_MMA(1, 0, At, B0); PG8_MMA(1, 1, At, B1); PG8_BAR; PG8_SCHED;
            } else {
            PG8_LDB(B0, 0, 0); PG8_SCHED; PG8_LDA(At, 0, 0); PG8_STAGE(PG8_SA(1, 1), a1 + hstep, voffA);
            PG8_WAIT_L(8); PG8_BAR; PG8_WAIT_L(0); PG8_MMA(0, 0, At, B0); PG8_BAR; PG8_SCHED;
            PG8_LDB(B1, 0, 1); PG8_STAGE(PG8_SB(0, 0), b2, voffB);
            PG8_BAR; PG8_WAIT_L(0); PG8_MMA(0, 1, At, B1); PG8_BAR;
            PG8_LDA(At, 0, 1); PG8_STAGE(PG8_SA(0, 0), a2, voffA);
            PG8_BAR; PG8_WAIT_L(0); PG8_MMA(1, 0, At, B0); PG8_BAR; PG8_SCHED;
            PG8_STAGE(PG8_SB(0, 1), b2 + hstep, voffB);
            PG8_WAIT_V(6); PG8_BAR; PG8_MMA(1, 1, At, B1); PG8_BAR;
            PG8_LDB(B0, 1, 0); PG8_SCHED; PG8_LDA(At, 1, 0); PG8_STAGE(PG8_SA(0, 1), a2 + hstep, voffA);
            PG8_WAIT_L(8); PG8_BAR; PG8_WAIT_L(0); PG8_MMA(0, 0, At, B0); PG8_BAR; PG8_SCHED;
            PG8_LDB(B1, 1, 1); PG8_STAGE(PG8_SB(1, 0), b3, voffB);
            PG8_BAR; PG8_WAIT_L(0); PG8_MMA(0, 1, At, B1); PG8_BAR;
            PG8_LDA(At, 1, 1); PG8_STAGE(PG8_SA(1, 0), a3, voffA);
            PG8_BAR; PG8_WAIT_L(0); PG8_MMA(1, 0, At, B0); PG8_BAR; PG8_SCHED;
            PG8_STAGE(PG8_SB(1, 1), b3 + hstep, voffB);
            PG8_WAIT_V(6); PG8_BAR; PG8_MMA(1, 1, At, B1); PG8_BAR;
            }
        }
        if constexpr (ALIGN_EPI) { if (wr == 0) PG8_BAR; }
        E(acc, cur, wr, wc, fr, fq);
        if (!has_next) break;
        if (nxt.seg == 0)
#pragma unroll
        for (int a = 0; a < 2; ++a)
#pragma unroll
            for (int b = 0; b < 2; ++b)
#pragma unroll
                for (int m = 0; m < 4; ++m)
#pragma unroll
                    for (int n = 0; n < 2; ++n) acc[a][b][m][n] = (f32x4){0.f, 0.f, 0.f, 0.f};
        cur = nxt; cA = nA; cB = nB; ++ui;
        if constexpr (ALIGN_EPI) { if (wr == 1) PG8_BAR; }
    }
    PG8_WAIT_V(0);
    if constexpr (!ALIGN_EPI) { if (wr == 0) PG8_BAR; }
    PG8_BAR;
#undef PG8_SA
#undef PG8_SB
#undef PG8_STAGE
#undef PG8_LDA
#undef PG8_LDB
#undef PG8_MMA
#undef PG8_WAIT_V
#undef PG8_WAIT_L
#undef PG8_BAR
#undef PG8_SCHED
}
}

#define LAS __attribute__((address_space(3)))
typedef unsigned short bf16;
typedef short bf16x8 __attribute__((ext_vector_type(8)));
typedef float f32x4 __attribute__((ext_vector_type(4)));
typedef unsigned u32x4 __attribute__((ext_vector_type(4)));
typedef unsigned u32x2 __attribute__((ext_vector_type(2)));
using pg8::cvt_pk_bf16;

constexpr int NWAVES = 8, NTHR = 512;
constexpr int DM = 2048, MP = 8192, MS = 1024, MT = 9216, TP = 2048, TS = 8;
constexpr int NIN = 11288, NPROJ = 11264, NPROJ_PAD = 11520, DFF = 5632;
constexpr int C_MQ = 0, C_MK = 1024, C_MV = 2048, C_MO = 3072, C_GQ = 4096, C_GK = 4608, C_GV = 5120, C_GR = 6144, C_GA = 7168, C_GB = 9216;
constexpr float EPS = 1e-6f;
constexpr int NCH = 16;
constexpr int LDS_BYTES = 147456;

constexpr size_t O_YP = 0, O_YS = 16777216, O_PC = 18874368, O_PN = 19922944, O_PM = 19927040, O_PS = 19927056, O_PCONV = 20451344,
                 O_SC = 20496400, O_SN = 54050832, O_SM = 54181904, O_SS = 54182416, O_SCONV = 70959632;

constexpr size_t MiB = 1u << 20;
constexpr size_t WS_GATES = 64 * 1024;
constexpr size_t WS_PART = WS_GATES + (size_t)MT * 32 * 4;
constexpr size_t WS_DN = WS_PART + (size_t)MT * 32 * 4;
constexpr size_t WS_NPREV = WS_DN + 256 * 256 * 4;
constexpr size_t WS_CHS = WS_NPREV + 256 * 256 * 2;
constexpr size_t WS_BEND = WS_CHS + 256 * 2 * 4;
constexpr size_t WS_RSTD = WS_BEND + 256 * 128 * 4;
static_assert(WS_RSTD + MT * 4 <= 4 * MiB, "small region");
constexpr size_t WS_WIN = 4 * MiB;
constexpr size_t WS_WA = WS_WIN + (size_t)NPROJ_PAD * DM * 2;
constexpr size_t WS_WB = WS_WA + (size_t)2048 * 1024 * 2;
constexpr size_t WS_WO = WS_WB + (size_t)2048 * 1024 * 2;
constexpr size_t WS_WUG = WS_WO + (size_t)2048 * 2048 * 2;
constexpr size_t WS_WD = WS_WUG + (size_t)2 * DFF * DM * 2;
constexpr size_t WS_R1 = WS_WD + (size_t)DM * DFF * 2;
static_assert(WS_R1 == 131 * MiB, "map");
constexpr size_t WS_XN = WS_R1;
constexpr size_t WS_X1W = WS_R1 + 36 * MiB;
constexpr size_t WS_X1 = WS_R1 + 72 * MiB;
constexpr size_t WS_DC = WS_R1;
constexpr size_t WS_DS = WS_R1 + 64 * MiB;
constexpr size_t WS_CT = WS_R1 + 96 * MiB;
constexpr size_t WS_ST = WS_R1 + 128 * MiB;
constexpr size_t WS_YM = WS_R1 + 144 * MiB;
constexpr size_t WS_YG = WS_YM + 18 * MiB;
constexpr size_t WS_PROJ = WS_YG + 18 * MiB;
constexpr size_t WS_U = WS_PROJ, WS_G = WS_PROJ + 99 * MiB;
constexpr size_t WS_END = WS_PROJ + 198 * MiB;
static_assert(WS_END == 509 * MiB, "map");

struct Args {
    const float* in[25]; float* out; unsigned char* ws; int ph_lo, ph_hi;
};
enum { I_XP = 0, I_XS, I_C, I_N, I_M, I_S, I_CONV, I_WIN, I_BI, I_BF, I_AUP, I_AB, I_MHW, I_GHW, I_WA, I_WB, I_WO, I_NMIX, I_NFFN, I_WUP, I_WGATE, I_CW, I_CB, I_WDOWN, I_FNW };

__device__ __forceinline__ float bf2f(unsigned short b) { return __builtin_bit_cast(float, (unsigned)b << 16); }
__device__ __forceinline__ float bflo(unsigned w) { return __builtin_bit_cast(float, w << 16); }
__device__ __forceinline__ float bfhi(unsigned w) { return __builtin_bit_cast(float, w & 0xffff0000u); }
__device__ __forceinline__ unsigned short f2bf(float f) { return (unsigned short)(cvt_pk_bf16(f, 0.f) & 0xffffu); }
__device__ __forceinline__ float logsig(float z) { return fminf(z, 0.f) - __logf(1.f + __expf(-fabsf(z))); }
__device__ __forceinline__ float sigm(float z) { return 1.f / (1.f + __expf(-z)); }
__device__ __forceinline__ float wave_sum(float v) {
#pragma unroll
    for (int o = 1; o < 64; o <<= 1) v += __shfl_xor(v, o);
    return v;
}
__device__ __forceinline__ float wave_max(float v) {
#pragma unroll
    for (int o = 1; o < 64; o <<= 1) v = fmaxf(v, __shfl_xor(v, o));
    return v;
}
__device__ __forceinline__ float sum4(f32x4 v) { return (v.x + v.y) + (v.z + v.w); }
__device__ __forceinline__ float dot4(f32x4 a, f32x4 b) { return (a.x * b.x + a.y * b.y) + (a.z * b.z + a.w * b.w); }
__device__ __forceinline__ float gelu_tanh(float v) { const float u = 0.7978845608028654f * (v + 0.044715f * v * v * v); return v * sigm(2.f * u); }

typedef f32x4 AccT[2][2][4][2];
struct EpiProj {
    static constexpr bool PERM = true;
    bf16* P; float* gates;
    __device__ __forceinline__ void operator()(AccT& acc, const pg8::Unit& u, int wr, int wc, int fr, int fq) const {
        const int row0 = u.pm * 256 + wr * 64 + fr;
        if (u.pn < 28) {
            const int col0 = u.pn * 256 + wc * 32 + 8 * fq;
#pragma unroll
            for (int ai = 0; ai < 2; ++ai)
#pragma unroll
                for (int m = 0; m < 4; ++m) { bf16* rowp = P + (size_t)(row0 + ai * 128 + m * 16) * NPROJ + col0;
#pragma unroll
                    for (int bj = 0; bj < 2; ++bj) { const f32x4 v0 = acc[ai][bj][m][0], v1 = acc[ai][bj][m][1]; u32x4 w;
                        w.x = cvt_pk_bf16(v0[0], v0[1]); w.y = cvt_pk_bf16(v0[2], v0[3]); w.z = cvt_pk_bf16(v1[0], v1[1]); w.w = cvt_pk_bf16(v1[2], v1[3]);
                        *(u32x4*)(rowp + bj * 128) = w; } }
        } else if (u.pn >= 28 && u.pn < 44) {
            const int n0 = (u.pn - 28) * 128 + wc * 32 + 8 * fq;
#pragma unroll
            for (int ai = 0; ai < 2; ++ai)
#pragma unroll
                for (int m = 0; m < 4; ++m) { bf16* rowp = P + (size_t)(row0 + ai * 128 + m * 16) * NPROJ;
                    float R[8], sb[8];
#pragma unroll
                    for (int i = 0; i < 8; ++i) { const float ga = acc[ai][0][m][i >> 2][i & 3], gb = acc[ai][1][m][i >> 2][i & 3];
                        const float ea = __expf(fminf(-ga, 40.f)), eb = __expf(fminf(-gb, 40.f)); sb[i] = __builtin_amdgcn_rcpf(1.f + eb); R[i] = (1.f + eb) * __builtin_amdgcn_rcpf(1.f + ea); }
                    u32x4 w; w.x = cvt_pk_bf16(R[0], R[1]); w.y = cvt_pk_bf16(R[2], R[3]); w.z = cvt_pk_bf16(R[4], R[5]); w.w = cvt_pk_bf16(R[6], R[7]);
                    *(u32x4*)(rowp + C_GA + n0) = w;
                    w.x = cvt_pk_bf16(sb[0], sb[1]); w.y = cvt_pk_bf16(sb[2], sb[3]); w.z = cvt_pk_bf16(sb[4], sb[5]); w.w = cvt_pk_bf16(sb[6], sb[7]);
                    *(u32x4*)(rowp + C_GB + n0) = w; }
        } else if (wc == 0) {
#pragma unroll
            for (int ai = 0; ai < 2; ++ai)
#pragma unroll
                for (int m = 0; m < 4; ++m) { float* rowp = gates + (size_t)(row0 + ai * 128 + m * 16) * 32 + 8 * fq;
                    *(f32x4*)rowp = acc[ai][0][m][0]; *(f32x4*)(rowp + 4) = acc[ai][0][m][1]; }
        }
    }
};
struct EpiBranch {
    static constexpr bool PERM = true;
    const bf16* P; bf16* O; float* tailp;
    __device__ __forceinline__ void operator()(AccT& acc, const pg8::Unit& u, int wr, int wc, int fr, int fq) const {
        const int row0 = u.pm * 256 + wr * 64 + fr, col0 = u.pn * 256 + wc * 32 + 8 * fq;
#pragma unroll
        for (int ai = 0; ai < 2; ++ai)
#pragma unroll
            for (int m = 0; m < 4; ++m) { const int row = row0 + ai * 128 + m * 16;
#pragma unroll
                for (int bj = 0; bj < 2; ++bj) { const int col = col0 + bj * 128;
                    const u32x4 gw = *(const u32x4*)(P + (size_t)row * NPROJ + (u.seg == 0 ? C_GA : C_GB) + col);
                    float fg[8] = {bflo(gw.x), bfhi(gw.x), bflo(gw.y), bfhi(gw.y), bflo(gw.z), bfhi(gw.z), bflo(gw.w), bfhi(gw.w)};
                    if (u.seg == 0) {
#pragma unroll
                        for (int i = 0; i < 8; ++i) acc[ai][bj][m][i >> 2][i & 3] *= fg[i];
                    } else {
                        float o[8];
#pragma unroll
                        for (int i = 0; i < 8; ++i) o[i] = acc[ai][bj][m][i >> 2][i & 3] * fg[i];
                        if (u.tail < 0) { u32x4 w; w.x = cvt_pk_bf16(o[0], o[1]); w.y = cvt_pk_bf16(o[2], o[3]); w.z = cvt_pk_bf16(o[4], o[5]); w.w = cvt_pk_bf16(o[6], o[7]);
                            *(u32x4*)(O + (size_t)row * DM + col) = w; }
                        else { float* p = tailp + (size_t)u.tail * 65536 + (row & 255) * 256 + (col & 255); *(f32x4*)p = (f32x4){o[0], o[1], o[2], o[3]}; *(f32x4*)(p + 4) = (f32x4){o[4], o[5], o[6], o[7]}; }
                    } } }
    }
};
struct EpiOut {
    static constexpr bool PERM = true;
    const float* xp; const float* xs; float* X1; bf16* X1W; const float* nw; float* part; float* tailp;
    __device__ __forceinline__ void operator()(AccT& acc, const pg8::Unit& u, int wr, int wc, int fr, int fq) const {
        const int row0 = u.pm * 256 + wr * 64 + fr, col0 = u.pn * 256 + wc * 32 + 8 * fq;
        if (u.tail >= 0) {
            float* tp = tailp + (size_t)u.tail * 65536 + (wr * 64 + fr) * 256 + wc * 32 + 8 * fq;
#pragma unroll
            for (int ai = 0; ai < 2; ++ai)
#pragma unroll
                for (int m = 0; m < 4; ++m)
#pragma unroll
                    for (int bj = 0; bj < 2; ++bj) { float* p = tp + (ai * 128 + m * 16) * 256 + bj * 128; *(f32x4*)p = acc[ai][bj][m][0]; *(f32x4*)(p + 4) = acc[ai][bj][m][1]; }
            return;
        }
#pragma unroll
        for (int ai = 0; ai < 2; ++ai)
#pragma unroll
            for (int m = 0; m < 4; ++m) { const int row = row0 + ai * 128 + m * 16;
                const float* xrow = row < MP ? xp + (size_t)row * DM : xs + (size_t)(row - MP) * DM;
                float ss = 0.f;
#pragma unroll
                for (int bj = 0; bj < 2; ++bj) { const int col = col0 + bj * 128;
                    const f32x4 v0 = acc[ai][bj][m][0] + *(const f32x4*)(xrow + col), v1 = acc[ai][bj][m][1] + *(const f32x4*)(xrow + col + 4);
                    *(f32x4*)(X1 + (size_t)row * DM + col) = v0; *(f32x4*)(X1 + (size_t)row * DM + col + 4) = v1;
                    ss += dot4(v0, v0) + dot4(v1, v1);
                    const f32x4 w0 = *(const f32x4*)(nw + col), w1 = *(const f32x4*)(nw + col + 4);
                    u32x4 w; w.x = cvt_pk_bf16(v0[0] * w0[0], v0[1] * w0[1]); w.y = cvt_pk_bf16(v0[2] * w0[2], v0[3] * w0[3]);
                    w.z = cvt_pk_bf16(v1[0] * w1[0], v1[1] * w1[1]); w.w = cvt_pk_bf16(v1[2] * w1[2], v1[3] * w1[3]);
                    *(u32x4*)(X1W + (size_t)row * DM + col) = w; }
                ss += __shfl_xor(ss, 16); ss += __shfl_xor(ss, 32);
                if (fq == 0) part[(size_t)row * 32 + u.pn * 4 + wc] = ss; }
    }
};
#define DPP_MOV(ctrl, oldv, srcv) __builtin_bit_cast(float, __builtin_amdgcn_update_dpp(__builtin_bit_cast(int, (float)(oldv)), __builtin_bit_cast(int, (float)(srcv)), (ctrl), 0xf, 0xf, false))
struct EpiUGAct {
    static constexpr bool PERM = true;
    const float* rstd; bf16* ACT; float* out; const float* cw; const float* cb; const float* cst; float* ub; LAS float* xch;
    __device__ __forceinline__ void operator()(AccT& acc, const pg8::Unit& u, int wr, int wc, int fr, int fq) const {
        const int row0 = u.pm * 256 + wr * 64 + fr, col = u.pn * 128 + wc * 32 + 8 * fq;
        const bool sample = u.pm >= 32;
#pragma unroll
        for (int ai = 0; ai < 2; ++ai)
#pragma unroll
            for (int m = 0; m < 4; ++m) { const int row = row0 + ai * 128 + m * 16;
                const float r = rstd[row];
                acc[ai][0][m][0] = acc[ai][0][m][0] * r; acc[ai][0][m][1] = acc[ai][0][m][1] * r; acc[ai][1][m][0] = acc[ai][1][m][0] * r; acc[ai][1][m][1] = acc[ai][1][m][1] * r;
                float* cs = nullptr;
                if (row < MP) { const int t = row & (TP - 1); if (t >= TP - 2) cs = out + O_PCONV + ((size_t)(row >> 11) * 2 + (t - (TP - 2))) * DFF + col; }
                else { const int rr = row - MP, t = rr & 7; if (t >= 6) cs = out + O_SCONV + ((size_t)(rr >> 3) * 2 + (t - 6)) * DFF + col; }
                if (cs) { *(f32x4*)cs = acc[ai][0][m][0]; *(f32x4*)(cs + 4) = acc[ai][0][m][1]; } }
        if (fr >= 14) {
#pragma unroll
            for (int ai = 0; ai < 2; ++ai) { LAS float* p = xch + ((((ai * 2 + wr) * 4 + wc) * 2 + (fr - 14)) * 4 + fq) * 8; *(LAS f32x4*)p = acc[ai][0][3][0]; *(LAS f32x4*)(p + 4) = acc[ai][0][3][1]; }
            if (!sample && wr == 1) { float* p = ub + ((size_t)u.pm * 6 + (fr - 14)) * DFF + col; *(f32x4*)p = acc[1][0][3][0]; *(f32x4*)(p + 4) = acc[1][0][3][1]; }
        }
        if (!sample && wr == 0 && fr < 2) { float* p = ub + ((size_t)u.pm * 6 + 2 + fr) * DFF + col; *(f32x4*)p = acc[0][0][0][0]; *(f32x4*)(p + 4) = acc[0][0][0][1];
            p += 2 * DFF; *(f32x4*)p = acc[0][1][0][0]; *(f32x4*)(p + 4) = acc[0][1][0][1]; }
        asm volatile("s_waitcnt lgkmcnt(0)" ::: "memory"); __builtin_amdgcn_s_barrier();
        const f32x4 k0a = *(const f32x4*)(cw + col), k0b = *(const f32x4*)(cw + col + 4), k1a = *(const f32x4*)(cw + DFF + col), k1b = *(const f32x4*)(cw + DFF + col + 4);
        const f32x4 k2a = *(const f32x4*)(cw + 2 * DFF + col), k2b = *(const f32x4*)(cw + 2 * DFF + col + 4), cba = *(const f32x4*)(cb + col), cbb = *(const f32x4*)(cb + col + 4);
#pragma unroll
        for (int ai = 0; ai < 2; ++ai) {
            f32x4 pe0 = {0.f, 0.f, 0.f, 0.f}, pe1 = {0.f, 0.f, 0.f, 0.f};
            if (!(ai == 0 && wr == 0) && fr >= 14) { const int sai = (wr == 1) ? ai : ai - 1, swr = wr ^ 1;
                const LAS float* p = xch + ((((sai * 2 + swr) * 4 + wc) * 2 + (fr - 14)) * 4 + fq) * 8; pe0 = *(const LAS f32x4*)p; pe1 = *(const LAS f32x4*)(p + 4); }
#pragma unroll
            for (int m = 0; m < 4; ++m) { const int row = row0 + ai * 128 + m * 16;
                const f32x4 c0 = acc[ai][0][m][0], c1 = acc[ai][0][m][1], v0 = m ? acc[ai][0][m ? m - 1 : 0][0] : pe0, v1 = m ? acc[ai][0][m ? m - 1 : 0][1] : pe1;
                float cur[8] = {c0[0], c0[1], c0[2], c0[3], c1[0], c1[1], c1[2], c1[3]}, prv[8] = {v0[0], v0[1], v0[2], v0[3], v1[0], v1[1], v1[2], v1[3]};
                float p1[8], p2[8];
#pragma unroll
                for (int i = 0; i < 8; ++i) { const float y1 = DPP_MOV(0x121, 0.f, prv[i]); p1[i] = DPP_MOV(0x111, y1, cur[i]); const float y2 = DPP_MOV(0x122, 0.f, prv[i]); p2[i] = DPP_MOV(0x112, y2, cur[i]); }
                if (sample) { const int t = fr & 7;
                    if (t < 2) { const float* st = cst + (size_t)((row - MP) >> 3) * 2 * DFF + col;
                        const f32x4 s1a = *(const f32x4*)(st + DFF), s1b = *(const f32x4*)(st + DFF + 4);
                        if (t == 0) { const f32x4 s0a = *(const f32x4*)st, s0b = *(const f32x4*)(st + 4);
#pragma unroll
                            for (int i = 0; i < 4; ++i) { p1[i] = s1a[i]; p1[4 + i] = s1b[i]; p2[i] = s0a[i]; p2[4 + i] = s0b[i]; } }
                        else {
#pragma unroll
                            for (int i = 0; i < 4; ++i) { p2[i] = s1a[i]; p2[4 + i] = s1b[i]; } } } }
                const f32x4 g0 = acc[ai][1][m][0], g1 = acc[ai][1][m][1];
                float o[8];
#pragma unroll
                for (int i = 0; i < 4; ++i) { o[i] = gelu_tanh(cba[i] + k0a[i] * p2[i] + k1a[i] * p1[i] + k2a[i] * cur[i]) * g0[i];
                    o[4 + i] = gelu_tanh(cbb[i] + k0b[i] * p2[4 + i] + k1b[i] * p1[4 + i] + k2b[i] * cur[4 + i]) * g1[i]; }
                u32x4 w; w.x = cvt_pk_bf16(o[0], o[1]); w.y = cvt_pk_bf16(o[2], o[3]); w.z = cvt_pk_bf16(o[4], o[5]); w.w = cvt_pk_bf16(o[6], o[7]);
                *(u32x4*)(ACT + (size_t)row * DFF + col) = w; }
        }
    }
};
struct EpiDown {
    static constexpr bool PERM = true;
    const float* X1; float* out; float* tailp;
    __device__ __forceinline__ void operator()(AccT& acc, const pg8::Unit& u, int wr, int wc, int fr, int fq) const {
        if (u.tail < 0) {
            const int row0 = u.pm * 256 + wr * 64 + fr, col0 = u.pn * 256 + wc * 32 + 8 * fq;
#pragma unroll
            for (int ai = 0; ai < 2; ++ai)
#pragma unroll
                for (int m = 0; m < 4; ++m) { const int row = row0 + ai * 128 + m * 16;
#pragma unroll
                    for (int bj = 0; bj < 2; ++bj) { const int col = col0 + bj * 128;
                        const f32x4 v0 = acc[ai][bj][m][0] + *(const f32x4*)(X1 + (size_t)row * DM + col), v1 = acc[ai][bj][m][1] + *(const f32x4*)(X1 + (size_t)row * DM + col + 4);
                        *(f32x4*)(out + (size_t)row * DM + col) = v0; *(f32x4*)(out + (size_t)row * DM + col + 4) = v1; } }
        } else {
            float* tp = tailp + (size_t)u.tail * 65536 + (wr * 64 + fr) * 256 + wc * 32 + 8 * fq;
#pragma unroll
            for (int ai = 0; ai < 2; ++ai)
#pragma unroll
                for (int m = 0; m < 4; ++m)
#pragma unroll
                    for (int bj = 0; bj < 2; ++bj) { float* p = tp + (ai * 128 + m * 16) * 256 + bj * 128; *(f32x4*)p = acc[ai][bj][m][0]; *(f32x4*)(p + 4) = acc[ai][bj][m][1]; }
        }
    }
};

template <class ColPtr>
__device__ __forceinline__ void transpose_item(const ColPtr& cp, int K, int srcN, bf16* WT, LAS float* scr, int kb, int nb, int lane) {
    const int k0 = 64 * kb, n0 = 64 * nb, kr = lane >> 4, n4 = (lane & 15) * 4;
    const float* src = cp(n0 + n4);
    f32x4 v[16];
#pragma unroll
    for (int i = 0; i < 16; ++i) v[i] = src ? *(const f32x4*)(src + (size_t)(k0 + 4 * i + kr) * srcN) : (f32x4){0.f, 0.f, 0.f, 0.f};
#pragma unroll
    for (int i = 0; i < 16; ++i) { LAS float* d = scr + (4 * i + kr) * 65 + n4; d[0] = v[i][0]; d[1] = v[i][1]; d[2] = v[i][2]; d[3] = v[i][3]; }
    asm volatile("s_waitcnt lgkmcnt(0)" ::: "memory");
    const int c = lane & 7;
#pragma unroll
    for (int j = 0; j < 8; ++j) { const int n = (lane >> 3) + 8 * j; const LAS float* s = scr + (8 * c) * 65 + n;
        u32x4 o; o.x = cvt_pk_bf16(s[0 * 65], s[1 * 65]); o.y = cvt_pk_bf16(s[2 * 65], s[3 * 65]); o.z = cvt_pk_bf16(s[4 * 65], s[5 * 65]); o.w = cvt_pk_bf16(s[6 * 65], s[7 * 65]);
        *(u32x4*)(WT + (size_t)(n0 + n) * K + k0 + 8 * c) = o; }
    asm volatile("s_waitcnt lgkmcnt(0)" ::: "memory");
}
struct ColWin { const float* W; __device__ __forceinline__ const float* operator()(int n) const {
    int c; if (n < 4096) c = n; else if (n < 7168) c = n + 8; else if (n < 11264) { const int l = n - 7168, q = l >> 8, w = l & 255; c = 7192 + (w < 128 ? 128 * q + w : 2048 + 128 * q + (w - 128)); } else if (n < 11272) c = 4096 + (n - 11264); else if (n < 11288) c = 7176 + (n - 11272); else return nullptr;
    return W + c; } };
struct ColPlain { const float* W; __device__ __forceinline__ const float* operator()(int n) const { return W + n; } };
struct ColUG { const float* Wu; const float* Wg; __device__ __forceinline__ const float* operator()(int n) const { const int pn = n >> 8, w = n & 255; return w < 128 ? Wu + pn * 128 + w : Wg + pn * 128 + (w - 128); } };

__device__ __forceinline__ void p0_prologue(const Args& a, LAS unsigned char* lds, int gwg, int nwgs, int mode) {
    int tid_ = threadIdx.x; asm volatile("" : "+v"(tid_));
    const int tid = tid_, lane = tid & 63, wave = __builtin_amdgcn_readfirstlane(tid >> 6);
    LAS float* scr = (LAS float*)(lds + wave * 16640);
    const int gw = gwg * NWAVES + wave, NGW = nwgs * NWAVES;
    unsigned char* ws = a.ws;
    constexpr int I_WIN_ = 32 * (NPROJ_PAD / 64), I_A = 16 * 32, I_O = 32 * 32, I_UG = 32 * (2 * DFF / 64), I_D = (DFF / 64) * 32;
    constexpr int NITEMS = I_WIN_ + 2 * I_A + I_O + I_UG + I_D;
    const int it0 = mode == 0 ? 0 : I_WIN_, it1 = mode == 0 ? I_WIN_ : NITEMS;
    for (int it = it0 + gw; it < it1; it += NGW) {
        int r = it;
        if (r < I_WIN_) { ColWin cp{a.in[I_WIN]}; const int nblk = NPROJ_PAD / 64; transpose_item(cp, DM, NIN, (bf16*)(ws + WS_WIN), scr, r / nblk, r % nblk, lane); continue; } r -= I_WIN_;
        if (r < I_A) { ColPlain cp{a.in[I_WA]}; transpose_item(cp, 1024, DM, (bf16*)(ws + WS_WA), scr, r / 32, r % 32, lane); continue; } r -= I_A;
        if (r < I_A) { ColPlain cp{a.in[I_WB]}; transpose_item(cp, 1024, DM, (bf16*)(ws + WS_WB), scr, r / 32, r % 32, lane); continue; } r -= I_A;
        if (r < I_O) { ColPlain cp{a.in[I_WO]}; transpose_item(cp, DM, DM, (bf16*)(ws + WS_WO), scr, r / 32, r % 32, lane); continue; } r -= I_O;
        if (r < I_UG) { ColUG cp{a.in[I_WUP], a.in[I_WGATE]}; const int nblk = 2 * DFF / 64; transpose_item(cp, DM, DFF, (bf16*)(ws + WS_WUG), scr, r / nblk, r % nblk, lane); continue; } r -= I_UG;
        { ColPlain cp{a.in[I_WDOWN]}; transpose_item(cp, DFF, DM, (bf16*)(ws + WS_WD), scr, r / 32, r % 32, lane); }
    }
    const float* nw = a.in[I_NMIX]; bf16* XN = (bf16*)(ws + WS_XN);
    if (mode == 0)
    for (int m = gw; m < MT; m += NGW) {
        const float* xrow = m < MP ? a.in[I_XP] + (size_t)m * DM : a.in[I_XS] + (size_t)(m - MP) * DM;
        f32x4 v[8]; float s = 0.f;
#pragma unroll
        for (int j = 0; j < 8; ++j) { v[j] = *(const f32x4*)(xrow + 4 * lane + 256 * j); s += dot4(v[j], v[j]); }
        const float r = rsqrtf(wave_sum(s) * (1.f / DM) + EPS);
#pragma unroll
        for (int j = 0; j < 8; ++j) { const f32x4 w = *(const f32x4*)(nw + 4 * lane + 256 * j); u32x2 o; o.x = cvt_pk_bf16(v[j][0] * r * w[0], v[j][1] * r * w[1]); o.y = cvt_pk_bf16(v[j][2] * r * w[2], v[j][3] * r * w[3]);
            *(u32x2*)(XN + (size_t)m * DM + 4 * lane + 256 * j) = o; }
    }
}

__device__ __forceinline__ void stage_v(LAS bf16* Vs, const bf16* P, int row0, int colbase, int tid) {
#pragma unroll
    for (int i = 0; i < 8; ++i) { const int idx = tid + NTHR * i, s = idx >> 5, p = idx & 31;
        *(LAS u32x4*)(Vs + s * 272 + p * 8) = *(const u32x4*)(P + (size_t)(row0 + s) * NPROJ + colbase + 8 * p); }
}
typedef short v4i16_t __attribute__((ext_vector_type(4)));
__device__ __forceinline__ u32x2 tr64(const LAS bf16* p) { return __builtin_bit_cast(u32x2, __builtin_amdgcn_ds_read_tr16_b64_v4i16((LAS v4i16_t*)p)); }
__device__ __forceinline__ bf16x8 tr_frag(const LAS bf16* img, int RS, int c0, int ks, int lane) {
    const int g = lane >> 4, q = (lane & 15) >> 2, p = lane & 3;
    const LAS bf16* a = img + (32 * ks + 4 * g + q) * RS + c0 + 4 * p;
    const u32x2 lo = tr64(a), hi = tr64(a + 16 * RS);
    u32x4 w; w.x = lo.x; w.y = lo.y; w.z = hi.x; w.w = hi.y;
    return __builtin_bit_cast(bf16x8, w);
}
__device__ __forceinline__ float wave_iscan_add(float v, int lane) {
#pragma unroll
    for (int o = 1; o < 64; o <<= 1) { const float t = __shfl_up(v, o); if (lane >= o) v += t; }
    return v;
}
__device__ __forceinline__ float wave_iscan_max(float v, int lane) {
#pragma unroll
    for (int o = 1; o < 64; o <<= 1) { const float t = __shfl_up(v, o); if (lane >= o) v = fmaxf(v, t); }
    return v;
}

__device__ __forceinline__ void gla_logdecay(const Args& a, const float* gates, int row0, int h, LAS float* galS, LAS float* segS, int tid, float (&la)[32], float& off, float& tot) {
    const int d = tid & 127, seg = tid >> 7;
    { const int t = tid >> 2, q = tid & 3; *(LAS f32x4*)(galS + t * 16 + q * 4) = *(const f32x4*)(gates + (size_t)(row0 + t) * 32 + 8 + q * 4); }
    float up[16];
#pragma unroll
    for (int j = 0; j < 16; ++j) up[j] = a.in[I_AUP][j * 512 + h * 128 + d];
    const float ab = a.in[I_AB][h * 128 + d];
    __syncthreads();
    float ssum = 0.f;
#pragma unroll
    for (int i = 0; i < 32; ++i) { const int t = seg * 32 + i; float z = ab;
#pragma unroll
        for (int q = 0; q < 4; ++q) { const f32x4 g = *(const LAS f32x4*)(galS + t * 16 + q * 4); z += g[0] * up[4 * q] + g[1] * up[4 * q + 1] + g[2] * up[4 * q + 2] + g[3] * up[4 * q + 3]; }
        la[i] = logsig(z) * (1.f / 16.f); ssum += la[i]; }
    segS[seg * 128 + d] = ssum;
    __syncthreads();
    off = 0.f; tot = 0.f;
#pragma unroll
    for (int s = 0; s < 4; ++s) { const float v = segS[s * 128 + d]; tot += v; off += (s < seg) ? v : 0.f; }
}

template <bool ML>
__device__ __forceinline__ void chunk_state(const Args& a, LAS unsigned char* lds, int bh, int c) {
    constexpr int DK = ML ? 256 : 128, NDT = DK / 16, RSK = DK + 16;
    int tid_ = threadIdx.x; asm volatile("" : "+v"(tid_));
    const int tid = tid_, lane = tid & 63, wave = __builtin_amdgcn_readfirstlane(tid >> 6), fr = lane & 15, fq = lane >> 4;
    const int b = bh >> 2, h = bh & 3, row0 = b * TP + c * 128, item = bh * NCH + c;
    unsigned char* ws = a.ws;
    const bf16* P = (const bf16*)(ws + WS_PROJ); const float* gates = (const float*)(ws + WS_GATES);
    LAS bf16* Ks = (LAS bf16*)lds; LAS bf16* Vs = (LAS bf16*)(lds + 69632); LAS float* sc = (LAS float*)(lds + 139264);
    __syncthreads();
    stage_v(Vs, P, row0, (ML ? C_MV : C_GV) + h * 256, tid);
    u32x4 kpre[8];
    if (ML) {
#pragma unroll
        for (int i = 0; i < 8; ++i) { const int idx = tid + NTHR * i, sr = idx >> 5, dp = idx & 31; kpre[i] = *(const u32x4*)(P + (size_t)(row0 + sr) * NPROJ + C_MK + h * 256 + 8 * dp); }
    }
    if (ML) {
        if (wave == 0) {
            const int t0 = 2 * lane;
            const float lf0 = logsig(gates[(size_t)(row0 + t0) * 32 + 4 + h] + a.in[I_BF][h]), lf1 = logsig(gates[(size_t)(row0 + t0 + 1) * 32 + 4 + h] + a.in[I_BF][h]);
            const float i0 = gates[(size_t)(row0 + t0) * 32 + h] + a.in[I_BI][h], i1 = gates[(size_t)(row0 + t0 + 1) * 32 + h] + a.in[I_BI][h];
            const float pr = lf0 + lf1, S = wave_iscan_add(pr, lane), ex = S - pr;
            const float ah0 = i0 - (ex + lf0), ah1 = i1 - S;
            const float Ah = wave_max(fmaxf(ah0, ah1));
            sc[t0] = __expf(ah0 - Ah) * (1.f / 16.f); sc[t0 + 1] = __expf(ah1 - Ah) * (1.f / 16.f);
            if (lane == 63) { float* chs = (float*)(ws + WS_CHS); chs[item * 2] = Ah; chs[item * 2 + 1] = S; }
        }
        __syncthreads();
#pragma unroll
        for (int i = 0; i < 8; ++i) { const int idx = tid + NTHR * i, s = idx >> 5, dp = idx & 31; const float w = sc[s];
            const u32x4 v = kpre[i];
            u32x4 o; o.x = cvt_pk_bf16(bflo(v.x) * w, bfhi(v.x) * w); o.y = cvt_pk_bf16(bflo(v.y) * w, bfhi(v.y) * w); o.z = cvt_pk_bf16(bflo(v.z) * w, bfhi(v.z) * w); o.w = cvt_pk_bf16(bflo(v.w) * w, bfhi(v.w) * w);
            *(LAS u32x4*)(Ks + s * RSK + 8 * dp) = o; }
    } else {
        float la[32], off, tot;
        const int d = tid & 127, seg = tid >> 7;
        unsigned short kraw[32];
#pragma unroll
        for (int i = 0; i < 32; ++i) kraw[i] = P[(size_t)(row0 + seg * 32 + i) * NPROJ + C_GK + h * 128 + d];
        LAS float* galS = (LAS float*)(lds + 36864); gla_logdecay(a, gates, row0, h, galS, galS + 2048, tid, la, off, tot);
        if (seg == 0) ((float*)(ws + WS_BEND))[item * 128 + d] = tot;
        float bcur = off;
#pragma unroll
        for (int i = 0; i < 32; ++i) { const int t = seg * 32 + i; bcur += la[i];
            const float kv = bf2f(kraw[i]);
            Ks[t * RSK + d] = f2bf(kv * __expf(tot - bcur)); }
    }
    __syncthreads();
    f32x4 acc[2][NDT];
#pragma unroll
    for (int e = 0; e < 2; ++e)
#pragma unroll
        for (int d = 0; d < NDT; ++d) acc[e][d] = (f32x4){0.f, 0.f, 0.f, 0.f};
#pragma unroll
    for (int ks = 0; ks < 4; ++ks) {
        bf16x8 vb[2];
#pragma unroll
        for (int e = 0; e < 2; ++e) vb[e] = tr_frag(Vs, 272, wave * 32 + e * 16, ks, lane);
#pragma unroll
        for (int d = 0; d < NDT; ++d) { const bf16x8 ka = tr_frag(Ks, RSK, d * 16, ks, lane);
#pragma unroll
            for (int e = 0; e < 2; ++e) acc[e][d] = __builtin_amdgcn_mfma_f32_16x16x32_bf16(ka, vb[e], acc[e][d], 0, 0, 0); }
    }
    float* dst = (float*)(ws + (ML ? WS_DC : WS_DS)) + (size_t)item * 256 * DK;
#pragma unroll
    for (int e = 0; e < 2; ++e)
#pragma unroll
        for (int d = 0; d < NDT; ++d) *(f32x4*)(dst + (size_t)(wave * 32 + e * 16 + fr) * DK + d * 16 + 4 * fq) = acc[e][d];
    if (ML && tid < 256) { float s = 0.f;
#pragma unroll 16
        for (int i = 0; i < 128; ++i) s += bf2f(Ks[i * RSK + tid]);
        ((float*)(ws + WS_DN))[item * 256 + tid] = s; }
}

__device__ __forceinline__ void scan_mlstm(const Args& a, int j) {
    int tid_ = threadIdx.x; asm volatile("" : "+v"(tid_));
    const int tid = tid_, bh = j >> 5, eb = j & 31;
    unsigned char* ws = a.ws;
    const float* chs = (const float*)(ws + WS_CHS);
    const int e = eb * 8 + (tid >> 6), d4 = (tid & 63) * 4;
    const float* dC = (const float*)(ws + WS_DC) + (size_t)bh * NCH * 65536 + (size_t)e * 256 + d4;
    bf16* CT = (bf16*)(ws + WS_CT) + (size_t)bh * NCH * 65536 + (size_t)e * 256 + d4;
    f32x4 Cv = {0.f, 0.f, 0.f, 0.f}; float Fs = 0.f, Mp = 0.f;
    const bool do_n = (eb == 0 && tid < 256);
    float nv = 0.f;
    f32x4 dv[NCH];
#pragma unroll
    for (int c = 0; c < NCH; ++c) dv[c] = *(const f32x4*)(dC + (size_t)c * 65536);
#pragma unroll
    for (int c = 0; c < NCH; ++c) {
        u32x2 o; o.x = cvt_pk_bf16(Cv[0], Cv[1]); o.y = cvt_pk_bf16(Cv[2], Cv[3]); *(u32x2*)(CT + (size_t)c * 65536) = o;
        if (do_n) ((bf16*)(ws + WS_NPREV))[(bh * NCH + c) * 256 + tid] = f2bf(nv);
        const float Ah = chs[(bh * NCH + c) * 2], bt = chs[(bh * NCH + c) * 2 + 1];
        const float Ac = Ah - Fs, Mn = fmaxf(Mp, Ac), f1 = __expf(Mp - Mn), f2 = __expf(Ac - Mn);
        Cv = Cv * f1 + dv[c] * f2;
        if (do_n) nv = nv * f1 + ((const float*)(ws + WS_DN))[(bh * NCH + c) * 256 + tid] * f2;
        Mp = Mn; Fs += bt;
    }
    float* oC = a.out + O_PC + (size_t)bh * 65536;
#pragma unroll
    for (int i = 0; i < 4; ++i) oC[(size_t)(d4 + i) * 256 + e] = Cv[i];
    if (do_n) a.out[O_PN + bh * 256 + tid] = nv;
    if (eb == 0 && tid == 0) a.out[O_PM + bh] = Fs + Mp;
}
__device__ __forceinline__ void scan_gla(const Args& a, int j) {
    int tid_ = threadIdx.x; asm volatile("" : "+v"(tid_));
    const int tid = tid_, bh = j >> 4, eb = j & 15;
    unsigned char* ws = a.ws;
    const float* bend = (const float*)(ws + WS_BEND);
    const int ee = eb * 16 + (tid >> 5), d4 = (tid & 31) * 4;
    const float* dS = (const float*)(ws + WS_DS) + (size_t)bh * NCH * 32768 + (size_t)ee * 128 + d4;
    bf16* ST = (bf16*)(ws + WS_ST) + (size_t)bh * NCH * 32768 + (size_t)ee * 128 + d4;
    f32x4 Sv = {0.f, 0.f, 0.f, 0.f};
    f32x4 dv[NCH];
#pragma unroll
    for (int c = 0; c < NCH; ++c) dv[c] = *(const f32x4*)(dS + (size_t)c * 32768);
#pragma unroll
    for (int c = 0; c < NCH; ++c) {
        u32x2 o; o.x = cvt_pk_bf16(Sv[0], Sv[1]); o.y = cvt_pk_bf16(Sv[2], Sv[3]); *(u32x2*)(ST + (size_t)c * 32768) = o;
        const f32x4 be = *(const f32x4*)(bend + (bh * NCH + c) * 128 + d4);
        Sv[0] = Sv[0] * __expf(be[0]) + dv[c][0]; Sv[1] = Sv[1] * __expf(be[1]) + dv[c][1]; Sv[2] = Sv[2] * __expf(be[2]) + dv[c][2]; Sv[3] = Sv[3] * __expf(be[3]) + dv[c][3];
    }
    float* oS = a.out + O_PS + (size_t)bh * 32768;
#pragma unroll
    for (int i = 0; i < 4; ++i) oS[(size_t)(d4 + i) * 256 + ee] = Sv[i];
}

template <bool ML>
__device__ __forceinline__ void chunk_out(const Args& a, LAS unsigned char* lds, int bh, int c) {
    constexpr int DK = ML ? 256 : 128, QS = DK + 8, NKK = DK / 32;
    int tid_ = threadIdx.x; asm volatile("" : "+v"(tid_));
    const int tid = tid_, lane = tid & 63, wave = __builtin_amdgcn_readfirstlane(tid >> 6), fr = lane & 15, fq = lane >> 4;
    const int b = bh >> 2, h = bh & 3, row0 = b * TP + c * 128, item = bh * NCH + c;
    unsigned char* ws = a.ws;
    const bf16* P = (const bf16*)(ws + WS_PROJ); const float* gates = (const float*)(ws + WS_GATES);
    LAS bf16* Qs = (LAS bf16*)lds; LAS bf16* Ks = Qs + 128 * QS;
    LAS float* sc = (LAS float*)(lds + 143616);
    __syncthreads();
    u32x4 qpre[ML ? 8 : 1], kpre2[ML ? 8 : 1];
    if (ML) {
#pragma unroll
        for (int i = 0; i < 8; ++i) { const int idx = tid + NTHR * i, tr = idx >> 5, p = idx & 31;
            qpre[i] = *(const u32x4*)(P + (size_t)(row0 + tr) * NPROJ + C_MQ + h * 256 + p * 8); kpre2[i] = *(const u32x4*)(P + (size_t)(row0 + tr) * NPROJ + C_MK + h * 256 + p * 8); }
    }
    if (ML) {
        if (wave == 0) {
            const float* chs = (const float*)(ws + WS_CHS);
            const float Ahc = lane < NCH ? chs[(bh * NCH + lane) * 2] : 0.f, btc = lane < NCH ? chs[(bh * NCH + lane) * 2 + 1] : 0.f;
            const float fsx = wave_iscan_add(btc, lane) - btc;
            const float Mp = fmaxf(0.f, wave_max(lane < c ? Ahc - fsx : -3.0e38f)), Fs = wave_sum(lane < c ? btc : 0.f);
            const int t0 = 2 * lane;
            const float lf0 = logsig(gates[(size_t)(row0 + t0) * 32 + 4 + h] + a.in[I_BF][h]), lf1 = logsig(gates[(size_t)(row0 + t0 + 1) * 32 + 4 + h] + a.in[I_BF][h]);
            const float i0 = gates[(size_t)(row0 + t0) * 32 + h] + a.in[I_BI][h], i1 = gates[(size_t)(row0 + t0 + 1) * 32 + h] + a.in[I_BI][h];
            const float pr = lf0 + lf1, S = wave_iscan_add(pr, lane), b0 = S - lf1, b1 = S;
            const float a0 = i0 - b0 - Fs, a1 = i1 - b1 - Fs;
            const float cm = wave_iscan_max(fmaxf(a0, a1), lane); float exm = __shfl_up(cm, 1); if (lane == 0) exm = -3.0e38f;
            const float M0 = fmaxf(fmaxf(Mp, exm), a0), M1 = fmaxf(M0, a1);
            sc[t0] = a0; sc[t0 + 1] = a1; sc[128 + t0] = M0; sc[128 + t0 + 1] = M1; sc[256 + t0] = __expf(Mp - M0); sc[256 + t0 + 1] = __expf(Mp - M1);
            sc[384 + t0] = __expf(-(Fs + b0 + M0)); sc[384 + t0 + 1] = __expf(-(Fs + b1 + M1));
        }
#pragma unroll
        for (int i = 0; i < 8; ++i) { const int idx = tid + NTHR * i, t = idx >> 5, p = idx & 31;
            *(LAS u32x4*)(Qs + t * QS + p * 8) = qpre[i];
            *(LAS u32x4*)(Ks + t * QS + p * 8) = kpre2[i]; }
    } else {
        float la[32], off, tot;
        const int d = tid & 127, seg = tid >> 7;
        unsigned short qraw[32], kraw[32];
#pragma unroll
        for (int i = 0; i < 32; ++i) { qraw[i] = P[(size_t)(row0 + seg * 32 + i) * NPROJ + C_GQ + h * 128 + d]; kraw[i] = P[(size_t)(row0 + seg * 32 + i) * NPROJ + C_GK + h * 128 + d]; }
        LAS float* galS = (LAS float*)(lds + 69632); LAS float* segS = galS + 128 * 16;
        gla_logdecay(a, gates, row0, h, galS, segS, tid, la, off, tot);
        float bcur = off;
#pragma unroll
        for (int i = 0; i < 32; ++i) { const int t = seg * 32 + i; bcur += la[i];
            const float qv = bf2f(qraw[i]), kv = bf2f(kraw[i]);
            Qs[t * QS + d] = f2bf(qv * 0.08838834764831845f * __expf(bcur)); Ks[t * QS + d] = f2bf(kv * __expf(-bcur)); }
    }
    __syncthreads();
    constexpr int NCP = ML ? 16 : 8;
    u32x4 cpre[NCP]; u32x4 npre = {0u, 0u, 0u, 0u};
    if (ML) { const bf16* CT = (const bf16*)(ws + WS_CT) + (size_t)item * 65536;
#pragma unroll
        for (int i = 0; i < NCP; ++i) { const int idx = tid + NTHR * i, e = idx >> 5, p = idx & 31; cpre[i] = *(const u32x4*)(CT + (size_t)e * 256 + p * 8); }
        if (tid < 32) npre = *(const u32x4*)((const bf16*)(ws + WS_NPREV) + (size_t)item * 256 + tid * 8);
    } else { const bf16* ST = (const bf16*)(ws + WS_ST) + (size_t)item * 32768;
#pragma unroll
        for (int i = 0; i < NCP; ++i) { const int idx = tid + NTHR * i, e = idx >> 4, p = idx & 15; cpre[i] = *(const u32x4*)(ST + (size_t)e * 128 + p * 8); }
    }
    bf16x8 qf[NKK];
#pragma unroll
    for (int kk = 0; kk < NKK; ++kk) qf[kk] = *(const LAS bf16x8*)(Qs + (wave * 16 + fr) * QS + kk * 32 + fq * 8);
    const int t = wave * 16 + fr;
    u32x2 pb[8]; float den = 0.f;
    {
        const float Mt = ML ? sc[128 + t] : 0.f;
#pragma unroll
        for (int st = 0; st < 8; ++st) { f32x4 s = {0.f, 0.f, 0.f, 0.f};
#pragma unroll
            for (int kk = 0; kk < NKK; ++kk) { const bf16x8 kf = *(const LAS bf16x8*)(Ks + (st * 16 + fr) * QS + kk * 32 + fq * 8); s = __builtin_amdgcn_mfma_f32_16x16x32_bf16(kf, qf[kk], s, 0, 0, 0); }
            float p[4];
            f32x4 as4 = {0.f, 0.f, 0.f, 0.f}; if (ML) as4 = *(const LAS f32x4*)(sc + st * 16 + 4 * fq);
#pragma unroll
            for (int r = 0; r < 4; ++r) { const int si = st * 16 + 4 * fq + r;
                const float e = ML ? s[r] * (1.f / 16.f) * __expf(fminf(as4[r] - Mt, 0.f)) : s[r];
                p[r] = (si <= t) ? e : 0.f;
                den += p[r]; }
            pb[st].x = cvt_pk_bf16(p[0], p[1]); pb[st].y = cvt_pk_bf16(p[2], p[3]);
            __builtin_amdgcn_sched_barrier(0); }
    }
    __syncthreads();
    LAS bf16* Cl = (LAS bf16*)lds;
    if (ML) {
#pragma unroll
        for (int i = 0; i < NCP; ++i) { const int idx = tid + NTHR * i, e = idx >> 5, p = idx & 31; *(LAS u32x4*)(Cl + e * QS + p * 8) = cpre[i]; }
        { const int e = tid >> 5, p = tid & 31; *(LAS u32x4*)(Cl + (256 + e) * QS + p * 8) = npre; }
    } else {
#pragma unroll
        for (int i = 0; i < NCP; ++i) { const int idx = tid + NTHR * i, e = idx >> 4, p = idx & 15; *(LAS u32x4*)(Cl + e * QS + p * 8) = cpre[i]; }
    }
    u32x4 vpre[8];
#pragma unroll
    for (int i = 0; i < 8; ++i) { const int idx = tid + NTHR * i, sr = idx >> 5, p = idx & 31; vpre[i] = *(const u32x4*)(P + (size_t)(row0 + sr) * NPROJ + (ML ? C_MV : C_GV) + h * 256 + 8 * p); }
    __syncthreads();
    f32x4 acc[16];
#pragma unroll
    for (int et = 0; et < 16; ++et) { acc[et] = (f32x4){0.f, 0.f, 0.f, 0.f};
#pragma unroll
        for (int kk = 0; kk < NKK; ++kk) { const bf16x8 cf = *(const LAS bf16x8*)(Cl + (et * 16 + fr) * QS + kk * 32 + fq * 8); acc[et] = __builtin_amdgcn_mfma_f32_16x16x32_bf16(cf, qf[kk], acc[et], 0, 0, 0); }
        if ((et & 1) == 1) __builtin_amdgcn_sched_barrier(0); }
    float wint = 1.f, qn = 0.f;
    if (ML) {
        f32x4 dn = {0.f, 0.f, 0.f, 0.f};
#pragma unroll
        for (int kk = 0; kk < NKK; ++kk) { const bf16x8 nf = *(const LAS bf16x8*)(Cl + (256 + fr) * QS + kk * 32 + fq * 8); dn = __builtin_amdgcn_mfma_f32_16x16x32_bf16(nf, qf[kk], dn, 0, 0, 0); }
        qn = __shfl(dn[0], fr);
        wint = sc[256 + t];
#pragma unroll
        for (int et = 0; et < 16; ++et) acc[et] = acc[et] * wint;
    }
    __syncthreads();
    LAS bf16* Vs = (LAS bf16*)lds;
#pragma unroll
    for (int i = 0; i < 8; ++i) { const int idx = tid + NTHR * i, sr = idx >> 5, p = idx & 31; *(LAS u32x4*)(Vs + sr * 272 + p * 8) = vpre[i]; }
    u32x2 gpre[16];
    { const bf16* gp0 = P + (size_t)(row0 + wave * 16 + fr) * NPROJ + (ML ? C_MO : C_GR) + h * 256 + 4 * fq;
#pragma unroll
      for (int et = 0; et < 16; ++et) gpre[et] = *(const u32x2*)(gp0 + et * 16); }
    __syncthreads();
#pragma unroll
    for (int ks = 0; ks < 4; ++ks) {
        u32x4 pw; pw.x = pb[2 * ks].x; pw.y = pb[2 * ks].y; pw.z = pb[2 * ks + 1].x; pw.w = pb[2 * ks + 1].y;
        const bf16x8 pf = __builtin_bit_cast(bf16x8, pw);
#pragma unroll
        for (int et = 0; et < 16; ++et) { acc[et] = __builtin_amdgcn_mfma_f32_16x16x32_bf16(tr_frag(Vs, 272, et * 16, ks, lane), pf, acc[et], 0, 0, 0); if ((et & 3) == 3) __builtin_amdgcn_sched_barrier(0); }
    }
    float inv = 1.f;
    if (ML) { den += __shfl_xor(den, 16); den += __shfl_xor(den, 32); den += wint * qn; inv = 1.f / fmaxf(fabsf(den), sc[384 + t]); }
    float ss = 0.f;
#pragma unroll
    for (int et = 0; et < 16; ++et) { acc[et] = acc[et] * inv; ss += dot4(acc[et], acc[et]); }
    ss += __shfl_xor(ss, 16); ss += __shfl_xor(ss, 32);
    const float rn = rsqrtf(ss * (1.f / 256.f) + EPS);
    const float* hw = a.in[ML ? I_MHW : I_GHW] + h * 256;
    const bf16* gp = P + (size_t)(row0 + t) * NPROJ + (ML ? C_MO : C_GR) + h * 256;
    bf16* yp = (bf16*)(ws + (ML ? WS_YM : WS_YG)) + (size_t)(row0 + t) * 1024 + h * 256;
#pragma unroll
    for (int et = 0; et < 16; ++et) { const int e = et * 16 + 4 * fq;
        const u32x2 gw = gpre[et]; const f32x4 w = *(const f32x4*)(hw + e);
        const float g0 = bflo(gw.x), g1 = bfhi(gw.x), g2 = bflo(gw.y), g3 = bfhi(gw.y);
        float o0 = acc[et][0] * rn * w[0], o1 = acc[et][1] * rn * w[1], o2 = acc[et][2] * rn * w[2], o3 = acc[et][3] * rn * w[3];
        if (ML) { o0 *= sigm(g0); o1 *= sigm(g1); o2 *= sigm(g2); o3 *= sigm(g3); } else { o0 *= g0 * sigm(g0); o1 *= g1 * sigm(g1); o2 *= g2 * sigm(g2); o3 *= g3 * sigm(g3); }
        u32x2 o; o.x = cvt_pk_bf16(o0, o1); o.y = cvt_pk_bf16(o2, o3); *(u32x2*)(yp + e) = o;
        if ((et & 3) == 3) __builtin_amdgcn_sched_barrier(0); }
}

template <bool ML>
__device__ __forceinline__ void sample_item(const Args& a, LAS unsigned char* lds, int b, int h) {
    constexpr int DK = ML ? 256 : 128;
    int tid_ = threadIdx.x; asm volatile("" : "+v"(tid_));
    const int tid = tid_, lane = tid & 63, wave = __builtin_amdgcn_readfirstlane(tid >> 6);
    unsigned char* ws = a.ws;
    const bf16* P = (const bf16*)(ws + WS_PROJ); const float* gates = (const float*)(ws + WS_GATES);
    const int row0 = MP + b * 8, bh = b * 4 + h;
    LAS float* qT = (LAS float*)lds;
    LAS float* wkT = qT + 2048;
    LAS float* kT = wkT + 2048;
    LAS float* vS = kT + 2048;
    LAS float* red = vS + 2048;
    LAS float* sm = red + 16384;
    const float* C0 = a.in[ML ? I_C : I_S] + (size_t)bh * DK * 256;
    float* C1 = a.out + (ML ? O_SC : O_SS) + (size_t)bh * DK * 256;
    f32x4 nx[8];
#pragma unroll
    for (int j = 0; j < 8; ++j) nx[j] = __builtin_nontemporal_load((const f32x4*)(C0 + (size_t)(wave + 8 * j) * 256 + 4 * lane));
    __syncthreads();
    float aS[8], Mt[8], bS[8]; float m0 = 0.f, dec = 1.f;
    if (ML) {
        m0 = a.in[I_M][bh]; float bs = 0.f, M = m0;
#pragma unroll
        for (int t = 0; t < 8; ++t) { const float mi = gates[(size_t)(row0 + t) * 32 + h], mf = gates[(size_t)(row0 + t) * 32 + 4 + h];
            bs += logsig(mf + a.in[I_BF][h]); bS[t] = bs; aS[t] = mi + a.in[I_BI][h] - bs; M = fmaxf(M, aS[t]); Mt[t] = M; }
        dec = __expf(m0 - Mt[7]);
        if (tid == 0) {
#pragma unroll
            for (int t = 0; t < 8; ++t) { sm[200 + t] = aS[t]; sm[208 + t] = Mt[t]; sm[216 + t] = bS[t]; } }
        if (tid < 256) { const int d = tid;
#pragma unroll
            for (int t = 0; t < 8; ++t) { const float qv = bf2f(P[(size_t)(row0 + t) * NPROJ + C_MQ + h * 256 + d]), kv = bf2f(P[(size_t)(row0 + t) * NPROJ + C_MK + h * 256 + d]) * (1.f / 16.f);
                qT[d * 8 + t] = qv; kT[d * 8 + t] = kv; wkT[d * 8 + t] = kv * __expf(aS[t] - Mt[7]); } }
    } else {
        if (tid < 128) { const int d = tid; float up[16];
#pragma unroll
            for (int j = 0; j < 16; ++j) up[j] = a.in[I_AUP][j * 512 + h * 128 + d];
            const float ab = a.in[I_AB][h * 128 + d];
            float bc[8]; float bs = 0.f;
#pragma unroll
            for (int t = 0; t < 8; ++t) { float z = ab;
#pragma unroll
                for (int j = 0; j < 16; ++j) z += gates[(size_t)(row0 + t) * 32 + 8 + j] * up[j];
                bs += logsig(z) * (1.f / 16.f); bc[t] = bs; }
            sm[72 + d] = __expf(bs);
#pragma unroll
            for (int t = 0; t < 8; ++t) { const float qv = bf2f(P[(size_t)(row0 + t) * NPROJ + C_GQ + h * 128 + d]), kv = bf2f(P[(size_t)(row0 + t) * NPROJ + C_GK + h * 128 + d]);
                qT[d * 8 + t] = qv * 0.08838834764831845f * __expf(bc[t]); kT[d * 8 + t] = kv * __expf(-bc[t]); wkT[d * 8 + t] = kv * __expf(bs - bc[t]); } }
    }
    { const int t = tid >> 6; const u32x2 w = *(const u32x2*)(P + (size_t)(row0 + t) * NPROJ + (ML ? C_MV : C_GV) + h * 256 + 4 * lane);
      *(LAS f32x4*)(vS + t * 256 + 4 * lane) = (f32x4){bflo(w.x), bfhi(w.x), bflo(w.y), bfhi(w.y)}; }
    __syncthreads();
    float prow, qn = 0.f;
    { const int s8 = lane & 7, part = lane >> 3; float sd = 0.f;
#pragma unroll 8
      for (int i = 0; i < DK / 8; ++i) { const int d = 8 * i + part; sd += qT[d * 8 + wave] * kT[d * 8 + s8]; }
      sd += __shfl_xor(sd, 8); sd += __shfl_xor(sd, 16); sd += __shfl_xor(sd, 32);
      if (ML) prow = (s8 <= wave) ? sd * __expf(sm[200 + s8] - sm[208 + wave]) : 0.f; else prow = (s8 <= wave) ? sd : 0.f; }
    if (ML) { const float* n0 = a.in[I_N] + (size_t)bh * 256; float sd = 0.f;
#pragma unroll
      for (int i = 0; i < 4; ++i) { const int d = lane + 64 * i; sd += qT[d * 8 + wave] * n0[d]; }
      qn = wave_sum(sd); }
    f32x4 v[8], acc[8];
#pragma unroll
    for (int s = 0; s < 8; ++s) { v[s] = *(const LAS f32x4*)(vS + s * 256 + 4 * lane); acc[s] = (f32x4){0.f, 0.f, 0.f, 0.f}; }
#pragma unroll
    for (int bt = 0; bt < DK / 64; ++bt) {
        f32x4 cur[8];
#pragma unroll
        for (int j = 0; j < 8; ++j) cur[j] = nx[j];
        if (bt + 1 < DK / 64) {
#pragma unroll
            for (int j = 0; j < 8; ++j) nx[j] = __builtin_nontemporal_load((const f32x4*)(C0 + (size_t)(wave + 8 * (8 * (bt + 1) + j)) * 256 + 4 * lane)); }
#pragma unroll
        for (int j = 0; j < 8; ++j) { const int d = wave + 8 * (8 * bt + j); const f32x4 cv = cur[j];
            const f32x4 q0 = *(const LAS f32x4*)(qT + d * 8), q1 = *(const LAS f32x4*)(qT + d * 8 + 4), k0 = *(const LAS f32x4*)(wkT + d * 8), k1 = *(const LAS f32x4*)(wkT + d * 8 + 4);
            const float dd = ML ? dec : sm[72 + d];
            acc[0] += cv * q0[0]; acc[1] += cv * q0[1]; acc[2] += cv * q0[2]; acc[3] += cv * q0[3]; acc[4] += cv * q1[0]; acc[5] += cv * q1[1]; acc[6] += cv * q1[2]; acc[7] += cv * q1[3];
            f32x4 cn = cv * dd;
            cn += v[0] * k0[0]; cn += v[1] * k0[1]; cn += v[2] * k0[2]; cn += v[3] * k0[3]; cn += v[4] * k1[0]; cn += v[5] * k1[1]; cn += v[6] * k1[2]; cn += v[7] * k1[3];
            __builtin_nontemporal_store(cn, (f32x4*)(C1 + (size_t)d * 256 + 4 * lane)); }
    }
#pragma unroll
    for (int s = 0; s < 8; ++s) *(LAS f32x4*)(red + (wave * 8 + s) * 256 + 4 * lane) = acc[s];
    __syncthreads();
    const int t = wave;
    f32x4 qc = {0.f, 0.f, 0.f, 0.f};
#pragma unroll
    for (int w = 0; w < 8; ++w) qc += *(const LAS f32x4*)(red + (w * 8 + t) * 256 + 4 * lane);
    float wint = 1.f, den = 0.f, Mtt = 0.f, btt = 0.f;
    if (ML) { Mtt = sm[208 + t]; btt = sm[216 + t]; wint = __expf(m0 - Mtt); }
    f32x4 num = qc * wint;
#pragma unroll
    for (int s = 0; s < 8; ++s) { const float p = __shfl(prow, s); num += v[s] * p; den += p; }
    if (ML) { den += wint * qn; const float fl = fmaxf(fabsf(den), __expf(-(btt + Mtt))); num = num * (1.f / fl); }
    const float rn = rsqrtf(wave_sum(dot4(num, num)) * (1.f / 256.f) + EPS);
    const f32x4 w = *(const f32x4*)(a.in[ML ? I_MHW : I_GHW] + h * 256 + 4 * lane);
    const u32x2 gw = *(const u32x2*)(P + (size_t)(row0 + t) * NPROJ + (ML ? C_MO : C_GR) + h * 256 + 4 * lane);
    const float g0 = bflo(gw.x), g1 = bfhi(gw.x), g2 = bflo(gw.y), g3 = bfhi(gw.y);
    float o0 = num[0] * rn * w[0], o1 = num[1] * rn * w[1], o2 = num[2] * rn * w[2], o3 = num[3] * rn * w[3];
    if (ML) { o0 *= sigm(g0); o1 *= sigm(g1); o2 *= sigm(g2); o3 *= sigm(g3); } else { o0 *= g0 * sigm(g0); o1 *= g1 * sigm(g1); o2 *= g2 * sigm(g2); o3 *= g3 * sigm(g3); }
    u32x2 o; o.x = cvt_pk_bf16(o0, o1); o.y = cvt_pk_bf16(o2, o3);
    *(u32x2*)((bf16*)(ws + (ML ? WS_YM : WS_YG)) + (size_t)(row0 + t) * 1024 + h * 256 + 4 * lane) = o;
    if (ML) {
        if (tid < 256) { float s = dec * a.in[I_N][(size_t)bh * 256 + tid];
#pragma unroll
            for (int q = 0; q < 8; ++q) s += wkT[tid * 8 + q];
            a.out[O_SN + (size_t)bh * 256 + tid] = s; }
        if (tid == 0) a.out[O_SM + bh] = bS[7] + Mt[7];
    }
}

__device__ __forceinline__ void merge_reduce(const Args& a, int vcu, int G) {
    int tid_ = threadIdx.x; asm volatile("" : "+v"(tid_));
    const int tid = tid_, lane = tid & 63, wave = tid >> 6;
    const float* tailp = a.out + O_YP; bf16* O = (bf16*)(a.ws + WS_XN);
    for (int rr = vcu * NWAVES + wave; rr < MS; rr += G * NWAVES) { const int m = MP + rr, pmo = rr >> 8;
#pragma unroll
        for (int j = 0; j < 8; ++j) { const float* tp = tailp + (size_t)(pmo * 8 + j) * 8 * 65536 + (rr & 255) * 256 + 4 * lane;
            f32x4 v = *(const f32x4*)tp;
#pragma unroll
            for (int sl = 1; sl < 8; ++sl) v += *(const f32x4*)(tp + (size_t)sl * 65536);
            u32x2 o; o.x = cvt_pk_bf16(v[0], v[1]); o.y = cvt_pk_bf16(v[2], v[3]); *(u32x2*)(O + (size_t)m * DM + 4 * lane + 256 * j) = o; }
    }
}
__device__ __forceinline__ void rstd_phase(const Args& a, int vcu, int G) {
    int tid_ = threadIdx.x; asm volatile("" : "+v"(tid_));
    const int tid = tid_, lane = tid & 63, wave = tid >> 6;
    const float* part = (const float*)(a.ws + WS_PART); float* rstd = (float*)(a.ws + WS_RSTD);
    const bool split = (G == 256); const int nplain = split ? MP : MT;
    for (int row = vcu * NTHR + tid; row < nplain; row += G * NTHR) { float s = 0.f;
#pragma unroll
        for (int i = 0; i < 8; ++i) s += sum4(*(const f32x4*)(part + (size_t)row * 32 + 4 * i));
        rstd[row] = rsqrtf(s * (1.f / DM) + EPS); }
    if (split) {
        const float* tailp = (const float*)(a.ws + WS_PROJ); const float* nw = a.in[I_NFFN]; float* X1 = (float*)(a.ws + WS_X1); bf16* X1W = (bf16*)(a.ws + WS_X1W);
        for (int rr = vcu * NWAVES + wave; rr < MS; rr += G * NWAVES) { const int m = MP + rr, pmo = rr >> 8;
            f32x4 v[8]; float ss = 0.f;
#pragma unroll
            for (int j = 0; j < 8; ++j) { v[j] = *(const f32x4*)(a.in[I_XS] + (size_t)rr * DM + 4 * lane + 256 * j);
                const float* tp = tailp + (size_t)(pmo * 8 + j) * 8 * 65536 + (rr & 255) * 256 + 4 * lane;
#pragma unroll
                for (int sl = 0; sl < 8; ++sl) v[j] += *(const f32x4*)(tp + (size_t)sl * 65536);
                ss += dot4(v[j], v[j]); }
            ss = wave_sum(ss);
            if (lane == 0) rstd[m] = rsqrtf(ss * (1.f / DM) + EPS);
#pragma unroll
            for (int j = 0; j < 8; ++j) { const f32x4 w = *(const f32x4*)(nw + 4 * lane + 256 * j);
                *(f32x4*)(X1 + (size_t)m * DM + 4 * lane + 256 * j) = v[j];
                u32x2 o; o.x = cvt_pk_bf16(v[j][0] * w[0], v[j][1] * w[1]); o.y = cvt_pk_bf16(v[j][2] * w[2], v[j][3] * w[3]);
                *(u32x2*)(X1W + (size_t)m * DM + 4 * lane + 256 * j) = o; }
        }
    }
}
__device__ __forceinline__ void act_fixup(const Args& a, int vcu, int G) {
    unsigned char* ws = a.ws; const float* ub = (const float*)(ws + WS_U); bf16* ACT = (bf16*)(ws + WS_G);
    const float* cw = a.in[I_CW]; const float* cb = a.in[I_CB];
    int tid_ = threadIdx.x; asm volatile("" : "+v"(tid_));
    for (int idx = vcu * NTHR + tid_; idx < 28 * DFF; idx += G * NTHR) {
        const int k = idx / DFF, col = idx % DFF, pm = (k / 7) * 8 + 1 + (k % 7);
        const float um2 = ub[((size_t)(pm - 1) * 6 + 0) * DFF + col], um1 = ub[((size_t)(pm - 1) * 6 + 1) * DFF + col];
        const float u0 = ub[((size_t)pm * 6 + 2) * DFF + col], u1 = ub[((size_t)pm * 6 + 3) * DFF + col], g0 = ub[((size_t)pm * 6 + 4) * DFF + col], g1 = ub[((size_t)pm * 6 + 5) * DFF + col];
        const float c0 = cw[col], c1 = cw[DFF + col], c2 = cw[2 * DFF + col], bb = cb[col];
        ACT[(size_t)(pm * 256) * DFF + col] = f2bf(gelu_tanh(bb + c0 * um2 + c1 * um1 + c2 * u0) * g0);
        ACT[(size_t)(pm * 256 + 1) * DFF + col] = f2bf(gelu_tanh(bb + c0 * um1 + c1 * u0 + c2 * u1) * g1);
    }
}
__device__ __forceinline__ void final_norm(const Args& a, int vcu, int G) {
    int tid_ = threadIdx.x; asm volatile("" : "+v"(tid_));
    const int tid = tid_, lane = tid & 63, wave = tid >> 6;
    const float* fw = a.in[I_FNW]; const float* X1 = (const float*)(a.ws + WS_X1); const float* tailp = (const float*)(a.ws + WS_U);
    const bool split = (G == 256);
    int tpm = -1, tpn = -1;
    if (split && lane < 32) { pg8::StaticOrder S; S.init(MT, DM, G, 0); pg8::Unit u; if (S.at(256 + lane, u)) { tpm = u.pm; tpn = u.pn; } }
    for (int m = vcu * NWAVES + wave; m < MT; m += G * NWAVES) {
        const int pm = m >> 8;
        float* row = a.out + (size_t)m * DM;
        f32x4 v[8]; float ss = 0.f;
#pragma unroll
        for (int j = 0; j < 8; ++j) {
            const unsigned long long mask = __ballot(tpm == pm && tpn == j);
            if (mask == 0ull) v[j] = *(const f32x4*)(row + 4 * lane + 256 * j);
            else { const int tt = __ffsll((long long)mask) - 1;
                v[j] = *(const f32x4*)(X1 + (size_t)m * DM + 4 * lane + 256 * j);
                const float* tp = tailp + (size_t)tt * 8 * 65536 + (m & 255) * 256 + 4 * lane;
#pragma unroll
                for (int sl = 0; sl < 8; ++sl) v[j] += *(const f32x4*)(tp + (size_t)sl * 65536); }
            ss += dot4(v[j], v[j]); }
        const float r = rsqrtf(wave_sum(ss) * (1.f / DM) + EPS);
#pragma unroll
        for (int j = 0; j < 8; ++j) { const f32x4 w = *(const f32x4*)(fw + 4 * lane + 256 * j);
            *(f32x4*)(row + 4 * lane + 256 * j) = (f32x4){v[j][0] * r * w[0], v[j][1] * r * w[1], v[j][2] * r * w[2], v[j][3] * r * w[3]}; }
    }
}

#define XB_TMO      128
#define XB_XCNT(j)  (256  + 64 * (j))
#define XB_XSUB(j)  (1280 + 64 * (j))
#define XB_XGEN(j)  (2304 + 64 * (j))
#define XB_TOP      3328
#define XB_TOPGEN   3392
#define XCD_BAR_WORDS 3456
#define XB_SPIN_CAP (1u << 18)

__device__ __forceinline__ unsigned xb_ld(unsigned* p)              { return __hip_atomic_load(p, __ATOMIC_RELAXED, __HIP_MEMORY_SCOPE_AGENT); }
__device__ __forceinline__ unsigned xb_add(unsigned* p, unsigned v) { return __hip_atomic_fetch_add(p, v, __ATOMIC_RELAXED, __HIP_MEMORY_SCOPE_AGENT); }
__device__ __forceinline__ unsigned xb_xcc_id() { return (unsigned)__builtin_amdgcn_s_getreg((3 << 11) | 20) & 0xFu; }
#define XB_SPIN(cond, bar) do { unsigned _sp = 0; while (cond) { __builtin_amdgcn_s_sleep(1); \
    if ((++_sp & 255u) == 0u) { if (xb_ld(&(bar)[XB_TMO])) break; if (_sp > XB_SPIN_CAP) { atomicAdd(&(bar)[XB_TMO], 1u); break; } } } } while (0)

struct XcdBarrier {
    unsigned* bar; unsigned x;
    volatile LAS unsigned* st;
};

__device__ __forceinline__ XcdBarrier xcd_barrier_post(unsigned* bar, volatile LAS unsigned* st) {
    XcdBarrier b; b.bar = bar; b.x = xb_xcc_id(); b.st = st;
    if (threadIdx.x == 0) (void)xb_add(&bar[XB_XCNT(b.x)], 1u);
    return b;
}
__device__ __forceinline__ void xcd_barrier_complete(unsigned* bar, unsigned x, unsigned& nloc, unsigned& nx) {
    const unsigned G = gridDim.x * gridDim.y * gridDim.z;
    unsigned sum, cnt, mine, sp = 0u;
    for (;;) {
        sum = 0u; cnt = 0u; mine = 0u;
#pragma unroll
        for (unsigned j = 0; j < 16; ++j) { const unsigned c = xb_ld(&bar[XB_XCNT(j)]); sum += c; cnt += (c > 0u) ? 1u : 0u; mine = (j == x) ? c : mine; }
        if (sum == G) break;
        __builtin_amdgcn_s_sleep(1);
        if ((++sp & 255u) == 0u) { if (xb_ld(&bar[XB_TMO])) break; if (sp > XB_SPIN_CAP) { atomicAdd(&bar[XB_TMO], 1u); break; } }
    }
    nloc = mine > 0u ? mine : 1u; nx = cnt > 0u ? cnt : 1u;
}

__device__ __forceinline__ void xcd_barrier(const XcdBarrier& b) {
    asm volatile("s_waitcnt vmcnt(0)" ::: "memory");
    __syncthreads();
    if (threadIdx.x == 0) {
        unsigned* bar = b.bar;
        __builtin_amdgcn_s_waitcnt(0);
        unsigned nloc = b.st[0], nx = b.st[1];
        if (nloc == 0u) { xcd_barrier_complete(bar, b.x, nloc, nx); b.st[0] = nloc; b.st[1] = nx; }
        const unsigned old = xb_add(&bar[XB_XSUB(b.x)], 1u);
        const unsigned gen = old / nloc;
        if (old + 1u == (gen + 1u) * nloc) {
            __builtin_amdgcn_fence(__ATOMIC_RELEASE, "agent");
            asm volatile("s_waitcnt vmcnt(0)" ::: "memory");
            const unsigned og = xb_add(&bar[XB_TOP], 1u);
            const unsigned tg = og / nx;
            if (og + 1u == (tg + 1u) * nx) xb_add(&bar[XB_TOPGEN], 1u);
            else XB_SPIN(xb_ld(&bar[XB_TOPGEN]) == tg, bar);
            __builtin_amdgcn_fence(__ATOMIC_ACQUIRE, "agent");
            xb_add(&bar[XB_XGEN(b.x)], 1u);
            asm volatile("s_waitcnt vmcnt(0)" ::: "memory");
        } else {
            XB_SPIN(xb_ld(&bar[XB_XGEN(b.x)]) == gen, bar);
            __builtin_amdgcn_fence(__ATOMIC_ACQUIRE, "agent");
            asm volatile("s_waitcnt vmcnt(0)" ::: "memory");
        }
    }
    __syncthreads();
}

constexpr int N_PHASES = 12;
__global__ void __launch_bounds__(NTHR) fwd_kernel(Args args) {
    extern __shared__ __attribute__((aligned(16))) unsigned char lds_raw[];
    LAS unsigned char* lds = (LAS unsigned char*)lds_raw;
    cg::grid_group grid = cg::this_grid();
    volatile LAS unsigned* bst = (volatile LAS unsigned*)(lds + LDS_BYTES - 16);
    if (threadIdx.x < 4) bst[threadIdx.x] = 0u;
    __syncthreads();
    XcdBarrier xbar = xcd_barrier_post((unsigned*)args.ws, bst);
    const int G = gridDim.x, bx = blockIdx.x;
    const int vcu = (G % 8 == 0) ? (bx % 8) * (G / 8) + bx / 8 : bx;
    const int lo = args.ph_lo, hi = args.ph_hi;
    unsigned char* ws = args.ws;
#ifndef USE_CG_SYNC
#define USE_CG_SYNC 0
#endif
#ifndef DOUBLE_MASK
#define DOUBLE_MASK 0
#endif
#define REP(k) for (int rep_ = 0; rep_ < 1 + ((DOUBLE_MASK >> (k)) & 1); ++rep_)
#ifndef DBL_P2
#define DBL_P2 0
#endif
#ifndef BIS
#define BIS 15
#endif
#ifndef PHASE_MASK
#define PHASE_MASK 0xfff
#endif
#define IN(k) (((PHASE_MASK >> (k)) & 1) && lo <= (k) && (k) < hi)
#define SEAM(k) do { if (IN(k) && IN((k) + 1)) { if (USE_CG_SYNC || lo < 0) grid.sync(); else xcd_barrier(xbar); } } while (0)
    if (IN(0)) REP(0) { p0_prologue(args, lds, vcu, G, 0); __syncthreads(); }
    SEAM(0);
    if (IN(1)) REP(1) {
        pg8::Gemm g{(const bf16*)(ws + WS_XN), (const bf16*)(ws + WS_WIN), nullptr, nullptr, MT, NPROJ_PAD, DM}; pg8::StaticOrder S; S.init(MT, NPROJ_PAD, G, bx);
        EpiProj E{(bf16*)(ws + WS_PROJ), (float*)(ws + WS_GATES)};
        pg8::gemm_phase<EpiProj, pg8::StaticOrder, true, true>(lds, g, S, E);
        { const int rem = S.nwg % G, nidle = rem ? G - rem : G, idx = rem ? bx - rem : bx;
          if (idx >= 0) p0_prologue(args, lds, idx, nidle, 1); }
        __syncthreads();
    }
    SEAM(1);
    if (IN(2)) REP(2) {
        for (int it = bx; it < 1536; it += G) {
            if (it < 512) { for (int r_ = 0; r_ < 1 + (DBL_P2 & 1); ++r_) sample_item<true>(args, lds, it >> 2, it & 3); }
            else if (it < 1024) { for (int r_ = 0; r_ < 1 + ((DBL_P2 >> 1) & 1); ++r_) sample_item<false>(args, lds, (it - 512) >> 2, (it - 512) & 3); }
            else if (it < 1280) { for (int r_ = 0; r_ < 1 + ((DBL_P2 >> 2) & 1); ++r_) chunk_state<true>(args, lds, (it - 1024) >> 4, (it - 1024) & 15); }
            else { for (int r_ = 0; r_ < 1 + ((DBL_P2 >> 3) & 1); ++r_) chunk_state<false>(args, lds, (it - 1280) >> 4, (it - 1280) & 15); }
        }
    }
    SEAM(2);
    if (IN(3)) REP(3) { for (int it = bx; it < 768; it += G) { if (it < 512) scan_mlstm(args, it); else scan_gla(args, it - 512); }
        if (G == 256) {
            pg8::Gemm g{(const bf16*)(ws + WS_YM), (const bf16*)(ws + WS_WA), (const bf16*)(ws + WS_YG), (const bf16*)(ws + WS_WB), MT, DM, 1024}; pg8::TailOnlyOrder<2, 16> S; S.c = bx;
            EpiBranch E{(const bf16*)(ws + WS_PROJ), (bf16*)(ws + WS_XN), args.out + O_YP};
            pg8::gemm_phase<EpiBranch, pg8::TailOnlyOrder<2, 16>, true, true>(lds, g, S, E);
        }
    }
    SEAM(3);
    if (IN(4)) REP(4) { for (int it = bx; it < 512; it += G) { if (it < 256) { if (BIS & 1) chunk_out<true>(args, lds, it >> 4, it & 15); } else { if (BIS & 2) chunk_out<false>(args, lds, (it - 256) >> 4, (it - 256) & 15); } } __syncthreads(); if (G == 256) merge_reduce(args, vcu, G); }
    SEAM(4);
    if (IN(5)) REP(5) {
        pg8::Gemm g{(const bf16*)(ws + WS_YM), (const bf16*)(ws + WS_WA), (const bf16*)(ws + WS_YG), (const bf16*)(ws + WS_WB), MT, DM, 1024}; EpiBranch E{(const bf16*)(ws + WS_PROJ), (bf16*)(ws + WS_XN), nullptr};
        if (G == 256) { pg8::MainOnlyOrder<2> S; S.S.init(MP, DM, G, bx); pg8::gemm_phase<EpiBranch, pg8::MainOnlyOrder<2>, true, true>(lds, g, S, E); }
        else { pg8::TwoSegOrder S; S.S.init(MT, DM, G, bx); pg8::gemm_phase<EpiBranch, pg8::TwoSegOrder, true, true>(lds, g, S, E); }
    }
    SEAM(5);
    if (IN(6)) REP(6) {
        pg8::Gemm g{(const bf16*)(ws + WS_XN), (const bf16*)(ws + WS_WO), nullptr, nullptr, MT, DM, DM}; pg8::SplitRowsOrder<1, 32> S; S.split = (G == 256); S.S.init(S.split ? MP : MT, DM, G, bx);
        EpiOut E{args.in[I_XP], args.in[I_XS], (float*)(ws + WS_X1), (bf16*)(ws + WS_X1W), args.in[I_NFFN], (float*)(ws + WS_PART), (float*)(ws + WS_PROJ)};
        pg8::gemm_phase<EpiOut, pg8::SplitRowsOrder<1, 32>, true, true>(lds, g, S, E);
    }
    SEAM(6);
    if (IN(7)) REP(7) rstd_phase(args, vcu, G);
    SEAM(7);
    if (IN(8)) REP(8) {
        pg8::Gemm g{(const bf16*)(ws + WS_X1W), (const bf16*)(ws + WS_WUG), nullptr, nullptr, MT, 2 * DFF, DM}; pg8::StaticOrder S; S.init(MT, 2 * DFF, G, bx);
        EpiUGAct E{(const float*)(ws + WS_RSTD), (bf16*)(ws + WS_G), args.out, args.in[I_CW], args.in[I_CB], args.in[I_CONV], (float*)(ws + WS_U), (LAS float*)(lds + 131072)};
        pg8::gemm_phase<EpiUGAct, pg8::StaticOrder, true, true>(lds, g, S, E);
    }
    SEAM(8);
    if (IN(9)) REP(9) act_fixup(args, vcu, G);
    SEAM(9);
    if (IN(10)) REP(10) {
        pg8::Gemm g{(const bf16*)(ws + WS_G), (const bf16*)(ws + WS_WD), nullptr, nullptr, MT, DM, DFF}; pg8::DownOrder S; S.S.init(MT, DM, G, bx); S.split = (G == 256);
        EpiDown E{(const float*)(ws + WS_X1), args.out, (float*)(ws + WS_U)};
        pg8::gemm_phase<EpiDown, pg8::DownOrder, true, true>(lds, g, S, E);
    }
    SEAM(10);
    if (IN(11)) REP(11) final_norm(args, vcu, G);
#ifdef EXTRA_SYNCS
    for (int i_ = 0; i_ < EXTRA_SYNCS; ++i_) xcd_barrier(xbar);
#endif
#undef IN
#undef SEAM
}

extern "C" void kernel_launch(void* const* d_in, const int* in_sizes, int n_in, void* d_out, int out_size, void* d_ws, size_t ws_size, hipStream_t stream) {
    static int grid = 0;
    if (grid == 0) {
        if (n_in != 25 || ws_size < WS_END) { fprintf(stderr, "kernel_launch: unexpected n_in %d / ws_size %zu (need %zu)\n", n_in, ws_size, (size_t)WS_END); grid = -1; return; }
        int dev = 0, cus = 0, per_cu = 0;
        (void)hipGetDevice(&dev); (void)hipDeviceGetAttribute(&cus, hipDeviceAttributeMultiprocessorCount, dev);
        if (hipFuncSetAttribute((const void*)fwd_kernel, hipFuncAttributeMaxDynamicSharedMemorySize, LDS_BYTES) != hipSuccess) { fprintf(stderr, "kernel_launch: hipFuncSetAttribute failed\n"); grid = -1; return; }
        if (hipOccupancyMaxActiveBlocksPerMultiprocessor(&per_cu, (const void*)fwd_kernel, NTHR, LDS_BYTES) != hipSuccess || per_cu < 1) { fprintf(stderr, "kernel_launch: occupancy query says %d\n", per_cu); per_cu = 1; }
        (void)hipGetLastError();
        grid = cus * 1;
        if (grid <= 0) grid = 256;
    }
    if (grid < 0) return;
    if (hipMemsetAsync(d_ws, 0, 65536, stream) != hipSuccess) { fprintf(stderr, "kernel_launch: memset failed\n"); return; }
    Args a{};
    for (int i = 0; i < 25; ++i) a.in[i] = (const float*)d_in[i];
    a.out = (float*)d_out; a.ws = (unsigned char*)d_ws;
    if (MK_N_LAUNCHES == 1) {
        a.ph_lo = 0; a.ph_hi = N_PHASES;
        void* kargs[] = {&a};
        hipError_t e = hipLaunchCooperativeKernel((const void*)fwd_kernel, dim3(grid), dim3(NTHR), kargs, LDS_BYTES, stream);
        if (e != hipSuccess) fprintf(stderr, "kernel_launch: cooperative launch failed: %s (grid %d)\n", hipGetErrorString(e), grid);
    } else {
        for (int p = 0; p < N_PHASES; ++p) { a.ph_lo = p; a.ph_hi = p + 1; hipLaunchKernelGGL(fwd_kernel, dim3(grid), dim3(NTHR), LDS_BYTES, stream, a); }
    }
}
```

```cpp
#include <hip/hip_runtime.h>
#include <hip/hip_cooperative_groups.h>
#include <cstdio>
#include <cstdint>
namespace cg = cooperative_groups;

#ifndef MK_N_LAUNCHES
#define MK_N_LAUNCHES 1
#endif

namespace pg8 {
#define PG8_LAS __attribute__((address_space(3)))
typedef unsigned short bf16_t;
typedef short bf16x8 __attribute__((ext_vector_type(8)));
typedef float f32x4 __attribute__((ext_vector_type(4)));
typedef unsigned u32x4 __attribute__((ext_vector_type(4)));
constexpr int BM = 256, BK = 64, HALF = 128, HTB = HALF * BK * 2  , STAGE_BYTES = 8 * HTB, NXCD = 8, WGM = 8;

__host__ __device__ __forceinline__ int lds_byte(int r, int c) { const int st = (r >> 4) * 2 + (c >> 5), rr = r & 15, cc = c & 31, ob = rr * 64 + cc * 2; return st * 1024 + (ob ^ (((ob >> 9) & 1) << 5)); }
__host__ __device__ __forceinline__ void stage_rc(int b, int& R, int& C) { const int st = b / 1024, sb = b % 1024, swz = sb ^ (((sb >> 9) & 1) << 5); R = (st >> 1) * 16 + swz / 64; C = (st & 1) * 32 + (swz % 64) / 2; }
__host__ __device__ __forceinline__ int perm32(int rho) { const int n = rho >> 4, i = rho & 15; return 8 * (i >> 2) + 4 * n + (i & 3); }

struct Unit { int pm, pn, seg, kt0, nkt, tail; };
struct Gemm { const bf16_t* A; const bf16_t* Bt; const bf16_t* A2; const bf16_t* Bt2; int M, N, K; };

struct StaticOrder {
    int nM, nN, nwg, G, c;
    __host__ __device__ void init(int M, int N, int G_, int c_) { nM = M / BM; nN = N / BM; nwg = nM * nN; G = G_; c = c_; }
    __host__ __device__ bool next(int i, Unit& u) const { return at((long)i * G + c, u); }
    __host__ __device__ bool at(long L, Unit& u) const {
        if (L >= nwg) return false;
        int wgid = (int)L; { const int q = nwg / NXCD, r = nwg % NXCD, xcd = wgid % NXCD, off = wgid / NXCD; wgid = (xcd < r ? xcd * (q + 1) : r * (q + 1) + (xcd - r) * q) + off; }
        const int nig = WGM * nN, gid = wgid / nig, fm = gid * WGM, gsz = (nM - fm) < WGM ? (nM - fm) : WGM;
        u.pm = fm + ((wgid % nig) % gsz); u.pn = (wgid % nig) / gsz; u.seg = 0; u.kt0 = 0; u.nkt = -1; u.tail = -1; return true;
    }
};
struct DownOrder {
    StaticOrder S; int mode, slot;
    __host__ __device__ __forceinline__ bool next(int i, Unit& u) const {
        if (mode == 0) return S.next(i, u);
        if (i != 0) return false;
        if (mode == 1) return S.at(S.c, u);
        const int tt = slot >> 2, sl = slot & 3;
        u.pm = 32 + (tt >> 3); u.pn = tt & 7; u.seg = 0; u.kt0 = 22 * sl; u.nkt = 22; u.tail = slot; return true;
    }
};
struct RowOffOrder {
    StaticOrder S; int pm0;
    __host__ __device__ __forceinline__ bool next(int i, Unit& u) const { if (!S.next(i, u)) return false; u.pm += pm0; return true; }
};
template <int NSEG, int KT>
struct SplitRowsOrder {
    StaticOrder S; bool split;
    __host__ __device__ bool next(int i, Unit& u) const {
        if (!split) { if (!S.next(i / NSEG, u)) return false; u.seg = i % NSEG; return true; }
        if (i < NSEG) { if (!S.at(S.c, u)) return false; u.seg = i; return true; }
        if (i >= 2 * NSEG) return false;
        const int tt = S.c >> 3, sl = S.c & 7;
        u.pm = 32 + (tt >> 3); u.pn = tt & 7; u.seg = i - NSEG; u.kt0 = (KT / 8) * sl; u.nkt = KT / 8; u.tail = tt * 8 + sl; return true;
    }
};
template <int NSEG, int KT>
struct TailOnlyOrder {
    int c;
    __host__ __device__ bool next(int i, Unit& u) const {
        if (i >= NSEG) return false;
        const int tt = c >> 3, sl = c & 7;
        u.pm = 32 + (tt >> 3); u.pn = tt & 7; u.seg = i; u.kt0 = (KT / 8) * sl; u.nkt = KT / 8; u.tail = tt * 8 + sl; return true;
    }
};
template <int NSEG>
struct MainOnlyOrder {
    StaticOrder S;
    __host__ __device__ bool next(int i, Unit& u) const { if (i >= NSEG) return false; if (!S.at(S.c, u)) return false; u.seg = i; return true; }
};
struct TwoSegOrder {
    StaticOrder S;
    __host__ __device__ bool next(int i, Unit& u) const { if (!S.next(i >> 1, u)) return false; u.seg = i & 1; return true; }
};

__device__ __forceinline__ unsigned cvt_pk_bf16(float lo, float hi) { unsigned r; asm volatile("v_cvt_pk_bf16_f32 %0, %1, %2" : "=v"(r) : "v"(lo), "v"(hi)); return r; }

template <class Epi, class Sched, bool ALIGN_EPI = false, bool SP2 = false>
__device__ __forceinline__ void gemm_phase(PG8_LAS unsigned char* lds, const Gemm g, const Sched& S, const Epi& E) {
    int tid_ = threadIdx.x; asm volatile("" : "+v"(tid_));
    const int tid = tid_, wid = __builtin_amdgcn_readfirstlane(tid >> 6), lane = tid & 63, wr = wid >> 2, wc = wid & 3, fr = lane & 15, fq = lane >> 4;
    const int K = g.K, ntf = K / BK;
    unsigned voffA[2], voffB[2];
#pragma unroll
    for (int i = 0; i < 2; ++i) { int R, C; stage_rc(tid * 16 + i * 8192, R, C); const int Rb = Epi::PERM ? ((R & ~31) + perm32(R & 31)) : R;
        voffA[i] = (unsigned)(R * K + C) * 2u; voffB[i] = (unsigned)(Rb * K + C) * 2u; }
    const size_t kstep = (size_t)(BK * 2);
    const size_t hstep = (size_t)HALF * K * 2;
    const size_t tstep = 2 * hstep;
    const unsigned ldsw = (unsigned)wid * 1024u;
    const int aoff = lds_byte(wr * 64 + fr, fq * 8), boff = lds_byte(wc * 32 + fr, fq * 8);
#define PG8_SA(b, h) (((b) * 2 + (h)) * HTB)
#define PG8_SB(b, h) ((4 + (b) * 2 + (h)) * HTB)
#define PG8_STAGE(bufoff, gbase, voff) do { _Pragma("unroll") for (int _i = 0; _i < 2; ++_i) \
        __builtin_amdgcn_global_load_lds((const unsigned*)((const char*)(gbase) + (voff)[_i]), (PG8_LAS unsigned*)(lds + (bufoff) + ldsw + _i * 8192), 16, 0, 0); } while (0)
#define PG8_LDA(dst, b, h) do { _Pragma("unroll") for (int m = 0; m < 4; ++m) _Pragma("unroll") for (int k = 0; k < 2; ++k) dst[m][k] = *(const PG8_LAS bf16x8*)(lds + PG8_SA(b, h) + aoff + m * 2048 + k * 1024); } while (0)
#define PG8_LDB(dst, b, h) do { _Pragma("unroll") for (int n = 0; n < 2; ++n) _Pragma("unroll") for (int k = 0; k < 2; ++k) dst[n][k] = *(const PG8_LAS bf16x8*)(lds + PG8_SB(b, h) + boff + n * 2048 + k * 1024); } while (0)
#define PG8_MMA(ai, bj, At, Bt) do { __builtin_amdgcn_s_setprio(1); _Pragma("unroll") for (int m = 0; m < 4; ++m) _Pragma("unroll") for (int n = 0; n < 2; ++n) _Pragma("unroll") for (int k = 0; k < 2; ++k) \
        acc[ai][bj][m][n] = __builtin_amdgcn_mfma_f32_16x16x32_bf16(Bt[n][k], At[m][k], acc[ai][bj][m][n], 0, 0, 0); __builtin_amdgcn_s_setprio(0); } while (0)
#define PG8_WAIT_V(n) asm volatile("s_waitcnt vmcnt(" #n ")" ::: "memory")
#define PG8_WAIT_L(n) asm volatile("s_waitcnt lgkmcnt(" #n ")" ::: "memory")
#define PG8_BAR __builtin_amdgcn_s_barrier()
#define PG8_SCHED __builtin_amdgcn_sched_barrier(0)
    Unit cur, nxt; int ui = 0;
    if (!S.next(0, cur)) return;
    f32x4 acc[2][2][4][2];
#pragma unroll
    for (int a = 0; a < 2; ++a)
#pragma unroll
        for (int b = 0; b < 2; ++b)
#pragma unroll
            for (int m = 0; m < 4; ++m)
#pragma unroll
                for (int n = 0; n < 2; ++n) acc[a][b][m][n] = (f32x4){0.f, 0.f, 0.f, 0.f};
    bf16x8 At[4][2], B0[2][2], B1[2][2];
    const char* cA = (const char*)(cur.seg ? g.A2 : g.A) + (size_t)cur.pm * tstep + (size_t)cur.kt0 * kstep; const char* cB = (const char*)(cur.seg ? g.Bt2 : g.Bt) + (size_t)cur.pn * tstep + (size_t)cur.kt0 * kstep;
    if constexpr (SP2) {
        PG8_STAGE(PG8_SB(0, 0), cB, voffB); PG8_STAGE(PG8_SB(0, 1), cB + hstep, voffB); PG8_STAGE(PG8_SA(0, 0), cA, voffA); PG8_STAGE(PG8_SA(0, 1), cA + hstep, voffA);
        if (wr == 1) PG8_BAR;
        PG8_WAIT_V(2); PG8_BAR;
        PG8_STAGE(PG8_SB(1, 0), cB + kstep, voffB); PG8_STAGE(PG8_SA(1, 0), cA + kstep, voffA); PG8_STAGE(PG8_SB(1, 1), cB + hstep + kstep, voffB);
        PG8_WAIT_V(6); PG8_BAR;
    } else {
        PG8_STAGE(PG8_SB(0, 0), cB, voffB); PG8_STAGE(PG8_SA(0, 0), cA, voffA); PG8_STAGE(PG8_SB(0, 1), cB + hstep, voffB); PG8_STAGE(PG8_SA(0, 1), cA + hstep, voffA);
        if (wr == 1) PG8_BAR;
        PG8_WAIT_V(4); PG8_BAR;
        PG8_STAGE(PG8_SB(1, 0), cB + kstep, voffB); PG8_STAGE(PG8_SA(1, 0), cA + kstep, voffA); PG8_STAGE(PG8_SB(1, 1), cB + hstep + kstep, voffB);
        PG8_WAIT_V(6); PG8_BAR;
    }
    for (;;) {
        const bool has_next = S.next(ui + 1, nxt);
        const char* nA = has_next ? (const char*)(nxt.seg ? g.A2 : g.A) + (size_t)nxt.pm * tstep + (size_t)nxt.kt0 * kstep : cA; const char* nB = has_next ? (const char*)(nxt.seg ? g.Bt2 : g.Bt) + (size_t)nxt.pn * tstep + (size_t)nxt.kt0 * kstep : cB;
        const int nt = cur.nkt > 0 ? cur.nkt : ntf;
        for (int t = 0; t < nt; t += 2) {
            const bool last = (t == nt - 2);
            const char* a1 = cA + (size_t)(t + 1) * kstep;
            const char* a2 = last ? nA : cA + (size_t)(t + 2) * kstep; const char* b2 = last ? nB : cB + (size_t)(t + 2) * kstep;
            const char* a3 = a2 + kstep; const char* b3 = b2 + kstep;
            if constexpr (SP2) {
            PG8_LDB(B0, 0, 0); PG8_LDB(B1, 0, 1); PG8_SCHED; PG8_LDA(At, 0, 0); PG8_STAGE(PG8_SA(1, 1), a1 + hstep, voffA);
            PG8_WAIT_V(8); PG8_WAIT_L(0); PG8_BAR; PG8_MMA(0, 0, At, B0); PG8_MMA(0, 1, At, B1); PG8_BAR; PG8_SCHED;
            PG8_LDA(At, 0, 1); PG8_STAGE(PG8_SB(0, 0), b2, voffB); PG8_STAGE(PG8_SB(0, 1), b2 + hstep, voffB); PG8_STAGE(PG8_SA(0, 0), a2, voffA);
            PG8_WAIT_V(8); PG8_WAIT_L(0); PG8_BAR; PG8_MMA(1, 0, At, B0); PG8_MMA(1, 1, At, B1); PG8_BAR; PG8_SCHED;
            PG8_LDB(B0, 1, 0); PG8_LDB(B1, 1, 1); PG8_SCHED; PG8_LDA(At, 1, 0); PG8_STAGE(PG8_SA(0, 1), a2 + hstep, voffA);
            PG8_WAIT_V(8); PG8_WAIT_L(0); PG8_BAR; PG8_MMA(0, 0, At, B0); PG8_MMA(0, 1, At, B1); PG8_BAR; PG8_SCHED;
            PG8_LDA(At, 1, 1); PG8_STAGE(PG8_SB(1, 0), b3, voffB); PG8_STAGE(PG8_SB(1, 1), b3 + hstep, voffB); PG8_STAGE(PG8_SA(1, 0), a3, voffA);
            PG8_WAIT_V(8); PG8_WAIT_L(0); PG8_BAR; PG8_MMA(1, 0, At, B0); PG8_MMA(1, 1, At, B1); PG8_BAR; PG8_SCHED;
            } else {
            PG8_LDB(B0, 0, 0); PG8_SCHED; PG8_LDA(At, 0, 0); PG8_STAGE(PG8_SA(1, 1), a1 + hstep, voffA);
            PG8_WAIT_L(8); PG8_BAR; PG8_WAIT_L(0); PG8_MMA(0, 0, At, B0); PG8_BAR; PG8_SCHED;
            PG8_LDB(B1, 0, 1); PG8_STAGE(PG8_SB(0, 0), b2, voffB);
            PG8_BAR; PG8_WAIT_L(0); PG8_MMA(0, 1, At, B1); PG8_BAR;
            PG8_LDA(At, 0, 1); PG8_STAGE(PG8_SA(0, 0), a2, voffA);
            PG8_BAR; PG8_WAIT_L(0); PG8_MMA(1, 0, At, B0); PG8_BAR; PG8_SCHED;
            PG8_STAGE(PG8_SB(0, 1), b2 + hstep, voffB);
            PG8_WAIT_V(6); PG8_BAR; PG8_MMA(1, 1, At, B1); PG8_BAR;
            PG8_LDB(B0, 1, 0); PG8_SCHED; PG8_LDA(At, 1, 0); PG8_STAGE(PG8_SA(0, 1), a2 + hstep, voffA);
            PG8_WAIT_L(8); PG8_BAR; PG8_WAIT_L(0); PG8_MMA(0, 0, At, B0); PG8_BAR; PG8_SCHED;
            PG8_LDB(B1, 1, 1); PG8_STAGE(PG8_SB(1, 0), b3, voffB);
            PG8_BAR; PG8_WAIT_L(0); PG8_MMA(0, 1, At, B1); PG8_BAR;
            PG8_LDA(At, 1, 1); PG8_STAGE(PG8_SA(1, 0), a3, voffA);
            PG8_BAR; PG8_WAIT_L(0); PG8_MMA(1, 0, At, B0); PG8_BAR; PG8_SCHED;
            PG8_STAGE(PG8_SB(1, 1), b3 + hstep, voffB);
            PG8_WAIT_V(6); PG8_BAR; PG8_MMA(1, 1, At, B1); PG8_BAR;
            }
        }
        if constexpr (ALIGN_EPI) { if (wr == 0) PG8_BAR; }
        E(acc, cur, wr, wc, fr, fq);
        if (!has_next) break;
        if (nxt.seg == 0)
#pragma unroll
        for (int a = 0; a < 2; ++a)
#pragma unroll
            for (int b = 0; b < 2; ++b)
#pragma unroll
                for (int m = 0; m < 4; ++m)
#pragma unroll
                    for (int n = 0; n < 2; ++n) acc[a][b][m][n] = (f32x4){0.f, 0.f, 0.f, 0.f};
        cur = nxt; cA = nA; cB = nB; ++ui;
        if constexpr (ALIGN_EPI) { if (wr == 1) PG8_BAR; }
    }
    PG8_WAIT_V(0);
    if constexpr (!ALIGN_EPI) { if (wr == 0) PG8_BAR; }
    PG8_BAR;
#undef PG8_SA
#undef PG8_SB
#undef PG8_STAGE
#undef PG8_LDA
#undef PG8_LDB
#undef PG8_MMA
#undef PG8_WAIT_V
#undef PG8_WAIT_L
#undef PG8_BAR
#undef PG8_SCHED
}
}

#define LAS __attribute__((address_space(3)))
typedef unsigned short bf16;
typedef short bf16x8 __attribute__((ext_vector_type(8)));
typedef float f32x4 __attribute__((ext_vector_type(4)));
typedef unsigned u32x4 __attribute__((ext_vector_type(4)));
typedef unsigned u32x2 __attribute__((ext_vector_type(2)));
using pg8::cvt_pk_bf16;

constexpr int NWAVES = 8, NTHR = 512;
constexpr int DM = 2048, MP = 8192, MS = 1024, MT = 9216, TP = 2048, TS = 8;
constexpr int NIN = 11288, NPROJ = 11264, NPROJ_PAD = 11520, DFF = 5632;
constexpr int C_MQ = 0, C_MK = 1024, C_MV = 2048, C_MO = 3072, C_GQ = 4096, C_GK = 4608, C_GV = 5120, C_GR = 6144, C_GA = 7168, C_GB = 9216;
constexpr float EPS = 1e-6f;
constexpr int NCH = 16;
constexpr int LDS_BYTES = 147456;

constexpr size_t O_YP = 0, O_YS = 16777216, O_PC = 18874368, O_PN = 19922944, O_PM = 19927040, O_PS = 19927056, O_PCONV = 20451344,
                 O_SC = 20496400, O_SN = 54050832, O_SM = 54181904, O_SS = 54182416, O_SCONV = 70959632;

constexpr size_t MiB = 1u << 20;
constexpr size_t WS_GATES = 64 * 1024;
constexpr size_t WS_PART = WS_GATES + (size_t)MT * 32 * 4;
constexpr size_t WS_DN = WS_PART + (size_t)MT * 32 * 4;
constexpr size_t WS_NPREV = WS_DN + 256 * 256 * 4;
constexpr size_t WS_CHS = WS_NPREV + 256 * 256 * 2;
constexpr size_t WS_BEND = WS_CHS + 256 * 2 * 4;
constexpr size_t WS_RSTD = WS_BEND + 256 * 128 * 4;
static_assert(WS_RSTD + MT * 4 <= 4 * MiB, "small region");
constexpr size_t WS_WIN = 4 * MiB;
constexpr size_t WS_WA = WS_WIN + (size_t)NPROJ_PAD * DM * 2;
constexpr size_t WS_WB = WS_WA + (size_t)2048 * 1024 * 2;
constexpr size_t WS_WO = WS_WB + (size_t)2048 * 1024 * 2;
constexpr size_t WS_WUG = WS_WO + (size_t)2048 * 2048 * 2;
constexpr size_t WS_WD = WS_WUG + (size_t)2 * DFF * DM * 2;
constexpr size_t WS_R1 = WS_WD + (size_t)DM * DFF * 2;
static_assert(WS_R1 == 131 * MiB, "map");
constexpr size_t WS_XN = WS_R1;
constexpr size_t WS_X1W = WS_R1 + 36 * MiB;
constexpr size_t WS_X1 = WS_R1 + 72 * MiB;
constexpr size_t WS_DC = WS_R1;
constexpr size_t WS_DS = WS_R1 + 64 * MiB;
constexpr size_t WS_CT = WS_R1 + 96 * MiB;
constexpr size_t WS_ST = WS_R1 + 128 * MiB;
constexpr size_t WS_YM = WS_R1 + 144 * MiB;
constexpr size_t WS_YG = WS_YM + 18 * MiB;
constexpr size_t WS_PROJ = WS_YG + 18 * MiB;
constexpr size_t WS_U = WS_PROJ, WS_G = WS_PROJ + 99 * MiB;
constexpr size_t WS_END = WS_PROJ + 198 * MiB;
static_assert(WS_END == 509 * MiB, "map");

struct Args {
    const float* in[25]; float* out; unsigned char* ws; int ph_lo, ph_hi;
};
enum { I_XP = 0, I_XS, I_C, I_N, I_M, I_S, I_CONV, I_WIN, I_BI, I_BF, I_AUP, I_AB, I_MHW, I_GHW, I_WA, I_WB, I_WO, I_NMIX, I_NFFN, I_WUP, I_WGATE, I_CW, I_CB, I_WDOWN, I_FNW };

__device__ __forceinline__ float bf2f(unsigned short b) { return __builtin_bit_cast(float, (unsigned)b << 16); }
__device__ __forceinline__ float bflo(unsigned w) { return __builtin_bit_cast(float, w << 16); }
__device__ __forceinline__ float bfhi(unsigned w) { return __builtin_bit_cast(float, w & 0xffff0000u); }
__device__ __forceinline__ unsigned short f2bf(float f) { return (unsigned short)(cvt_pk_bf16(f, 0.f) & 0xffffu); }
__device__ __forceinline__ float logsig(float z) { return fminf(z, 0.f) - __logf(1.f + __expf(-fabsf(z))); }
__device__ __forceinline__ float sigm(float z) { return 1.f / (1.f + __expf(-z)); }
__device__ __forceinline__ float wave_sum(float v) {
#pragma unroll
    for (int o = 1; o < 64; o <<= 1) v += __shfl_xor(v, o);
    return v;
}
__device__ __forceinline__ float wave_max(float v) {
#pragma unroll
    for (int o = 1; o < 64; o <<= 1) v = fmaxf(v, __shfl_xor(v, o));
    return v;
}
__device__ __forceinline__ float sum4(f32x4 v) { return (v.x + v.y) + (v.z + v.w); }
__device__ __forceinline__ float dot4(f32x4 a, f32x4 b) { return (a.x * b.x + a.y * b.y) + (a.z * b.z + a.w * b.w); }
__device__ __forceinline__ float gelu_tanh(float v) { const float u = 0.7978845608028654f * (v + 0.044715f * v * v * v); return v * sigm(2.f * u); }

typedef f32x4 AccT[2][2][4][2];
struct EpiProj {
    static constexpr bool PERM = true;
    bf16* P; float* gates;
    __device__ __forceinline__ void operator()(AccT& acc, const pg8::Unit& u, int wr, int wc, int fr, int fq) const {
        const int row0 = u.pm * 256 + wr * 64 + fr;
        if (u.pn < 28) {
            const int col0 = u.pn * 256 + wc * 32 + 8 * fq;
#pragma unroll
            for (int ai = 0; ai < 2; ++ai)
#pragma unroll
                for (int m = 0; m < 4; ++m) { bf16* rowp = P + (size_t)(row0 + ai * 128 + m * 16) * NPROJ + col0;
#pragma unroll
                    for (int bj = 0; bj < 2; ++bj) { const f32x4 v0 = acc[ai][bj][m][0], v1 = acc[ai][bj][m][1]; u32x4 w;
                        w.x = cvt_pk_bf16(v0[0], v0[1]); w.y = cvt_pk_bf16(v0[2], v0[3]); w.z = cvt_pk_bf16(v1[0], v1[1]); w.w = cvt_pk_bf16(v1[2], v1[3]);
                        *(u32x4*)(rowp + bj * 128) = w; } }
        } else if (u.pn >= 28 && u.pn < 44) {
            const int n0 = (u.pn - 28) * 128 + wc * 32 + 8 * fq;
#pragma unroll
            for (int ai = 0; ai < 2; ++ai)
#pragma unroll
                for (int m = 0; m < 4; ++m) { bf16* rowp = P + (size_t)(row0 + ai * 128 + m * 16) * NPROJ;
                    float R[8], sb[8];
#pragma unroll
                    for (int i = 0; i < 8; ++i) { const float ga = acc[ai][0][m][i >> 2][i & 3], gb = acc[ai][1][m][i >> 2][i & 3];
                        const float ea = __expf(fminf(-ga, 40.f)), eb = __expf(fminf(-gb, 40.f)); sb[i] = __builtin_amdgcn_rcpf(1.f + eb); R[i] = (1.f + eb) * __builtin_amdgcn_rcpf(1.f + ea); }
                    u32x4 w; w.x = cvt_pk_bf16(R[0], R[1]); w.y = cvt_pk_bf16(R[2], R[3]); w.z = cvt_pk_bf16(R[4], R[5]); w.w = cvt_pk_bf16(R[6], R[7]);
                    *(u32x4*)(rowp + C_GA + n0) = w;
                    w.x = cvt_pk_bf16(sb[0], sb[1]); w.y = cvt_pk_bf16(sb[2], sb[3]); w.z = cvt_pk_bf16(sb[4], sb[5]); w.w = cvt_pk_bf16(sb[6], sb[7]);
                    *(u32x4*)(rowp + C_GB + n0) = w; }
        } else if (wc == 0) {
#pragma unroll
            for (int ai = 0; ai < 2; ++ai)
#pragma unroll
                for (int m = 0; m < 4; ++m) { float* rowp = gates + (size_t)(row0 + ai * 128 + m * 16) * 32 + 8 * fq;
                    *(f32x4*)rowp = acc[ai][0][m][0]; *(f32x4*)(rowp + 4) = acc[ai][0][m][1]; }
        }
    }
};
struct EpiBranch {
    static constexpr bool PERM = true;
    const bf16* P; bf16* O; float* tailp;
    __device__ __forceinline__ void operator()(AccT& acc, const pg8::Unit& u, int wr, int wc, int fr, int fq) const {
        const int row0 = u.pm * 256 + wr * 64 + fr, col0 = u.pn * 256 + wc * 32 + 8 * fq;
#pragma unroll
        for (int ai = 0; ai < 2; ++ai)
#pragma unroll
            for (int m = 0; m < 4; ++m) { const int row = row0 + ai * 128 + m * 16;
#pragma unroll
                for (int bj = 0; bj < 2; ++bj) { const int col = col0 + bj * 128;
                    const u32x4 gw = *(const u32x4*)(P + (size_t)row * NPROJ + (u.seg == 0 ? C_GA : C_GB) + col);
                    float fg[8] = {bflo(gw.x), bfhi(gw.x), bflo(gw.y), bfhi(gw.y), bflo(gw.z), bfhi(gw.z), bflo(gw.w), bfhi(gw.w)};
                    if (u.seg == 0) {
#pragma unroll
                        for (int i = 0; i < 8; ++i) acc[ai][bj][m][i >> 2][i & 3] *= fg[i];
                    } else {
                        float o[8];
#pragma unroll
                        for (int i = 0; i < 8; ++i) o[i] = acc[ai][bj][m][i >> 2][i & 3] * fg[i];
                        if (u.tail < 0) { u32x4 w; w.x = cvt_pk_bf16(o[0], o[1]); w.y = cvt_pk_bf16(o[2], o[3]); w.z = cvt_pk_bf16(o[4], o[5]); w.w = cvt_pk_bf16(o[6], o[7]);
                            *(u32x4*)(O + (size_t)row * DM + col) = w; }
                        else { float* p = tailp + (size_t)u.tail * 65536 + (row & 255) * 256 + (col & 255); *(f32x4*)p = (f32x4){o[0], o[1], o[2], o[3]}; *(f32x4*)(p + 4) = (f32x4){o[4], o[5], o[6], o[7]}; }
                    } } }
    }
};
struct EpiOut {
    static constexpr bool PERM = true;
    const float* xp; const float* xs; float* X1; bf16* X1W; const float* nw; float* part; float* tailp;
    __device__ __forceinline__ void operator()(AccT& acc, const pg8::Unit& u, int wr, int wc, int fr, int fq) const {
        const int row0 = u.pm * 256 + wr * 64 + fr, col0 = u.pn * 256 + wc * 32 + 8 * fq;
        if (u.tail >= 0) {
            float* tp = tailp + (size_t)u.tail * 65536 + (wr * 64 + fr) * 256 + wc * 32 + 8 * fq;
#pragma unroll
            for (int ai = 0; ai < 2; ++ai)
#pragma unroll
                for (int m = 0; m < 4; ++m)
#pragma unroll
                    for (int bj = 0; bj < 2; ++bj) { float* p = tp + (ai * 128 + m * 16) * 256 + bj * 128; *(f32x4*)p = acc[ai][bj][m][0]; *(f32x4*)(p + 4) = acc[ai][bj][m][1]; }
            return;
        }
#pragma unroll
        for (int ai = 0; ai < 2; ++ai)
#pragma unroll
            for (int m = 0; m < 4; ++m) { const int row = row0 + ai * 128 + m * 16;
                const float* xrow = row < MP ? xp + (size_t)row * DM : xs + (size_t)(row - MP) * DM;
                float ss = 0.f;
#pragma unroll
                for (int bj = 0; bj < 2; ++bj) { const int col = col0 + bj * 128;
                    const f32x4 v0 = acc[ai][bj][m][0] + *(const f32x4*)(xrow + col), v1 = acc[ai][bj][m][1] + *(const f32x4*)(xrow + col + 4);
                    *(f32x4*)(X1 + (size_t)row * DM + col) = v0; *(f32x4*)(X1 + (size_t)row * DM + col + 4) = v1;
                    ss += dot4(v0, v0) + dot4(v1, v1);
                    const f32x4 w0 = *(const f32x4*)(nw + col), w1 = *(const f32x4*)(nw + col + 4);
                    u32x4 w; w.x = cvt_pk_bf16(v0[0] * w0[0], v0[1] * w0[1]); w.y = cvt_pk_bf16(v0[2] * w0[2], v0[3] * w0[3]);
                    w.z = cvt_pk_bf16(v1[0] * w1[0], v1[1] * w1[1]); w.w = cvt_pk_bf16(v1[2] * w1[2], v1[3] * w1[3]);
                    *(u32x4*)(X1W + (size_t)row * DM + col) = w; }
                ss += __shfl_xor(ss, 16); ss += __shfl_xor(ss, 32);
                if (fq == 0) part[(size_t)row * 32 + u.pn * 4 + wc] = ss; }
    }
};
#define DPP_MOV(ctrl, oldv, srcv) __builtin_bit_cast(float, __builtin_amdgcn_update_dpp(__builtin_bit_cast(int, (float)(oldv)), __builtin_bit_cast(int, (float)(srcv)), (ctrl), 0xf, 0xf, false))
struct EpiUGAct {
    static constexpr bool PERM = true;
    const float* rstd; bf16* ACT; float* out; const float* cw; const float* cb; const float* cst; float* ub; LAS float* xch;
    __device__ __forceinline__ void operator()(AccT& acc, const pg8::Unit& u, int wr, int wc, int fr, int fq) const {
        const int row0 = u.pm * 256 + wr * 64 + fr, col = u.pn * 128 + wc * 32 + 8 * fq;
        const bool sample = u.pm >= 32;
#pragma unroll
        for (int ai = 0; ai < 2; ++ai)
#pragma unroll
            for (int m = 0; m < 4; ++m) { const int row = row0 + ai * 128 + m * 16;
                const float r = rstd[row];
                acc[ai][0][m][0] = acc[ai][0][m][0] * r; acc[ai][0][m][1] = acc[ai][0][m][1] * r; acc[ai][1][m][0] = acc[ai][1][m][0] * r; acc[ai][1][m][1] = acc[ai][1][m][1] * r;
                float* cs = nullptr;
                if (row < MP) { const int t = row & (TP - 1); if (t >= TP - 2) cs = out + O_PCONV + ((size_t)(row >> 11) * 2 + (t - (TP - 2))) * DFF + col; }
                else { const int rr = row - MP, t = rr & 7; if (t >= 6) cs = out + O_SCONV + ((size_t)(rr >> 3) * 2 + (t - 6)) * DFF + col; }
                if (cs) { *(f32x4*)cs = acc[ai][0][m][0]; *(f32x4*)(cs + 4) = acc[ai][0][m][1]; } }
        if (fr >= 14) {
#pragma unroll
            for (int ai = 0; ai < 2; ++ai) { LAS float* p = xch + ((((ai * 2 + wr) * 4 + wc) * 2 + (fr - 14)) * 4 + fq) * 8; *(LAS f32x4*)p = acc[ai][0][3][0]; *(LAS f32x4*)(p + 4) = acc[ai][0][3][1]; }
            if (!sample && wr == 1) { float* p = ub + ((size_t)u.pm * 6 + (fr - 14)) * DFF + col; *(f32x4*)p = acc[1][0][3][0]; *(f32x4*)(p + 4) = acc[1][0][3][1]; }
        }
        if (!sample && wr == 0 && fr < 2) { float* p = ub + ((size_t)u.pm * 6 + 2 + fr) * DFF + col; *(f32x4*)p = acc[0][0][0][0]; *(f32x4*)(p + 4) = acc[0][0][0][1];
            p += 2 * DFF; *(f32x4*)p = acc[0][1][0][0]; *(f32x4*)(p + 4) = acc[0][1][0][1]; }
        asm volatile("s_waitcnt lgkmcnt(0)" ::: "memory"); __builtin_amdgcn_s_barrier();
        const f32x4 k0a = *(const f32x4*)(cw + col), k0b = *(const f32x4*)(cw + col + 4), k1a = *(const f32x4*)(cw + DFF + col), k1b = *(const f32x4*)(cw + DFF + col + 4);
        const f32x4 k2a = *(const f32x4*)(cw + 2 * DFF + col), k2b = *(const f32x4*)(cw + 2 * DFF + col + 4), cba = *(const f32x4*)(cb + col), cbb = *(const f32x4*)(cb + col + 4);
#pragma unroll
        for (int ai = 0; ai < 2; ++ai) {
            f32x4 pe0 = {0.f, 0.f, 0.f, 0.f}, pe1 = {0.f, 0.f, 0.f, 0.f};
            if (!(ai == 0 && wr == 0) && fr >= 14) { const int sai = (wr == 1) ? ai : ai - 1, swr = wr ^ 1;
                const LAS float* p = xch + ((((sai * 2 + swr) * 4 + wc) * 2 + (fr - 14)) * 4 + fq) * 8; pe0 = *(const LAS f32x4*)p; pe1 = *(const LAS f32x4*)(p + 4); }
#pragma unroll
            for (int m = 0; m < 4; ++m) { const int row = row0 + ai * 128 + m * 16;
                const f32x4 c0 = acc[ai][0][m][0], c1 = acc[ai][0][m][1], v0 = m ? acc[ai][0][m ? m - 1 : 0][0] : pe0, v1 = m ? acc[ai][0][m ? m - 1 : 0][1] : pe1;
                float cur[8] = {c0[0], c0[1], c0[2], c0[3], c1[0], c1[1], c1[2], c1[3]}, prv[8] = {v0[0], v0[1], v0[2], v0[3], v1[0], v1[1], v1[2], v1[3]};
                float p1[8], p2[8];
#pragma unroll
                for (int i = 0; i < 8; ++i) { const float y1 = DPP_MOV(0x121, 0.f, prv[i]); p1[i] = DPP_MOV(0x111, y1, cur[i]); const float y2 = DPP_MOV(0x122, 0.f, prv[i]); p2[i] = DPP_MOV(0x112, y2, cur[i]); }
                if (sample) { const int t = fr & 7;
                    if (t < 2) { const float* st = cst + (size_t)((row - MP) >> 3) * 2 * DFF + col;
                        const f32x4 s1a = *(const f32x4*)(st + DFF), s1b = *(const f32x4*)(st + DFF + 4);
                        if (t == 0) { const f32x4 s0a = *(const f32x4*)st, s0b = *(const f32x4*)(st + 4);
#pragma unroll
                            for (int i = 0; i < 4; ++i) { p1[i] = s1a[i]; p1[4 + i] = s1b[i]; p2[i] = s0a[i]; p2[4 + i] = s0b[i]; } }
                        else {
#pragma unroll
                            for (int i = 0; i < 4; ++i) { p2[i] = s1a[i]; p2[4 + i] = s1b[i]; } } } }
                const f32x4 g0 = acc[ai][1][m][0], g1 = acc[ai][1][m][1];
                float o[8];
#pragma unroll
                for (int i = 0; i < 4; ++i) { o[i] = gelu_tanh(cba[i] + k0a[i] * p2[i] + k1a[i] * p1[i] + k2a[i] * cur[i]) * g0[i];
                    o[4 + i] = gelu_tanh(cbb[i] + k0b[i] * p2[4 + i] + k1b[i] * p1[4 + i] + k2b[i] * cur[4 + i]) * g1[i]; }
                u32x4 w; w.x = cvt_pk_bf16(o[0], o[1]); w.y = cvt_pk_bf16(o[2], o[3]); w.z = cvt_pk_bf16(o[4], o[5]); w.w = cvt_pk_bf16(o[6], o[7]);
                *(u32x4*)(ACT + (size_t)row * DFF + col) = w; }
        }
    }
};
struct EpiDown {
    static constexpr bool PERM = true;
    const float* X1; float* out; float* tailp;
    __device__ __forceinline__ void operator()(AccT& acc, const pg8::Unit& u, int wr, int wc, int fr, int fq) const {
        if (u.tail < 0) {
            const int row0 = u.pm * 256 + wr * 64 + fr, col0 = u.pn * 256 + wc * 32 + 8 * fq;
#pragma unroll
            for (int ai = 0; ai < 2; ++ai)
#pragma unroll
                for (int m = 0; m < 4; ++m) { const int row = row0 + ai * 128 + m * 16;
#pragma unroll
                    for (int bj = 0; bj < 2; ++bj) { const int col = col0 + bj * 128;
                        const f32x4 v0 = acc[ai][bj][m][0] + *(const f32x4*)(X1 + (size_t)row * DM + col), v1 = acc[ai][bj][m][1] + *(const f32x4*)(X1 + (size_t)row * DM + col + 4);
                        *(f32x4*)(out + (size_t)row * DM + col) = v0; *(f32x4*)(out + (size_t)row * DM + col + 4) = v1; } }
        } else {
            float* tp = tailp + (size_t)u.tail * 65536 + (wr * 64 + fr) * 256 + wc * 32 + 8 * fq;
#pragma unroll
            for (int ai = 0; ai < 2; ++ai)
#pragma unroll
                for (int m = 0; m < 4; ++m)
#pragma unroll
                    for (int bj = 0; bj < 2; ++bj) { float* p = tp + (ai * 128 + m * 16) * 256 + bj * 128; *(f32x4*)p = acc[ai][bj][m][0]; *(f32x4*)(p + 4) = acc[ai][bj][m][1]; }
        }
    }
};

template <class ColPtr>
__device__ __forceinline__ void transpose_item(const ColPtr& cp, int K, int srcN, bf16* WT, LAS float* scr, int kb, int nb, int lane) {
    const int k0 = 64 * kb, n0 = 64 * nb, kr = lane >> 4, n4 = (lane & 15) * 4;
    const float* src = cp(n0 + n4);
    f32x4 v[16];
#pragma unroll
    for (int i = 0; i < 16; ++i) v[i] = src ? *(const f32x4*)(src + (size_t)(k0 + 4 * i + kr) * srcN) : (f32x4){0.f, 0.f, 0.f, 0.f};
#pragma unroll
    for (int i = 0; i < 16; ++i) { LAS float* d = scr + (4 * i + kr) * 65 + n4; d[0] = v[i][0]; d[1] = v[i][1]; d[2] = v[i][2]; d[3] = v[i][3]; }
    asm volatile("s_waitcnt lgkmcnt(0)" ::: "memory");
    const int c = lane & 7;
#pragma unroll
    for (int j = 0; j < 8; ++j) { const int n = (lane >> 3) + 8 * j; const LAS float* s = scr + (8 * c) * 65 + n;
        u32x4 o; o.x = cvt_pk_bf16(s[0 * 65], s[1 * 65]); o.y = cvt_pk_bf16(s[2 * 65], s[3 * 65]); o.z = cvt_pk_bf16(s[4 * 65], s[5 * 65]); o.w = cvt_pk_bf16(s[6 * 65], s[7 * 65]);
        *(u32x4*)(WT + (size_t)(n0 + n) * K + k0 + 8 * c) = o; }
    asm volatile("s_waitcnt lgkmcnt(0)" ::: "memory");
}
struct ColWin { const float* W; __device__ __forceinline__ const float* operator()(int n) const {
    int c; if (n < 4096) c = n; else if (n < 7168) c = n + 8; else if (n < 11264) { const int l = n - 7168, q = l >> 8, w = l & 255; c = 7192 + (w < 128 ? 128 * q + w : 2048 + 128 * q + (w - 128)); } else if (n < 11272) c = 4096 + (n - 11264); else if (n < 11288) c = 7176 + (n - 11272); else return nullptr;
    return W + c; } };
struct ColPlain { const float* W; __device__ __forceinline__ const float* operator()(int n) const { return W + n; } };
struct ColUG { const float* Wu; const float* Wg; __device__ __forceinline__ const float* operator()(int n) const { const int pn = n >> 8, w = n & 255; return w < 128 ? Wu + pn * 128 + w : Wg + pn * 128 + (w - 128); } };

__device__ __forceinline__ void p0_prologue(const Args& a, LAS unsigned char* lds, int gwg, int nwgs, int mode) {
    int tid_ = threadIdx.x; asm volatile("" : "+v"(tid_));
    const int tid = tid_, lane = tid & 63, wave = __builtin_amdgcn_readfirstlane(tid >> 6);
    LAS float* scr = (LAS float*)(lds + wave * 16640);
    const int gw = gwg * NWAVES + wave, NGW = nwgs * NWAVES;
    unsigned char* ws = a.ws;
    constexpr int I_WIN_ = 32 * (NPROJ_PAD / 64), I_A = 16 * 32, I_O = 32 * 32, I_UG = 32 * (2 * DFF / 64), I_D = (DFF / 64) * 32;
    constexpr int NITEMS = I_WIN_ + 2 * I_A + I_O + I_UG + I_D;
    const int it0 = mode == 0 ? 0 : I_WIN_, it1 = mode == 0 ? I_WIN_ : NITEMS;
    for (int it = it0 + gw; it < it1; it += NGW) {
        int r = it;
        if (r < I_WIN_) { ColWin cp{a.in[I_WIN]}; const int nblk = NPROJ_PAD / 64; transpose_item(cp, DM, NIN, (bf16*)(ws + WS_WIN), scr, r / nblk, r % nblk, lane); continue; } r -= I_WIN_;
        if (r < I_A) { ColPlain cp{a.in[I_WA]}; transpose_item(cp, 1024, DM, (bf16*)(ws + WS_WA), scr, r / 32, r % 32, lane); continue; } r -= I_A;
        if (r < I_A) { ColPlain cp{a.in[I_WB]}; transpose_item(cp, 1024, DM, (bf16*)(ws + WS_WB), scr, r / 32, r % 32, lane); continue; } r -= I_A;
        if (r < I_O) { ColPlain cp{a.in[I_WO]}; transpose_item(cp, DM, DM, (bf16*)(ws + WS_WO), scr, r / 32, r % 32, lane); continue; } r -= I_O;
        if (r < I_UG) { ColUG cp{a.in[I_WUP], a.in[I_WGATE]}; const int nblk = 2 * DFF / 64; transpose_item(cp, DM, DFF, (bf16*)(ws + WS_WUG), scr, r / nblk, r % nblk, lane); continue; } r -= I_UG;
        { ColPlain cp{a.in[I_WDOWN]}; transpose_item(cp, DFF, DM, (bf16*)(ws + WS_WD), scr, r / 32, r % 32, lane); }
    }
    const float* nw = a.in[I_NMIX]; bf16* XN = (bf16*)(ws + WS_XN);
    if (mode == 0)
    for (int m = gw; m < MT; m += NGW) {
        const float* xrow = m < MP ? a.in[I_XP] + (size_t)m * DM : a.in[I_XS] + (size_t)(m - MP) * DM;
        f32x4 v[8]; float s = 0.f;
#pragma unroll
        for (int j = 0; j < 8; ++j) { v[j] = *(const f32x4*)(xrow + 4 * lane + 256 * j); s += dot4(v[j], v[j]); }
        const float r = rsqrtf(wave_sum(s) * (1.f / DM) + EPS);
#pragma unroll
        for (int j = 0; j < 8; ++j) { const f32x4 w = *(const f32x4*)(nw + 4 * lane + 256 * j); u32x2 o; o.x = cvt_pk_bf16(v[j][0] * r * w[0], v[j][1] * r * w[1]); o.y = cvt_pk_bf16(v[j][2] * r * w[2], v[j][3] * r * w[3]);
            *(u32x2*)(XN + (size_t)m * DM + 4 * lane + 256 * j) = o; }
    }
}

__device__ __forceinline__ void stage_v(LAS bf16* Vs, const bf16* P, int row0, int colbase, int tid) {
#pragma unroll
    for (int i = 0; i < 8; ++i) { const int idx = tid + NTHR * i, s = idx >> 5, p = idx & 31;
        *(LAS u32x4*)(Vs + s * 272 + p * 8) = *(const u32x4*)(P + (size_t)(row0 + s) * NPROJ + colbase + 8 * p); }
}
typedef short v4i16_t __attribute__((ext_vector_type(4)));
__device__ __forceinline__ u32x2 tr64(const LAS bf16* p) { return __builtin_bit_cast(u32x2, __builtin_amdgcn_ds_read_tr16_b64_v4i16((LAS v4i16_t*)p)); }
__device__ __forceinline__ bf16x8 tr_frag(const LAS bf16* img, int RS, int c0, int ks, int lane) {
    const int g = lane >> 4, q = (lane & 15) >> 2, p = lane & 3;
    const LAS bf16* a = img + (32 * ks + 4 * g + q) * RS + c0 + 4 * p;
    const u32x2 lo = tr64(a), hi = tr64(a + 16 * RS);
    u32x4 w; w.x = lo.x; w.y = lo.y; w.z = hi.x; w.w = hi.y;
    return __builtin_bit_cast(bf16x8, w);
}
__device__ __forceinline__ float wave_iscan_add(float v, int lane) {
#pragma unroll
    for (int o = 1; o < 64; o <<= 1) { const float t = __shfl_up(v, o); if (lane >= o) v += t; }
    return v;
}
__device__ __forceinline__ float wave_iscan_max(float v, int lane) {
#pragma unroll
    for (int o = 1; o < 64; o <<= 1) { const float t = __shfl_up(v, o); if (lane >= o) v = fmaxf(v, t); }
    return v;
}

__device__ __forceinline__ void gla_logdecay(const Args& a, const float* gates, int row0, int h, LAS float* galS, LAS float* segS, int tid, float (&la)[32], float& off, float& tot) {
    const int d = tid & 127, seg = tid >> 7;
    { const int t = tid >> 2, q = tid & 3; *(LAS f32x4*)(galS + t * 16 + q * 4) = *(const f32x4*)(gates + (size_t)(row0 + t) * 32 + 8 + q * 4); }
    float up[16];
#pragma unroll
    for (int j = 0; j < 16; ++j) up[j] = a.in[I_AUP][j * 512 + h * 128 + d];
    const float ab = a.in[I_AB][h * 128 + d];
    __syncthreads();
    float ssum = 0.f;
#pragma unroll
    for (int i = 0; i < 32; ++i) { const int t = seg * 32 + i; float z = ab;
#pragma unroll
        for (int q = 0; q < 4; ++q) { const f32x4 g = *(const LAS f32x4*)(galS + t * 16 + q * 4); z += g[0] * up[4 * q] + g[1] * up[4 * q + 1] + g[2] * up[4 * q + 2] + g[3] * up[4 * q + 3]; }
        la[i] = logsig(z) * (1.f / 16.f); ssum += la[i]; }
    segS[seg * 128 + d] = ssum;
    __syncthreads();
    off = 0.f; tot = 0.f;
#pragma unroll
    for (int s = 0; s < 4; ++s) { const float v = segS[s * 128 + d]; tot += v; off += (s < seg) ? v : 0.f; }
}

template <bool ML>
__device__ __forceinline__ void chunk_state(const Args& a, LAS unsigned char* lds, int bh, int c) {
    constexpr int DK = ML ? 256 : 128, NDT = DK / 16, RSK = DK + 16;
    int tid_ = threadIdx.x; asm volatile("" : "+v"(tid_));
    const int tid = tid_, lane = tid & 63, wave = __builtin_amdgcn_readfirstlane(tid >> 6), fr = lane & 15, fq = lane >> 4;
    const int b = bh >> 2, h = bh & 3, row0 = b * TP + c * 128, item = bh * NCH + c;
    unsigned char* ws = a.ws;
    const bf16* P = (const bf16*)(ws + WS_PROJ); const float* gates = (const float*)(ws + WS_GATES);
    LAS bf16* Ks = (LAS bf16*)lds; LAS bf16* Vs = (LAS bf16*)(lds + 69632); LAS float* sc = (LAS float*)(lds + 139264);
    __syncthreads();
    stage_v(Vs, P, row0, (ML ? C_MV : C_GV) + h * 256, tid);
    u32x4 kpre[8];
    if (ML) {
#pragma unroll
        for (int i = 0; i < 8; ++i) { const int idx = tid + NTHR * i, sr = idx >> 5, dp = idx & 31; kpre[i] = *(const u32x4*)(P + (size_t)(row0 + sr) * NPROJ + C_MK + h * 256 + 8 * dp); }
    }
    if (ML) {
        if (wave == 0) {
            const int t0 = 2 * lane;
            const float lf0 = logsig(gates[(size_t)(row0 + t0) * 32 + 4 + h] + a.in[I_BF][h]), lf1 = logsig(gates[(size_t)(row0 + t0 + 1) * 32 + 4 + h] + a.in[I_BF][h]);
            const float i0 = gates[(size_t)(row0 + t0) * 32 + h] + a.in[I_BI][h], i1 = gates[(size_t)(row0 + t0 + 1) * 32 + h] + a.in[I_BI][h];
            const float pr = lf0 + lf1, S = wave_iscan_add(pr, lane), ex = S - pr;
            const float ah0 = i0 - (ex + lf0), ah1 = i1 - S;
            const float Ah = wave_max(fmaxf(ah0, ah1));
            sc[t0] = __expf(ah0 - Ah) * (1.f / 16.f); sc[t0 + 1] = __expf(ah1 - Ah) * (1.f / 16.f);
            if (lane == 63) { float* chs = (float*)(ws + WS_CHS); chs[item * 2] = Ah; chs[item * 2 + 1] = S; }
        }
        __syncthreads();
#pragma unroll
        for (int i = 0; i < 8; ++i) { const int idx = tid + NTHR * i, s = idx >> 5, dp = idx & 31; const float w = sc[s];
            const u32x4 v = kpre[i];
            u32x4 o; o.x = cvt_pk_bf16(bflo(v.x) * w, bfhi(v.x) * w); o.y = cvt_pk_bf16(bflo(v.y) * w, bfhi(v.y) * w); o.z = cvt_pk_bf16(bflo(v.z) * w, bfhi(v.z) * w); o.w = cvt_pk_bf16(bflo(v.w) * w, bfhi(v.w) * w);
            *(LAS u32x4*)(Ks + s * RSK + 8 * dp) = o; }
    } else {
        float la[32], off, tot;
        const int d = tid & 127, seg = tid >> 7;
        unsigned short kraw[32];
#pragma unroll
        for (int i = 0; i < 32; ++i) kraw[i] = P[(size_t)(row0 + seg * 32 + i) * NPROJ + C_GK + h * 128 + d];
        LAS float* galS = (LAS float*)(lds + 36864); gla_logdecay(a, gates, row0, h, galS, galS + 2048, tid, la, off, tot);
        if (seg == 0) ((float*)(ws + WS_BEND))[item * 128 + d] = tot;
        float bcur = off;
#pragma unroll
        for (int i = 0; i < 32; ++i) { const int t = seg * 32 + i; bcur += la[i];
            const float kv = bf2f(kraw[i]);
            Ks[t * RSK + d] = f2bf(kv * __expf(tot - bcur)); }
    }
    __syncthreads();
    f32x4 acc[2][NDT];
#pragma unroll
    for (int e = 0; e < 2; ++e)
#pragma unroll
        for (int d = 0; d < NDT; ++d) acc[e][d] = (f32x4){0.f, 0.f, 0.f, 0.f};
#pragma unroll
    for (int ks = 0; ks < 4; ++ks) {
        bf16x8 vb[2];
#pragma unroll
        for (int e = 0; e < 2; ++e) vb[e] = tr_frag(Vs, 272, wave * 32 + e * 16, ks, lane);
#pragma unroll
        for (int d = 0; d < NDT; ++d) { const bf16x8 ka = tr_frag(Ks, RSK, d * 16, ks, lane);
#pragma unroll
            for (int e = 0; e < 2; ++e) acc[e][d] = __builtin_amdgcn_mfma_f32_16x16x32_bf16(ka, vb[e], acc[e][d], 0, 0, 0); }
    }
    float* dst = (float*)(ws + (ML ? WS_DC : WS_DS)) + (size_t)item * 256 * DK;
#pragma unroll
    for (int e = 0; e < 2; ++e)
#pragma unroll
        for (int d = 0; d < NDT; ++d) *(f32x4*)(dst + (size_t)(wave * 32 + e * 16 + fr) * DK + d * 16 + 4 * fq) = acc[e][d];
    if (ML && tid < 256) { float s = 0.f;
#pragma unroll 16
        for (int i = 0; i < 128; ++i) s += bf2f(Ks[i * RSK + tid]);
        ((float*)(ws + WS_DN))[item * 256 + tid] = s; }
}

__device__ __forceinline__ void scan_mlstm(const Args& a, int j) {
    int tid_ = threadIdx.x; asm volatile("" : "+v"(tid_));
    const int tid = tid_, bh = j >> 5, eb = j & 31;
    unsigned char* ws = a.ws;
    const float* chs = (const float*)(ws + WS_CHS);
    const int e = eb * 8 + (tid >> 6), d4 = (tid & 63) * 4;
    const float* dC = (const float*)(ws + WS_DC) + (size_t)bh * NCH * 65536 + (size_t)e * 256 + d4;
    bf16* CT = (bf16*)(ws + WS_CT) + (size_t)bh * NCH * 65536 + (size_t)e * 256 + d4;
    f32x4 Cv = {0.f, 0.f, 0.f, 0.f}; float Fs = 0.f, Mp = 0.f;
    const bool do_n = (eb == 0 && tid < 256);
    float nv = 0.f;
    f32x4 dv[NCH];
#pragma unroll
    for (int c = 0; c < NCH; ++c) dv[c] = *(const f32x4*)(dC + (size_t)c * 65536);
#pragma unroll
    for (int c = 0; c < NCH; ++c) {
        u32x2 o; o.x = cvt_pk_bf16(Cv[0], Cv[1]); o.y = cvt_pk_bf16(Cv[2], Cv[3]); *(u32x2*)(CT + (size_t)c * 65536) = o;
        if (do_n) ((bf16*)(ws + WS_NPREV))[(bh * NCH + c) * 256 + tid] = f2bf(nv);
        const float Ah = chs[(bh * NCH + c) * 2], bt = chs[(bh * NCH + c) * 2 + 1];
        const float Ac = Ah - Fs, Mn = fmaxf(Mp, Ac), f1 = __expf(Mp - Mn), f2 = __expf(Ac - Mn);
        Cv = Cv * f1 + dv[c] * f2;
        if (do_n) nv = nv * f1 + ((const float*)(ws + WS_DN))[(bh * NCH + c) * 256 + tid] * f2;
        Mp = Mn; Fs += bt;
    }
    float* oC = a.out + O_PC + (size_t)bh * 65536;
#pragma unroll
    for (int i = 0; i < 4; ++i) oC[(size_t)(d4 + i) * 256 + e] = Cv[i];
    if (do_n) a.out[O_PN + bh * 256 + tid] = nv;
    if (eb == 0 && tid == 0) a.out[O_PM + bh] = Fs + Mp;
}
__device__ __forceinline__ void scan_gla(const Args& a, int j) {
    int tid_ = threadIdx.x; asm volatile("" : "+v"(tid_));
    const int tid = tid_, bh = j >> 4, eb = j & 15;
    unsigned char* ws = a.ws;
    const float* bend = (const float*)(ws + WS_BEND);
    const int ee = eb * 16 + (tid >> 5), d4 = (tid & 31) * 4;
    const float* dS = (const float*)(ws + WS_DS) + (size_t)bh * NCH * 32768 + (size_t)ee * 128 + d4;
    bf16* ST = (bf16*)(ws + WS_ST) + (size_t)bh * NCH * 32768 + (size_t)ee * 128 + d4;
    f32x4 Sv = {0.f, 0.f, 0.f, 0.f};
    f32x4 dv[NCH];
#pragma unroll
    for (int c = 0; c < NCH; ++c) dv[c] = *(const f32x4*)(dS + (size_t)c * 32768);
#pragma unroll
    for (int c = 0; c < NCH; ++c) {
        u32x2 o; o.x = cvt_pk_bf16(Sv[0], Sv[1]); o.y = cvt_pk_bf16(Sv[2], Sv[3]); *(u32x2*)(ST + (size_t)c * 32768) = o;
        const f32x4 be = *(const f32x4*)(bend + (bh * NCH + c) * 128 + d4);
        Sv[0] = Sv[0] * __expf(be[0]) + dv[c][0]; Sv[1] = Sv[1] * __expf(be[1]) + dv[c][1]; Sv[2] = Sv[2] * __expf(be[2]) + dv[c][2]; Sv[3] = Sv[3] * __expf(be[3]) + dv[c][3];
    }
    float* oS = a.out + O_PS + (size_t)bh * 32768;
#pragma unroll
    for (int i = 0; i < 4; ++i) oS[(size_t)(d4 + i) * 256 + ee] = Sv[i];
}

template <bool ML>
__device__ __forceinline__ void chunk_out(const Args& a, LAS unsigned char* lds, int bh, int c) {
    constexpr int DK = ML ? 256 : 128, QS = DK + 8, NKK = DK / 32;
    int tid_ = threadIdx.x; asm volatile("" : "+v"(tid_));
    const int tid = tid_, lane = tid & 63, wave = __builtin_amdgcn_readfirstlane(tid >> 6), fr = lane & 15, fq = lane >> 4;
    const int b = bh >> 2, h = bh & 3, row0 = b * TP + c * 128, item = bh * NCH + c;
    unsigned char* ws = a.ws;
    const bf16* P = (const bf16*)(ws + WS_PROJ); const float* gates = (const float*)(ws + WS_GATES);
    LAS bf16* Qs = (LAS bf16*)lds; LAS bf16* Ks = Qs + 128 * QS;
    LAS float* sc = (LAS float*)(lds + 143616);
    __syncthreads();
    u32x4 qpre[ML ? 8 : 1], kpre2[ML ? 8 : 1];
    if (ML) {
#pragma unroll
        for (int i = 0; i < 8; ++i) { const int idx = tid + NTHR * i, tr = idx >> 5, p = idx & 31;
            qpre[i] = *(const u32x4*)(P + (size_t)(row0 + tr) * NPROJ + C_MQ + h * 256 + p * 8); kpre2[i] = *(const u32x4*)(P + (size_t)(row0 + tr) * NPROJ + C_MK + h * 256 + p * 8); }
    }
    if (ML) {
        if (wave == 0) {
            const float* chs = (const float*)(ws + WS_CHS);
            const float Ahc = lane < NCH ? chs[(bh * NCH + lane) * 2] : 0.f, btc = lane < NCH ? chs[(bh * NCH + lane) * 2 + 1] : 0.f;
            const float fsx = wave_iscan_add(btc, lane) - btc;
            const float Mp = fmaxf(0.f, wave_max(lane < c ? Ahc - fsx : -3.0e38f)), Fs = wave_sum(lane < c ? btc : 0.f);
            const int t0 = 2 * lane;
            const float lf0 = logsig(gates[(size_t)(row0 + t0) * 32 + 4 + h] + a.in[I_BF][h]), lf1 = logsig(gates[(size_t)(row0 + t0 + 1) * 32 + 4 + h] + a.in[I_BF][h]);
            const float i0 = gates[(size_t)(row0 + t0) * 32 + h] + a.in[I_BI][h], i1 = gates[(size_t)(row0 + t0 + 1) * 32 + h] + a.in[I_BI][h];
            const float pr = lf0 + lf1, S = wave_iscan_add(pr, lane), b0 = S - lf1, b1 = S;
            const float a0 = i0 - b0 - Fs, a1 = i1 - b1 - Fs;
            const float cm = wave_iscan_max(fmaxf(a0, a1), lane); float exm = __shfl_up(cm, 1); if (lane == 0) exm = -3.0e38f;
            const float M0 = fmaxf(fmaxf(Mp, exm), a0), M1 = fmaxf(M0, a1);
            sc[t0] = a0; sc[t0 + 1] = a1; sc[128 + t0] = M0; sc[128 + t0 + 1] = M1; sc[256 + t0] = __expf(Mp - M0); sc[256 + t0 + 1] = __expf(Mp - M1);
            sc[384 + t0] = __expf(-(Fs + b0 + M0)); sc[384 + t0 + 1] = __expf(-(Fs + b1 + M1));
        }
#pragma unroll
        for (int i = 0; i < 8; ++i) { const int idx = tid + NTHR * i, t = idx >> 5, p = idx & 31;
            *(LAS u32x4*)(Qs + t * QS + p * 8) = qpre[i];
            *(LAS u32x4*)(Ks + t * QS + p * 8) = kpre2[i]; }
    } else {
        float la[32], off, tot;
        const int d = tid & 127, seg = tid >> 7;
        unsigned short qraw[32], kraw[32];
#pragma unroll
        for (int i = 0; i < 32; ++i) { qraw[i] = P[(size_t)(row0 + seg * 32 + i) * NPROJ + C_GQ + h * 128 + d]; kraw[i] = P[(size_t)(row0 + seg * 32 + i) * NPROJ + C_GK + h * 128 + d]; }
        LAS float* galS = (LAS float*)(lds + 69632); LAS float* segS = galS + 128 * 16;
        gla_logdecay(a, gates, row0, h, galS, segS, tid, la, off, tot);
        float bcur = off;
#pragma unroll
        for (int i = 0; i < 32; ++i) { const int t = seg * 32 + i; bcur += la[i];
            const float qv = bf2f(qraw[i]), kv = bf2f(kraw[i]);
            Qs[t * QS + d] = f2bf(qv * 0.08838834764831845f * __expf(bcur)); Ks[t * QS + d] = f2bf(kv * __expf(-bcur)); }
    }
    __syncthreads();
    constexpr int NCP = ML ? 16 : 8;
    u32x4 cpre[NCP]; u32x4 npre = {0u, 0u, 0u, 0u};
    if (ML) { const bf16* CT = (const bf16*)(ws + WS_CT) + (size_t)item * 65536;
#pragma unroll
        for (int i = 0; i < NCP; ++i) { const int idx = tid + NTHR * i, e = idx >> 5, p = idx & 31; cpre[i] = *(const u32x4*)(CT + (size_t)e * 256 + p * 8); }
        if (tid < 32) npre = *(const u32x4*)((const bf16*)(ws + WS_NPREV) + (size_t)item * 256 + tid * 8);
    } else { const bf16* ST = (const bf16*)(ws + WS_ST) + (size_t)item * 32768;
#pragma unroll
        for (int i = 0; i < NCP; ++i) { const int idx = tid + NTHR * i, e = idx >> 4, p = idx & 15; cpre[i] = *(const u32x4*)(ST + (size_t)e * 128 + p * 8); }
    }
    bf16x8 qf[NKK];
#pragma unroll
    for (int kk = 0; kk < NKK; ++kk) qf[kk] = *(const LAS bf16x8*)(Qs + (wave * 16 + fr) * QS + kk * 32 + fq * 8);
    const int t = wave * 16 + fr;
    u32x2 pb[8]; float den = 0.f;
    {
        const float Mt = ML ? sc[128 + t] : 0.f;
#pragma unroll
        for (int st = 0; st < 8; ++st) { f32x4 s = {0.f, 0.f, 0.f, 0.f};
#pragma unroll
            for (int kk = 0; kk < NKK; ++kk) { const bf16x8 kf = *(const LAS bf16x8*)(Ks + (st * 16 + fr) * QS + kk * 32 + fq * 8); s = __builtin_amdgcn_mfma_f32_16x16x32_bf16(kf, qf[kk], s, 0, 0, 0); }
            float p[4];
            f32x4 as4 = {0.f, 0.f, 0.f, 0.f}; if (ML) as4 = *(const LAS f32x4*)(sc + st * 16 + 4 * fq);
#pragma unroll
            for (int r = 0; r < 4; ++r) { const int si = st * 16 + 4 * fq + r;
                const float e = ML ? s[r] * (1.f / 16.f) * __expf(fminf(as4[r] - Mt, 0.f)) : s[r];
                p[r] = (si <= t) ? e : 0.f;
                den += p[r]; }
            pb[st].x = cvt_pk_bf16(p[0], p[1]); pb[st].y = cvt_pk_bf16(p[2], p[3]);
            __builtin_amdgcn_sched_barrier(0); }
    }
    __syncthreads();
    LAS bf16* Cl = (LAS bf16*)lds;
    if (ML) {
#pragma unroll
        for (int i = 0; i < NCP; ++i) { const int idx = tid + NTHR * i, e = idx >> 5, p = idx & 31; *(LAS u32x4*)(Cl + e * QS + p * 8) = cpre[i]; }
        { const int e = tid >> 5, p = tid & 31; *(LAS u32x4*)(Cl + (256 + e) * QS + p * 8) = npre; }
    } else {
#pragma unroll
        for (int i = 0; i < NCP; ++i) { const int idx = tid + NTHR * i, e = idx >> 4, p = idx & 15; *(LAS u32x4*)(Cl + e * QS + p * 8) = cpre[i]; }
    }
    u32x4 vpre[8];
#pragma unroll
    for (int i = 0; i < 8; ++i) { const int idx = tid + NTHR * i, sr = idx >> 5, p = idx & 31; vpre[i] = *(const u32x4*)(P + (size_t)(row0 + sr) * NPROJ + (ML ? C_MV : C_GV) + h * 256 + 8 * p); }
    __syncthreads();
    f32x4 acc[16];
#pragma unroll
    for (int et = 0; et < 16; ++et) { acc[et] = (f32x4){0.f, 0.f, 0.f, 0.f};
#pragma unroll
        for (int kk = 0; kk < NKK; ++kk) { const bf16x8 cf = *(const LAS bf16x8*)(Cl + (et * 16 + fr) * QS + kk * 32 + fq * 8); acc[et] = __builtin_amdgcn_mfma_f32_16x16x32_bf16(cf, qf[kk], acc[et], 0, 0, 0); }
        if ((et & 1) == 1) __builtin_amdgcn_sched_barrier(0); }
    float wint = 1.f, qn = 0.f;
    if (ML) {
        f32x4 dn = {0.f, 0.f, 0.f, 0.f};
#pragma unroll
        for (int kk = 0; kk < NKK; ++kk) { const bf16x8 nf = *(const LAS bf16x8*)(Cl + (256 + fr) * QS + kk * 32 + fq * 8); dn = __builtin_amdgcn_mfma_f32_16x16x32_bf16(nf, qf[kk], dn, 0, 0, 0); }
        qn = __shfl(dn[0], fr);
        wint = sc[256 + t];
#pragma unroll
        for (int et = 0; et < 16; ++et) acc[et] = acc[et] * wint;
    }
    __syncthreads();
    LAS bf16* Vs = (LAS bf16*)lds;
#pragma unroll
    for (int i = 0; i < 8; ++i) { const int idx = tid + NTHR * i, sr = idx >> 5, p = idx & 31; *(LAS u32x4*)(Vs + sr * 272 + p * 8) = vpre[i]; }
    u32x2 gpre[16];
    { const bf16* gp0 = P + (size_t)(row0 + wave * 16 + fr) * NPROJ + (ML ? C_MO : C_GR) + h * 256 + 4 * fq;
#pragma unroll
      for (int et = 0; et < 16; ++et) gpre[et] = *(const u32x2*)(gp0 + et * 16); }
    __syncthreads();
#pragma unroll
    for (int ks = 0; ks < 4; ++ks) {
        u32x4 pw; pw.x = pb[2 * ks].x; pw.y = pb[2 * ks].y; pw.z = pb[2 * ks + 1].x; pw.w = pb[2 * ks + 1].y;
        const bf16x8 pf = __builtin_bit_cast(bf16x8, pw);
#pragma unroll
        for (int et = 0; et < 16; ++et) { acc[et] = __builtin_amdgcn_mfma_f32_16x16x32_bf16(tr_frag(Vs, 272, et * 16, ks, lane), pf, acc[et], 0, 0, 0); if ((et & 3) == 3) __builtin_amdgcn_sched_barrier(0); }
    }
    float inv = 1.f;
    if (ML) { den += __shfl_xor(den, 16); den += __shfl_xor(den, 32); den += wint * qn; inv = 1.f / fmaxf(fabsf(den), sc[384 + t]); }
    float ss = 0.f;
#pragma unroll
    for (int et = 0; et < 16; ++et) { acc[et] = acc[et] * inv; ss += dot4(acc[et], acc[et]); }
    ss += __shfl_xor(ss, 16); ss += __shfl_xor(ss, 32);
    const float rn = rsqrtf(ss * (1.f / 256.f) + EPS);
    const float* hw = a.in[ML ? I_MHW : I_GHW] + h * 256;
    const bf16* gp = P + (size_t)(row0 + t) * NPROJ + (ML ? C_MO : C_GR) + h * 256;
    bf16* yp = (bf16*)(ws + (ML ? WS_YM : WS_YG)) + (size_t)(row0 + t) * 1024 + h * 256;
#pragma unroll
    for (int et = 0; et < 16; ++et) { const int e = et * 16 + 4 * fq;
        const u32x2 gw = gpre[et]; const f32x4 w = *(const f32x4*)(hw + e);
        const float g0 = bflo(gw.x), g1 = bfhi(gw.x), g2 = bflo(gw.y), g3 = bfhi(gw.y);
        float o0 = acc[et][0] * rn * w[0], o1 = acc[et][1] * rn * w[1], o2 = acc[et][2] * rn * w[2], o3 = acc[et][3] * rn * w[3];
        if (ML) { o0 *= sigm(g0); o1 *= sigm(g1); o2 *= sigm(g2); o3 *= sigm(g3); } else { o0 *= g0 * sigm(g0); o1 *= g1 * sigm(g1); o2 *= g2 * sigm(g2); o3 *= g3 * sigm(g3); }
        u32x2 o; o.x = cvt_pk_bf16(o0, o1); o.y = cvt_pk_bf16(o2, o3); *(u32x2*)(yp + e) = o;
        if ((et & 3) == 3) __builtin_amdgcn_sched_barrier(0); }
}

template <bool ML>
__device__ __forceinline__ void sample_item(const Args& a, LAS unsigned char* lds, int b, int h) {
    constexpr int DK = ML ? 256 : 128;
    int tid_ = threadIdx.x; asm volatile("" : "+v"(tid_));
    const int tid = tid_, lane = tid & 63, wave = __builtin_amdgcn_readfirstlane(tid >> 6);
    unsigned char* ws = a.ws;
    const bf16* P = (const bf16*)(ws + WS_PROJ); const float* gates = (const float*)(ws + WS_GATES);
    const int row0 = MP + b * 8, bh = b * 4 + h;
    LAS float* qT = (LAS float*)lds;
    LAS float* wkT = qT + 2048;
    LAS float* kT = wkT + 2048;
    LAS float* vS = kT + 2048;
    LAS float* red = vS + 2048;
    LAS float* sm = red + 16384;
    const float* C0 = a.in[ML ? I_C : I_S] + (size_t)bh * DK * 256;
    float* C1 = a.out + (ML ? O_SC : O_SS) + (size_t)bh * DK * 256;
    f32x4 nx[8];
#pragma unroll
    for (int j = 0; j < 8; ++j) nx[j] = __builtin_nontemporal_load((const f32x4*)(C0 + (size_t)(wave + 8 * j) * 256 + 4 * lane));
    __syncthreads();
    float aS[8], Mt[8], bS[8]; float m0 = 0.f, dec = 1.f;
    if (ML) {
        m0 = a.in[I_M][bh]; float bs = 0.f, M = m0;
#pragma unroll
        for (int t = 0; t < 8; ++t) { const float mi = gates[(size_t)(row0 + t) * 32 + h], mf = gates[(size_t)(row0 + t) * 32 + 4 + h];
            bs += logsig(mf + a.in[I_BF][h]); bS[t] = bs; aS[t] = mi + a.in[I_BI][h] - bs; M = fmaxf(M, aS[t]); Mt[t] = M; }
        dec = __expf(m0 - Mt[7]);
        if (tid == 0) {
#pragma unroll
            for (int t = 0; t < 8; ++t) { sm[200 + t] = aS[t]; sm[208 + t] = Mt[t]; sm[216 + t] = bS[t]; } }
        if (tid < 256) { const int d = tid;
#pragma unroll
            for (int t = 0; t < 8; ++t) { const float qv = bf2f(P[(size_t)(row0 + t) * NPROJ + C_MQ + h * 256 + d]), kv = bf2f(P[(size_t)(row0 + t) * NPROJ + C_MK + h * 256 + d]) * (1.f / 16.f);
                qT[d * 8 + t] = qv; kT[d * 8 + t] = kv; wkT[d * 8 + t] = kv * __expf(aS[t] - Mt[7]); } }
    } else {
        if (tid < 128) { const int d = tid; float up[16];
#pragma unroll
            for (int j = 0; j < 16; ++j) up[j] = a.in[I_AUP][j * 512 + h * 128 + d];
            const float ab = a.in[I_AB][h * 128 + d];
            float bc[8]; float bs = 0.f;
#pragma unroll
            for (int t = 0; t < 8; ++t) { float z = ab;
#pragma unroll
                for (int j = 0; j < 16; ++j) z += gates[(size_t)(row0 + t) * 32 + 8 + j] * up[j];
                bs += logsig(z) * (1.f / 16.f); bc[t] = bs; }
            sm[72 + d] = __expf(bs);
#pragma unroll
            for (int t = 0; t < 8; ++t) { const float qv = bf2f(P[(size_t)(row0 + t) * NPROJ + C_GQ + h * 128 + d]), kv = bf2f(P[(size_t)(row0 + t) * NPROJ + C_GK + h * 128 + d]);
                qT[d * 8 + t] = qv * 0.08838834764831845f * __expf(bc[t]); kT[d * 8 + t] = kv * __expf(-bc[t]); wkT[d * 8 + t] = kv * __expf(bs - bc[t]); } }
    }
    { const int t = tid >> 6; const u32x2 w = *(const u32x2*)(P + (size_t)(row0 + t) * NPROJ + (ML ? C_MV : C_GV) + h * 256 + 4 * lane);
      *(LAS f32x4*)(vS + t * 256 + 4 * lane) = (f32x4){bflo(w.x), bfhi(w.x), bflo(w.y), bfhi(w.y)}; }
    __syncthreads();
    float prow, qn = 0.f;
    { const int s8 = lane & 7, part = lane >> 3; float sd = 0.f;
#pragma unroll 8
      for (int i = 0; i < DK / 8; ++i) { const int d = 8 * i + part; sd += qT[d * 8 + wave] * kT[d * 8 + s8]; }
      sd += __shfl_xor(sd, 8); sd += __shfl_xor(sd, 16); sd += __shfl_xor(sd, 32);
      if (ML) prow = (s8 <= wave) ? sd * __expf(sm[200 + s8] - sm[208 + wave]) : 0.f; else prow = (s8 <= wave) ? sd : 0.f; }
    if (ML) { const float* n0 = a.in[I_N] + (size_t)bh * 256; float sd = 0.f;
#pragma unroll
      for (int i = 0; i < 4; ++i) { const int d = lane + 64 * i; sd += qT[d * 8 + wave] * n0[d]; }
      qn = wave_sum(sd); }
    f32x4 v[8], acc[8];
#pragma unroll
    for (int s = 0; s < 8; ++s) { v[s] = *(const LAS f32x4*)(vS + s * 256 + 4 * lane); acc[s] = (f32x4){0.f, 0.f, 0.f, 0.f}; }
#pragma unroll
    for (int bt = 0; bt < DK / 64; ++bt) {
        f32x4 cur[8];
#pragma unroll
        for (int j = 0; j < 8; ++j) cur[j] = nx[j];
        if (bt + 1 < DK / 64) {
#pragma unroll
            for (int j = 0; j < 8; ++j) nx[j] = __builtin_nontemporal_load((const f32x4*)(C0 + (size_t)(wave + 8 * (8 * (bt + 1) + j)) * 256 + 4 * lane)); }
#pragma unroll
        for (int j = 0; j < 8; ++j) { const int d = wave + 8 * (8 * bt + j); const f32x4 cv = cur[j];
            const f32x4 q0 = *(const LAS f32x4*)(qT + d * 8), q1 = *(const LAS f32x4*)(qT + d * 8 + 4), k0 = *(const LAS f32x4*)(wkT + d * 8), k1 = *(const LAS f32x4*)(wkT + d * 8 + 4);
            const float dd = ML ? dec : sm[72 + d];
            acc[0] += cv * q0[0]; acc[1] += cv * q0[1]; acc[2] += cv * q0[2]; acc[3] += cv * q0[3]; acc[4] += cv * q1[0]; acc[5] += cv * q1[1]; acc[6] += cv * q1[2]; acc[7] += cv * q1[3];
            f32x4 cn = cv * dd;
            cn += v[0] * k0[0]; cn += v[1] * k0[1]; cn += v[2] * k0[2]; cn += v[3] * k0[3]; cn += v[4] * k1[0]; cn += v[5] * k1[1]; cn += v[6] * k1[2]; cn += v[7] * k1[3];
            __builtin_nontemporal_store(cn, (f32x4*)(C1 + (size_t)d * 256 + 4 * lane)); }
    }
#pragma unroll
    for (int s = 0; s < 8; ++s) *(LAS f32x4*)(red + (wave * 8 + s) * 256 + 4 * lane) = acc[s];
    __syncthreads();
    const int t = wave;
    f32x4 qc = {0.f, 0.f, 0.f, 0.f};
#pragma unroll
    for (int w = 0; w < 8; ++w) qc += *(const LAS f32x4*)(red + (w * 8 + t) * 256 + 4 * lane);
    float wint = 1.f, den = 0.f, Mtt = 0.f, btt = 0.f;
    if (ML) { Mtt = sm[208 + t]; btt = sm[216 + t]; wint = __expf(m0 - Mtt); }
    f32x4 num = qc * wint;
#pragma unroll
    for (int s = 0; s < 8; ++s) { const float p = __shfl(prow, s); num += v[s] * p; den += p; }
    if (ML) { den += wint * qn; const float fl = fmaxf(fabsf(den), __expf(-(btt + Mtt))); num = num * (1.f / fl); }
    const float rn = rsqrtf(wave_sum(dot4(num, num)) * (1.f / 256.f) + EPS);
    const f32x4 w = *(const f32x4*)(a.in[ML ? I_MHW : I_GHW] + h * 256 + 4 * lane);
    const u32x2 gw = *(const u32x2*)(P + (size_t)(row0 + t) * NPROJ + (ML ? C_MO : C_GR) + h * 256 + 4 * lane);
    const float g0 = bflo(gw.x), g1 = bfhi(gw.x), g2 = bflo(gw.y), g3 = bfhi(gw.y);
    float o0 = num[0] * rn * w[0], o1 = num[1] * rn * w[1], o2 = num[2] * rn * w[2], o3 = num[3] * rn * w[3];
    if (ML) { o0 *= sigm(g0); o1 *= sigm(g1); o2 *= sigm(g2); o3 *= sigm(g3); } else { o0 *= g0 * sigm(g0); o1 *= g1 * sigm(g1); o2 *= g2 * sigm(g2); o3 *= g3 * sigm(g3); }
    u32x2 o; o.x = cvt_pk_bf16(o0, o1); o.y = cvt_pk_bf16(o2, o3);
    *(u32x2*)((bf16*)(ws + (ML ? WS_YM : WS_YG)) + (size_t)(row0 + t) * 1024 + h * 256 + 4 * lane) = o;
    if (ML) {
        if (tid < 256) { float s = dec * a.in[I_N][(size_t)bh * 256 + tid];
#pragma unroll
            for (int q = 0; q < 8; ++q) s += wkT[tid * 8 + q];
            a.out[O_SN + (size_t)bh * 256 + tid] = s; }
        if (tid == 0) a.out[O_SM + bh] = bS[7] + Mt[7];
    }
}

__device__ __forceinline__ void merge_reduce(const Args& a, int vcu, int G) {
    int tid_ = threadIdx.x; asm volatile("" : "+v"(tid_));
    const int tid = tid_, lane = tid & 63, wave = tid >> 6;
    const float* tailp = a.out + O_YP; bf16* O = (bf16*)(a.ws + WS_XN);
    for (int rr = vcu * NWAVES + wave; rr < MS; rr += G * NWAVES) { const int m = MP + rr, pmo = rr >> 8;
#pragma unroll
        for (int j = 0; j < 8; ++j) { const float* tp = tailp + (size_t)(pmo * 8 + j) * 8 * 65536 + (rr & 255) * 256 + 4 * lane;
            f32x4 v = *(const f32x4*)tp;
#pragma unroll
            for (int sl = 1; sl < 8; ++sl) v += *(const f32x4*)(tp + (size_t)sl * 65536);
            u32x2 o; o.x = cvt_pk_bf16(v[0], v[1]); o.y = cvt_pk_bf16(v[2], v[3]); *(u32x2*)(O + (size_t)m * DM + 4 * lane + 256 * j) = o; }
    }
}
__device__ __forceinline__ void rstd_phase(const Args& a, int vcu, int G) {
    int tid_ = threadIdx.x; asm volatile("" : "+v"(tid_));
    const int tid = tid_, lane = tid & 63, wave = tid >> 6;
    const float* part = (const float*)(a.ws + WS_PART); float* rstd = (float*)(a.ws + WS_RSTD);
    const bool split = (G == 256); const int nplain = split ? MP : MT;
    for (int row = vcu * NTHR + tid; row < nplain; row += G * NTHR) { float s = 0.f;
#pragma unroll
        for (int i = 0; i < 8; ++i) s += sum4(*(const f32x4*)(part + (size_t)row * 32 + 4 * i));
        rstd[row] = rsqrtf(s * (1.f / DM) + EPS); }
    if (split) {
        const float* tailp = (const float*)(a.ws + WS_PROJ); const float* nw = a.in[I_NFFN]; float* X1 = (float*)(a.ws + WS_X1); bf16* X1W = (bf16*)(a.ws + WS_X1W);
        for (int rr = vcu * NWAVES + wave; rr < MS; rr += G * NWAVES) { const int m = MP + rr, pmo = rr >> 8;
            f32x4 v[8]; float ss = 0.f;
#pragma unroll
            for (int j = 0; j < 8; ++j) { v[j] = *(const f32x4*)(a.in[I_XS] + (size_t)rr * DM + 4 * lane + 256 * j);
                const float* tp = tailp + (size_t)(pmo * 8 + j) * 8 * 65536 + (rr & 255) * 256 + 4 * lane;
#pragma unroll
                for (int sl = 0; sl < 8; ++sl) v[j] += *(const f32x4*)(tp + (size_t)sl * 65536);
                ss += dot4(v[j], v[j]); }
            ss = wave_sum(ss);
            if (lane == 0) rstd[m] = rsqrtf(ss * (1.f / DM) + EPS);
#pragma unroll
            for (int j = 0; j < 8; ++j) { const f32x4 w = *(const f32x4*)(nw + 4 * lane + 256 * j);
                *(f32x4*)(X1 + (size_t)m * DM + 4 * lane + 256 * j) = v[j];
                u32x2 o; o.x = cvt_pk_bf16(v[j][0] * w[0], v[j][1] * w[1]); o.y = cvt_pk_bf16(v[j][2] * w[2], v[j][3] * w[3]);
                *(u32x2*)(X1W + (size_t)m * DM + 4 * lane + 256 * j) = o; }
        }
    }
}
__device__ __forceinline__ void act_fixup(const Args& a, int vcu, int G) {
    unsigned char* ws = a.ws; const float* ub = (const float*)(ws + WS_U); bf16* ACT = (bf16*)(ws + WS_G);
    const float* cw = a.in[I_CW]; const float* cb = a.in[I_CB];
    int tid_ = threadIdx.x; asm volatile("" : "+v"(tid_));
    for (int idx = vcu * NTHR + tid_; idx < 28 * DFF; idx += G * NTHR) {
        const int k = idx / DFF, col = idx % DFF, pm = (k / 7) * 8 + 1 + (k % 7);
        const float um2 = ub[((size_t)(pm - 1) * 6 + 0) * DFF + col], um1 = ub[((size_t)(pm - 1) * 6 + 1) * DFF + col];
        const float u0 = ub[((size_t)pm * 6 + 2) * DFF + col], u1 = ub[((size_t)pm * 6 + 3) * DFF + col], g0 = ub[((size_t)pm * 6 + 4) * DFF + col], g1 = ub[((size_t)pm * 6 + 5) * DFF + col];
        const float c0 = cw[col], c1 = cw[DFF + col], c2 = cw[2 * DFF + col], bb = cb[col];
        ACT[(size_t)(pm * 256) * DFF + col] = f2bf(gelu_tanh(bb + c0 * um2 + c1 * um1 + c2 * u0) * g0);
        ACT[(size_t)(pm * 256 + 1) * DFF + col] = f2bf(gelu_tanh(bb + c0 * um1 + c1 * u0 + c2 * u1) * g1);
    }
}
__device__ __forceinline__ void final_norm(const Args& a, int vcu, int G, bool rsplit) {
    int tid_ = threadIdx.x; asm volatile("" : "+v"(tid_));
    const int tid = tid_, lane = tid & 63, wave = tid >> 6;
    const float* fw = a.in[I_FNW]; const float* X1 = (const float*)(a.ws + WS_X1); const float* tailp = (const float*)(a.ws + WS_U + 8 * MiB);
    for (int m = vcu * NWAVES + wave; m < MT; m += G * NWAVES) {
        float* row = a.out + (size_t)m * DM;
        f32x4 v[8]; float ss = 0.f;
        if (rsplit && m >= MP) {
            const int rr = m - MP, pmo = rr >> 8;
#pragma unroll
            for (int j = 0; j < 8; ++j) { v[j] = *(const f32x4*)(X1 + (size_t)m * DM + 4 * lane + 256 * j);
                const float* tp = tailp + (size_t)(pmo * 8 + j) * 4 * 65536 + (rr & 255) * 256 + 4 * lane;
#pragma unroll
                for (int sl = 0; sl < 4; ++sl) v[j] += *(const f32x4*)(tp + (size_t)sl * 65536);
                ss += dot4(v[j], v[j]); }
        } else {
#pragma unroll
            for (int j = 0; j < 8; ++j) { v[j] = *(const f32x4*)(row + 4 * lane + 256 * j); ss += dot4(v[j], v[j]); }
        }
        const float r = rsqrtf(wave_sum(ss) * (1.f / DM) + EPS);
#pragma unroll
        for (int j = 0; j < 8; ++j) { const f32x4 w = *(const f32x4*)(fw + 4 * lane + 256 * j);
            *(f32x4*)(row + 4 * lane + 256 * j) = (f32x4){v[j][0] * r * w[0], v[j][1] * r * w[1], v[j][2] * r * w[2], v[j][3] * r * w[3]}; }
    }
}

#define XB_TMO      128
#define XB_XCNT(j)  (256  + 64 * (j))
#define XB_XSUB(j)  (1280 + 64 * (j))
#define XB_XGEN(j)  (2304 + 64 * (j))
#define XB_TOP      3328
#define XB_TOPGEN   3392
#define XCD_BAR_WORDS 3456
#define XB_SPIN_CAP (1u << 18)

__device__ __forceinline__ unsigned xb_ld(unsigned* p)              { return __hip_atomic_load(p, __ATOMIC_RELAXED, __HIP_MEMORY_SCOPE_AGENT); }
__device__ __forceinline__ unsigned xb_add(unsigned* p, unsigned v) { return __hip_atomic_fetch_add(p, v, __ATOMIC_RELAXED, __HIP_MEMORY_SCOPE_AGENT); }
__device__ __forceinline__ unsigned xb_xcc_id() { return (unsigned)__builtin_amdgcn_s_getreg((3 << 11) | 20) & 0xFu; }
#define XB_SPIN(cond, bar) do { unsigned _sp = 0; while (cond) { __builtin_amdgcn_s_sleep(1); \
    if ((++_sp & 255u) == 0u) { if (xb_ld(&(bar)[XB_TMO])) break; if (_sp > XB_SPIN_CAP) { atomicAdd(&(bar)[XB_TMO], 1u); break; } } } } while (0)

struct XcdBarrier {
    unsigned* bar; unsigned x;
    volatile LAS unsigned* st;
};

__device__ __forceinline__ XcdBarrier xcd_barrier_post(unsigned* bar, volatile LAS unsigned* st) {
    XcdBarrier b; b.bar = bar; b.x = xb_xcc_id(); b.st = st;
    if (threadIdx.x == 0) (void)xb_add(&bar[XB_XCNT(b.x)], 1u);
    return b;
}
__device__ __forceinline__ void xcd_barrier_complete(unsigned* bar, unsigned x, unsigned& nloc, unsigned& nx) {
    const unsigned G = gridDim.x * gridDim.y * gridDim.z;
    unsigned sum, cnt, mine, sp = 0u;
    for (;;) {
        sum = 0u; cnt = 0u; mine = 0u;
#pragma unroll
        for (unsigned j = 0; j < 16; ++j) { const unsigned c = xb_ld(&bar[XB_XCNT(j)]); sum += c; cnt += (c > 0u) ? 1u : 0u; mine = (j == x) ? c : mine; }
        if (sum == G) break;
        __builtin_amdgcn_s_sleep(1);
        if ((++sp & 255u) == 0u) { if (xb_ld(&bar[XB_TMO])) break; if (sp > XB_SPIN_CAP) { atomicAdd(&bar[XB_TMO], 1u); break; } }
    }
    nloc = mine > 0u ? mine : 1u; nx = cnt > 0u ? cnt : 1u;
}

__device__ __forceinline__ void xcd_barrier(const XcdBarrier& b) {
    asm volatile("s_waitcnt vmcnt(0)" ::: "memory");
    __syncthreads();
    if (threadIdx.x == 0) {
        unsigned* bar = b.bar;
        __builtin_amdgcn_s_waitcnt(0);
        unsigned nloc = b.st[0], nx = b.st[1];
        if (nloc == 0u) { xcd_barrier_complete(bar, b.x, nloc, nx); b.st[0] = nloc; b.st[1] = nx; }
        const unsigned old = xb_add(&bar[XB_XSUB(b.x)], 1u);
        const unsigned gen = old / nloc;
        if (old + 1u == (gen + 1u) * nloc) {
            __builtin_amdgcn_fence(__ATOMIC_RELEASE, "agent");
            asm volatile("s_waitcnt vmcnt(0)" ::: "memory");
            const unsigned og = xb_add(&bar[XB_TOP], 1u);
            const unsigned tg = og / nx;
            if (og + 1u == (tg + 1u) * nx) xb_add(&bar[XB_TOPGEN], 1u);
            else XB_SPIN(xb_ld(&bar[XB_TOPGEN]) == tg, bar);
            __builtin_amdgcn_fence(__ATOMIC_ACQUIRE, "agent");
            xb_add(&bar[XB_XGEN(b.x)], 1u);
            asm volatile("s_waitcnt vmcnt(0)" ::: "memory");
        } else {
            XB_SPIN(xb_ld(&bar[XB_XGEN(b.x)]) == gen, bar);
            __builtin_amdgcn_fence(__ATOMIC_ACQUIRE, "agent");
            asm volatile("s_waitcnt vmcnt(0)" ::: "memory");
        }
    }
    __syncthreads();
}

constexpr int N_PHASES = 12;
__global__ void __launch_bounds__(NTHR) fwd_kernel(Args args) {
    extern __shared__ __attribute__((aligned(16))) unsigned char lds_raw[];
    LAS unsigned char* lds = (LAS unsigned char*)lds_raw;
    cg::grid_group grid = cg::this_grid();
    volatile LAS unsigned* bst = (volatile LAS unsigned*)(lds + LDS_BYTES - 16);
    if (threadIdx.x < 4) bst[threadIdx.x] = 0u;
    __syncthreads();
    XcdBarrier xbar = xcd_barrier_post((unsigned*)args.ws, bst);
    const int G = gridDim.x, bx = blockIdx.x;
    const int vcu = (G % 8 == 0) ? (bx % 8) * (G / 8) + bx / 8 : bx;
    const int lo = args.ph_lo, hi = args.ph_hi;
    unsigned char* ws = args.ws;
#ifndef USE_CG_SYNC
#define USE_CG_SYNC 0
#endif
#ifndef DOUBLE_MASK
#define DOUBLE_MASK 0
#endif
#define REP(k) for (int rep_ = 0; rep_ < 1 + ((DOUBLE_MASK >> (k)) & 1); ++rep_)
#ifndef DBL_P2
#define DBL_P2 0
#endif
#ifndef BIS
#define BIS 15
#endif
#ifndef PHASE_MASK
#define PHASE_MASK 0xfff
#endif
#define IN(k) (((PHASE_MASK >> (k)) & 1) && lo <= (k) && (k) < hi)
#define SEAM(k) do { if (IN(k) && IN((k) + 1)) { if (USE_CG_SYNC || lo < 0) grid.sync(); else xcd_barrier(xbar); } } while (0)
    if (IN(0)) REP(0) { p0_prologue(args, lds, vcu, G, 0); __syncthreads(); }
    SEAM(0);
    if (IN(1)) REP(1) {
        pg8::Gemm g{(const bf16*)(ws + WS_XN), (const bf16*)(ws + WS_WIN), nullptr, nullptr, MT, NPROJ_PAD, DM}; pg8::StaticOrder S; S.init(MT, NPROJ_PAD, G, bx);
        EpiProj E{(bf16*)(ws + WS_PROJ), (float*)(ws + WS_GATES)};
        pg8::gemm_phase<EpiProj, pg8::StaticOrder, true, true>(lds, g, S, E);
        { const int rem = S.nwg % G, nidle = rem ? G - rem : G, idx = rem ? bx - rem : bx;
          if (idx >= 0) p0_prologue(args, lds, idx, nidle, 1); }
        __syncthreads();
    }
    SEAM(1);
    if (IN(2)) REP(2) {
        for (int it = bx; it < 1536; it += G) {
            if (it < 512) { for (int r_ = 0; r_ < 1 + (DBL_P2 & 1); ++r_) sample_item<true>(args, lds, it >> 2, it & 3); }
            else if (it < 1024) { for (int r_ = 0; r_ < 1 + ((DBL_P2 >> 1) & 1); ++r_) sample_item<false>(args, lds, (it - 512) >> 2, (it - 512) & 3); }
            else if (it < 1280) { for (int r_ = 0; r_ < 1 + ((DBL_P2 >> 2) & 1); ++r_) chunk_state<true>(args, lds, (it - 1024) >> 4, (it - 1024) & 15); }
            else { for (int r_ = 0; r_ < 1 + ((DBL_P2 >> 3) & 1); ++r_) chunk_state<false>(args, lds, (it - 1280) >> 4, (it - 1280) & 15); }
        }
    }
    SEAM(2);
    if (IN(3)) REP(3) { for (int it = bx; it < 768; it += G) { if (it < 512) scan_mlstm(args, it); else scan_gla(args, it - 512); }
        if (G == 256) {
            pg8::Gemm g{(const bf16*)(ws + WS_YM), (const bf16*)(ws + WS_WA), (const bf16*)(ws + WS_YG), (const bf16*)(ws + WS_WB), MT, DM, 1024}; pg8::TailOnlyOrder<2, 16> S; S.c = bx;
            EpiBranch E{(const bf16*)(ws + WS_PROJ), (bf16*)(ws + WS_XN), args.out + O_YP};
            pg8::gemm_phase<EpiBranch, pg8::TailOnlyOrder<2, 16>, true, true>(lds, g, S, E);
        }
    }
    SEAM(3);
    if (IN(4)) REP(4) { for (int it = bx; it < 512; it += G) { if (it < 256) { if (BIS & 1) chunk_out<true>(args, lds, it >> 4, it & 15); } else { if (BIS & 2) chunk_out<false>(args, lds, (it - 256) >> 4, (it - 256) & 15); } } __syncthreads(); if (G == 256) merge_reduce(args, vcu, G); }
    SEAM(4);
    if (IN(5)) REP(5) {
        pg8::Gemm g{(const bf16*)(ws + WS_YM), (const bf16*)(ws + WS_WA), (const bf16*)(ws + WS_YG), (const bf16*)(ws + WS_WB), MT, DM, 1024}; EpiBranch E{(const bf16*)(ws + WS_PROJ), (bf16*)(ws + WS_XN), nullptr};
        if (G == 256) { pg8::MainOnlyOrder<2> S; S.S.init(MP, DM, G, bx); pg8::gemm_phase<EpiBranch, pg8::MainOnlyOrder<2>, true, true>(lds, g, S, E); }
        else { pg8::TwoSegOrder S; S.S.init(MT, DM, G, bx); pg8::gemm_phase<EpiBranch, pg8::TwoSegOrder, true, true>(lds, g, S, E); }
    }
    SEAM(5);
    if (IN(6)) REP(6) {
        pg8::Gemm g{(const bf16*)(ws + WS_XN), (const bf16*)(ws + WS_WO), nullptr, nullptr, MT, DM, DM}; pg8::SplitRowsOrder<1, 32> S; S.split = (G == 256); S.S.init(S.split ? MP : MT, DM, G, bx);
        EpiOut E{args.in[I_XP], args.in[I_XS], (float*)(ws + WS_X1), (bf16*)(ws + WS_X1W), args.in[I_NFFN], (float*)(ws + WS_PART), (float*)(ws + WS_PROJ)};
        pg8::gemm_phase<EpiOut, pg8::SplitRowsOrder<1, 32>, true, true>(lds, g, S, E);
    }
    SEAM(6);
    if (IN(7)) REP(7) rstd_phase(args, vcu, G);
    SEAM(7);
    const bool rsplit = (G == 256) && (hi - lo > 1);
    if (IN(8)) REP(8) {
        pg8::Gemm g{(const bf16*)(ws + WS_X1W), (const bf16*)(ws + WS_WUG), nullptr, nullptr, MT, 2 * DFF, DM};
        EpiUGAct E{(const float*)(ws + WS_RSTD), (bf16*)(ws + WS_G), args.out, args.in[I_CW], args.in[I_CB], args.in[I_CONV], (float*)(ws + WS_U), (LAS float*)(lds + 131072)};
        for (int half = rsplit ? 0 : 1; half < 2; ++half) {
            pg8::RowOffOrder S;
            if (!rsplit) { S.S.init(MT, 2 * DFF, G, bx); S.pm0 = 0; } else if (half == 0) { S.S.init(MS, 2 * DFF, G, bx); S.pm0 = 32; } else { S.S.init(MP, 2 * DFF, G, bx); S.pm0 = 0; }
            pg8::gemm_phase<EpiUGAct, pg8::RowOffOrder, true, true>(lds, g, S, E);
            if (rsplit && half == 0) xcd_barrier(xbar);
        }
        if (rsplit && bx >= 128) {
            pg8::Gemm gd{(const bf16*)(ws + WS_G), (const bf16*)(ws + WS_WD), nullptr, nullptr, MT, DM, DFF}; pg8::DownOrder D; D.S.init(MP, DM, G, bx); D.mode = 2; D.slot = bx - 128;
            EpiDown Ed{(const float*)(ws + WS_X1), args.out, (float*)(ws + WS_U + 8 * MiB)};
            pg8::gemm_phase<EpiDown, pg8::DownOrder, true, true>(lds, gd, D, Ed);
        }
    }
    SEAM(8);
    if (IN(9)) REP(9) act_fixup(args, vcu, G);
    SEAM(9);
    if (IN(10)) REP(10) {
        pg8::Gemm g{(const bf16*)(ws + WS_G), (const bf16*)(ws + WS_WD), nullptr, nullptr, MT, DM, DFF}; pg8::DownOrder S; S.S.init(rsplit ? MP : MT, DM, G, bx); S.mode = rsplit ? 1 : 0; S.slot = 0;
        EpiDown E{(const float*)(ws + WS_X1), args.out, (float*)(ws + WS_U + 8 * MiB)};
        pg8::gemm_phase<EpiDown, pg8::DownOrder, true, true>(lds, g, S, E);
    }
    SEAM(10);
    if (IN(11)) REP(11) final_norm(args, vcu, G, rsplit);
#ifdef EXTRA_SYNCS
    for (int i_ = 0; i_ < EXTRA_SYNCS; ++i_) xcd_barrier(xbar);
#endif
#undef IN
#undef SEAM
}

extern "C" void kernel_launch(void* const* d_in, const int* in_sizes, int n_in, void* d_out, int out_size, void* d_ws, size_t ws_size, hipStream_t stream) {
    static int grid = 0;
    if (grid == 0) {
        if (n_in != 25 || ws_size < WS_END) { fprintf(stderr, "kernel_launch: unexpected n_in %d / ws_size %zu (need %zu)\n", n_in, ws_size, (size_t)WS_END); grid = -1; return; }
        int dev = 0, cus = 0, per_cu = 0;
        (void)hipGetDevice(&dev); (void)hipDeviceGetAttribute(&cus, hipDeviceAttributeMultiprocessorCount, dev);
        if (hipFuncSetAttribute((const void*)fwd_kernel, hipFuncAttributeMaxDynamicSharedMemorySize, LDS_BYTES) != hipSuccess) { fprintf(stderr, "kernel_launch: hipFuncSetAttribute failed\n"); grid = -1; return; }
        if (hipOccupancyMaxActiveBlocksPerMultiprocessor(&per_cu, (const void*)fwd_kernel, NTHR, LDS_BYTES) != hipSuccess || per_cu < 1) { fprintf(stderr, "kernel_launch: occupancy query says %d\n", per_cu); per_cu = 1; }
        (void)hipGetLastError();
        grid = cus * 1;
        if (grid <= 0) grid = 256;
    }
    if (grid < 0) return;
    if (hipMemsetAsync(d_ws, 0, 65536, stream) != hipSuccess) { fprintf(stderr, "kernel_launch: memset failed\n"); return; }
    Args a{};
    for (int i = 0; i < 25; ++i) a.in[i] = (const float*)d_in[i];
    a.out = (float*)d_out; a.ws = (unsigned char*)d_ws;
    if (MK_N_LAUNCHES == 1) {
        a.ph_lo = 0; a.ph_hi = N_PHASES;
        void* kargs[] = {&a};
        hipError_t e = hipLaunchCooperativeKernel((const void*)fwd_kernel, dim3(grid), dim3(NTHR), kargs, LDS_BYTES, stream);
        if (e != hipSuccess) fprintf(stderr, "kernel_launch: cooperative launch failed: %s (grid %d)\n", hipGetErrorString(e), grid);
    } else {
        for (int p = 0; p < N_PHASES; ++p) { a.ph_lo = p; a.ph_hi = p + 1; hipLaunchKernelGGL(fwd_kernel, dim3(grid), dim3(NTHR), LDS_BYTES, stream, a); }
    }
}
```
